# Optimizing an MI355X kernel written in HIP

```python
import math
import jax
import jax.numpy as jnp
from jax import lax
import numpy as np

D_MODEL = 1024
BATCH = 8
SEQ = 4096
DEPTH = 2

GRID_W = 64
CTX_LEN = 256
HEAD_DIM = 64
ROPE_BASE = 10000.0
SWA_Q_HEADS = 4
SWA_KV_HEADS = 2
SWA_WINDOW = 128
SWA_BLOCK = 128
NA_HEADS = 4
NA_KH = 8
NA_KW = 16
DIFF_HEADS = 4
DIFF_V_DIM = 2 * HEAD_DIM
DIFF_BLOCK = 128
Q_SIZES = [SWA_Q_HEADS * HEAD_DIM, NA_HEADS * HEAD_DIM, DIFF_HEADS * 2 * HEAD_DIM]
KV_SIZES = [SWA_KV_HEADS * HEAD_DIM, SWA_KV_HEADS * HEAD_DIM, NA_HEADS * HEAD_DIM, NA_HEADS * HEAD_DIM,
            DIFF_HEADS * 2 * HEAD_DIM, DIFF_HEADS * DIFF_V_DIM]
Q_COLS = sum(Q_SIZES)
KV_COLS = sum(KV_SIZES)
IN_COLS = Q_COLS + KV_COLS
MIX_WIDTH = (SWA_Q_HEADS + NA_HEADS) * HEAD_DIM + DIFF_HEADS * DIFF_V_DIM
N_EXPERTS = 256
TOP_K = 8
N_GROUPS = 8
TOPK_GROUPS = 4
EXPERT_FF = 256
SHARED_FF = 256
ROUTED_SCALE = 2.5
MOE_BLOCK = 128
N_MOD = 6
EPS = 1e-6
NEG_INF = -1e30

kernel_name = 'hybrid_dit_swa_na2d_diff_moe'


def rmsnorm(x, g):
    xf = x.astype(jnp.float32)
    y = xf * lax.rsqrt(jnp.mean(xf * xf, axis=-1, keepdims=True) + EPS)
    return (y * g.astype(jnp.float32)).astype(x.dtype)


def modulate(x, shift, scale):
    return x * (1.0 + scale) + shift


def axial_rope_tables(n_tokens):
    n_freq = HEAD_DIM // 4
    inv = 1.0 / (ROPE_BASE ** (jnp.arange(n_freq, dtype=jnp.float32) / n_freq))
    t = jnp.arange(n_tokens)
    row = (t // GRID_W).astype(jnp.float32)
    col = (t % GRID_W).astype(jnp.float32)
    ar = row[:, None] * inv
    ac = col[:, None] * inv
    return (jnp.cos(ar), jnp.sin(ar), jnp.cos(ac), jnp.sin(ac))


def _rotate(x, cos, sin):
    x1, x2 = jnp.split(x, 2, axis=-1)
    cos = cos[:, None, :].astype(x.dtype)
    sin = sin[:, None, :].astype(x.dtype)
    return jnp.concatenate([x1 * cos - x2 * sin, x2 * cos + x1 * sin], axis=-1)


def apply_axial_rope(x, rope):
    cr, sr, cc, sc = rope
    half = x.shape[-1] // 2
    return jnp.concatenate([_rotate(x[..., :half], cr, sr), _rotate(x[..., half:], cc, sc)], axis=-1)


def _split_cols(t, sizes):
    return jnp.split(t, [int(s) for s in np.cumsum(sizes)[:-1]], axis=-1)


def _heads(t, *shape):
    return t.reshape(t.shape[:-1] + shape)


def split_q(q):
    qa, qb, qd = _split_cols(q, Q_SIZES)
    return (_heads(qa, SWA_Q_HEADS, HEAD_DIM), _heads(qb, NA_HEADS, HEAD_DIM),
            _heads(qd, DIFF_HEADS, 2, HEAD_DIM))


def split_kv(kv):
    ka, va, kb, vb, kd, vd = _split_cols(kv, KV_SIZES)
    return (_heads(ka, SWA_KV_HEADS, HEAD_DIM), _heads(va, SWA_KV_HEADS, HEAD_DIM),
            _heads(kb, NA_HEADS, HEAD_DIM), _heads(vb, NA_HEADS, HEAD_DIM),
            _heads(kd, DIFF_HEADS, 2, HEAD_DIM), _heads(vd, DIFF_HEADS, DIFF_V_DIM))


def swa_latent(q, k, v, kc, vc, sink):
    B, S, H, D = q.shape
    KVH = k.shape[2]
    G = H // KVH
    nb = S // SWA_BLOCK
    scale = D ** -0.5
    qb = q.reshape(B, nb, SWA_BLOCK, KVH, G, D)

    def band(t):
        tp = jnp.pad(t, ((0, 0), (SWA_BLOCK, SWA_BLOCK), (0, 0), (0, 0)))
        tp = tp.reshape(B, nb + 2, SWA_BLOCK, KVH, D)
        return jnp.concatenate([tp[:, :-2], tp[:, 1:-1], tp[:, 2:]], axis=2)

    kb, vb = band(k), band(v)
    blk = jnp.arange(nb)[:, None]
    qpos = blk * SWA_BLOCK + jnp.arange(SWA_BLOCK)[None, :]
    kpos = blk * SWA_BLOCK - SWA_BLOCK + jnp.arange(3 * SWA_BLOCK)[None, :]
    valid = ((jnp.abs(qpos[:, :, None] - kpos[:, None, :]) <= SWA_WINDOW)
             & (kpos[:, None, :] >= 0) & (kpos[:, None, :] < S))
    s_loc = jnp.einsum('bnqhgd,bnkhd->bnhgqk', qb, kb).astype(jnp.float32) * scale
    s_loc = jnp.where(valid[None, :, None, None], s_loc, NEG_INF)
    s_ctx = jnp.einsum('bnqhgd,bchd->bnhgqc', qb, kc).astype(jnp.float32) * scale
    s_sink = jnp.broadcast_to(sink.astype(jnp.float32).reshape(KVH, G)[:, :, None, None],
                              s_loc.shape[:-1] + (1,))
    p = jax.nn.softmax(jnp.concatenate([s_loc, s_ctx, s_sink], axis=-1), axis=-1)
    L = 3 * SWA_BLOCK
    C = kc.shape[1]
    o = (jnp.einsum('bnhgqk,bnkhd->bnqhgd', p[..., :L].astype(v.dtype), vb)
         + jnp.einsum('bnhgqc,bchd->bnqhgd', p[..., L:L + C].astype(v.dtype), vc))
    return o.reshape(B, S, H * D)


def swa_context(q, k, v, sink):
    B, C, H, D = q.shape
    KVH = k.shape[2]
    G = H // KVH
    qg = q.reshape(B, C, KVH, G, D)
    s = jnp.einsum('bqhgd,bkhd->bhgqk', qg, k).astype(jnp.float32) * (D ** -0.5)
    s_sink = jnp.broadcast_to(sink.astype(jnp.float32).reshape(KVH, G)[None, :, :, None, None],
                              s.shape[:-1] + (1,))
    p = jax.nn.softmax(jnp.concatenate([s, s_sink], axis=-1), axis=-1)
    o = jnp.einsum('bhgqk,bkhd->bqhgd', p[..., :C].astype(v.dtype), v)
    return o.reshape(B, C, H * D)


def na2d_latent(q, k, v, kc, vc, rpb):
    B, S, H, D = q.shape
    rows = S // GRID_W
    kh = min(NA_KH, rows)
    ncb = GRID_W // NA_KW
    scale = D ** -0.5
    qg = q.reshape(B, rows, ncb, NA_KW, H, D)
    kg = k.reshape(B, rows, GRID_W, H, D)
    vg = v.reshape(B, rows, GRID_W, H, D)
    r = jnp.arange(rows)
    ridx = jnp.clip(r - kh // 2, 0, rows - kh)[:, None] + jnp.arange(kh)[None, :]
    cb = jnp.arange(ncb)
    cidx = jnp.clip(cb * NA_KW - NA_KW // 2, 0, GRID_W - 2 * NA_KW)[:, None] + jnp.arange(2 * NA_KW)[None, :]
    L = kh * 2 * NA_KW
    gi_r = ridx[:, None, :, None]
    gi_c = cidx[None, :, None, :]
    kn = kg[:, gi_r, gi_c].reshape(B, rows, ncb, L, H, D)
    vn = vg[:, gi_r, gi_c].reshape(B, rows, ncb, L, H, D)
    qcol = cb[:, None] * NA_KW + jnp.arange(NA_KW)[None, :]
    cstart = jnp.clip(qcol - NA_KW // 2, 0, GRID_W - NA_KW)
    col_ok = (cidx[:, None, :] >= cstart[:, :, None]) & (cidx[:, None, :] < cstart[:, :, None] + NA_KW)
    mask = jnp.broadcast_to(col_ok[:, :, None, :], (ncb, NA_KW, kh, 2 * NA_KW)).reshape(ncb, NA_KW, L)
    dr = ridx - r[:, None]
    dc = jnp.clip(cidx[:, None, :] - qcol[:, :, None], -(NA_KW - 1), NA_KW - 1)
    bias = rpb.astype(jnp.float32)[:, (dr + NA_KH - 1)[:, None, None, :, None], (dc + NA_KW - 1)[None, :, :, None, :]]
    bias = bias.reshape(H, rows, ncb, NA_KW, L)
    s_loc = jnp.einsum('brnqhd,brnkhd->bhrnqk', qg, kn).astype(jnp.float32) * scale + bias[None]
    s_loc = jnp.where(mask, s_loc, NEG_INF)
    s_ctx = jnp.einsum('brnqhd,bchd->bhrnqc', qg, kc).astype(jnp.float32) * scale
    p = jax.nn.softmax(jnp.concatenate([s_loc, s_ctx], axis=-1), axis=-1)
    o = (jnp.einsum('bhrnqk,brnkhd->brnqhd', p[..., :L].astype(v.dtype), vn)
         + jnp.einsum('bhrnqc,bchd->brnqhd', p[..., L:].astype(v.dtype), vc))
    return o.reshape(B, S, H * D)


def dense_context(q, k, v):
    B, C, H, D = q.shape
    s = jnp.einsum('bqhd,bkhd->bhqk', q, k).astype(jnp.float32) * (D ** -0.5)
    p = jax.nn.softmax(s, axis=-1)
    return jnp.einsum('bhqk,bkhd->bqhd', p.astype(v.dtype), v).reshape(B, C, H * D)


def diff_core(q1, q2, k1, k2, v, lam):
    scale = q1.shape[-1] ** -0.5
    s1 = jnp.einsum('bqhd,bkhd->bhqk', q1, k1).astype(jnp.float32) * scale
    s2 = jnp.einsum('bqhd,bkhd->bhqk', q2, k2).astype(jnp.float32) * scale
    p = jax.nn.softmax(s1, axis=-1) - lam * jax.nn.softmax(s2, axis=-1)
    return jnp.einsum('bhqk,bkhe->bqhe', p.astype(v.dtype), v)


def diff_latent(q1, q2, k1, k2, v, k1c, k2c, vc, lam):
    B, S, H, D = q1.shape
    nb = S // DIFF_BLOCK
    k1a = jnp.concatenate([k1, k1c], axis=1)
    k2a = jnp.concatenate([k2, k2c], axis=1)
    va = jnp.concatenate([v, vc], axis=1)

    def to_blocks(t):
        return t.reshape(B, nb, DIFF_BLOCK, H, D).transpose(1, 0, 2, 3, 4)

    o = lax.map(lambda qq: diff_core(qq[0], qq[1], k1a, k2a, va, lam), (to_blocks(q1), to_blocks(q2)))
    return o.transpose(1, 0, 2, 3, 4).reshape(B, S, H, DIFF_V_DIM)


def diff_post(o, subln_g, lam_init):
    return (rmsnorm(o, subln_g) * (1.0 - lam_init)).reshape(o.shape[0], o.shape[1], -1)


def moe_ffn(h, w_router, router_bias, w_gate, w_up, w_down, ws_gate, ws_up, ws_down):
    T, D = h.shape
    scores = jax.nn.sigmoid((h @ w_router).astype(jnp.float32))
    grouped = (scores + router_bias.astype(jnp.float32)).reshape(T, N_GROUPS, N_EXPERTS // N_GROUPS)
    group_score = jnp.sum(lax.top_k(grouped, 2)[0], axis=-1)
    _, gidx = lax.top_k(group_score, TOPK_GROUPS)
    gmask = jnp.any(gidx[:, :, None] == jnp.arange(N_GROUPS)[None, None, :], axis=1)
    masked = jnp.where(gmask[:, :, None], grouped, -jnp.inf).reshape(T, N_EXPERTS)
    _, eidx = lax.top_k(masked, TOP_K)
    w = jnp.take_along_axis(scores, eidx, axis=-1)
    w = w / jnp.sum(w, axis=-1, keepdims=True) * ROUTED_SCALE

    tk = T * TOP_K
    flat_e = eidx.reshape(-1)
    flat_tok = jnp.arange(tk, dtype=jnp.int32) // TOP_K
    order = jnp.argsort(flat_e)
    sorted_e = flat_e[order]
    counts = jnp.zeros((N_EXPERTS,), jnp.int32).at[flat_e].add(1)
    starts = jnp.cumsum(counts) - counts
    padded = (counts + MOE_BLOCK - 1) // MOE_BLOCK * MOE_BLOCK
    pend = jnp.cumsum(padded)
    pstart = pend - padded
    dest = pstart[sorted_e] + (jnp.arange(tk, dtype=jnp.int32) - starts[sorted_e])
    n_blk = -(-tk // MOE_BLOCK) + N_EXPERTS
    n_rows = n_blk * MOE_BLOCK
    row_tok = jnp.full((n_rows,), T, jnp.int32).at[dest].set(flat_tok[order])
    row_w = jnp.zeros((n_rows,), jnp.float32).at[dest].set(w.reshape(-1)[order])
    blk_e = jnp.minimum(jnp.searchsorted(pend, jnp.arange(n_blk, dtype=jnp.int32) * MOE_BLOCK, side='right'),
                        N_EXPERTS - 1)
    h_pad = jnp.concatenate([h, jnp.zeros((1, D), h.dtype)], axis=0)

    def expert_block(y, blk):
        toks, e, wt = blk
        xb = h_pad[toks]
        ob = (jax.nn.silu(xb @ w_gate[e]) * (xb @ w_up[e])) @ w_down[e]
        return y.at[toks].add(ob * wt[:, None].astype(ob.dtype)), None

    y, _ = lax.scan(expert_block, jnp.zeros((T + 1, D), h.dtype),
                    (row_tok.reshape(n_blk, MOE_BLOCK), blk_e, row_w.reshape(n_blk, MOE_BLOCK)))
    shared = (jax.nn.silu(h @ ws_gate) * (h @ ws_up)) @ ws_down
    return y[:T] + shared


def hybrid_layer(x, ctx, c, c_ctx, rope, layer_idx, last, w_mod, b_mod, g_mix, g_ffn, w_in, w_out,
                 sink, rpb, lam_q1, lam_k1, lam_q2, lam_k2, subln_g, w_router, router_bias,
                 w_gate, w_up, w_down, ws_gate, ws_up, ws_down):
    B, S, D = x.shape
    C = ctx.shape[1]
    mod = (jax.nn.silu(c) @ w_mod + b_mod)[:, None, :]
    sh_a, sc_a, g_a, sh_f, sc_f, g_f = jnp.split(mod, N_MOD, axis=-1)
    n_mod_c = 2 if last else N_MOD
    mod_c = jax.nn.silu(c_ctx) @ w_mod[:, :n_mod_c * D] + b_mod[:n_mod_c * D]
    mc = jnp.split(mod_c, n_mod_c)

    h = modulate(rmsnorm(x, g_mix), sh_a, sc_a)
    hc = modulate(rmsnorm(ctx, g_mix), mc[0], mc[1])
    proj = h @ w_in
    if last:
        kv_c = hc @ w_in[:, Q_COLS:]
    else:
        proj_c = hc @ w_in
        kv_c = proj_c[..., Q_COLS:]
    qa, qb, qd = split_q(proj[..., :Q_COLS])
    ka, va, kb, vb, kd, vd = split_kv(proj[..., Q_COLS:])
    kac, vac, kbc, vbc, kdc, vdc = split_kv(kv_c)

    lam_init = 0.8 - 0.6 * math.exp(-0.3 * layer_idx)
    lam = (jnp.exp(jnp.sum(lam_q1.astype(jnp.float32) * lam_k1.astype(jnp.float32)))
           - jnp.exp(jnp.sum(lam_q2.astype(jnp.float32) * lam_k2.astype(jnp.float32))) + lam_init)

    o_a = swa_latent(apply_axial_rope(qa, rope), apply_axial_rope(ka, rope), va, kac, vac, sink)
    o_b = na2d_latent(qb, kb, vb, kbc, vbc, rpb)
    o_d = diff_latent(apply_axial_rope(qd[..., 0, :], rope), apply_axial_rope(qd[..., 1, :], rope),
                      apply_axial_rope(kd[..., 0, :], rope), apply_axial_rope(kd[..., 1, :], rope), vd,
                      kdc[..., 0, :], kdc[..., 1, :], vdc, lam)
    o_d = diff_post(o_d, subln_g, lam_init)
    x = x + g_a * (jnp.concatenate([o_a, o_b, o_d], axis=-1) @ w_out)

    if not last:
        qac, qbc, qdc = split_q(proj_c[..., :Q_COLS])
        oc_a = swa_context(qac, kac, vac, sink)
        oc_b = dense_context(qbc, kbc, vbc)
        oc_d = diff_post(diff_core(qdc[..., 0, :], qdc[..., 1, :], kdc[..., 0, :], kdc[..., 1, :], vdc, lam),
                         subln_g, lam_init)
        ctx = ctx + mc[2] * (jnp.concatenate([oc_a, oc_b, oc_d], axis=-1) @ w_out)

    hf = modulate(rmsnorm(x, g_ffn), sh_f, sc_f)
    moe_w = (w_router, router_bias, w_gate, w_up, w_down, ws_gate, ws_up, ws_down)
    if last:
        x = x + g_f * moe_ffn(hf.reshape(B * S, D), *moe_w).reshape(B, S, D)
    else:
        hfc = modulate(rmsnorm(ctx, g_ffn), mc[3], mc[4])
        y = moe_ffn(jnp.concatenate([hf.reshape(B * S, D), hfc.reshape(B * C, D)], axis=0), *moe_w)
        x = x + g_f * y[:B * S].reshape(B, S, D)
        ctx = ctx + mc[5] * y[B * S:].reshape(B, C, D)
    return x, ctx


def setup_inputs(seed: int = 0) -> dict:
    key = jax.random.key(seed)
    ks = jax.random.split(key, 26)
    D = D_MODEL
    E = N_EXPERTS
    F = EXPERT_FF

    def nrm(k, shape, scale):
        return jax.random.normal(k, shape, jnp.float32) * scale

    return {
        'x': nrm(ks[0], (BATCH, SEQ, D), 1.0),
        'c': nrm(ks[1], (BATCH, D), 1.0),
        'ctx': nrm(ks[2], (BATCH, CTX_LEN, D), 1.0),
        'c_ctx': nrm(ks[3], (D,), 1.0),
        'w_mod': nrm(ks[4], (DEPTH, D, N_MOD * D), 0.5 * D ** -0.5),
        'b_mod': nrm(ks[5], (DEPTH, N_MOD * D), 0.02),
        'g_mix': 1.0 + nrm(ks[6], (DEPTH, D), 0.02),
        'g_ffn': 1.0 + nrm(ks[7], (DEPTH, D), 0.02),
        'w_in': nrm(ks[8], (DEPTH, D, IN_COLS), D ** -0.5),
        'w_out': nrm(ks[9], (DEPTH, MIX_WIDTH, D), MIX_WIDTH ** -0.5),
        'attn_sink': nrm(ks[10], (DEPTH, SWA_Q_HEADS), 0.5),
        'na_rpb': nrm(ks[11], (DEPTH, NA_HEADS, 2 * NA_KH - 1, 2 * NA_KW - 1), 0.1),
        'lam_q1': nrm(ks[12], (DEPTH, HEAD_DIM), 0.1),
        'lam_k1': nrm(ks[13], (DEPTH, HEAD_DIM), 0.1),
        'lam_q2': nrm(ks[14], (DEPTH, HEAD_DIM), 0.1),
        'lam_k2': nrm(ks[15], (DEPTH, HEAD_DIM), 0.1),
        'subln_g': 1.0 + nrm(ks[16], (DEPTH, DIFF_V_DIM), 0.02),
        'w_router': nrm(ks[17], (DEPTH, D, E), D ** -0.5),
        'router_bias': nrm(ks[18], (DEPTH, E), 0.01),
        'w_gate': nrm(ks[19], (DEPTH, E, D, F), D ** -0.5),
        'w_up': nrm(ks[20], (DEPTH, E, D, F), D ** -0.5),
        'w_down': nrm(ks[21], (DEPTH, E, F, D), F ** -0.5),
        'ws_gate': nrm(ks[22], (DEPTH, D, SHARED_FF), D ** -0.5),
        'ws_up': nrm(ks[23], (DEPTH, D, SHARED_FF), D ** -0.5),
        'ws_down': nrm(ks[24], (DEPTH, SHARED_FF, D), SHARED_FF ** -0.5),
        'g_final': 1.0 + nrm(ks[25], (D,), 0.02),
    }


def reference(x, c, ctx, c_ctx, w_mod, b_mod, g_mix, g_ffn, w_in, w_out, attn_sink, na_rpb,
              lam_q1, lam_k1, lam_q2, lam_k2, subln_g, w_router, router_bias, w_gate, w_up, w_down,
              ws_gate, ws_up, ws_down, g_final):
    rope = axial_rope_tables(x.shape[1])
    for i in range(DEPTH):
        x, ctx = hybrid_layer(x, ctx, c, c_ctx, rope, i, i == DEPTH - 1,
                              w_mod[i], b_mod[i], g_mix[i], g_ffn[i], w_in[i], w_out[i],
                              attn_sink[i], na_rpb[i], lam_q1[i], lam_k1[i], lam_q2[i], lam_k2[i],
                              subln_g[i], w_router[i], router_bias[i], w_gate[i], w_up[i], w_down[i],
                              ws_gate[i], ws_up[i], ws_down[i])
    return rmsnorm(x, g_final)
```

```cpp
#include <hip/hip_runtime.h>
#include <hip/hip_bf16.h>
#include <cstdio>
#include <cstdint>

#define XB_TMO      128
#define XB_XCNT(j)  (256  + 64 * (j))
#define XB_XSUB(j)  (1280 + 64 * (j))
#define XB_XGEN(j)  (2304 + 64 * (j))
#define XB_TOP      3328
#define XB_TOPGEN   3392
#define XCD_BAR_WORDS 3456
#define XB_SPIN_CAP (1u << 22)
#define LAS __attribute__((address_space(3)))

__device__ __forceinline__ unsigned xb_ld(unsigned* p)              { return __hip_atomic_load(p, __ATOMIC_RELAXED, __HIP_MEMORY_SCOPE_AGENT); }
__device__ __forceinline__ unsigned xb_add(unsigned* p, unsigned v) { return __hip_atomic_fetch_add(p, v, __ATOMIC_RELAXED, __HIP_MEMORY_SCOPE_AGENT); }
__device__ __forceinline__ unsigned xb_xcc_id() { return (unsigned)__builtin_amdgcn_s_getreg((3 << 11) | 20) & 0xFu; }
#define XB_SPIN(cond, bar) do { unsigned _sp = 0; while (cond) { __builtin_amdgcn_s_sleep(1); \
    if ((++_sp & 255u) == 0u) { if (xb_ld(&(bar)[XB_TMO])) break; if (_sp > XB_SPIN_CAP) { atomicAdd(&(bar)[XB_TMO], 1u); break; } } } } while (0)

struct XcdBarrier {
    unsigned* bar; unsigned x;
    volatile LAS unsigned* st;
};

__device__ __forceinline__ XcdBarrier xcd_barrier_post(unsigned* bar, volatile LAS unsigned* st) {
    XcdBarrier b; b.bar = bar; b.x = xb_xcc_id(); b.st = st;
    if (threadIdx.x == 0) (void)xb_add(&bar[XB_XCNT(b.x)], 1u);
    return b;
}
__device__ __forceinline__ void xcd_barrier_complete(unsigned* bar, unsigned x, unsigned& nloc, unsigned& nx) {
    const unsigned G = gridDim.x * gridDim.y * gridDim.z;
    unsigned sum, cnt, mine, sp = 0u;
    for (;;) {
        sum = 0u; cnt = 0u; mine = 0u;
#pragma unroll
        for (unsigned j = 0; j < 16; ++j) { const unsigned c = xb_ld(&bar[XB_XCNT(j)]); sum += c; cnt += (c > 0u) ? 1u : 0u; mine = (j == x) ? c : mine; }
        if (sum == G) break;
        __builtin_amdgcn_s_sleep(1);
        if ((++sp & 255u) == 0u) { if (xb_ld(&bar[XB_TMO])) break; if (sp > XB_SPIN_CAP) { atomicAdd(&bar[XB_TMO], 1u); break; } }
    }
    nloc = mine > 0u ? mine : 1u; nx = cnt > 0u ? cnt : 1u;
}

__device__ __forceinline__ void xcd_barrier(const XcdBarrier& b) {
    asm volatile("s_waitcnt vmcnt(0)" ::: "memory");
    __syncthreads();
    if (threadIdx.x == 0) {
        unsigned* bar = b.bar;
        __builtin_amdgcn_s_waitcnt(0);
        unsigned nloc = b.st[0], nx = b.st[1];
        if (nloc == 0u) { xcd_barrier_complete(bar, b.x, nloc, nx); b.st[0] = nloc; b.st[1] = nx; }
        const unsigned old = xb_add(&bar[XB_XSUB(b.x)], 1u);
        const unsigned gen = old / nloc;
        if (old + 1u == (gen + 1u) * nloc) {
            __builtin_amdgcn_fence(__ATOMIC_RELEASE, "agent");
            asm volatile("s_waitcnt vmcnt(0)" ::: "memory");
            const unsigned og = xb_add(&bar[XB_TOP], 1u);
            const unsigned tg = og / nx;
            if (og + 1u == (tg + 1u) * nx) xb_add(&bar[XB_TOPGEN], 1u);
            else XB_SPIN(xb_ld(&bar[XB_TOPGEN]) == tg, bar);
            __builtin_amdgcn_fence(__ATOMIC_ACQUIRE, "agent");
            xb_add(&bar[XB_XGEN(b.x)], 1u);
            asm volatile("s_waitcnt vmcnt(0)" ::: "memory");
        } else {
            XB_SPIN(xb_ld(&bar[XB_XGEN(b.x)]) == gen, bar);
            __builtin_amdgcn_fence(__ATOMIC_ACQUIRE, "agent");
            asm volatile("s_waitcnt vmcnt(0)" ::: "memory");
        }
    }
    __syncthreads();
}

constexpr int DM = 1024, NB = 8, SEQ = 4096, CTXL = 256;
constexpr int TL = NB * SEQ;
constexpr int TC = NB * CTXL;
constexpr int TT = TL + TC;
constexpr int INC = 2816, QC = 1024, KVC = 1792;
constexpr int NE = 256, NEX = 257, FF = 256;
constexpr float EPSV = 1e-6f;
constexpr float LOG2E = 1.4426950408889634f;
constexpr float QSCALE = 0.125f * LOG2E;
constexpr float MIX_SCALE = 4.0f, W_SCALE = 32.0f, WD_SCALE = 16.0f, ACT_SCALE = 2.0f;
constexpr int NTHREADS = 512;
constexpr int NWAVES = 8;
constexpr int LDS_MAIN = 131072;
constexpr int LDS_AUX = 8192 + 16384 + 8192;
constexpr int LDS_BYTES = LDS_MAIN + LDS_AUX;
constexpr int LDS_STG = LDS_MAIN + 8192;
static_assert(LDS_BYTES <= 163840, "LDS");

typedef unsigned short bf16_t;
typedef __attribute__((ext_vector_type(8))) short bf16x8;
typedef __attribute__((ext_vector_type(4))) short s16x4;
typedef __attribute__((ext_vector_type(16))) float f32x16;
typedef __attribute__((ext_vector_type(2))) float f32x2;
typedef __attribute__((ext_vector_type(2))) __bf16 bf16x2v;
typedef short v4i16_t __attribute__((ext_vector_type(4)));
typedef __attribute__((ext_vector_type(4))) unsigned u32x4;
typedef __attribute__((ext_vector_type(2))) unsigned u32x2;
typedef __attribute__((ext_vector_type(4))) float f32x4;
#define DI __device__ __forceinline__
#define MFMA32(a, b, c) __builtin_amdgcn_mfma_f32_32x32x16_bf16((a), (b), (c), 0, 0, 0)

DI unsigned pk2(float lo, float hi) { f32x2 v = {lo, hi}; bf16x2v b = __builtin_convertvector(v, bf16x2v); return __builtin_bit_cast(unsigned, b); }
DI unsigned pk4_fp8(float a, float b, float c, float d) { int w = 0; w = __builtin_amdgcn_cvt_pk_fp8_f32(a, b, w, false); w = __builtin_amdgcn_cvt_pk_fp8_f32(c, d, w, true); return (unsigned)w; }
DI float bf2f(bf16_t u) { return __uint_as_float(((unsigned)u) << 16); }
DI float bflo(unsigned u) { return __uint_as_float(u << 16); }
DI float bfhi(unsigned u) { return __uint_as_float(u & 0xffff0000u); }
DI f32x4 bf4_f32(u32x2 w) { return f32x4{bflo(w.x), bfhi(w.x), bflo(w.y), bfhi(w.y)}; }
DI u32x2 f32_bf4(f32x4 v) { u32x2 o; o.x = pk2(v[0], v[1]); o.y = pk2(v[2], v[3]); return o; }
DI int crow(int reg, int hi) { return (reg & 3) + 8 * (reg >> 2) + 4 * hi; }
#define DPPI(v, CTRL) __builtin_amdgcn_update_dpp(0, (v), (CTRL), 0xf, 0xf, true)
#define DPPF(v, CTRL) __builtin_bit_cast(float, __builtin_amdgcn_update_dpp(0, __builtin_bit_cast(int, (v)), (CTRL), 0xf, 0xf, true))
#define DPP_XOR1 0xB1
#define DPP_XOR2 0x4E
#define DPP_HMIR 0x141
#define DPP_MIR  0x140
#define DPP_SHR(n) (0x110 + (n))
DI float rdlane_f(float v, int l) { return __builtin_bit_cast(float, __builtin_amdgcn_readlane(__builtin_bit_cast(int, v), l)); }
DI float wave_sum(float v) {
    v += DPPF(v, DPP_XOR1); v += DPPF(v, DPP_XOR2); v += DPPF(v, DPP_HMIR); v += DPPF(v, DPP_MIR);
    return (rdlane_f(v, 0) + rdlane_f(v, 16)) + (rdlane_f(v, 32) + rdlane_f(v, 48));
}
DI float half_swap_sum(float v) {
    const auto rr = __builtin_amdgcn_permlane32_swap(__float_as_uint(v), __float_as_uint(v), false, false);
    return __uint_as_float(rr[0]) + __uint_as_float(rr[1]);
}
DI float siluf(float v) { return v / (1.f + __expf(-v)); }

struct Params {
    const float* in[26];
    float* out;
    unsigned char* ws;
};
enum { I_X = 0, I_C, I_CTX, I_CCTX, I_WMOD, I_BMOD, I_GMIX, I_GFFN, I_WIN, I_WOUT, I_SINK, I_RPB, I_LQ1, I_LK1, I_LQ2, I_LK2, I_SUBLN,
       I_WR, I_RB, I_WG, I_WU, I_WD, I_SG, I_SU, I_SD, I_GFINAL };

constexpr size_t MiB = 1u << 20;
constexpr size_t WS_BAR = 0;
constexpr size_t WS_CNT = 16384;
constexpr int CNT_STRIDE = 64, CNT_LAYER = 257 * 64;
constexpr size_t WS_ZERO_BYTES = 163840;
constexpr size_t WS_ROPE = 196608;
constexpr size_t WS_MOD = 262144;
constexpr size_t WS_WIN = 1 * MiB;
constexpr size_t WS_WOUT = 12 * MiB;
constexpr size_t WS_WR = 16 * MiB;
constexpr size_t WS_WGU = 17 * MiB;
constexpr size_t WS_WD = WS_WGU + 514 * MiB;
constexpr size_t WS_XBUF = WS_WD + 257 * MiB;
constexpr size_t WS_HBUF = WS_XBUF + 136 * MiB;
constexpr size_t WS_SLOTW = WS_HBUF + 68 * MiB;
constexpr size_t WS_LIST = WS_SLOTW + 2 * MiB;
constexpr size_t WS_R = WS_LIST + 34 * MiB;
constexpr size_t WS_Q = WS_R;
constexpr size_t WS_KV = WS_R + 68 * MiB;
constexpr size_t WS_MIX = WS_R + 187 * MiB;
constexpr size_t WS_PARK = WS_R + 221 * MiB;
constexpr size_t WS_Q8 = WS_R + 290 * MiB;
constexpr size_t WS_K8 = WS_R + 324 * MiB;
constexpr size_t WS_VT8 = WS_R + 358 * MiB;
constexpr int VT_ROWS = 896, VT_TILE = 896 * 64;
constexpr size_t WS_LOGIT = WS_R + 256 * MiB;
constexpr size_t WS_ACT = WS_R;
constexpr size_t WS_HIN8 = WS_WGU + 300 * MiB;
constexpr size_t WS_H8 = WS_R + 80 * MiB;
constexpr size_t WS_YS = WS_R + 153 * MiB;
constexpr size_t WS_EINFO = WS_R + 512 * MiB;
constexpr size_t WS_WRP = WS_R + 460 * MiB;
constexpr size_t WS_CB = WS_R + 470 * MiB;
constexpr size_t WS_RSTD = WS_R + 471 * MiB;
constexpr size_t WS_ROWCTR = 151552;
constexpr size_t WS_END = WS_YS + 612 * MiB;
static_assert(WS_END <= 2048 * MiB, "workspace");

struct Ctx {
    const Params* p;
    char* smem;
    int tid, lane, wid, r32, hi;
    int bid, nblk;
};
DI int map_row(int type, int n) {
    if (type == 1) {
        const int hb = n >> 6, d = n & 63;
        const bool roped = (hb < 4) || (hb >= 8 && hb < 16) || (hb == 16) || (hb == 17) || (hb >= 28 && hb < 36);
        int d2 = d;
        if (roped) d2 = (d < 16) ? 2 * d : (d < 32) ? 2 * (d - 16) + 1 : (d < 48) ? 2 * (d - 16) : 2 * (d - 32) + 1;
        return (hb << 6) | d2;
    }
    if (type == 2) return 2 * n;
    if (type == 3) return 2 * n + 1;
    return n;
}

struct TItem { const float* W; int K, N, kt, nt, type; void* dst; bool f8; float ws; };
DI void tload(const Ctx& c, float (&v)[4][2][8], const TItem& it) {
    const int wid4 = c.wid & 3, nq = c.lane & 31, kh = c.lane >> 5;
    const int k0 = it.kt * 128, n0 = it.nt * 128;
#pragma unroll
    for (int cc = 0; cc < 2; ++cc) {
        const int kc = 2 * wid4 + kh + 8 * cc;
#pragma unroll
        for (int j = 0; j < 8; ++j) {
            const f32x4 f = *(const f32x4*)(it.W + (size_t)(k0 + kc * 8 + j) * it.N + n0 + 4 * nq);
            v[0][cc][j] = f[0]; v[1][cc][j] = f[1]; v[2][cc][j] = f[2]; v[3][cc][j] = f[3];
        }
    }
}
DI void tfinish(const Ctx& c, const float (&v)[4][2][8], const TItem& it) {
    LAS char* lds = (LAS char*)c.smem + (c.tid >> 8) * 36864;
    const int wid4 = c.wid & 3, nq = c.lane & 31, kh = c.lane >> 5;
    const int k0 = it.kt * 128, n0 = it.nt * 128, K = it.K;
    const float wscale = it.ws;
#pragma unroll
    for (int cc = 0; cc < 2; ++cc) {
        const int kc = 2 * wid4 + kh + 8 * cc;
#pragma unroll
        for (int q = 0; q < 4; ++q) {
            const int n = 4 * nq + q;
            if (it.f8) {
                u32x2 u; u.x = pk4_fp8(v[q][cc][0] * wscale, v[q][cc][1] * wscale, v[q][cc][2] * wscale, v[q][cc][3] * wscale); u.y = pk4_fp8(v[q][cc][4] * wscale, v[q][cc][5] * wscale, v[q][cc][6] * wscale, v[q][cc][7] * wscale);
                *(LAS u32x2*)(lds + n * 144 + ((((kc >> 1) ^ ((n >> 3) & 7))) << 4) + (kc & 1) * 8) = u;
            } else {
                u32x4 u; u.x = pk2(v[q][cc][0], v[q][cc][1]); u.y = pk2(v[q][cc][2], v[q][cc][3]); u.z = pk2(v[q][cc][4], v[q][cc][5]); u.w = pk2(v[q][cc][6], v[q][cc][7]);
                *(LAS u32x4*)(lds + n * 272 + kc * 16) = u;
            }
        }
    }
    __syncthreads();
    int tq = c.tid; asm volatile("" : "+v"(tq));
    lds = (LAS char*)c.smem + (tq >> 8) * 36864;
    const int tid8 = tq & 255;
    if (it.f8) {
        unsigned char* dst = (unsigned char*)it.dst;
#pragma unroll
        for (int j = 0; j < 4; ++j) {
            const int idx = tid8 + 256 * j, c16 = idx & 7, n = idx >> 3;
            const u32x4 u = *(LAS u32x4*)(lds + n * 144 + ((c16 ^ ((n >> 3) & 7)) << 4));
            const int row = map_row(it.type, n0 + n);
            *(u32x4*)(dst + (size_t)row * K + k0 + c16 * 16) = u;
        }
    } else {
        bf16_t* dst = (bf16_t*)it.dst;
#pragma unroll
        for (int j = 0; j < 8; ++j) {
            const int idx = tid8 + 256 * j, c16 = idx & 15, n = idx >> 4;
            const u32x4 u = *(LAS u32x4*)(lds + n * 272 + c16 * 16);
            const int row = map_row(it.type, n0 + n);
            *(u32x4*)(dst + (size_t)row * K + k0 + c16 * 8) = u;
        }
    }
    __syncthreads();
}

DI void mod_item(const Ctx& c, int l, int cg) {
    const Params& p = *c.p;
    LAS float* sv = (LAS float*)c.smem;
    LAS float* part = (LAS float*)(c.smem + 36864);
    for (int idx = c.tid; idx < 9 * 1024; idx += NTHREADS) {
        const int b = idx >> 10, k = idx & 1023;
        const float v = (b < 8) ? p.in[I_C][b * 1024 + k] : p.in[I_CCTX][k];
        sv[idx] = siluf(v);
    }
    __syncthreads();
    const int col = c.tid & 63, kq = c.tid >> 6;
    float acc[9];
#pragma unroll
    for (int b = 0; b < 9; ++b) acc[b] = 0.f;
    const float* wp = p.in[I_WMOD] + ((size_t)l * 1024 + kq * 128) * 6144 + cg * 64 + col;
    for (int k = 0; k < 128; k += 8) {
        float w[8];
#pragma unroll
        for (int u = 0; u < 8; ++u) w[u] = wp[(size_t)(k + u) * 6144];
#pragma unroll
        for (int u = 0; u < 8; ++u)
#pragma unroll
            for (int b = 0; b < 9; ++b) acc[b] += sv[b * 1024 + kq * 128 + k + u] * w[u];
    }
#pragma unroll
    for (int b = 0; b < 9; ++b) part[(kq * 9 + b) * 64 + col] = acc[b];
    __syncthreads();
    float* modv = (float*)(p.ws + WS_MOD);
    for (int idx = c.tid; idx < 576; idx += NTHREADS) {
        const int b = idx >> 6, cl = idx & 63;
        float s = 0.f;
#pragma unroll
        for (int q = 0; q < 8; ++q) s += part[(q * 9 + b) * 64 + cl];
        modv[(size_t)(l * 9 + b) * 6144 + cg * 64 + cl] = s + p.in[I_BMOD][l * 6144 + cg * 64 + cl];
    }
    __syncthreads();
}

DI void rope_item(const Ctx& c) {
    float2* tab = (float2*)(c.p->ws + WS_ROPE);
    for (int idx = c.tid; idx < 1024; idx += NTHREADS) {
        const int pos = idx >> 4, i = idx & 15;
        const float inv = 1.0f / powf(10000.0f, (float)i / 16.0f);
        const float ang = (float)pos * inv;
        float sn, cs; sincosf(ang, &sn, &cs);
        tab[idx] = make_float2(cs, sn);
    }
}

constexpr int PRO_PER_LAYER = 12592;
DI TItem transpose_decode(const Ctx& c, int r) {
    const Params& p = *c.p;
    const int l = r / PRO_PER_LAYER; r -= l * PRO_PER_LAYER;
    unsigned char* wgu = (unsigned char*)(p.ws + WS_WGU) + (size_t)l * 257 * 524288;
    unsigned char* wd = (unsigned char*)(p.ws + WS_WD) + (size_t)l * 257 * 262144;
    TItem t; t.f8 = true; t.ws = W_SCALE;
    if (r < 4096) { const int e = r >> 4, s = r & 15; t.W = p.in[I_WG] + (size_t)(l * 256 + e) * 262144; t.K = 1024; t.N = 256; t.kt = s >> 1; t.nt = s & 1; t.dst = wgu + (size_t)e * 524288; t.type = 2; }
    else if (r < 8192) { r -= 4096; const int e = r >> 4, s = r & 15; t.W = p.in[I_WU] + (size_t)(l * 256 + e) * 262144; t.K = 1024; t.N = 256; t.kt = s >> 1; t.nt = s & 1; t.dst = wgu + (size_t)e * 524288; t.type = 3; }
    else if (r < 12288) { r -= 8192; const int e = r >> 4, s = r & 15; t.W = p.in[I_WD] + (size_t)(l * 256 + e) * 262144; t.K = 256; t.N = 1024; t.kt = s >> 3; t.nt = s & 7; t.dst = wd + (size_t)e * 262144; t.type = 0; t.ws = WD_SCALE; }
    else {
        r -= 12288;
        if (r < 176) { t.W = p.in[I_WIN] + (size_t)l * 1024 * 2816; t.K = 1024; t.N = 2816; t.kt = r / 22; t.nt = r % 22; t.dst = (unsigned char*)(p.ws + WS_WIN) + (size_t)l * 2816 * 1024; t.type = 1; }
        else if (r < 240) { r -= 176; t.W = p.in[I_WOUT] + (size_t)l * 1048576; t.K = 1024; t.N = 1024; t.kt = r >> 3; t.nt = r & 7; t.dst = (unsigned char*)(p.ws + WS_WOUT) + (size_t)l * 1048576; t.type = 0; }
        else if (r < 256) { r -= 240; t.W = p.in[I_WR] + (size_t)l * 262144; t.K = 1024; t.N = 256; t.kt = r >> 1; t.nt = r & 1; t.dst = (bf16_t*)(p.ws + WS_WR) + (size_t)l * 262144; t.type = 0; t.f8 = false; }
        else if (r < 272) { r -= 256; t.W = p.in[I_SG] + (size_t)l * 262144; t.K = 1024; t.N = 256; t.kt = r >> 1; t.nt = r & 1; t.dst = wgu + (size_t)256 * 524288; t.type = 2; }
        else if (r < 288) { r -= 272; t.W = p.in[I_SU] + (size_t)l * 262144; t.K = 1024; t.N = 256; t.kt = r >> 1; t.nt = r & 1; t.dst = wgu + (size_t)256 * 524288; t.type = 3; }
        else { r -= 288; t.W = p.in[I_SD] + (size_t)l * 262144; t.K = 256; t.N = 1024; t.kt = r >> 3; t.nt = r & 7; t.dst = wd + (size_t)256 * 262144; t.type = 0; t.ws = WD_SCALE; }
    }
    return t;
}
template <class RMap>
DI void convert_pairs(const Ctx& c, int first, int stride, int n, RMap rmap) {
    if (n <= 0) return;
    const int half = c.tid >> 8;
    float va[4][2][8], vb[4][2][8];
    TItem ia = transpose_decode(c, rmap(first) + half), ib = ia;
    tload(c, va, ia);
    int i = 0;
    for (;;) {
        const bool m1 = i + 1 < n;
        if (m1) { ib = transpose_decode(c, rmap(first + (i + 1) * stride) + half); tload(c, vb, ib); }
        tfinish(c, va, ia);
        if (!m1) break;
        ++i;
        const bool m2 = i + 1 < n;
        if (m2) { ia = transpose_decode(c, rmap(first + (i + 1) * stride) + half); tload(c, va, ia); }
        tfinish(c, vb, ib);
        if (!m2) break;
        ++i;
    }
}
constexpr int PRO_EXPERT = 12288, PRO_SMALL = PRO_PER_LAYER - PRO_EXPERT;
constexpr int CONV_CHUNK = 8, CONV_NCHUNK = 2 * PRO_EXPERT / 2 / CONV_CHUNK;
DI int rmap_small(int q) { const int l = q / (PRO_SMALL / 2), s = q - l * (PRO_SMALL / 2); return l * PRO_PER_LAYER + PRO_EXPERT + 2 * s; }
DI int rmap_expert(int q) { const int l = q / (PRO_EXPERT / 2), s = q - l * (PRO_EXPERT / 2); return l * PRO_PER_LAYER + 2 * s; }
DI void phase_prologue(const Ctx& c) {
    for (int it = c.bid; it < 193; it += c.nblk) { if (it < 192) mod_item(c, it / 96, it % 96); else rope_item(c); }
    __syncthreads();
    constexpr int NP = PRO_SMALL;
    const int n = (NP > c.bid) ? (NP - c.bid + c.nblk - 1) / c.nblk : 0;
    convert_pairs(c, c.bid, c.nblk, n, [](int q) { return rmap_small(q); });
}

template <bool XBF>
DI void norm_mod_row(const float* __restrict__ xrow, const float* __restrict__ g, const float* __restrict__ sh, const float* __restrict__ sc, bf16_t* __restrict__ orow, unsigned char* __restrict__ o8, int lane) {
    float4 v[4]; float s = 0.f;
#pragma unroll
    for (int j = 0; j < 4; ++j) { if constexpr (XBF) { const f32x4 t4 = bf4_f32(((const u32x2*)xrow)[lane + 64 * j]); v[j] = make_float4(t4[0], t4[1], t4[2], t4[3]); } else v[j] = ((const float4*)xrow)[lane + 64 * j]; s += (v[j].x * v[j].x + v[j].y * v[j].y) + (v[j].z * v[j].z + v[j].w * v[j].w); }
    const float rstd = rsqrtf(wave_sum(s) * (1.f / DM) + EPSV);
#pragma unroll
    for (int j = 0; j < 4; ++j) {
        const float4 gg = ((const float4*)g)[lane + 64 * j], shh = ((const float4*)sh)[lane + 64 * j], scc = ((const float4*)sc)[lane + 64 * j];
        const float y0 = v[j].x * rstd * gg.x * (1.f + scc.x) + shh.x, y1 = v[j].y * rstd * gg.y * (1.f + scc.y) + shh.y;
        const float y2 = v[j].z * rstd * gg.z * (1.f + scc.z) + shh.z, y3 = v[j].w * rstd * gg.w * (1.f + scc.w) + shh.w;
        u32x2 o; o.x = pk2(y0, y1); o.y = pk2(y2, y3);
        if (orow) ((u32x2*)orow)[lane + 64 * j] = o;
        if (o8) ((unsigned*)o8)[lane + 64 * j] = pk4_fp8(y0, y1, y2, y3);
    }
}

DI void wrp_items(const Ctx& c) {
    const Params& p = *c.p;
    const float* modv = (const float*)(p.ws + WS_MOD);
    const bf16_t* wr = (const bf16_t*)(p.ws + WS_WR);
    bf16_t* wrp = (bf16_t*)(p.ws + WS_WRP);
    float* cb = (float*)(p.ws + WS_CB);
    const int lane = c.lane;
    for (int idx = c.bid * NWAVES + c.wid; idx < 2 * 9 * 256; idx += c.nblk * NWAVES) {
        const int l = idx / 2304, r = idx - l * 2304, b = r >> 8, e = r & 255;
        const float* g = p.in[I_GFFN] + l * 1024 + 16 * lane;
        const float* mv = modv + (size_t)(l * 9 + b) * 6144 + 3072 + 16 * lane;
        const bf16_t* src = wr + ((size_t)l * 256 + e) * 1024 + 16 * lane;
        const u32x4 w0 = *(const u32x4*)src, w1 = *(const u32x4*)(src + 8);
        float wv[16];
        wv[0] = bflo(w0.x); wv[1] = bfhi(w0.x); wv[2] = bflo(w0.y); wv[3] = bfhi(w0.y); wv[4] = bflo(w0.z); wv[5] = bfhi(w0.z); wv[6] = bflo(w0.w); wv[7] = bfhi(w0.w);
        wv[8] = bflo(w1.x); wv[9] = bfhi(w1.x); wv[10] = bflo(w1.y); wv[11] = bfhi(w1.y); wv[12] = bflo(w1.z); wv[13] = bfhi(w1.z); wv[14] = bflo(w1.w); wv[15] = bfhi(w1.w);
        float s = 0.f, o[16];
#pragma unroll
        for (int j = 0; j < 4; ++j) {
            const f32x4 gg = *(const f32x4*)(g + 4 * j), sh = *(const f32x4*)(mv + 4 * j), sc = *(const f32x4*)(mv + 1024 + 4 * j);
#pragma unroll
            for (int i = 0; i < 4; ++i) { o[4 * j + i] = wv[4 * j + i] * gg[i] * (1.f + sc[i]); s += sh[i] * wv[4 * j + i]; }
        }
        u32x4 o0, o1;
        o0.x = pk2(o[0], o[1]); o0.y = pk2(o[2], o[3]); o0.z = pk2(o[4], o[5]); o0.w = pk2(o[6], o[7]);
        o1.x = pk2(o[8], o[9]); o1.y = pk2(o[10], o[11]); o1.z = pk2(o[12], o[13]); o1.w = pk2(o[14], o[15]);
        bf16_t* dst = wrp + ((size_t)(l * 9 + b) * 256 + e) * 1024 + 16 * lane;
        *(u32x4*)dst = o0; *(u32x4*)(dst + 8) = o1;
        s = wave_sum(s);
        if (lane == 0) cb[(l * 9 + b) * 256 + e] = s;
    }
}
DI void norm_ffn_row(const bf16_t* __restrict__ xrow, const float* __restrict__ g, const float* __restrict__ sh, const float* __restrict__ sc, unsigned char* __restrict__ o8, float* __restrict__ rstd_out, int lane) {
    f32x4 v[4]; float s = 0.f;
#pragma unroll
    for (int j = 0; j < 4; ++j) { v[j] = bf4_f32(((const u32x2*)xrow)[lane + 64 * j]); s += (v[j][0] * v[j][0] + v[j][1] * v[j][1]) + (v[j][2] * v[j][2] + v[j][3] * v[j][3]); }
    const float rstd = rsqrtf(wave_sum(s) * (1.f / DM) + EPSV);
#pragma unroll
    for (int j = 0; j < 4; ++j) {
        const f32x4 gg = ((const f32x4*)g)[lane + 64 * j], shh = ((const f32x4*)sh)[lane + 64 * j], scc = ((const f32x4*)sc)[lane + 64 * j];
        const f32x4 y = v[j] * rstd * gg * (1.f + scc) + shh;
        ((unsigned*)o8)[lane + 64 * j] = pk4_fp8(y[0], y[1], y[2], y[3]);
    }
    if (lane == 0) *rstd_out = rstd;
}

DI void phase_norm(const Ctx& c, int l, int nrows, bool from_inputs, int which) {
    const Params& p = *c.p;
    const float* modv = (const float*)(p.ws + WS_MOD);
    const float* g = p.in[which ? I_GFFN : I_GMIX] + l * 1024;
    bf16_t* hbuf = (bf16_t*)(p.ws + WS_HBUF);
    const float* xbuf = (const float*)(p.ws + WS_XBUF);
    for (int t = c.bid * NWAVES + c.wid; t < nrows; t += c.nblk * NWAVES) {
        const float* xrow = from_inputs ? (t < TL ? p.in[I_X] + (size_t)t * DM : p.in[I_CTX] + (size_t)(t - TL) * DM) : (const float*)((const bf16_t*)xbuf + (size_t)t * DM);
        const int b = t < TL ? (t >> 12) : 8;
        const float* mv = modv + (size_t)(l * 9 + b) * 6144 + (which ? 3072 : 0);
        if (from_inputs) norm_mod_row<false>(xrow, g, mv, mv + 1024, (bf16_t*)nullptr,        (unsigned char*)(p.ws + (which ? WS_H8 : WS_HIN8)) + (size_t)t * DM, c.lane);
        else norm_mod_row<true>(xrow, g, mv, mv + 1024, hbuf + (size_t)t * DM, (unsigned char*)(p.ws + (which ? WS_H8 : WS_HIN8)) + (size_t)t * DM, c.lane);
    }
}

namespace g8 {
constexpr int BM = 256, BK = 64, HALF = 128, HTB = HALF * BK * 2;
DI int lds_byte(int r, int c) { const int st = (r >> 4) * 2 + (c >> 5), rr = r & 15, cc = c & 31, ob = rr * 64 + cc * 2; return st * 1024 + (ob ^ (((ob >> 9) & 1) << 5)); }
DI void stage_rc(int b, int& R, int& C) { const int st = b / 1024, sb = b % 1024, swz = sb ^ (((sb >> 9) & 1) << 5); R = (st >> 1) * 16 + swz / 64; C = (st & 1) * 32 + (swz % 64) / 2; }
DI int perm32(int rho) { const int n = rho >> 4, i = rho & 15; return 8 * (i >> 2) + 4 * n + (i & 3); }
struct Unit { int pm, pn, e, ti, ne, rbase, ix; };

typedef __attribute__((ext_vector_type(8))) int v8i_t;
typedef __attribute__((ext_vector_type(4))) int v4i_t;
template <class Epi, class Sched>
DI void gemm_phase(LAS unsigned char* lds, const int tid, const int RB, const Sched& S, const Epi& E) {
    constexpr bool F8 = Epi::F8;
    const int wid = __builtin_amdgcn_readfirstlane(tid >> 6), lane = tid & 63, wr = wid >> 2, wc = wid & 3, fr = lane & 15, fq = lane >> 4;
    const int nt = RB / 128;
    int Rr[2], Cc[2]; unsigned voffB[2], voffA[2];
#pragma unroll
    for (int i = 0; i < 2; ++i) { int R, C; stage_rc(tid * 16 + i * 8192, R, C); Rr[i] = R; Cc[i] = C * 2; const int Rb = Epi::PERM ? ((R & ~31) + perm32(R & 31)) : R; voffB[i] = (unsigned)(Rb * RB + C * 2); voffA[i] = (unsigned)(R * RB + C * 2); }
    constexpr bool GA = Sched::GATHER;
    int unit_scale = 0x7F7F7F7F; asm volatile("" : "+v"(unit_scale));
    const size_t kstep = (size_t)(BK * 2);
    const size_t hstep = (size_t)HALF * RB;
    const unsigned ldsw = (unsigned)wid * 1024u;
    const int aoff = F8 ? lds_byte(wr * 64 + fr, (fq >> 1) * 32 + (fq & 1) * 16) : lds_byte(wr * 64 + fr, fq * 8);
    const int boff = F8 ? lds_byte(wc * 32 + fr, (fq >> 1) * 32 + (fq & 1) * 16) : lds_byte(wc * 32 + fr, fq * 8);
#define G8_SA(b, h) (((b) * 2 + (h)) * HTB)
#define G8_SB(b, h) ((4 + (b) * 2 + (h)) * HTB)
#define G8_STAGE_B(bufoff, gbase) do { _Pragma("unroll") for (int _i = 0; _i < 2; ++_i) \
        __builtin_amdgcn_global_load_lds((const unsigned*)((const char*)(gbase) + voffB[_i]), (LAS unsigned*)(lds + (bufoff) + ldsw + _i * 8192), 16, 0, 0); } while (0)
#define G8_STAGE_A(bufoff, uptr, koff, VO, h) do { _Pragma("unroll") for (int _i = 0; _i < 2; ++_i) { \
        const char* _s = GA ? (Ab + (koff) + VO[h][_i]) : ((uptr) + (koff) + ((h) ? hstep : (size_t)0) + voffA[_i]); \
        __builtin_amdgcn_global_load_lds((const unsigned*)_s, (LAS unsigned*)(lds + (bufoff) + ldsw + _i * 8192), 16, 0, 0); } } while (0)
#define G8_LDA(dst, b, h) do { _Pragma("unroll") for (int m = 0; m < 4; ++m) { \
        if constexpr (F8) { dst##8[m].lo = *(const LAS v4i_t*)(lds + G8_SA(b, h) + aoff + m * 2048); dst##8[m].hi = *(const LAS v4i_t*)(lds + G8_SA(b, h) + aoff + m * 2048 + 16); } \
        else { _Pragma("unroll") for (int k = 0; k < 2; ++k) dst[m][k] = *(const LAS bf16x8*)(lds + G8_SA(b, h) + aoff + m * 2048 + k * 1024); } } } while (0)
#define G8_LDB(dst, b, h) do { _Pragma("unroll") for (int n = 0; n < 2; ++n) { \
        if constexpr (F8) { dst##8[n].lo = *(const LAS v4i_t*)(lds + G8_SB(b, h) + boff + n * 2048); dst##8[n].hi = *(const LAS v4i_t*)(lds + G8_SB(b, h) + boff + n * 2048 + 16); } \
        else { _Pragma("unroll") for (int k = 0; k < 2; ++k) dst[n][k] = *(const LAS bf16x8*)(lds + G8_SB(b, h) + boff + n * 2048 + k * 1024); } } } while (0)
#define G8_MMA(ai, bj, At, Bt) do { __builtin_amdgcn_s_setprio(1); _Pragma("unroll") for (int m = 0; m < 4; ++m) _Pragma("unroll") for (int n = 0; n < 2; ++n) { \
        if constexpr (F8) asm volatile("v_mfma_scale_f32_16x16x128_f8f6f4 %0, %1, %2, %0, %3, %3 op_sel_hi:[0,0,0]" : "+v"(acc[ai][bj][m][n]) : "v"(Bt##8[n]), "v"(At##8[m]), "v"(unit_scale)); \
        else { _Pragma("unroll") for (int k = 0; k < 2; ++k) acc[ai][bj][m][n] = __builtin_amdgcn_mfma_f32_16x16x32_bf16(Bt[n][k], At[m][k], acc[ai][bj][m][n], 0, 0, 0); } } \
        __builtin_amdgcn_s_setprio(0); } while (0)
#define G8_WAIT_V(n) asm volatile("s_waitcnt vmcnt(" #n ")" ::: "memory")
#define G8_WAIT_L(n) asm volatile("s_waitcnt lgkmcnt(" #n ")" ::: "memory")
#define G8_BAR __builtin_amdgcn_s_barrier()
#define G8_SCHED __builtin_amdgcn_sched_barrier(0)
    Unit cur, nxt; int ui = 0;
    if (!S.next(0, cur)) return;
    f32x4 acc[2][2][4][2];
#pragma unroll
    for (int a = 0; a < 2; ++a)
#pragma unroll
        for (int b = 0; b < 2; ++b)
#pragma unroll
            for (int m = 0; m < 4; ++m)
#pragma unroll
                for (int n = 0; n < 2; ++n) acc[a][b][m][n] = (f32x4){0.f, 0.f, 0.f, 0.f};
    if constexpr (F8) asm volatile("s_nop 3" ::: "memory");
    bf16x8 At[F8 ? 1 : 4][2], B0[F8 ? 1 : 2][2], B1[F8 ? 1 : 2][2];
    v8i_t At8[F8 ? 4 : 1], B08[F8 ? 2 : 1], B18[F8 ? 2 : 1];
    unsigned vAc[2][2], vAn[2][2];
#pragma unroll
    for (int h = 0; h < 2; ++h)
#pragma unroll
        for (int i = 0; i < 2; ++i) vAc[h][i] = GA ? (S.a_off(cur, h * 128 + Rr[i]) + (unsigned)Cc[i]) : 0u;
    const char* Ab = S.a_base();
    const char* cA = GA ? Ab : S.a_ptr(cur);
    const char* cB = S.b_base(cur);
    G8_STAGE_B(G8_SB(0, 0), cB); G8_STAGE_A(G8_SA(0, 0), cA, 0, vAc, 0); G8_STAGE_B(G8_SB(0, 1), cB + hstep); G8_STAGE_A(G8_SA(0, 1), cA, 0, vAc, 1);
    if (wr == 1) G8_BAR;
    G8_WAIT_V(4); G8_BAR;
    G8_STAGE_B(G8_SB(1, 0), cB + kstep); G8_STAGE_A(G8_SA(1, 0), cA, kstep, vAc, 0); G8_STAGE_B(G8_SB(1, 1), cB + hstep + kstep);
    G8_WAIT_V(6); G8_BAR;
    for (;;) {
        const bool has_next = S.next(ui + 1, nxt);
        const char* nB = has_next ? S.b_base(nxt) : cB;
        const char* nA = GA ? Ab : (has_next ? S.a_ptr(nxt) : cA);
#pragma unroll
        for (int h = 0; h < 2; ++h)
#pragma unroll
            for (int i = 0; i < 2; ++i) vAn[h][i] = GA ? (has_next ? (S.a_off(nxt, h * 128 + Rr[i]) + (unsigned)Cc[i]) : vAc[h][i]) : 0u;
#pragma unroll 1
        for (int t = 0; t < nt; t += 2) {
            const bool last = (t == nt - 2);
            const size_t ka1 = (size_t)(t + 1) * kstep;
            const size_t ka2 = last ? (size_t)0 : (size_t)(t + 2) * kstep;
            const size_t ka3 = ka2 + kstep;
            const char* b2 = last ? nB : cB + (size_t)(t + 2) * kstep;
            const char* b3 = b2 + kstep;
            unsigned v2[2][2];
#pragma unroll
            for (int h = 0; h < 2; ++h)
#pragma unroll
                for (int i = 0; i < 2; ++i) v2[h][i] = GA ? (last ? vAn[h][i] : vAc[h][i]) : 0u;
            const char* a2p = last ? nA : cA;
            G8_LDB(B0, 0, 0); G8_SCHED; G8_LDA(At, 0, 0); G8_STAGE_A(G8_SA(1, 1), cA, ka1, vAc, 1);
            G8_WAIT_L(8); G8_BAR; G8_WAIT_L(0); G8_MMA(0, 0, At, B0); G8_BAR; G8_SCHED;
            G8_LDB(B1, 0, 1); G8_STAGE_B(G8_SB(0, 0), b2);
            G8_BAR; G8_WAIT_L(0); G8_MMA(0, 1, At, B1); G8_BAR;
            G8_LDA(At, 0, 1); G8_STAGE_A(G8_SA(0, 0), a2p, ka2, v2, 0);
            G8_BAR; G8_WAIT_L(0); G8_MMA(1, 0, At, B0); G8_BAR; G8_SCHED;
            G8_STAGE_B(G8_SB(0, 1), b2 + hstep);
            G8_WAIT_V(6); G8_BAR; G8_MMA(1, 1, At, B1); G8_BAR;
            G8_LDB(B0, 1, 0); G8_SCHED; G8_LDA(At, 1, 0); G8_STAGE_A(G8_SA(0, 1), a2p, ka2, v2, 1);
            G8_WAIT_L(8); G8_BAR; G8_WAIT_L(0); G8_MMA(0, 0, At, B0); G8_BAR; G8_SCHED;
            G8_LDB(B1, 1, 1); G8_STAGE_B(G8_SB(1, 0), b3);
            G8_BAR; G8_WAIT_L(0); G8_MMA(0, 1, At, B1); G8_BAR;
            G8_LDA(At, 1, 1); G8_STAGE_A(G8_SA(1, 0), a2p, ka3, v2, 0);
            G8_BAR; G8_WAIT_L(0); G8_MMA(1, 0, At, B0); G8_BAR; G8_SCHED;
            G8_STAGE_B(G8_SB(1, 1), b3 + hstep);
            G8_WAIT_V(6); G8_BAR; G8_MMA(1, 1, At, B1); G8_BAR;
        }
        if constexpr (F8) asm volatile("s_nop 15\n\ts_nop 15" ::: "memory");
        E(acc, cur, wr, wc, fr, fq);
        if (!has_next) break;
#pragma unroll
        for (int a = 0; a < 2; ++a)
#pragma unroll
            for (int b = 0; b < 2; ++b)
#pragma unroll
                for (int m = 0; m < 4; ++m)
#pragma unroll
                    for (int n = 0; n < 2; ++n) acc[a][b][m][n] = (f32x4){0.f, 0.f, 0.f, 0.f};
        if constexpr (F8) asm volatile("s_nop 3" ::: "memory");
        cur = nxt; cB = nB; cA = nA; ++ui;
#pragma unroll
        for (int h = 0; h < 2; ++h)
#pragma unroll
            for (int i = 0; i < 2; ++i) vAc[h][i] = vAn[h][i];
    }
    G8_WAIT_V(0);
    if (wr == 0) G8_BAR;
    G8_BAR;
#undef G8_SA
#undef G8_SB
#undef G8_STAGE_A
#undef G8_STAGE_B
#undef G8_LDA
#undef G8_LDB
#undef G8_MMA
#undef G8_WAIT_V
#undef G8_WAIT_L
#undef G8_BAR
#undef G8_SCHED
}

struct DenseSched {
    static constexpr bool GATHER = false;
    int nM, nN, nwg, G, c, RB; const char* A; const char* Bt;
    DI void init(const void* A_, const void* Bt_, int M, int N, int RB_, int G_, int c_) { A = (const char*)A_; Bt = (const char*)Bt_; nM = M / BM; nN = N / BM; nwg = nM * nN; G = G_; c = c_; RB = RB_; }
    DI bool next(int i, Unit& u) const {
        const int L = i * G + c; if (L >= nwg) return false;
        int wgid = L; { const int q = nwg / 8, r = nwg % 8, xcd = wgid % 8, off = wgid / 8; wgid = (xcd < r ? xcd * (q + 1) : r * (q + 1) + (xcd - r) * q) + off; }
        const int nig = 8 * nN, gid = wgid / nig, fm = gid * 8, gsz = (nM - fm) < 8 ? (nM - fm) : 8;
        u.pm = fm + ((wgid % nig) % gsz); u.pn = (wgid % nig) / gsz; u.e = 0; u.ti = 0; u.ne = 0; u.rbase = 0; u.ix = 0; return true;
    }
    DI const char* a_base() const { return A; }
    DI unsigned a_off(const Unit&, int) const { return 0u; }
    DI const char* a_ptr(const Unit& u) const { return A + (size_t)u.pm * BM * RB; }
    DI const char* b_base(const Unit& u) const { return Bt + (size_t)u.pn * BM * RB; }
};
}
struct EpiInproj {
    static constexpr bool F8 = true;
    static constexpr bool PERM = true;
    const LAS float2* rope;
    unsigned char* q8; unsigned char* k8; unsigned char* vt8;
    LAS unsigned char* stg; int tid;
    static DI bool isv_cb(int cb) { const int kv = cb - 16; return (cb >= 16) && ((kv == 2) || (kv == 3) || (kv >= 8 && kv < 12) || (kv >= 20)); }
    DI void operator()(const f32x4 (&acc)[2][2][4][2], const g8::Unit& u, int wr, int wc, int fr, int fq) const {
        const bool lat = (u.pm * 256 < TL);
#pragma unroll
        for (int bj = 0; bj < 2; ++bj) {
            const int col0 = u.pn * 256 + bj * 128 + wc * 32 + 8 * fq;
            const int cb = col0 >> 6, kv = cb - 16;
            if (!isv_cb(cb)) continue;
            const float scale = 1.0f / W_SCALE;
            const int vrow0 = (kv < 4 ? (kv - 2) * 64 : (kv < 12 ? 128 + (kv - 8) * 64 : 384 + (kv - 20) * 64)) + (col0 & 63);
            const int pos = 32 * ((fr >> 2) & 1) + 4 * (((fr >> 3) << 2) | (fr & 3));
#pragma unroll
            for (int ai = 0; ai < 2; ++ai) {
                const int t0 = u.pm * 256 + ai * 128 + wr * 64;
                const int b = t0 < TL ? (t0 >> 12) : ((t0 - TL) >> 8);
                const int tile = t0 < TL ? ((t0 & 4095) >> 6) : (64 + (((t0 - TL) & 255) >> 6));
                unsigned char* base = vt8 + (size_t)(b * 68 + tile) * VT_TILE + (size_t)vrow0 * 64 + pos;
#pragma unroll
                for (int n = 0; n < 2; ++n)
#pragma unroll
                    for (int j = 0; j < 4; ++j)
                        *(unsigned*)(base + (4 * n + j) * 64) = pk4_fp8(acc[ai][bj][0][n][j] * scale, acc[ai][bj][1][n][j] * scale, acc[ai][bj][2][n][j] * scale, acc[ai][bj][3][n][j] * scale);
            }
        }
        if (!((u.pn < 6) || (u.pn == 7) || (u.pn == 8))) return;
        constexpr int RS = 272;
        if (wr == 0) __builtin_amdgcn_s_barrier();
#pragma unroll
        for (int ai = 0; ai < 2; ++ai)
#pragma unroll
            for (int mh = 0; mh < 2; ++mh) {
#pragma unroll
                for (int bj = 0; bj < 2; ++bj) {
                    const int col0 = u.pn * 256 + bj * 128 + wc * 32 + 8 * fq;
                    const int cb = col0 >> 6, i0 = (col0 & 63) >> 1;
                    if (isv_cb(cb)) continue;
                    const bool isq = cb < 16;
                    const bool roped = ((cb < 4) || (cb >= 8 && cb < 16) || (cb == 16) || (cb == 17) || (cb >= 28 && cb < 36)) && lat;
                    const float scale = (isq ? QSCALE : 1.0f) * (1.0f / W_SCALE);
#pragma unroll
                    for (int mm = 0; mm < 2; ++mm) {
                        const int m = mh * 2 + mm;
                        const int t = u.pm * 256 + ai * 128 + wr * 64 + m * 16 + fr;
                        f32x4 v0 = acc[ai][bj][m][0], v1 = acc[ai][bj][m][1];
                        if (roped) {
                            const int s = t & 4095;
                            const int pos = (i0 < 16) ? (s >> 6) : (s & 63);
                            const f32x4 ca = *(const LAS f32x4*)(rope + pos * 16 + (i0 & 15)), cb2 = *(const LAS f32x4*)(rope + pos * 16 + (i0 & 15) + 2);
                            f32x4 o0, o1;
                            o0[0] = v0[0] * ca[0] - v0[1] * ca[1]; o0[1] = v0[1] * ca[0] + v0[0] * ca[1];
                            o0[2] = v0[2] * ca[2] - v0[3] * ca[3]; o0[3] = v0[3] * ca[2] + v0[2] * ca[3];
                            o1[0] = v1[0] * cb2[0] - v1[1] * cb2[1]; o1[1] = v1[1] * cb2[0] + v1[0] * cb2[1];
                            o1[2] = v1[2] * cb2[2] - v1[3] * cb2[3]; o1[3] = v1[3] * cb2[2] + v1[2] * cb2[3];
                            v0 = o0; v1 = o1;
                        }
                        v0 *= scale; v1 *= scale;
                        u32x2 w; w.x = pk4_fp8(v0[0], v0[1], v0[2], v0[3]); w.y = pk4_fp8(v1[0], v1[1], v1[2], v1[3]);
                        *(LAS u32x2*)(stg + (wr * 32 + mm * 16 + fr) * RS + bj * 128 + wc * 32 + 8 * fq) = w;
                    }
                }
                asm volatile("s_waitcnt lgkmcnt(0)" ::: "memory"); __builtin_amdgcn_s_barrier(); asm volatile("" ::: "memory");
#pragma unroll
                for (int k = 0; k < 2; ++k) {
                    const int idx = tid + k * 512, rl = idx >> 4, pc = idx & 15;
                    const int cb = u.pn * 4 + (pc >> 2);
                    if (!isv_cb(cb)) {
                        const u32x4 v = *(const LAS u32x4*)(stg + rl * RS + pc * 16);
                        const int t = u.pm * 256 + ai * 128 + (rl >> 5) * 64 + mh * 32 + (rl & 31);
                        const int kv = cb - 16, ki = kv < 2 ? kv : (kv < 8 ? kv - 2 : kv - 6);
                        unsigned char* dst = (cb < 16) ? q8 + (size_t)t * 1024 + cb * 64 + (pc & 3) * 16 : k8 + (size_t)t * 1024 + ki * 64 + (pc & 3) * 16;
                        *(u32x4*)dst = v;
                    }
                }
                asm volatile("s_waitcnt lgkmcnt(0)" ::: "memory"); __builtin_amdgcn_s_barrier(); asm volatile("" ::: "memory");
            }
        if (wr == 1) __builtin_amdgcn_s_barrier();
    }
};
DI void phase_inproj(const Ctx& c, int l) {
    const Params& p = *c.p;
    g8::DenseSched S; S.init(p.ws + WS_HIN8, (const unsigned char*)(p.ws + WS_WIN) + (size_t)l * 2816 * 1024, TT, INC, DM, c.nblk, c.bid);
    {
        const float* rg = (const float*)(p.ws + WS_ROPE);
        LAS float* rl = (LAS float*)(c.smem + LDS_MAIN + 256);
        for (int i = c.tid; i < 2048; i += NTHREADS) rl[i] = rg[i];
        __syncthreads();
    }
    EpiInproj E; E.rope = (const LAS float2*)(c.smem + LDS_MAIN + 256); E.stg = (LAS unsigned char*)c.smem + LDS_MAIN + 256 + 8192; E.tid = c.tid;
    E.q8 = (unsigned char*)(p.ws + WS_Q8); E.k8 = (unsigned char*)(p.ws + WS_K8); E.vt8 = (unsigned char*)(p.ws + WS_VT8);
    g8::gemm_phase((LAS unsigned char*)c.smem, c.tid, DM, S, E);
}

struct EpiOutproj {
    static constexpr bool F8 = true;
    static constexpr bool PERM = false;
    float* xbuf; const float* modv; const float* x_in; const float* ctx_in; int l;
    DI void operator()(const f32x4 (&acc)[2][2][4][2], const g8::Unit& u, int wr, int wc, int fr, int fq) const {
        const int b = (u.pm * 256) < TL ? ((u.pm * 256) >> 12) : 8;
        const int col0 = u.pn * 256 + wc * 32 + 4 * fq;
        const float* gate = modv + (size_t)(l * 9 + b) * 6144 + 2048 + col0;
        f32x4 g[2][2];
#pragma unroll
        for (int bj = 0; bj < 2; ++bj)
#pragma unroll
            for (int n = 0; n < 2; ++n) g[bj][n] = *(const f32x4*)(gate + bj * 128 + n * 16) * (1.0f / (MIX_SCALE * W_SCALE));
#pragma unroll
        for (int ai = 0; ai < 2; ++ai)
#pragma unroll
            for (int m = 0; m < 4; ++m) {
                const int t = u.pm * 256 + ai * 128 + wr * 64 + m * 16 + fr;
                const float* xin = (t < TL ? x_in + (size_t)t * DM : ctx_in + (size_t)(t - TL) * DM) + col0;
                bf16_t* xo = (bf16_t*)xbuf + (size_t)t * DM + col0;
#pragma unroll
                for (int bj = 0; bj < 2; ++bj)
#pragma unroll
                    for (int n = 0; n < 2; ++n) {
                        const f32x4 x = (l == 0) ? *(const f32x4*)(xin + bj * 128 + n * 16) : bf4_f32(*(const u32x2*)(xo + bj * 128 + n * 16));
                        *(u32x2*)(xo + bj * 128 + n * 16) = f32_bf4(x + g[bj][n] * acc[ai][bj][m][n]);
                    }
            }
    }
};
DI void phase_outproj(const Ctx& c, int l, int nrows) {
    const Params& p = *c.p;
    g8::DenseSched S; S.init(p.ws + WS_MIX, (const unsigned char*)(p.ws + WS_WOUT) + (size_t)l * 1048576, nrows, DM, DM, c.nblk, c.bid);
    EpiOutproj E; E.xbuf = (float*)(p.ws + WS_XBUF); E.modv = (const float*)(p.ws + WS_MOD); E.x_in = p.in[I_X]; E.ctx_in = p.in[I_CTX]; E.l = l;
    g8::gemm_phase((LAS unsigned char*)c.smem, c.tid, DM, S, E);
}

struct EpiRouter {
    static constexpr bool F8 = false;
    static constexpr bool PERM = false;
    float* logit;
    DI void operator()(const f32x4 (&acc)[2][2][4][2], const g8::Unit& u, int wr, int wc, int fr, int fq) const {
#pragma unroll
        for (int ai = 0; ai < 2; ++ai)
#pragma unroll
            for (int m = 0; m < 4; ++m) {
                const int t = u.pm * 256 + ai * 128 + wr * 64 + m * 16 + fr;
#pragma unroll
                for (int bj = 0; bj < 2; ++bj)
#pragma unroll
                    for (int n = 0; n < 2; ++n) *(f32x4*)(logit + (size_t)t * NE + bj * 128 + wc * 32 + n * 16 + 4 * fq) = acc[ai][bj][m][n];
            }
    }
};
DI void phase_router(const Ctx& c, int l, int nrows) {
    const Params& p = *c.p;
    g8::DenseSched S; S.init(p.ws + WS_HBUF, (const bf16_t*)(p.ws + WS_WR) + (size_t)l * 262144, nrows, NE, DM * 2, c.nblk, c.bid);
    EpiRouter E; E.logit = (float*)(p.ws + WS_LOGIT);
    g8::gemm_phase((LAS unsigned char*)c.smem, c.tid, DM * 2, S, E);
}

struct RouterSched : g8::DenseSched {
    DI const char* b_base(const g8::Unit& u) const { const int b = (u.pm * 256) < TL ? ((u.pm * 256) >> 12) : 8; return Bt + (size_t)b * 524288 + (size_t)u.pn * 256 * RB; }
};
DI void phase_norm_router(const Ctx& c, int l, int nrows) {
    const Params& p = *c.p;
    {
        RouterSched S; S.init(p.ws + WS_XBUF, (const bf16_t*)(p.ws + WS_WRP) + (size_t)l * 9 * 262144, nrows, NE, DM * 2, c.nblk, c.bid);
        EpiRouter E; E.logit = (float*)(p.ws + WS_LOGIT);
        g8::gemm_phase((LAS unsigned char*)c.smem, c.tid, DM * 2, S, E);
    }
    int* ctr = (int*)(p.ws + WS_ROWCTR) + l * 64;
    LAS int* slot = (LAS int*)(c.smem + LDS_MAIN + 64);
    const float* modv = (const float*)(p.ws + WS_MOD);
    const float* g = p.in[I_GFFN] + l * 1024;
    const bf16_t* xbuf = (const bf16_t*)(p.ws + WS_XBUF);
    unsigned char* h8 = (unsigned char*)(p.ws + WS_H8);
    float* rstd = (float*)(p.ws + WS_RSTD);
    for (;;) {
        if (c.tid == 0) slot[0] = atomicAdd(ctr, 64);
        __syncthreads();
        const int base = slot[0];
        __syncthreads();
        if (base >= nrows) break;
#pragma unroll 1
        for (int i = 0; i < 8; ++i) {
            const int t = base + c.wid * 8 + i;
            if (t < nrows) {
                const int b = t < TL ? (t >> 12) : 8;
                const float* mv = modv + (size_t)(l * 9 + b) * 6144 + 3072;
                norm_ffn_row(xbuf + (size_t)t * DM, g, mv, mv + 1024, h8 + (size_t)t * DM, rstd + t, c.lane);
            }
        }
    }
}

DI void phase_route(const Ctx& c, int l, int nrows) {
    const Params& p = *c.p;
    const float* logit = (const float*)(p.ws + WS_LOGIT);
    const float* rb = p.in[I_RB] + l * NE;
    int* cnt = (int*)(p.ws + WS_CNT) + l * CNT_LAYER;
    int* list = (int*)(p.ws + WS_LIST);
    float* slotw = (float*)(p.ws + WS_SLOTW);
    int* einfo = (int*)(p.ws + WS_EINFO);
    LAS int* lcnt = (LAS int*)c.smem;
    LAS int* rec = (LAS int*)(c.smem + 1024);
    LAS float* recw = (LAS float*)(c.smem + 1024 + 8 * 24 * 8 * 4);
    constexpr int RMAX = 24;
    const int lane = c.lane;
    if (c.tid < 256) lcnt[c.tid] = 0;
    __syncthreads();
    const f32x4 bias = ((const f32x4*)rb)[lane];
    const float NINF = -__builtin_inff();
    int it = 0;
    const float* rstd = (const float*)(p.ws + WS_RSTD);
    const float* cbl = (const float*)(p.ws + WS_CB) + l * 9 * 256;
    for (int t = c.bid * NWAVES + c.wid; t < nrows; t += c.nblk * NWAVES, ++it) {
        const int bb = t < TL ? (t >> 12) : 8;
        const f32x4 lg = ((const f32x4*)(logit + (size_t)t * NE))[lane] * rstd[t] + ((const f32x4*)(cbl + bb * 256))[lane];
        const float s0 = 1.f / (1.f + __expf(-lg.x)), s1 = 1.f / (1.f + __expf(-lg.y)), s2 = 1.f / (1.f + __expf(-lg.z)), s3 = 1.f / (1.f + __expf(-lg.w));
        float m0 = s0 + bias.x, m1 = s1 + bias.y, m2 = s2 + bias.z, m3 = s3 + bias.w;
        float a1 = fmaxf(m0, m1), a2 = fminf(m0, m1);
        { const float b1 = fmaxf(m2, m3), b2 = fminf(m2, m3); const float n1 = fmaxf(a1, b1), n2 = fmaxf(fminf(a1, b1), fmaxf(a2, b2)); a1 = n1; a2 = n2; }
        { const float b1 = DPPF(a1, DPP_XOR1), b2 = DPPF(a2, DPP_XOR1); const float n1 = fmaxf(a1, b1), n2 = fmaxf(fminf(a1, b1), fmaxf(a2, b2)); a1 = n1; a2 = n2; }
        { const float b1 = DPPF(a1, DPP_XOR2), b2 = DPPF(a2, DPP_XOR2); const float n1 = fmaxf(a1, b1), n2 = fmaxf(fminf(a1, b1), fmaxf(a2, b2)); a1 = n1; a2 = n2; }
        { const float b1 = DPPF(a1, DPP_HMIR), b2 = DPPF(a2, DPP_HMIR); const float n1 = fmaxf(a1, b1), n2 = fmaxf(fminf(a1, b1), fmaxf(a2, b2)); a1 = n1; a2 = n2; }
        const float gs = a1 + a2;
        const int g = lane >> 3;
        int rank = 0;
#pragma unroll
        for (int j = 0; j < 8; ++j) { const float gj = rdlane_f(gs, j * 8); rank += ((gj > gs) || (gj == gs && j < g)) ? 1 : 0; }
        if (rank >= 4) { m0 = NINF; m1 = NINF; m2 = NINF; m3 = NINF; }
        float wsum = 0.f, my_w = 0.f; int my_e = 0;
#pragma unroll
        for (int k = 0; k < 8; ++k) {
            float bv = m0, bs = s0; int bi = 0;
            if (m1 > bv) { bv = m1; bs = s1; bi = 1; }
            if (m2 > bv) { bv = m2; bs = s2; bi = 2; }
            if (m3 > bv) { bv = m3; bs = s3; bi = 3; }
            float v = bv;
            v = fmaxf(v, DPPF(v, DPP_XOR1)); v = fmaxf(v, DPPF(v, DPP_XOR2)); v = fmaxf(v, DPPF(v, DPP_HMIR)); v = fmaxf(v, DPPF(v, DPP_MIR));
            const float wmx = fmaxf(fmaxf(rdlane_f(v, 0), rdlane_f(v, 16)), fmaxf(rdlane_f(v, 32), rdlane_f(v, 48)));
            const unsigned long long bal = __ballot(bv == wmx);
            const int win = __ffsll((long long)bal) - 1;
            const int sub = __builtin_amdgcn_readlane(bi, win);
            const float sw = rdlane_f(bs, win);
            if (lane == win) { if (sub == 0) m0 = NINF; else if (sub == 1) m1 = NINF; else if (sub == 2) m2 = NINF; else m3 = NINF; }
            wsum += sw;
            if (lane == k) { my_e = win * 4 + sub; my_w = sw; }
        }
        if (lane < 8 && it < RMAX) {
            const int lp = __hip_atomic_fetch_add(&lcnt[my_e], 1, __ATOMIC_RELAXED, __HIP_MEMORY_SCOPE_WORKGROUP);
            rec[(c.wid * RMAX + it) * 8 + lane] = (my_e << 16) | lp;
            recw[(c.wid * RMAX + it) * 8 + lane] = my_w / wsum * 2.5f;
        }
    }
    __syncthreads();
    if (c.tid < 256) { const int n = lcnt[c.tid]; lcnt[c.tid] = (n > 0) ? atomicAdd(&cnt[c.tid * CNT_STRIDE], n) : 0; }
    __syncthreads();
    it = 0;
    for (int t = c.bid * NWAVES + c.wid; t < nrows; t += c.nblk * NWAVES, ++it) {
        if (lane < 8 && it < RMAX) {
            const int r = rec[(c.wid * RMAX + it) * 8 + lane];
            const int e = r >> 16, pos = lcnt[e] + (r & 0xffff);
            list[(size_t)e * TT + pos] = t;
            slotw[(size_t)t * 8 + lane] = recw[(c.wid * RMAX + it) * 8 + lane];
            einfo[(size_t)t * 8 + lane] = (e << 16) | pos;
        }
    }
}

DI void moe_setup(const Ctx& c, int l, int nrows) {
    const int* cnt = (const int*)(c.p->ws + WS_CNT) + l * CNT_LAYER;
    LAS int* tstart = (LAS int*)(c.smem + LDS_MAIN + 1024);
    LAS int* roff = (LAS int*)(c.smem + LDS_MAIN + 2064);
    LAS int* cntl = (LAS int*)(c.smem + LDS_MAIN + 3104);
    LAS int* wtot = (LAS int*)(c.smem + LDS_MAIN + 4160);
    const int n = (c.tid < 256) ? cnt[c.tid * CNT_STRIDE] : 0;
    const int nt = (n + 255) >> 8;
    int vt = nt, vr = n;
    vt += DPPI(vt, DPP_SHR(1)); vr += DPPI(vr, DPP_SHR(1)); vt += DPPI(vt, DPP_SHR(2)); vr += DPPI(vr, DPP_SHR(2));
    vt += DPPI(vt, DPP_SHR(4)); vr += DPPI(vr, DPP_SHR(4)); vt += DPPI(vt, DPP_SHR(8)); vr += DPPI(vr, DPP_SHR(8));
    { const int t0 = __builtin_amdgcn_readlane(vt, 15), t1 = __builtin_amdgcn_readlane(vt, 31), t2 = __builtin_amdgcn_readlane(vt, 47);
      const int r0 = __builtin_amdgcn_readlane(vr, 15), r1 = __builtin_amdgcn_readlane(vr, 31), r2 = __builtin_amdgcn_readlane(vr, 47);
      const int row = c.lane >> 4;
      vt += (row > 0 ? t0 : 0) + (row > 1 ? t1 : 0) + (row > 2 ? t2 : 0); vr += (row > 0 ? r0 : 0) + (row > 1 ? r1 : 0) + (row > 2 ? r2 : 0); }
    if (c.lane == 63 && c.wid < 4) { wtot[c.wid] = vt; wtot[4 + c.wid] = vr; }
    __syncthreads();
    if (c.tid < 256) {
        int pt = 0, pr = 0;
        for (int w = 0; w < c.wid; ++w) { pt += wtot[w]; pr += wtot[4 + w]; }
        tstart[c.tid] = pt + vt - nt; roff[c.tid] = pr + vr - n; cntl[c.tid] = n;
        if (c.tid == 255) { tstart[256] = pt + vt; roff[256] = pr + vr; tstart[257] = pt + vt + nrows / 256; roff[257] = pr + vr + nrows; cntl[256] = nrows; }
    }
    __syncthreads();
}

constexpr int MOE_MAXU = 32, MOE_MAXG = 12;
template <bool GATHER_>
struct MoeSched {
    static constexpr bool GATHER = GATHER_;
    const LAS int* utab; const LAS unsigned* toks; int nmy;
    const char* A; const char* W; size_t wstride; int RB;
    DI bool next(int i, g8::Unit& u) const {
        if (i >= nmy) return false;
        const LAS int* e = utab + i * 8;
        u.pn = __builtin_amdgcn_readfirstlane(e[0]); u.e = __builtin_amdgcn_readfirstlane(e[1]); u.ti = __builtin_amdgcn_readfirstlane(e[2]);
        u.ne = __builtin_amdgcn_readfirstlane(e[3]); u.rbase = __builtin_amdgcn_readfirstlane(e[4]); u.pm = __builtin_amdgcn_readfirstlane(e[5]); u.ix = i;
        return true;
    }
    DI const char* a_base() const { return A; }
    DI unsigned a_off(const g8::Unit& u, int row) const { return toks[u.ix * 256 + row]; }
    DI const char* a_ptr(const g8::Unit& u) const { return A + (size_t)u.rbase * RB; }
    DI const char* b_base(const g8::Unit& u) const { return W + (size_t)u.e * wstride + (size_t)u.pn * 256 * RB; }
};
DI int moe_units(const Ctx& c, int NB, bool gather, const int* list, int rowbytes) {
    const LAS int* tstart = (const LAS int*)(c.smem + LDS_MAIN + 1024);
    const LAS int* roff = (const LAS int*)(c.smem + LDS_MAIN + 2064);
    const LAS int* cntl = (const LAS int*)(c.smem + LDS_MAIN + 3104);
    LAS int* utab = (LAS int*)(c.smem + LDS_MAIN + 4224);
    LAS unsigned* toks = (LAS unsigned*)(c.smem + LDS_MAIN + 8192);
    const int nunits = tstart[257] * NB;
    int nmy = (nunits > c.bid) ? (nunits - c.bid + c.nblk - 1) / c.nblk : 0;
    { const int cap = gather ? MOE_MAXG : MOE_MAXU; nmy = nmy > cap ? cap : nmy; }
    if (c.tid < nmy) {
        const int L = c.tid * c.nblk + c.bid;
        int w = L; { const int q = nunits / 8, r = nunits % 8, xcd = w % 8, off = w / 8; w = (xcd < r ? xcd * (q + 1) : r * (q + 1) + (xcd - r) * q) + off; }
        const int tile = w / NB;
        int lo = 0, hi = 256;
        while (lo < hi) { const int mid = (lo + hi + 1) >> 1; if (tstart[mid] <= tile) lo = mid; else hi = mid - 1; }
        const int ti = tile - tstart[lo];
        LAS int* e = utab + c.tid * 8;
        e[0] = w - tile * NB; e[1] = lo; e[2] = ti; e[3] = cntl[lo]; e[4] = roff[lo] + ti * 256; e[5] = tile;
    }
    __syncthreads();
    if (gather) {
        for (int idx = c.tid; idx < nmy * 256; idx += NTHREADS) {
            const LAS int* e = utab + (idx >> 8) * 8;
            const int ex = e[1], ne = e[3];
            int ridx = e[2] * 256 + (idx & 255); ridx = ridx < ne ? ridx : ne - 1;
            const int tok = (ex < 256) ? list[(size_t)ex * TT + ridx] : ridx;
            toks[idx] = (unsigned)tok * (unsigned)rowbytes;
        }
        __syncthreads();
    }
    return nmy;
}

#ifdef E1_DIRECT
struct EpiE1 {
    static constexpr bool F8 = true;
    static constexpr bool PERM = true;
    unsigned char* act;
    LAS unsigned char* stg; int tid;
    DI void operator()(const f32x4 (&acc)[2][2][4][2], const g8::Unit& u, int wr, int wc, int fr, int fq) const {
        constexpr float IS = 1.0f / W_SCALE;
#pragma unroll
        for (int ai = 0; ai < 2; ++ai)
#pragma unroll
            for (int m = 0; m < 4; ++m) {
                const int row = ai * 128 + wr * 64 + m * 16 + fr;
                if (u.ti * 256 + row < u.ne) {
#pragma unroll
                    for (int bj = 0; bj < 2; ++bj) {
                        const int col0 = u.pn * 256 + bj * 128 + wc * 32 + 8 * fq;
                        const f32x4 v0 = acc[ai][bj][m][0] * IS, v1 = acc[ai][bj][m][1] * IS;
                        const float a0 = v0[0] * __builtin_amdgcn_rcpf(1.f + __expf(-v0[0])) * v0[1], a1 = v0[2] * __builtin_amdgcn_rcpf(1.f + __expf(-v0[2])) * v0[3];
                        const float a2 = v1[0] * __builtin_amdgcn_rcpf(1.f + __expf(-v1[0])) * v1[1], a3 = v1[2] * __builtin_amdgcn_rcpf(1.f + __expf(-v1[2])) * v1[3];
                        *(unsigned*)(act + (size_t)(u.rbase + row) * FF + (col0 >> 1)) = pk4_fp8(a0 * ACT_SCALE, a1 * ACT_SCALE, a2 * ACT_SCALE, a3 * ACT_SCALE);
                    }
                }
            }
    }
};
#else
struct EpiE1 {
    static constexpr bool F8 = true;
    static constexpr bool PERM = true;
    unsigned char* act;
    LAS unsigned char* stg; int tid;
    DI void operator()(const f32x4 (&acc)[2][2][4][2], const g8::Unit& u, int wr, int wc, int fr, int fq) const {
        constexpr float IS = 1.0f / W_SCALE;
        constexpr int RS = 144;
        if (wr == 0) __builtin_amdgcn_s_barrier();
#pragma unroll
        for (int ai = 0; ai < 2; ++ai)
#pragma unroll
            for (int mh = 0; mh < 2; ++mh) {
#pragma unroll
                for (int mm = 0; mm < 2; ++mm) {
                    const int m = mh * 2 + mm;
                    LAS unsigned char* d = stg + (wr * 32 + mm * 16 + fr) * RS + wc * 16 + 4 * fq;
#pragma unroll
                    for (int bj = 0; bj < 2; ++bj) {
                        const f32x4 v0 = acc[ai][bj][m][0] * IS, v1 = acc[ai][bj][m][1] * IS;
                        const float a0 = v0[0] * __builtin_amdgcn_rcpf(1.f + __expf(-v0[0])) * v0[1], a1 = v0[2] * __builtin_amdgcn_rcpf(1.f + __expf(-v0[2])) * v0[3];
                        const float a2 = v1[0] * __builtin_amdgcn_rcpf(1.f + __expf(-v1[0])) * v1[1], a3 = v1[2] * __builtin_amdgcn_rcpf(1.f + __expf(-v1[2])) * v1[3];
                        *(LAS unsigned*)(d + bj * 64) = pk4_fp8(a0 * ACT_SCALE, a1 * ACT_SCALE, a2 * ACT_SCALE, a3 * ACT_SCALE);
                    }
                }
                asm volatile("s_waitcnt lgkmcnt(0)" ::: "memory"); __builtin_amdgcn_s_barrier(); asm volatile("" ::: "memory");
                {
                    const int rl = tid >> 3, pc = tid & 7;
                    const u32x4 v = *(const LAS u32x4*)(stg + rl * RS + pc * 16);
                    const int row = ai * 128 + (rl >> 5) * 64 + mh * 32 + (rl & 31);
                    if (u.ti * 256 + row < u.ne) *(u32x4*)(act + (size_t)(u.rbase + row) * FF + u.pn * 128 + pc * 16) = v;
                }
                asm volatile("s_waitcnt lgkmcnt(0)" ::: "memory"); __builtin_amdgcn_s_barrier(); asm volatile("" ::: "memory");
            }
        if (wr == 1) __builtin_amdgcn_s_barrier();
    }
};
#endif
DI void phase_e1(const Ctx& c, int l, int nrows) {
    const Params& p = *c.p;
    moe_setup(c, l, nrows);
    MoeSched<true> S;
    S.nmy = moe_units(c, 2, true, (const int*)(p.ws + WS_LIST), DM);
    S.utab = (const LAS int*)(c.smem + LDS_MAIN + 4224); S.toks = (const LAS unsigned*)(c.smem + LDS_MAIN + 8192);
    S.A = (const char*)(p.ws + WS_H8); S.W = (const char*)(p.ws + WS_WGU) + (size_t)l * 257 * 524288; S.wstride = 524288; S.RB = DM;
    EpiE1 E; E.act = (unsigned char*)(p.ws + WS_ACT); E.stg = (LAS unsigned char*)c.smem + LDS_MAIN + 8192 + MOE_MAXG * 1024; E.tid = c.tid;
    g8::gemm_phase((LAS unsigned char*)c.smem, c.tid, DM, S, E);
}

struct EpiE2 {
    static constexpr bool F8 = true;
    static constexpr bool PERM = true;
    unsigned char* ys;
    LAS unsigned char* stg; int tid;
    DI void operator()(const f32x4 (&acc)[2][2][4][2], const g8::Unit& u, int wr, int wc, int fr, int fq) const {
        constexpr float SC = 16.f / (ACT_SCALE * WD_SCALE);
        constexpr int RS = 272;
        if (wr == 0) __builtin_amdgcn_s_barrier();
#pragma unroll
        for (int ai = 0; ai < 2; ++ai)
#pragma unroll
            for (int mh = 0; mh < 2; ++mh) {
#pragma unroll
                for (int mm = 0; mm < 2; ++mm) {
                    const int m = mh * 2 + mm;
                    LAS unsigned char* d = stg + (wr * 32 + mm * 16 + fr) * RS + wc * 32 + 8 * fq;
#pragma unroll
                    for (int bj = 0; bj < 2; ++bj) {
                        const f32x4 v0 = acc[ai][bj][m][0] * SC, v1 = acc[ai][bj][m][1] * SC;
                        int w0 = 0, w1 = 0;
                        w0 = __builtin_amdgcn_cvt_pk_fp8_f32(v0[0], v0[1], w0, false); w0 = __builtin_amdgcn_cvt_pk_fp8_f32(v0[2], v0[3], w0, true);
                        w1 = __builtin_amdgcn_cvt_pk_fp8_f32(v1[0], v1[1], w1, false); w1 = __builtin_amdgcn_cvt_pk_fp8_f32(v1[2], v1[3], w1, true);
                        u32x2 o; o.x = (unsigned)w0; o.y = (unsigned)w1;
                        *(LAS u32x2*)(d + bj * 128) = o;
                    }
                }
                asm volatile("s_waitcnt lgkmcnt(0)" ::: "memory"); __builtin_amdgcn_s_barrier(); asm volatile("" ::: "memory");
#pragma unroll
                for (int k = 0; k < 2; ++k) {
                    const int idx = tid + k * 512, rl = idx >> 4, pc = idx & 15;
                    const u32x4 v = *(const LAS u32x4*)(stg + rl * RS + pc * 16);
                    const int row = ai * 128 + (rl >> 5) * 64 + mh * 32 + (rl & 31);
                    if (u.ti * 256 + row < u.ne) *(u32x4*)(ys + (size_t)(u.rbase + row) * DM + u.pn * 256 + pc * 16) = v;
                }
                asm volatile("s_waitcnt lgkmcnt(0)" ::: "memory"); __builtin_amdgcn_s_barrier(); asm volatile("" ::: "memory");
            }
        if (wr == 1) __builtin_amdgcn_s_barrier();
    }
};
DI void phase_e2(const Ctx& c, int l, int nrows) {
    const Params& p = *c.p;
    moe_setup(c, l, nrows);
    MoeSched<false> S;
    S.nmy = moe_units(c, 4, false, nullptr, 0);
    S.utab = (const LAS int*)(c.smem + LDS_MAIN + 4224); S.toks = (const LAS unsigned*)(c.smem + LDS_MAIN + 8192);
    S.A = (const char*)(p.ws + WS_ACT); S.W = (const char*)(p.ws + WS_WD) + (size_t)l * 257 * 262144; S.wstride = 262144; S.RB = FF;
    EpiE2 E; E.ys = (unsigned char*)(p.ws + WS_YS); E.stg = (LAS unsigned char*)c.smem + LDS_STG; E.tid = c.tid;
    g8::gemm_phase((LAS unsigned char*)c.smem, c.tid, FF, S, E);
}

DI void phase_combine(const Ctx& c, int l, int nrows, bool last) {
    const Params& p = *c.p;
    moe_setup(c, l, nrows);
    const LAS int* roff = (const LAS int*)(c.smem + LDS_MAIN + 2064);
    const unsigned char* ys = (const unsigned char*)(p.ws + WS_YS);
    const int* einfo = (const int*)(p.ws + WS_EINFO);
    const float* slotw = (const float*)(p.ws + WS_SLOTW);
    float* xbuf = (float*)(p.ws + WS_XBUF);
    bf16_t* hbuf = (bf16_t*)(p.ws + WS_HBUF);
    const float* modv = (const float*)(p.ws + WS_MOD);
    const int lane = c.lane;
    const int shared0 = roff[256];
    for (int t = c.bid * NWAVES + c.wid; t < nrows; t += c.nblk * NWAVES) {
        const int b = t < TL ? (t >> 12) : 8;
        const float* gate = modv + (size_t)(l * 9 + b) * 6144 + 5120 + 16 * lane;
        int myrow = 0; float myw = 0.f;
        if (lane < 8) { const int ei = einfo[(size_t)t * 8 + lane]; myrow = roff[ei >> 16] + (ei & 0xffff); myw = slotw[(size_t)t * 8 + lane] * (1.f / 16.f); }
        if (lane == 8) { myrow = shared0 + t; myw = 1.f / 16.f; }
        f32x4 v[4], a[4];
        {
            const u32x4 x0 = *(const u32x4*)((const bf16_t*)xbuf + (size_t)t * DM + 16 * lane), x1 = *(const u32x4*)((const bf16_t*)xbuf + (size_t)t * DM + 16 * lane + 8);
            v[0] = bf4_f32(u32x2{x0.x, x0.y}); v[1] = bf4_f32(u32x2{x0.z, x0.w}); v[2] = bf4_f32(u32x2{x1.x, x1.y}); v[3] = bf4_f32(u32x2{x1.z, x1.w});
        }
#pragma unroll
        for (int j = 0; j < 4; ++j) a[j] = f32x4{0.f, 0.f, 0.f, 0.f};
#pragma unroll
        for (int k = 0; k < 9; ++k) {
            const int row = __builtin_amdgcn_readlane(myrow, k); const float w = rdlane_f(myw, k);
            const u32x4 y = *(const u32x4*)(ys + (size_t)row * DM + 16 * lane);
#pragma unroll
            for (int j = 0; j < 4; ++j) {
                const unsigned word = (j == 0) ? y.x : (j == 1) ? y.y : (j == 2) ? y.z : y.w;
                const auto lo = __builtin_amdgcn_cvt_pk_f32_fp8((int)word, false), hi = __builtin_amdgcn_cvt_pk_f32_fp8((int)word, true);
                a[j].x += w * lo[0]; a[j].y += w * lo[1]; a[j].z += w * hi[0]; a[j].w += w * hi[1];
            }
        }
        float s = 0.f;
#pragma unroll
        for (int j = 0; j < 4; ++j) {
            const f32x4 g = *(const f32x4*)(gate + 4 * j);
            v[j] += g * a[j];
            s += (v[j].x * v[j].x + v[j].y * v[j].y) + (v[j].z * v[j].z + v[j].w * v[j].w);
        }
        const float rstd = rsqrtf(wave_sum(s) * (1.f / DM) + EPSV);
        if (last) {
            const float* gf = p.in[I_GFINAL] + 16 * lane;
#pragma unroll
            for (int j = 0; j < 4; ++j) {
                const f32x4 g = *(const f32x4*)(gf + 4 * j);
                *(f32x4*)(p.out + (size_t)t * DM + 16 * lane + 4 * j) = v[j] * rstd * g;
            }
        } else {
            const float* g = p.in[I_GMIX] + (l + 1) * 1024 + 16 * lane;
            const float* mv = modv + (size_t)((l + 1) * 9 + b) * 6144 + 16 * lane;
            u32x4 o8;
#pragma unroll
            for (int j = 0; j < 4; ++j) {
                *(u32x2*)((bf16_t*)xbuf + (size_t)t * DM + 16 * lane + 4 * j) = f32_bf4(v[j]);
                const f32x4 gg = *(const f32x4*)(g + 4 * j), shh = *(const f32x4*)(mv + 4 * j), scc = *(const f32x4*)(mv + 1024 + 4 * j);
                const f32x4 y = v[j] * rstd * gg * (1.f + scc) + shh;
                const unsigned w8 = pk4_fp8(y.x, y.y, y.z, y.w);
                if (j == 0) o8.x = w8; else if (j == 1) o8.y = w8; else if (j == 2) o8.z = w8; else o8.w = w8;
            }
            *(u32x4*)((unsigned char*)(p.ws + WS_HIN8) + (size_t)t * DM + 16 * lane) = o8;
        }
    }
}
DI void glds16(const void* g, LAS char* l) { __builtin_amdgcn_global_load_lds((const unsigned*)g, (LAS unsigned*)l, 16, 0, 0); }
#define VM_DRAIN() asm volatile("s_waitcnt vmcnt(0)" ::: "memory")
constexpr float FLASH_THR = 8.0f;
struct ModNone { DI bool active(int) const { return true; } DI void apply(int, f32x16&, f32x16&) const {} };
struct ModSwa {
    int nloc, kpos0, qpos, qmin, hi_;
    DI bool active(int j) const { if (j >= nloc) return true; const int k0 = kpos0 + 64 * j; return (k0 + 63 >= qmin - 128) && (k0 <= qmin + 31 + 128); }
    DI void apply(int j, f32x16& s0, f32x16& s1) const {
        if (j >= nloc) return;
        const int hi = hi_;
        const int kb = kpos0 + 64 * j + 4 * hi - qpos;
        const float NINF = -__builtin_inff();
#pragma unroll
        for (int r = 0; r < 16; ++r) {
            const int d = kb + (r & 3) + 8 * (r >> 2);
            if (d < -128 || d > 128) s0[r] = NINF;
            if (d + 32 < -128 || d + 32 > 128) s1[r] = NINF;
        }
    }
};
struct ModNa {
    int nloc, kr0, qr, qc, rs, cs, hi_;
    const LAS float* rpb;
    DI bool active(int j) const { if (j >= nloc) return true; const int kr = kr0 + j; return kr >= rs && kr < rs + 8; }
    DI void apply(int j, f32x16& s0, f32x16& s1) const {
        if (j >= nloc) return;
        const int hi = hi_;
        const int kr = kr0 + j;
        const LAS float* row = rpb + (kr - qr + 7) * 31 + 15 - qc;
        const float NINF = -__builtin_inff();
        float b0[16], b1[16];
#pragma unroll
        for (int r = 0; r < 16; ++r) { const int kc = 4 * hi + (r & 3) + 8 * (r >> 2); b0[r] = row[kc]; b1[r] = row[kc + 32]; }
#pragma unroll
        for (int r = 0; r < 16; ++r) {
            const int kc = 4 * hi + (r & 3) + 8 * (r >> 2);
            const bool ok0 = (kc >= cs) && (kc < cs + 16), ok1 = (kc + 32 >= cs) && (kc + 32 < cs + 16);
            s0[r] = ok0 ? s0[r] + b0[r] : NINF;
            s1[r] = ok1 ? s1[r] + b1[r] : NINF;
        }
    }
};


typedef __attribute__((ext_vector_type(8))) int v8i_f;
typedef __attribute__((ext_vector_type(4))) int v4i_f;
DI void mfma8(f32x16& d, const v8i_f& a, const v8i_f& b, const f32x16& c, int sc) {
    asm volatile("v_mfma_scale_f32_32x32x64_f8f6f4 %0, %1, %2, %3, %4, %4 op_sel_hi:[0,0,0]" : "=&v"(d) : "v"(a), "v"(b), "v"(c), "v"(sc));
}
DI void mfma8_acc(f32x16& d, const v8i_f& a, const v8i_f& b, int sc) {
    asm volatile("v_mfma_scale_f32_32x32x64_f8f6f4 %0, %1, %2, %0, %3, %3 op_sel_hi:[0,0,0]" : "+v"(d) : "v"(a), "v"(b), "v"(sc));
}
template <int DV> struct F8State { float m, l; f32x16 o[DV / 32]; f32x16 cinit; };

template <int DV, class Tok0, class Tile0, class Mod>
DI void pass8(const Ctx& c, int ki, int vrow0, int ntiles, Tok0 tok0, Tile0 vtile, Mod& mod, const v8i_f& qf, F8State<DV>& st) {
    constexpr int ND = DV / 32, STAGE = 4096 + DV * 64;
    const unsigned char* k8 = (const unsigned char*)(c.p->ws + WS_K8);
    const unsigned char* vt8 = (const unsigned char*)(c.p->ws + WS_VT8);
    LAS char* lds = (LAS char*)c.smem;
    const int lane = c.lane, r32 = c.r32, hi = c.hi, w = c.wid;
    int usc = 0x7F7F7F7F; asm volatile("" : "+v"(usc));
    const int prow = 16 * (w & 3) + (lane >> 2), pslot = lane & 3;
    const unsigned koff = (unsigned)(prow * 1024 + ki * 64 + ((pslot ^ ((prow >> 2) & 3)) << 4));
    const int vpiece = (DV == 128) ? w : (w & 3);
    const int vrow = 16 * vpiece + (lane >> 2);
    const unsigned voff = (unsigned)((vrow0 + vrow) * 64 + ((pslot ^ ((vrow >> 2) & 3)) << 4));
    auto issue = [&](int j, LAS char* stage) {
        if (w < 4) glds16(k8 + tok0(j) * 1024 + koff, stage + w * 1024);
        if (DV == 128 || w >= 4) glds16(vt8 + vtile(j) * (size_t)VT_TILE + voff, stage + 4096 + vpiece * 1024);
    };
    st.m = 0.f; st.l = 0.f;
#pragma unroll
    for (int r = 0; r < 16; ++r) st.cinit[r] = 0.f;
#pragma unroll
    for (int d = 0; d < ND; ++d)
#pragma unroll
        for (int r = 0; r < 16; ++r) st.o[d][r] = 0.f;
    issue(0, lds);
    VM_DRAIN();
    __syncthreads();
    const int f = (r32 >> 2) & 3;
    const int o_lo = r32 * 64 + (((2 * hi) ^ f) << 4), o_hi = r32 * 64 + (((2 * hi + 1) ^ f) << 4);
    for (int j = 0; j < ntiles; ++j) {
        if (j + 1 < ntiles) issue(j + 1, lds + ((j + 1) & 1) * STAGE);
        const LAS char* stage = lds + (j & 1) * STAGE;
        if (mod.active(j)) {
            v8i_f ka, kb;
            ka.lo = *(const LAS v4i_f*)(stage + o_lo); ka.hi = *(const LAS v4i_f*)(stage + o_hi);
            kb.lo = *(const LAS v4i_f*)(stage + 2048 + o_lo); kb.hi = *(const LAS v4i_f*)(stage + 2048 + o_hi);
            f32x16 s0, s1;
            mfma8(s0, ka, qf, st.cinit, usc); mfma8(s1, kb, qf, st.cinit, usc);
            v8i_f va, vb;
            va.lo = *(const LAS v4i_f*)(stage + 4096 + o_lo); va.hi = *(const LAS v4i_f*)(stage + 4096 + o_hi);
            vb.lo = *(const LAS v4i_f*)(stage + 4096 + 2048 + o_lo); vb.hi = *(const LAS v4i_f*)(stage + 4096 + 2048 + o_hi);
            asm volatile("s_nop 15\n\ts_nop 15" : "+v"(s0), "+v"(s1));
            mod.apply(j, s0, s1);
            float mx = fmaxf(fmaxf(s0[0], s0[1]), s1[0]);
            mx = fmaxf(fmaxf(mx, s1[1]), fmaxf(s0[2], s1[2]));
#pragma unroll
            for (int r = 3; r < 15; r += 2) mx = fmaxf(fmaxf(mx, s0[r]), fmaxf(s0[r + 1], fmaxf(s1[r], s1[r + 1])));
            mx = fmaxf(mx, fmaxf(s0[15], s1[15]));
            { const auto rr = __builtin_amdgcn_permlane32_swap(__float_as_uint(mx), __float_as_uint(mx), false, false); mx = fmaxf(__uint_as_float(rr[0]), __uint_as_float(rr[1])); }
            const bool seen = mx > -1e29f;
            const bool started = half_swap_sum(st.l) > 0.f;
            const bool mv = (mx > FLASH_THR) || (!started && seen);
            if (__any(mv)) {
                const float d = mv ? mx : 0.f;
                const float fs = (mv && started) ? __builtin_amdgcn_exp2f(-d) : 1.f;
                st.m += d; st.l *= fs;
                const float nm2 = -st.m;
                asm volatile("s_nop 15\n\ts_nop 15");
#pragma unroll
                for (int dd = 0; dd < ND; ++dd) asm volatile("" : "+v"(st.o[dd]));
#pragma unroll
                for (int r = 0; r < 16; ++r) { s0[r] -= d; s1[r] -= d; st.cinit[r] = nm2; }
#pragma unroll
                for (int dd = 0; dd < ND; ++dd)
#pragma unroll
                    for (int r = 0; r < 16; ++r) st.o[dd][r] *= fs;
            }
            float rs0 = 0.f, rs1 = 0.f;
#pragma unroll
            for (int r = 0; r < 16; ++r) { s0[r] = __builtin_amdgcn_exp2f(s0[r]); s1[r] = __builtin_amdgcn_exp2f(s1[r]); rs0 += s0[r]; rs1 += s1[r]; }
            st.l += rs0 + rs1;
            v8i_f pf;
#pragma unroll
            for (int idx = 0; idx < 8; ++idx) { const int r0 = (idx >> 2) * 4 + (idx & 3); pf[idx] = (int)pk4_fp8(s0[r0], s0[r0 + 8], s1[r0], s1[r0 + 8]); }
            asm volatile("s_nop 3" : "+v"(pf));
            mfma8_acc(st.o[0], va, pf, usc); mfma8_acc(st.o[1], vb, pf, usc);
            if constexpr (DV == 128) {
                va.lo = *(const LAS v4i_f*)(stage + 4096 + 4096 + o_lo); va.hi = *(const LAS v4i_f*)(stage + 4096 + 4096 + o_hi);
                vb.lo = *(const LAS v4i_f*)(stage + 4096 + 6144 + o_lo); vb.hi = *(const LAS v4i_f*)(stage + 4096 + 6144 + o_hi);
                mfma8_acc(st.o[2], va, pf, usc); mfma8_acc(st.o[3], vb, pf, usc);
            }
        }
        VM_DRAIN();
        __syncthreads();
    }
    asm volatile("s_nop 15\n\ts_nop 15");
#pragma unroll
    for (int dd = 0; dd < ND; ++dd) asm volatile("" : "+v"(st.o[dd]));
}

DI v8i_f load_q8(const Ctx& c, size_t qtok, int cb) {
    const unsigned char* q8 = (const unsigned char*)(c.p->ws + WS_Q8) + qtok * 1024 + cb * 64 + 32 * c.hi;
    v8i_f qf; qf.lo = *(const v4i_f*)q8; qf.hi = *(const v4i_f*)(q8 + 16);
    return qf;
}
template <int DV>
DI void store_o8(const F8State<DV>& st, float inv, unsigned char* __restrict__ orow, int hi) {
    const float s = inv * MIX_SCALE;
#pragma unroll
    for (int dt = 0; dt < DV / 32; ++dt)
#pragma unroll
        for (int g = 0; g < 4; ++g)
            *(unsigned*)(orow + 32 * dt + 8 * g + 4 * hi) = pk4_fp8(st.o[dt][4 * g] * s, st.o[dt][4 * g + 1] * s, st.o[dt][4 * g + 2] * s, st.o[dt][4 * g + 3] * s);
}

DI void attn_swa_item(const Ctx& c, int l, int b, int h, int qb, bool ctxq) {
    const Params& p = *c.p;
    unsigned char* mix = (unsigned char*)(p.ws + WS_MIX);
    const int kvh = h >> 1;
    const size_t qtok = ctxq ? (size_t)TL + b * CTXL + c.wid * 32 + c.r32 : (size_t)b * SEQ + qb * 256 + c.wid * 32 + c.r32;
    const v8i_f qf = load_q8(c, qtok, h);
    F8State<64> st;
    ModSwa mod; mod.hi_ = c.hi;
    int j0 = 0;
    if (ctxq) { mod.nloc = 0; mod.kpos0 = 0; }
    else { j0 = 4 * qb - 2; if (j0 < 0) j0 = 0; int j1 = 4 * qb + 5; if (j1 > 63) j1 = 63; mod.nloc = j1 - j0 + 1; mod.kpos0 = 64 * j0; }
    mod.qmin = qb * 256 + c.wid * 32; mod.qpos = mod.qmin + c.r32;
    const int nloc = mod.nloc;
    const size_t lbase = (size_t)b * SEQ + 64 * j0, cbase = (size_t)TL + b * CTXL;
    auto tok0 = [&](int j) { return j < nloc ? lbase + 64 * j : cbase + 64 * (j - nloc); };
    const size_t vt0 = (size_t)b * 68;
    auto vtile = [&](int j) { return vt0 + (j < nloc ? j0 + j : 64 + (j - nloc)); };
    pass8<64>(c, kvh, kvh * 64, nloc + 4, tok0, vtile, mod, qf, st);
    float lt = half_swap_sum(st.l);
    lt += __builtin_amdgcn_exp2f(p.in[I_SINK][l * 4 + h] * LOG2E - st.m);
    store_o8<64>(st, 1.f / lt, mix + qtok * DM + h * 64, c.hi);
}

DI void attn_na_item(const Ctx& c, int l, int b, int h, int qb, bool ctxq) {
    const Params& p = *c.p;
    unsigned char* mix = (unsigned char*)(p.ws + WS_MIX);
    LAS float* rpbl = (LAS float*)(c.smem + LDS_MAIN + 1024);
    __syncthreads();
    if (!ctxq) for (int i = c.tid; i < 465; i += NTHREADS) rpbl[i] = p.in[I_RPB][(size_t)(l * 4 + h) * 465 + i] * LOG2E;
    __syncthreads();
    const size_t qtok = ctxq ? (size_t)TL + b * CTXL + c.wid * 32 + c.r32 : (size_t)b * SEQ + qb * 256 + c.wid * 32 + c.r32;
    const v8i_f qf = load_q8(c, qtok, 4 + h);
    F8State<64> st;
    ModNa mod; mod.rpb = rpbl; mod.hi_ = c.hi;
    int kr0 = 0;
    if (ctxq) { mod.nloc = 0; mod.kr0 = 0; mod.qr = 0; mod.qc = 0; mod.rs = 0; mod.cs = 0; }
    else {
        const int r_lo = 4 * qb, r_hi = 4 * qb + 3;
        int a = r_lo - 4; a = a < 0 ? 0 : (a > 56 ? 56 : a);
        int bb = r_hi - 4; bb = bb < 0 ? 0 : (bb > 56 ? 56 : bb);
        kr0 = a; mod.kr0 = a; mod.nloc = bb + 7 - a + 1;
        mod.qr = 4 * qb + (c.wid >> 1); mod.qc = 32 * (c.wid & 1) + c.r32;
        int rs = mod.qr - 4; rs = rs < 0 ? 0 : (rs > 56 ? 56 : rs); mod.rs = rs;
        int cs = mod.qc - 8; cs = cs < 0 ? 0 : (cs > 48 ? 48 : cs); mod.cs = cs;
    }
    const int nloc = mod.nloc;
    const size_t lbase = (size_t)b * SEQ + 64 * kr0, cbase = (size_t)TL + b * CTXL;
    auto tok0 = [&](int j) { return j < nloc ? lbase + 64 * j : cbase + 64 * (j - nloc); };
    const size_t vt0 = (size_t)b * 68;
    auto vtile = [&](int j) { return vt0 + (j < nloc ? kr0 + j : 64 + (j - nloc)); };
    pass8<64>(c, 2 + h, 128 + h * 64, nloc + 4, tok0, vtile, mod, qf, st);
    const float lt = half_swap_sum(st.l);
    store_o8<64>(st, 1.f / lt, mix + qtok * DM + 256 + h * 64, c.hi);
}

DI void attn_diff_item(const Ctx& c, int l, int b, int h, int qb, bool ctxq) {
    const Params& p = *c.p;
    unsigned char* mix = (unsigned char*)(p.ws + WS_MIX);
    const size_t qtok = ctxq ? (size_t)TL + b * CTXL + c.wid * 32 + c.r32 : (size_t)b * SEQ + qb * 256 + c.wid * 32 + c.r32;
    const int nloc = ctxq ? 0 : 64;
    const size_t lbase = (size_t)b * SEQ, cbase = (size_t)TL + b * CTXL;
    auto tok0 = [&](int j) { return j < nloc ? lbase + 64 * j : cbase + 64 * (j - nloc); };
    const size_t vt0 = (size_t)b * 68;
    auto vtile = [&](int j) { return vt0 + (j < nloc ? j : 64 + (j - nloc)); };
    unsigned char* orow = mix + qtok * DM + 512 + h * 128;
    bf16_t* prow = (bf16_t*)(p.ws + WS_PARK) + qtok * 512 + h * 128;
    ModNone mod;
    F8State<128> st;
    {
        const v8i_f qf = load_q8(c, qtok, 8 + 2 * h);
        pass8<128>(c, 6 + 2 * h, 384 + h * 128, nloc + 4, tok0, vtile, mod, qf, st);
        const float inv = 1.f / half_swap_sum(st.l);
#pragma unroll
        for (int dt = 0; dt < 4; ++dt)
#pragma unroll
            for (int g = 0; g < 4; ++g) {
                u32x2 u; u.x = pk2(st.o[dt][4 * g] * inv, st.o[dt][4 * g + 1] * inv); u.y = pk2(st.o[dt][4 * g + 2] * inv, st.o[dt][4 * g + 3] * inv);
                *(u32x2*)(prow + 32 * dt + 8 * g + 4 * c.hi) = u;
            }
    }
    const v8i_f qf = load_q8(c, qtok, 8 + 2 * h + 1);
    pass8<128>(c, 6 + 2 * h + 1, 384 + h * 128, nloc + 4, tok0, vtile, mod, qf, st);
    const float lam_init = 0.8f - 0.6f * __expf(-0.3f * (float)l);
    const float d1 = wave_sum(p.in[I_LQ1][l * 64 + c.lane] * p.in[I_LK1][l * 64 + c.lane]);
    const float d2 = wave_sum(p.in[I_LQ2][l * 64 + c.lane] * p.in[I_LK2][l * 64 + c.lane]);
    const float lam = __expf(d1) - __expf(d2) + lam_init;
    const float inv2 = lam / half_swap_sum(st.l);
    float ss = 0.f;
#pragma unroll
    for (int dt = 0; dt < 4; ++dt)
#pragma unroll
        for (int g = 0; g < 4; ++g) {
            const u32x2 u = *(const u32x2*)(prow + 32 * dt + 8 * g + 4 * c.hi);
            const float a0 = bflo(u.x) - st.o[dt][4 * g] * inv2, a1 = bfhi(u.x) - st.o[dt][4 * g + 1] * inv2;
            const float a2 = bflo(u.y) - st.o[dt][4 * g + 2] * inv2, a3 = bfhi(u.y) - st.o[dt][4 * g + 3] * inv2;
            st.o[dt][4 * g] = a0; st.o[dt][4 * g + 1] = a1; st.o[dt][4 * g + 2] = a2; st.o[dt][4 * g + 3] = a3;
            ss += (a0 * a0 + a1 * a1) + (a2 * a2 + a3 * a3);
        }
    ss = half_swap_sum(ss);
    const float rn = rsqrtf(ss * (1.f / 128.f) + EPSV) * (1.f - lam_init);
    const float* sg = p.in[I_SUBLN] + l * 128;
#pragma unroll
    for (int dt = 0; dt < 4; ++dt)
#pragma unroll
        for (int g = 0; g < 4; ++g) {
            const f32x4 gg = *(const f32x4*)(sg + 32 * dt + 8 * g + 4 * c.hi);
            const float rs = rn * MIX_SCALE;
            *(unsigned*)(orow + 32 * dt + 8 * g + 4 * c.hi) = pk4_fp8(st.o[dt][4 * g] * rs * gg.x, st.o[dt][4 * g + 1] * rs * gg.y, st.o[dt][4 * g + 2] * rs * gg.z, st.o[dt][4 * g + 3] * rs * gg.w);
        }
}

DI void attn_decode(int it, int& b, int& h, int& qb, bool& ctxq) {
    if (it < 512) {
        const int xcd = it & 7, j = it >> 3;
        const int bh = xcd * 4 + (j >> 4); qb = j & 15;
        b = bh >> 2; h = bh & 3; ctxq = false;
    } else {
        const int i = it - 512;
        qb = 0; h = i & 3; b = i >> 2; ctxq = true;
    }
}
DI Ctx reopaque(const Ctx& c) {
    Ctx d = c; int t = c.tid; asm volatile("" : "+v"(t));
    d.tid = t; d.lane = t & 63; d.wid = __builtin_amdgcn_readfirstlane(t >> 6); d.r32 = t & 31; d.hi = (t >> 5) & 1;
    return d;
}
DI void phase_attn0_convert(const Ctx& c) {
    int* actr = (int*)(c.p->ws + WS_ROWCTR) + 128;
    int* cctr = (int*)(c.p->ws + WS_ROWCTR) + 192;
    LAS int* slot = (LAS int*)(c.smem + LDS_MAIN + 64);
    constexpr int NIT = 544, NATT = 3 * NIT;
    const bool prefer_conv = (c.bid & 1) != 0;
    for (;;) {
        if (c.tid == 0) {
            int k = -1, v = 0;
            if (prefer_conv) {
                v = atomicAdd(cctr, 1); if (v < CONV_NCHUNK) k = 1;
                if (k < 0) { v = atomicAdd(actr, 1); if (v < NATT) k = 0; }
            } else {
                v = atomicAdd(actr, 1); if (v < NATT) k = 0;
                if (k < 0) { v = atomicAdd(cctr, 1); if (v < CONV_NCHUNK) k = 1; }
            }
            slot[0] = k; slot[1] = v;
        }
        __syncthreads();
        const int kind = slot[0], idx = slot[1];
        __syncthreads();
        if (kind < 0) break;
        if (kind == 1) {
            convert_pairs(reopaque(c), idx * CONV_CHUNK, 1, CONV_CHUNK, [](int q) { return rmap_expert(q); });
        } else {
            const int grp = idx / NIT, it = idx - grp * NIT;
            int b, h, qb; bool ctxq; attn_decode(it, b, h, qb, ctxq);
            if (grp == 0) attn_diff_item(reopaque(c), 0, b, h, qb, ctxq);
            else if (grp == 1) attn_swa_item(reopaque(c), 0, b, h, qb, ctxq);
            else attn_na_item(reopaque(c), 0, b, h, qb, ctxq);
        }
    }
}
DI void phase_attn(const Ctx& c, int l) {
    const int NIT = 512 + ((l == 0) ? 32 : 0);
    for (int it = c.bid; it < NIT; it += c.nblk) { int b, h, qb; bool ctxq; attn_decode(it, b, h, qb, ctxq); attn_diff_item(c, l, b, h, qb, ctxq); }
    for (int it = c.bid; it < NIT; it += c.nblk) { int b, h, qb; bool ctxq; attn_decode(it, b, h, qb, ctxq); attn_swa_item(c, l, b, h, qb, ctxq); }
    for (int it = c.bid; it < NIT; it += c.nblk) { int b, h, qb; bool ctxq; attn_decode(it, b, h, qb, ctxq); attn_na_item(c, l, b, h, qb, ctxq); }
}
#ifndef WAVES_PER_SIMD
#define WAVES_PER_SIMD 2
#endif
#ifndef PROBE_REP
#define PROBE_REP 0
#endif
#ifndef DBG_MODE
#define DBG_MODE 0
#endif
DI Ctx mkctx(const Params& p, char* smem, int wave_s) {
    Ctx c; c.p = &p; c.smem = smem;
    int t = wave_s * 64 + (int)__builtin_amdgcn_mbcnt_hi(~0u, __builtin_amdgcn_mbcnt_lo(~0u, 0u)); asm volatile("" : "+v"(t));
    c.tid = t; c.lane = t & 63; c.wid = __builtin_amdgcn_readfirstlane(t >> 6); c.r32 = t & 31; c.hi = (t >> 5) & 1;
    int b = blockIdx.x, n = gridDim.x; asm volatile("" : "+s"(b), "+s"(n));
    c.bid = b; c.nblk = n;
    return c;
}
__global__ void __launch_bounds__(NTHREADS, WAVES_PER_SIMD) mega(Params p) {
    extern __shared__ __attribute__((aligned(16))) char smem[];
    Ctx c; c.p = &p; c.smem = smem; c.tid = threadIdx.x; c.lane = c.tid & 63; c.wid = c.tid >> 6; c.r32 = c.lane & 31; c.hi = c.lane >> 5;
    c.bid = blockIdx.x; c.nblk = gridDim.x;
    const int wave_s = __builtin_amdgcn_readfirstlane((int)threadIdx.x >> 6);
#define FRESH() mkctx(p, smem, wave_s)
#define GRID_SYNC() do { XcdBarrier bb_ = bar; asm volatile("" : "+s"(bb_.bar), "+s"(bb_.x)); xcd_barrier(bb_); } while (0)
    volatile LAS unsigned* xbw = (volatile LAS unsigned*)(smem + LDS_MAIN);
    if (c.tid == 0) { xbw[0] = 0u; xbw[1] = 0u; xbw[2] = 0u; xbw[3] = 0u; }
    __syncthreads();
    XcdBarrier bar = xcd_barrier_post((unsigned*)(p.ws + WS_BAR), xbw);
    asm volatile("; PHASE_MARK prologue" ::: "memory");
    phase_prologue(FRESH());
    GRID_SYNC();
#if PROBE_REP == 1
    asm volatile("; PHASE_MARK prologue" ::: "memory");
    phase_prologue(FRESH());
    GRID_SYNC();
#endif
    asm volatile("; PHASE_MARK norm" ::: "memory");
    phase_norm(FRESH(), 0, TT, true, 0);
    wrp_items(FRESH());
    GRID_SYNC();
#if PROBE_REP == 9
    phase_norm(FRESH(), 0, TT, true, 0);
    GRID_SYNC();
#endif
#if PROBE_REP == 13
#pragma unroll 1
    for (int z = 0; z < 20; ++z) { GRID_SYNC(); }
#endif
#pragma unroll 1
    for (int l = 0; l < 2; ++l) {
        const bool last = (l == 1);
        const int nrows = last ? TL : TT;
        asm volatile("; PHASE_MARK inproj" ::: "memory");
        asm volatile("; PHASE_MARK inproj" ::: "memory");
    phase_inproj(FRESH(), l);
        GRID_SYNC();
#if PROBE_REP == 2
        asm volatile("; PHASE_MARK inproj" ::: "memory");
        asm volatile("; PHASE_MARK inproj" ::: "memory");
    phase_inproj(FRESH(), l);
        GRID_SYNC();
#endif
        asm volatile("; PHASE_MARK attn" ::: "memory");
        asm volatile("; PHASE_MARK attn" ::: "memory");
        if (l == 0) phase_attn0_convert(FRESH()); else phase_attn(FRESH(), l);
        GRID_SYNC();
#if PROBE_REP == 3
        asm volatile("; PHASE_MARK attn" ::: "memory");
        asm volatile("; PHASE_MARK attn" ::: "memory");
    phase_attn(FRESH(), l);
        GRID_SYNC();
#endif
        asm volatile("; PHASE_MARK outproj" ::: "memory");
        asm volatile("; PHASE_MARK outproj" ::: "memory");
    phase_outproj(FRESH(), l, nrows);
        GRID_SYNC();
#if PROBE_REP == 7
        if (l == 0) { phase_outproj(FRESH(), l, nrows); GRID_SYNC(); }
#endif
#if DBG_MODE != 1
        asm volatile("; PHASE_MARK router" ::: "memory");
    phase_norm_router(FRESH(), l, nrows);
        GRID_SYNC();
        asm volatile("; PHASE_MARK route" ::: "memory");
        asm volatile("; PHASE_MARK route" ::: "memory");
    phase_route(FRESH(), l, nrows);
        GRID_SYNC();
        asm volatile("; PHASE_MARK e1" ::: "memory");
        asm volatile("; PHASE_MARK e1" ::: "memory");
    phase_e1(FRESH(), l, nrows);
        GRID_SYNC();
#if PROBE_REP == 4
        asm volatile("; PHASE_MARK e1" ::: "memory");
        asm volatile("; PHASE_MARK e1" ::: "memory");
    phase_e1(FRESH(), l, nrows);
        GRID_SYNC();
#endif
        asm volatile("; PHASE_MARK e2" ::: "memory");
        asm volatile("; PHASE_MARK e2" ::: "memory");
    phase_e2(FRESH(), l, nrows);
        GRID_SYNC();
#if PROBE_REP == 5
        asm volatile("; PHASE_MARK e2" ::: "memory");
        asm volatile("; PHASE_MARK e2" ::: "memory");
    phase_e2(FRESH(), l, nrows);
        GRID_SYNC();
#endif
#endif
        asm volatile("; PHASE_MARK combine" ::: "memory");
        asm volatile("; PHASE_MARK combine" ::: "memory");
    phase_combine(FRESH(), l, nrows, last);
#if PROBE_REP == 8
        if (last) { GRID_SYNC(); phase_combine(FRESH(), l, nrows, last); }
#endif
        if (!last) { GRID_SYNC(); }
    }
}

extern "C" void kernel_launch(void* const* d_in, const int* in_sizes, int n_in, void* d_out, int out_size, void* d_ws, size_t ws_size, hipStream_t stream) {
    static int grid = 0;
    if (grid == 0) {
        int dev = 0, cus = 0, per_cu = 0;
        if (n_in != 26 || ws_size < WS_END) { fprintf(stderr, "kernel_launch: unexpected n_in %d / ws %zu (need %zu)\n", n_in, ws_size, (size_t)WS_END); grid = -1; return; }
        if (hipGetDevice(&dev) != hipSuccess || hipDeviceGetAttribute(&cus, hipDeviceAttributeMultiprocessorCount, dev) != hipSuccess) { grid = -1; return; }
        if (hipFuncSetAttribute((const void*)mega, hipFuncAttributeMaxDynamicSharedMemorySize, LDS_BYTES) != hipSuccess) { grid = -1; return; }
        if (hipOccupancyMaxActiveBlocksPerMultiprocessor(&per_cu, (const void*)mega, NTHREADS, LDS_BYTES) != hipSuccess || per_cu < 1) per_cu = 1;
        (void)hipGetLastError();
        grid = cus;
    }
    if (grid < 0) return;
    (void)hipMemsetAsync((char*)d_ws + WS_BAR, 0, WS_ZERO_BYTES, stream);
    Params p{};
    for (int i = 0; i < 26; ++i) p.in[i] = (const float*)d_in[i];
    p.out = (float*)d_out; p.ws = (unsigned char*)d_ws;
    hipLaunchKernelGGL(mega, dim3(grid), dim3(NTHREADS), LDS_BYTES, stream, p);
}
```

```cpp
#include <hip/hip_runtime.h>
#include <hip/hip_bf16.h>
#include <cstdio>
#include <cstdint>

#define XB_TMO      128
#define XB_XCNT(j)  (256  + 64 * (j))
#define XB_XSUB(j)  (1280 + 64 * (j))
#define XB_XGEN(j)  (2304 + 64 * (j))
#define XB_TOP      3328
#define XB_TOPGEN   3392
#define XCD_BAR_WORDS 3456
#define XB_SPIN_CAP (1u << 22)
#define LAS __attribute__((address_space(3)))

__device__ __forceinline__ unsigned xb_ld(unsigned* p)              { return __hip_atomic_load(p, __ATOMIC_RELAXED, __HIP_MEMORY_SCOPE_AGENT); }
__device__ __forceinline__ unsigned xb_add(unsigned* p, unsigned v) { return __hip_atomic_fetch_add(p, v, __ATOMIC_RELAXED, __HIP_MEMORY_SCOPE_AGENT); }
__device__ __forceinline__ unsigned xb_xcc_id() { return (unsigned)__builtin_amdgcn_s_getreg((3 << 11) | 20) & 0xFu; }
#define XB_SPIN(cond, bar) do { unsigned _sp = 0; while (cond) { __builtin_amdgcn_s_sleep(1); \
    if ((++_sp & 255u) == 0u) { if (xb_ld(&(bar)[XB_TMO])) break; if (_sp > XB_SPIN_CAP) { atomicAdd(&(bar)[XB_TMO], 1u); break; } } } } while (0)

struct XcdBarrier {
    unsigned* bar; unsigned x;
    volatile LAS unsigned* st;
};

__device__ __forceinline__ XcdBarrier xcd_barrier_post(unsigned* bar, volatile LAS unsigned* st) {
    XcdBarrier b; b.bar = bar; b.x = xb_xcc_id(); b.st = st;
    if (threadIdx.x == 0) (void)xb_add(&bar[XB_XCNT(b.x)], 1u);
    return b;
}
__device__ __forceinline__ void xcd_barrier_complete(unsigned* bar, unsigned x, unsigned& nloc, unsigned& nx) {
    const unsigned G = gridDim.x * gridDim.y * gridDim.z;
    unsigned sum, cnt, mine, sp = 0u;
    for (;;) {
        sum = 0u; cnt = 0u; mine = 0u;
#pragma unroll
        for (unsigned j = 0; j < 16; ++j) { const unsigned c = xb_ld(&bar[XB_XCNT(j)]); sum += c; cnt += (c > 0u) ? 1u : 0u; mine = (j == x) ? c : mine; }
        if (sum == G) break;
        __builtin_amdgcn_s_sleep(1);
        if ((++sp & 255u) == 0u) { if (xb_ld(&bar[XB_TMO])) break; if (sp > XB_SPIN_CAP) { atomicAdd(&bar[XB_TMO], 1u); break; } }
    }
    nloc = mine > 0u ? mine : 1u; nx = cnt > 0u ? cnt : 1u;
}

__device__ __forceinline__ void xcd_barrier(const XcdBarrier& b) {
    asm volatile("s_waitcnt vmcnt(0)" ::: "memory");
    __syncthreads();
    if (threadIdx.x == 0) {
        unsigned* bar = b.bar;
        __builtin_amdgcn_s_waitcnt(0);
        unsigned nloc = b.st[0], nx = b.st[1];
        if (nloc == 0u) { xcd_barrier_complete(bar, b.x, nloc, nx); b.st[0] = nloc; b.st[1] = nx; }
        const unsigned old = xb_add(&bar[XB_XSUB(b.x)], 1u);
        const unsigned gen = old / nloc;
        if (old + 1u == (gen + 1u) * nloc) {
            __builtin_amdgcn_fence(__ATOMIC_RELEASE, "agent");
            asm volatile("s_waitcnt vmcnt(0)" ::: "memory");
            const unsigned og = xb_add(&bar[XB_TOP], 1u);
            const unsigned tg = og / nx;
            if (og + 1u == (tg + 1u) * nx) xb_add(&bar[XB_TOPGEN], 1u);
            else XB_SPIN(xb_ld(&bar[XB_TOPGEN]) == tg, bar);
            __builtin_amdgcn_fence(__ATOMIC_ACQUIRE, "agent");
            xb_add(&bar[XB_XGEN(b.x)], 1u);
            asm volatile("s_waitcnt vmcnt(0)" ::: "memory");
        } else {
            XB_SPIN(xb_ld(&bar[XB_XGEN(b.x)]) == gen, bar);
            __builtin_amdgcn_fence(__ATOMIC_ACQUIRE, "agent");
            asm volatile("s_waitcnt vmcnt(0)" ::: "memory");
        }
    }
    __syncthreads();
}

constexpr int DM = 1024, NB = 8, SEQ = 4096, CTXL = 256;
constexpr int TL = NB * SEQ;
constexpr int TC = NB * CTXL;
constexpr int TT = TL + TC;
constexpr int INC = 2816, QC = 1024, KVC = 1792;
constexpr int NE = 256, NEX = 257, FF = 256;
constexpr float EPSV = 1e-6f;
constexpr float LOG2E = 1.4426950408889634f;
constexpr float QSCALE = 0.125f * LOG2E;
constexpr float MIX_SCALE = 4.0f, W_SCALE = 32.0f, WD_SCALE = 16.0f, ACT_SCALE = 2.0f;
constexpr int NTHREADS = 512;
constexpr int NWAVES = 8;
constexpr int LDS_MAIN = 131072;
constexpr int LDS_AUX = 8192 + 16384 + 8192;
constexpr int LDS_BYTES = LDS_MAIN + LDS_AUX;
constexpr int LDS_STG = LDS_MAIN + 8192;
static_assert(LDS_BYTES <= 163840, "LDS");

typedef unsigned short bf16_t;
typedef __attribute__((ext_vector_type(8))) short bf16x8;
typedef __attribute__((ext_vector_type(4))) short s16x4;
typedef __attribute__((ext_vector_type(16))) float f32x16;
typedef __attribute__((ext_vector_type(2))) float f32x2;
typedef __attribute__((ext_vector_type(2))) __bf16 bf16x2v;
typedef short v4i16_t __attribute__((ext_vector_type(4)));
typedef __attribute__((ext_vector_type(4))) unsigned u32x4;
typedef __attribute__((ext_vector_type(2))) unsigned u32x2;
typedef __attribute__((ext_vector_type(4))) float f32x4;
#define DI __device__ __forceinline__
#define MFMA32(a, b, c) __builtin_amdgcn_mfma_f32_32x32x16_bf16((a), (b), (c), 0, 0, 0)

DI unsigned pk2(float lo, float hi) { f32x2 v = {lo, hi}; bf16x2v b = __builtin_convertvector(v, bf16x2v); return __builtin_bit_cast(unsigned, b); }
DI unsigned pk4_fp8(float a, float b, float c, float d) { int w = 0; w = __builtin_amdgcn_cvt_pk_fp8_f32(a, b, w, false); w = __builtin_amdgcn_cvt_pk_fp8_f32(c, d, w, true); return (unsigned)w; }
DI float bf2f(bf16_t u) { return __uint_as_float(((unsigned)u) << 16); }
DI float bflo(unsigned u) { return __uint_as_float(u << 16); }
DI float bfhi(unsigned u) { return __uint_as_float(u & 0xffff0000u); }
DI f32x4 bf4_f32(u32x2 w) { return f32x4{bflo(w.x), bfhi(w.x), bflo(w.y), bfhi(w.y)}; }
DI u32x2 f32_bf4(f32x4 v) { u32x2 o; o.x = pk2(v[0], v[1]); o.y = pk2(v[2], v[3]); return o; }
DI int crow(int reg, int hi) { return (reg & 3) + 8 * (reg >> 2) + 4 * hi; }
#define DPPI(v, CTRL) __builtin_amdgcn_update_dpp(0, (v), (CTRL), 0xf, 0xf, true)
#define DPPF(v, CTRL) __builtin_bit_cast(float, __builtin_amdgcn_update_dpp(0, __builtin_bit_cast(int, (v)), (CTRL), 0xf, 0xf, true))
#define DPP_XOR1 0xB1
#define DPP_XOR2 0x4E
#define DPP_HMIR 0x141
#define DPP_MIR  0x140
#define DPP_SHR(n) (0x110 + (n))
DI float rdlane_f(float v, int l) { return __builtin_bit_cast(float, __builtin_amdgcn_readlane(__builtin_bit_cast(int, v), l)); }
DI float wave_sum(float v) {
    v += DPPF(v, DPP_XOR1); v += DPPF(v, DPP_XOR2); v += DPPF(v, DPP_HMIR); v += DPPF(v, DPP_MIR);
    return (rdlane_f(v, 0) + rdlane_f(v, 16)) + (rdlane_f(v, 32) + rdlane_f(v, 48));
}
DI float half_swap_sum(float v) {
    const auto rr = __builtin_amdgcn_permlane32_swap(__float_as_uint(v), __float_as_uint(v), false, false);
    return __uint_as_float(rr[0]) + __uint_as_float(rr[1]);
}
DI float siluf(float v) { return v / (1.f + __expf(-v)); }

struct Params {
    const float* in[26];
    float* out;
    unsigned char* ws;
};
enum { I_X = 0, I_C, I_CTX, I_CCTX, I_WMOD, I_BMOD, I_GMIX, I_GFFN, I_WIN, I_WOUT, I_SINK, I_RPB, I_LQ1, I_LK1, I_LQ2, I_LK2, I_SUBLN,
       I_WR, I_RB, I_WG, I_WU, I_WD, I_SG, I_SU, I_SD, I_GFINAL };

constexpr size_t MiB = 1u << 20;
constexpr size_t WS_BAR = 0;
constexpr size_t WS_CNT = 16384;
constexpr int CNT_STRIDE = 64, CNT_LAYER = 257 * 64;
constexpr size_t WS_ZERO_BYTES = 163840;
constexpr size_t WS_ROPE = 196608;
constexpr size_t WS_MOD = 262144;
constexpr size_t WS_WIN = 1 * MiB;
constexpr size_t WS_WOUT = 12 * MiB;
constexpr size_t WS_WR = 16 * MiB;
constexpr size_t WS_WGU = 17 * MiB;
constexpr size_t WS_WD = WS_WGU + 514 * MiB;
constexpr size_t WS_XBUF = WS_WD + 257 * MiB;
constexpr size_t WS_HBUF = WS_XBUF + 136 * MiB;
constexpr size_t WS_SLOTW = WS_HBUF + 68 * MiB;
constexpr size_t WS_LIST = WS_SLOTW + 2 * MiB;
constexpr size_t WS_R = WS_LIST + 34 * MiB;
constexpr size_t WS_Q = WS_R;
constexpr size_t WS_KV = WS_R + 68 * MiB;
constexpr size_t WS_MIX = WS_R + 187 * MiB;
constexpr size_t WS_PARK = WS_R + 221 * MiB;
constexpr size_t WS_Q8 = WS_R + 290 * MiB;
constexpr size_t WS_K8 = WS_R + 324 * MiB;
constexpr size_t WS_VT8 = WS_R + 358 * MiB;
constexpr int VT_ROWS = 896, VT_TILE = 896 * 64;
constexpr size_t WS_LOGIT = WS_R + 256 * MiB;
constexpr size_t WS_ACT = WS_R;
constexpr size_t WS_HIN8 = WS_WGU + 300 * MiB;
constexpr size_t WS_H8 = WS_R + 80 * MiB;
constexpr size_t WS_YS = WS_R + 153 * MiB;
constexpr size_t WS_EINFO = WS_R + 512 * MiB;
constexpr size_t WS_WRP = WS_R + 460 * MiB;
constexpr size_t WS_CB = WS_R + 470 * MiB;
constexpr size_t WS_RSTD = WS_R + 471 * MiB;
constexpr size_t WS_ROWCTR = 151552;
constexpr size_t WS_END = WS_YS + 612 * MiB;
static_assert(WS_END <= 2048 * MiB, "workspace");

struct Ctx {
    const Params* p;
    char* smem;
    int tid, lane, wid, r32, hi;
    int bid, nblk;
};
DI int map_row(int type, int n) {
    if (type == 1) {
        const int hb = n >> 6, d = n & 63;
        const bool roped = (hb < 4) || (hb >= 8 && hb < 16) || (hb == 16) || (hb == 17) || (hb >= 28 && hb < 36);
        int d2 = d;
        if (roped) d2 = (d < 16) ? 2 * d : (d < 32) ? 2 * (d - 16) + 1 : (d < 48) ? 2 * (d - 16) : 2 * (d - 32) + 1;
        return (hb << 6) | d2;
    }
    if (type == 2) return 2 * n;
    if (type == 3) return 2 * n + 1;
    return n;
}

struct TItem { const float* W; int K, N, kt, nt, type; void* dst; bool f8; float ws; };
DI void tload(const Ctx& c, float (&v)[4][2][8], const TItem& it) {
    const int wid4 = c.wid & 3;
    const int k0 = it.kt * 128, n0 = it.nt * 128;
#pragma unroll
    for (int cc = 0; cc < 4; ++cc) {
        const int kc = 4 * wid4 + cc;
#pragma unroll
        for (int j = 0; j < 8; ++j)
#pragma unroll
            for (int i = 0; i < 2; ++i) v[cc][i][j] = it.W[(size_t)(k0 + kc * 8 + j) * it.N + n0 + c.lane + 64 * i];
    }
}
DI void tfinish(const Ctx& c, const float (&v)[4][2][8], const TItem& it) {
    LAS char* lds = (LAS char*)c.smem + (c.tid >> 8) * 36864;
    const int wid4 = c.wid & 3, tid8 = c.tid & 255;
    const int k0 = it.kt * 128, n0 = it.nt * 128, K = it.K;
    const float wscale = it.ws;
#pragma unroll
    for (int cc = 0; cc < 4; ++cc) {
        const int kc = 4 * wid4 + cc;
#pragma unroll
        for (int i = 0; i < 2; ++i) {
            if (it.f8) {
                u32x2 u; u.x = pk4_fp8(v[cc][i][0] * wscale, v[cc][i][1] * wscale, v[cc][i][2] * wscale, v[cc][i][3] * wscale); u.y = pk4_fp8(v[cc][i][4] * wscale, v[cc][i][5] * wscale, v[cc][i][6] * wscale, v[cc][i][7] * wscale);
                *(LAS u32x2*)(lds + (c.lane + 64 * i) * 144 + kc * 8) = u;
            } else {
                u32x4 u; u.x = pk2(v[cc][i][0], v[cc][i][1]); u.y = pk2(v[cc][i][2], v[cc][i][3]); u.z = pk2(v[cc][i][4], v[cc][i][5]); u.w = pk2(v[cc][i][6], v[cc][i][7]);
                *(LAS u32x4*)(lds + (c.lane + 64 * i) * 272 + kc * 16) = u;
            }
        }
    }
    __syncthreads();
    if (it.f8) {
        unsigned char* dst = (unsigned char*)it.dst;
#pragma unroll
        for (int j = 0; j < 4; ++j) {
            const int idx = tid8 + 256 * j, c16 = idx & 7, n = idx >> 3;
            const u32x4 u = *(LAS u32x4*)(lds + n * 144 + c16 * 16);
            const int row = map_row(it.type, n0 + n);
            *(u32x4*)(dst + (size_t)row * K + k0 + c16 * 16) = u;
        }
    } else {
        bf16_t* dst = (bf16_t*)it.dst;
#pragma unroll
        for (int j = 0; j < 8; ++j) {
            const int idx = tid8 + 256 * j, c16 = idx & 15, n = idx >> 4;
            const u32x4 u = *(LAS u32x4*)(lds + n * 272 + c16 * 16);
            const int row = map_row(it.type, n0 + n);
            *(u32x4*)(dst + (size_t)row * K + k0 + c16 * 8) = u;
        }
    }
    __syncthreads();
}

DI void mod_item(const Ctx& c, int l, int cg) {
    const Params& p = *c.p;
    LAS float* sv = (LAS float*)c.smem;
    LAS float* part = (LAS float*)(c.smem + 36864);
    for (int idx = c.tid; idx < 9 * 1024; idx += NTHREADS) {
        const int b = idx >> 10, k = idx & 1023;
        const float v = (b < 8) ? p.in[I_C][b * 1024 + k] : p.in[I_CCTX][k];
        sv[idx] = siluf(v);
    }
    __syncthreads();
    const int col = c.tid & 63, kq = c.tid >> 6;
    float acc[9];
#pragma unroll
    for (int b = 0; b < 9; ++b) acc[b] = 0.f;
    const float* wp = p.in[I_WMOD] + ((size_t)l * 1024 + kq * 128) * 6144 + cg * 64 + col;
    for (int k = 0; k < 128; k += 8) {
        float w[8];
#pragma unroll
        for (int u = 0; u < 8; ++u) w[u] = wp[(size_t)(k + u) * 6144];
#pragma unroll
        for (int u = 0; u < 8; ++u)
#pragma unroll
            for (int b = 0; b < 9; ++b) acc[b] += sv[b * 1024 + kq * 128 + k + u] * w[u];
    }
#pragma unroll
    for (int b = 0; b < 9; ++b) part[(kq * 9 + b) * 64 + col] = acc[b];
    __syncthreads();
    float* modv = (float*)(p.ws + WS_MOD);
    for (int idx = c.tid; idx < 576; idx += NTHREADS) {
        const int b = idx >> 6, cl = idx & 63;
        float s = 0.f;
#pragma unroll
        for (int q = 0; q < 8; ++q) s += part[(q * 9 + b) * 64 + cl];
        modv[(size_t)(l * 9 + b) * 6144 + cg * 64 + cl] = s + p.in[I_BMOD][l * 6144 + cg * 64 + cl];
    }
    __syncthreads();
}

DI void rope_item(const Ctx& c) {
    float2* tab = (float2*)(c.p->ws + WS_ROPE);
    for (int idx = c.tid; idx < 1024; idx += NTHREADS) {
        const int pos = idx >> 4, i = idx & 15;
        const float inv = 1.0f / powf(10000.0f, (float)i / 16.0f);
        const float ang = (float)pos * inv;
        float sn, cs; sincosf(ang, &sn, &cs);
        tab[idx] = make_float2(cs, sn);
    }
}

constexpr int PRO_PER_LAYER = 12592;
DI TItem transpose_decode(const Ctx& c, int r) {
    const Params& p = *c.p;
    const int l = r / PRO_PER_LAYER; r -= l * PRO_PER_LAYER;
    unsigned char* wgu = (unsigned char*)(p.ws + WS_WGU) + (size_t)l * 257 * 524288;
    unsigned char* wd = (unsigned char*)(p.ws + WS_WD) + (size_t)l * 257 * 262144;
    TItem t; t.f8 = true; t.ws = W_SCALE;
    if (r < 4096) { const int e = r >> 4, s = r & 15; t.W = p.in[I_WG] + (size_t)(l * 256 + e) * 262144; t.K = 1024; t.N = 256; t.kt = s >> 1; t.nt = s & 1; t.dst = wgu + (size_t)e * 524288; t.type = 2; }
    else if (r < 8192) { r -= 4096; const int e = r >> 4, s = r & 15; t.W = p.in[I_WU] + (size_t)(l * 256 + e) * 262144; t.K = 1024; t.N = 256; t.kt = s >> 1; t.nt = s & 1; t.dst = wgu + (size_t)e * 524288; t.type = 3; }
    else if (r < 12288) { r -= 8192; const int e = r >> 4, s = r & 15; t.W = p.in[I_WD] + (size_t)(l * 256 + e) * 262144; t.K = 256; t.N = 1024; t.kt = s >> 3; t.nt = s & 7; t.dst = wd + (size_t)e * 262144; t.type = 0; t.ws = WD_SCALE; }
    else {
        r -= 12288;
        if (r < 176) { t.W = p.in[I_WIN] + (size_t)l * 1024 * 2816; t.K = 1024; t.N = 2816; t.kt = r / 22; t.nt = r % 22; t.dst = (unsigned char*)(p.ws + WS_WIN) + (size_t)l * 2816 * 1024; t.type = 1; }
        else if (r < 240) { r -= 176; t.W = p.in[I_WOUT] + (size_t)l * 1048576; t.K = 1024; t.N = 1024; t.kt = r >> 3; t.nt = r & 7; t.dst = (unsigned char*)(p.ws + WS_WOUT) + (size_t)l * 1048576; t.type = 0; }
        else if (r < 256) { r -= 240; t.W = p.in[I_WR] + (size_t)l * 262144; t.K = 1024; t.N = 256; t.kt = r >> 1; t.nt = r & 1; t.dst = (bf16_t*)(p.ws + WS_WR) + (size_t)l * 262144; t.type = 0; t.f8 = false; }
        else if (r < 272) { r -= 256; t.W = p.in[I_SG] + (size_t)l * 262144; t.K = 1024; t.N = 256; t.kt = r >> 1; t.nt = r & 1; t.dst = wgu + (size_t)256 * 524288; t.type = 2; }
        else if (r < 288) { r -= 272; t.W = p.in[I_SU] + (size_t)l * 262144; t.K = 1024; t.N = 256; t.kt = r >> 1; t.nt = r & 1; t.dst = wgu + (size_t)256 * 524288; t.type = 3; }
        else { r -= 288; t.W = p.in[I_SD] + (size_t)l * 262144; t.K = 256; t.N = 1024; t.kt = r >> 3; t.nt = r & 7; t.dst = wd + (size_t)256 * 262144; t.type = 0; t.ws = WD_SCALE; }
    }
    return t;
}
template <class RMap>
DI void convert_pairs(const Ctx& c, int first, int stride, int n, RMap rmap) {
    if (n <= 0) return;
    const int half = c.tid >> 8;
    float va[4][2][8], vb[4][2][8];
    TItem ia = transpose_decode(c, rmap(first) + half), ib = ia;
    tload(c, va, ia);
    int i = 0;
    for (;;) {
        const bool m1 = i + 1 < n;
        if (m1) { ib = transpose_decode(c, rmap(first + (i + 1) * stride) + half); tload(c, vb, ib); }
        tfinish(c, va, ia);
        if (!m1) break;
        ++i;
        const bool m2 = i + 1 < n;
        if (m2) { ia = transpose_decode(c, rmap(first + (i + 1) * stride) + half); tload(c, va, ia); }
        tfinish(c, vb, ib);
        if (!m2) break;
        ++i;
    }
}
constexpr int PRO_EXPERT = 12288, PRO_SMALL = PRO_PER_LAYER - PRO_EXPERT;
constexpr int CONV_CHUNK = 8, CONV_NCHUNK = 2 * PRO_EXPERT / 2 / CONV_CHUNK;
DI int rmap_small(int q) { const int l = q / (PRO_SMALL / 2), s = q - l * (PRO_SMALL / 2); return l * PRO_PER_LAYER + PRO_EXPERT + 2 * s; }
DI int rmap_expert(int q) { const int l = q / (PRO_EXPERT / 2), s = q - l * (PRO_EXPERT / 2); return l * PRO_PER_LAYER + 2 * s; }
DI void phase_prologue(const Ctx& c) {
    for (int it = c.bid; it < 193; it += c.nblk) { if (it < 192) mod_item(c, it / 96, it % 96); else rope_item(c); }
    __syncthreads();
    constexpr int NP = PRO_SMALL;
    const int n = (NP > c.bid) ? (NP - c.bid + c.nblk - 1) / c.nblk : 0;
    convert_pairs(c, c.bid, c.nblk, n, [](int q) { return rmap_small(q); });
}

template <bool XBF>
DI void norm_mod_row(const float* __restrict__ xrow, const float* __restrict__ g, const float* __restrict__ sh, const float* __restrict__ sc, bf16_t* __restrict__ orow, unsigned char* __restrict__ o8, int lane) {
    float4 v[4]; float s = 0.f;
#pragma unroll
    for (int j = 0; j < 4; ++j) { if constexpr (XBF) { const f32x4 t4 = bf4_f32(((const u32x2*)xrow)[lane + 64 * j]); v[j] = make_float4(t4[0], t4[1], t4[2], t4[3]); } else v[j] = ((const float4*)xrow)[lane + 64 * j]; s += (v[j].x * v[j].x + v[j].y * v[j].y) + (v[j].z * v[j].z + v[j].w * v[j].w); }
    const float rstd = rsqrtf(wave_sum(s) * (1.f / DM) + EPSV);
#pragma unroll
    for (int j = 0; j < 4; ++j) {
        const float4 gg = ((const float4*)g)[lane + 64 * j], shh = ((const float4*)sh)[lane + 64 * j], scc = ((const float4*)sc)[lane + 64 * j];
        const float y0 = v[j].x * rstd * gg.x * (1.f + scc.x) + shh.x, y1 = v[j].y * rstd * gg.y * (1.f + scc.y) + shh.y;
        const float y2 = v[j].z * rstd * gg.z * (1.f + scc.z) + shh.z, y3 = v[j].w * rstd * gg.w * (1.f + scc.w) + shh.w;
        u32x2 o; o.x = pk2(y0, y1); o.y = pk2(y2, y3);
        if (orow) ((u32x2*)orow)[lane + 64 * j] = o;
        if (o8) ((unsigned*)o8)[lane + 64 * j] = pk4_fp8(y0, y1, y2, y3);
    }
}

DI void wrp_items(const Ctx& c) {
    const Params& p = *c.p;
    const float* modv = (const float*)(p.ws + WS_MOD);
    const bf16_t* wr = (const bf16_t*)(p.ws + WS_WR);
    bf16_t* wrp = (bf16_t*)(p.ws + WS_WRP);
    float* cb = (float*)(p.ws + WS_CB);
    const int lane = c.lane;
    for (int idx = c.bid * NWAVES + c.wid; idx < 2 * 9 * 256; idx += c.nblk * NWAVES) {
        const int l = idx / 2304, r = idx - l * 2304, b = r >> 8, e = r & 255;
        const float* g = p.in[I_GFFN] + l * 1024 + 16 * lane;
        const float* mv = modv + (size_t)(l * 9 + b) * 6144 + 3072 + 16 * lane;
        const bf16_t* src = wr + ((size_t)l * 256 + e) * 1024 + 16 * lane;
        const u32x4 w0 = *(const u32x4*)src, w1 = *(const u32x4*)(src + 8);
        float wv[16];
        wv[0] = bflo(w0.x); wv[1] = bfhi(w0.x); wv[2] = bflo(w0.y); wv[3] = bfhi(w0.y); wv[4] = bflo(w0.z); wv[5] = bfhi(w0.z); wv[6] = bflo(w0.w); wv[7] = bfhi(w0.w);
        wv[8] = bflo(w1.x); wv[9] = bfhi(w1.x); wv[10] = bflo(w1.y); wv[11] = bfhi(w1.y); wv[12] = bflo(w1.z); wv[13] = bfhi(w1.z); wv[14] = bflo(w1.w); wv[15] = bfhi(w1.w);
        float s = 0.f, o[16];
#pragma unroll
        for (int j = 0; j < 4; ++j) {
            const f32x4 gg = *(const f32x4*)(g + 4 * j), sh = *(const f32x4*)(mv + 4 * j), sc = *(const f32x4*)(mv + 1024 + 4 * j);
#pragma unroll
            for (int i = 0; i < 4; ++i) { o[4 * j + i] = wv[4 * j + i] * gg[i] * (1.f + sc[i]); s += sh[i] * wv[4 * j + i]; }
        }
        u32x4 o0, o1;
        o0.x = pk2(o[0], o[1]); o0.y = pk2(o[2], o[3]); o0.z = pk2(o[4], o[5]); o0.w = pk2(o[6], o[7]);
        o1.x = pk2(o[8], o[9]); o1.y = pk2(o[10], o[11]); o1.z = pk2(o[12], o[13]); o1.w = pk2(o[14], o[15]);
        bf16_t* dst = wrp + ((size_t)(l * 9 + b) * 256 + e) * 1024 + 16 * lane;
        *(u32x4*)dst = o0; *(u32x4*)(dst + 8) = o1;
        s = wave_sum(s);
        if (lane == 0) cb[(l * 9 + b) * 256 + e] = s;
    }
}
DI void norm_ffn_row(const bf16_t* __restrict__ xrow, const float* __restrict__ g, const float* __restrict__ sh, const float* __restrict__ sc, unsigned char* __restrict__ o8, float* __restrict__ rstd_out, int lane) {
    f32x4 v[4]; float s = 0.f;
#pragma unroll
    for (int j = 0; j < 4; ++j) { v[j] = bf4_f32(((const u32x2*)xrow)[lane + 64 * j]); s += (v[j][0] * v[j][0] + v[j][1] * v[j][1]) + (v[j][2] * v[j][2] + v[j][3] * v[j][3]); }
    const float rstd = rsqrtf(wave_sum(s) * (1.f / DM) + EPSV);
#pragma unroll
    for (int j = 0; j < 4; ++j) {
        const f32x4 gg = ((const f32x4*)g)[lane + 64 * j], shh = ((const f32x4*)sh)[lane + 64 * j], scc = ((const f32x4*)sc)[lane + 64 * j];
        const f32x4 y = v[j] * rstd * gg * (1.f + scc) + shh;
        ((unsigned*)o8)[lane + 64 * j] = pk4_fp8(y[0], y[1], y[2], y[3]);
    }
    if (lane == 0) *rstd_out = rstd;
}

DI void phase_norm(const Ctx& c, int l, int nrows, bool from_inputs, int which) {
    const Params& p = *c.p;
    const float* modv = (const float*)(p.ws + WS_MOD);
    const float* g = p.in[which ? I_GFFN : I_GMIX] + l * 1024;
    bf16_t* hbuf = (bf16_t*)(p.ws + WS_HBUF);
    const float* xbuf = (const float*)(p.ws + WS_XBUF);
    for (int t = c.bid * NWAVES + c.wid; t < nrows; t += c.nblk * NWAVES) {
        const float* xrow = from_inputs ? (t < TL ? p.in[I_X] + (size_t)t * DM : p.in[I_CTX] + (size_t)(t - TL) * DM) : (const float*)((const bf16_t*)xbuf + (size_t)t * DM);
        const int b = t < TL ? (t >> 12) : 8;
        const float* mv = modv + (size_t)(l * 9 + b) * 6144 + (which ? 3072 : 0);
        if (from_inputs) norm_mod_row<false>(xrow, g, mv, mv + 1024, (bf16_t*)nullptr,        (unsigned char*)(p.ws + (which ? WS_H8 : WS_HIN8)) + (size_t)t * DM, c.lane);
        else norm_mod_row<true>(xrow, g, mv, mv + 1024, hbuf + (size_t)t * DM, (unsigned char*)(p.ws + (which ? WS_H8 : WS_HIN8)) + (size_t)t * DM, c.lane);
    }
}

namespace g8 {
constexpr int BM = 256, BK = 64, HALF = 128, HTB = HALF * BK * 2;
DI int lds_byte(int r, int c) { const int st = (r >> 4) * 2 + (c >> 5), rr = r & 15, cc = c & 31, ob = rr * 64 + cc * 2; return st * 1024 + (ob ^ (((ob >> 9) & 1) << 5)); }
DI void stage_rc(int b, int& R, int& C) { const int st = b / 1024, sb = b % 1024, swz = sb ^ (((sb >> 9) & 1) << 5); R = (st >> 1) * 16 + swz / 64; C = (st & 1) * 32 + (swz % 64) / 2; }
DI int perm32(int rho) { const int n = rho >> 4, i = rho & 15; return 8 * (i >> 2) + 4 * n + (i & 3); }
struct Unit { int pm, pn, e, ti, ne, rbase, ix; };

typedef __attribute__((ext_vector_type(8))) int v8i_t;
typedef __attribute__((ext_vector_type(4))) int v4i_t;
template <class Epi, class Sched>
DI void gemm_phase(LAS unsigned char* lds, const int tid, const int RB, const Sched& S, const Epi& E) {
    constexpr bool F8 = Epi::F8;
    const int wid = __builtin_amdgcn_readfirstlane(tid >> 6), lane = tid & 63, wr = wid >> 2, wc = wid & 3, fr = lane & 15, fq = lane >> 4;
    const int nt = RB / 128;
    int Rr[2], Cc[2]; unsigned voffB[2], voffA[2];
#pragma unroll
    for (int i = 0; i < 2; ++i) { int R, C; stage_rc(tid * 16 + i * 8192, R, C); Rr[i] = R; Cc[i] = C * 2; const int Rb = Epi::PERM ? ((R & ~31) + perm32(R & 31)) : R; voffB[i] = (unsigned)(Rb * RB + C * 2); voffA[i] = (unsigned)(R * RB + C * 2); }
    constexpr bool GA = Sched::GATHER;
    int unit_scale = 0x7F7F7F7F; asm volatile("" : "+v"(unit_scale));
    const size_t kstep = (size_t)(BK * 2);
    const size_t hstep = (size_t)HALF * RB;
    const unsigned ldsw = (unsigned)wid * 1024u;
    const int aoff = F8 ? lds_byte(wr * 64 + fr, (fq >> 1) * 32 + (fq & 1) * 16) : lds_byte(wr * 64 + fr, fq * 8);
    const int boff = F8 ? lds_byte(wc * 32 + fr, (fq >> 1) * 32 + (fq & 1) * 16) : lds_byte(wc * 32 + fr, fq * 8);
#define G8_SA(b, h) (((b) * 2 + (h)) * HTB)
#define G8_SB(b, h) ((4 + (b) * 2 + (h)) * HTB)
#define G8_STAGE_B(bufoff, gbase) do { _Pragma("unroll") for (int _i = 0; _i < 2; ++_i) \
        __builtin_amdgcn_global_load_lds((const unsigned*)((const char*)(gbase) + voffB[_i]), (LAS unsigned*)(lds + (bufoff) + ldsw + _i * 8192), 16, 0, 0); } while (0)
#define G8_STAGE_A(bufoff, uptr, koff, VO, h) do { _Pragma("unroll") for (int _i = 0; _i < 2; ++_i) { \
        const char* _s = GA ? (Ab + (koff) + VO[h][_i]) : ((uptr) + (koff) + ((h) ? hstep : (size_t)0) + voffA[_i]); \
        __builtin_amdgcn_global_load_lds((const unsigned*)_s, (LAS unsigned*)(lds + (bufoff) + ldsw + _i * 8192), 16, 0, 0); } } while (0)
#define G8_LDA(dst, b, h) do { _Pragma("unroll") for (int m = 0; m < 4; ++m) { \
        if constexpr (F8) { dst##8[m].lo = *(const LAS v4i_t*)(lds + G8_SA(b, h) + aoff + m * 2048); dst##8[m].hi = *(const LAS v4i_t*)(lds + G8_SA(b, h) + aoff + m * 2048 + 16); } \
        else { _Pragma("unroll") for (int k = 0; k < 2; ++k) dst[m][k] = *(const LAS bf16x8*)(lds + G8_SA(b, h) + aoff + m * 2048 + k * 1024); } } } while (0)
#define G8_LDB(dst, b, h) do { _Pragma("unroll") for (int n = 0; n < 2; ++n) { \
        if constexpr (F8) { dst##8[n].lo = *(const LAS v4i_t*)(lds + G8_SB(b, h) + boff + n * 2048); dst##8[n].hi = *(const LAS v4i_t*)(lds + G8_SB(b, h) + boff + n * 2048 + 16); } \
        else { _Pragma("unroll") for (int k = 0; k < 2; ++k) dst[n][k] = *(const LAS bf16x8*)(lds + G8_SB(b, h) + boff + n * 2048 + k * 1024); } } } while (0)
#define G8_MMA(ai, bj, At, Bt) do { __builtin_amdgcn_s_setprio(1); _Pragma("unroll") for (int m = 0; m < 4; ++m) _Pragma("unroll") for (int n = 0; n < 2; ++n) { \
        if constexpr (F8) asm volatile("v_mfma_scale_f32_16x16x128_f8f6f4 %0, %1, %2, %0, %3, %3 op_sel_hi:[0,0,0]" : "+v"(acc[ai][bj][m][n]) : "v"(Bt##8[n]), "v"(At##8[m]), "v"(unit_scale)); \
        else { _Pragma("unroll") for (int k = 0; k < 2; ++k) acc[ai][bj][m][n] = __builtin_amdgcn_mfma_f32_16x16x32_bf16(Bt[n][k], At[m][k], acc[ai][bj][m][n], 0, 0, 0); } } \
        __builtin_amdgcn_s_setprio(0); } while (0)
#define G8_WAIT_V(n) asm volatile("s_waitcnt vmcnt(" #n ")" ::: "memory")
#define G8_WAIT_L(n) asm volatile("s_waitcnt lgkmcnt(" #n ")" ::: "memory")
#define G8_BAR __builtin_amdgcn_s_barrier()
#define G8_SCHED __builtin_amdgcn_sched_barrier(0)
    Unit cur, nxt; int ui = 0;
    if (!S.next(0, cur)) return;
    f32x4 acc[2][2][4][2];
#pragma unroll
    for (int a = 0; a < 2; ++a)
#pragma unroll
        for (int b = 0; b < 2; ++b)
#pragma unroll
            for (int m = 0; m < 4; ++m)
#pragma unroll
                for (int n = 0; n < 2; ++n) acc[a][b][m][n] = (f32x4){0.f, 0.f, 0.f, 0.f};
    if constexpr (F8) asm volatile("s_nop 3" ::: "memory");
    bf16x8 At[F8 ? 1 : 4][2], B0[F8 ? 1 : 2][2], B1[F8 ? 1 : 2][2];
    v8i_t At8[F8 ? 4 : 1], B08[F8 ? 2 : 1], B18[F8 ? 2 : 1];
    unsigned vAc[2][2], vAn[2][2];
#pragma unroll
    for (int h = 0; h < 2; ++h)
#pragma unroll
        for (int i = 0; i < 2; ++i) vAc[h][i] = GA ? (S.a_off(cur, h * 128 + Rr[i]) + (unsigned)Cc[i]) : 0u;
    const char* Ab = S.a_base();
    const char* cA = GA ? Ab : S.a_ptr(cur);
    const char* cB = S.b_base(cur);
    G8_STAGE_B(G8_SB(0, 0), cB); G8_STAGE_A(G8_SA(0, 0), cA, 0, vAc, 0); G8_STAGE_B(G8_SB(0, 1), cB + hstep); G8_STAGE_A(G8_SA(0, 1), cA, 0, vAc, 1);
    if (wr == 1) G8_BAR;
    G8_WAIT_V(4); G8_BAR;
    G8_STAGE_B(G8_SB(1, 0), cB + kstep); G8_STAGE_A(G8_SA(1, 0), cA, kstep, vAc, 0); G8_STAGE_B(G8_SB(1, 1), cB + hstep + kstep);
    G8_WAIT_V(6); G8_BAR;
    for (;;) {
        const bool has_next = S.next(ui + 1, nxt);
        const char* nB = has_next ? S.b_base(nxt) : cB;
        const char* nA = GA ? Ab : (has_next ? S.a_ptr(nxt) : cA);
#pragma unroll
        for (int h = 0; h < 2; ++h)
#pragma unroll
            for (int i = 0; i < 2; ++i) vAn[h][i] = GA ? (has_next ? (S.a_off(nxt, h * 128 + Rr[i]) + (unsigned)Cc[i]) : vAc[h][i]) : 0u;
#pragma unroll 1
        for (int t = 0; t < nt; t += 2) {
            const bool last = (t == nt - 2);
            const size_t ka1 = (size_t)(t + 1) * kstep;
            const size_t ka2 = last ? (size_t)0 : (size_t)(t + 2) * kstep;
            const size_t ka3 = ka2 + kstep;
            const char* b2 = last ? nB : cB + (size_t)(t + 2) * kstep;
            const char* b3 = b2 + kstep;
            unsigned v2[2][2];
#pragma unroll
            for (int h = 0; h < 2; ++h)
#pragma unroll
                for (int i = 0; i < 2; ++i) v2[h][i] = GA ? (last ? vAn[h][i] : vAc[h][i]) : 0u;
            const char* a2p = last ? nA : cA;
            G8_LDB(B0, 0, 0); G8_SCHED; G8_LDA(At, 0, 0); G8_STAGE_A(G8_SA(1, 1), cA, ka1, vAc, 1);
            G8_WAIT_L(8); G8_BAR; G8_WAIT_L(0); G8_MMA(0, 0, At, B0); G8_BAR; G8_SCHED;
            G8_LDB(B1, 0, 1); G8_STAGE_B(G8_SB(0, 0), b2);
            G8_BAR; G8_WAIT_L(0); G8_MMA(0, 1, At, B1); G8_BAR;
            G8_LDA(At, 0, 1); G8_STAGE_A(G8_SA(0, 0), a2p, ka2, v2, 0);
            G8_BAR; G8_WAIT_L(0); G8_MMA(1, 0, At, B0); G8_BAR; G8_SCHED;
            G8_STAGE_B(G8_SB(0, 1), b2 + hstep);
            G8_WAIT_V(6); G8_BAR; G8_MMA(1, 1, At, B1); G8_BAR;
            G8_LDB(B0, 1, 0); G8_SCHED; G8_LDA(At, 1, 0); G8_STAGE_A(G8_SA(0, 1), a2p, ka2, v2, 1);
            G8_WAIT_L(8); G8_BAR; G8_WAIT_L(0); G8_MMA(0, 0, At, B0); G8_BAR; G8_SCHED;
            G8_LDB(B1, 1, 1); G8_STAGE_B(G8_SB(1, 0), b3);
            G8_BAR; G8_WAIT_L(0); G8_MMA(0, 1, At, B1); G8_BAR;
            G8_LDA(At, 1, 1); G8_STAGE_A(G8_SA(1, 0), a2p, ka3, v2, 0);
            G8_BAR; G8_WAIT_L(0); G8_MMA(1, 0, At, B0); G8_BAR; G8_SCHED;
            G8_STAGE_B(G8_SB(1, 1), b3 + hstep);
            G8_WAIT_V(6); G8_BAR; G8_MMA(1, 1, At, B1); G8_BAR;
        }
        if constexpr (F8) asm volatile("s_nop 15\n\ts_nop 15" ::: "memory");
        E(acc, cur, wr, wc, fr, fq);
        if (!has_next) break;
#pragma unroll
        for (int a = 0; a < 2; ++a)
#pragma unroll
            for (int b = 0; b < 2; ++b)
#pragma unroll
                for (int m = 0; m < 4; ++m)
#pragma unroll
                    for (int n = 0; n < 2; ++n) acc[a][b][m][n] = (f32x4){0.f, 0.f, 0.f, 0.f};
        if constexpr (F8) asm volatile("s_nop 3" ::: "memory");
        cur = nxt; cB = nB; cA = nA; ++ui;
#pragma unroll
        for (int h = 0; h < 2; ++h)
#pragma unroll
            for (int i = 0; i < 2; ++i) vAc[h][i] = vAn[h][i];
    }
    G8_WAIT_V(0);
    if (wr == 0) G8_BAR;
    G8_BAR;
#undef G8_SA
#undef G8_SB
#undef G8_STAGE_A
#undef G8_STAGE_B
#undef G8_LDA
#undef G8_LDB
#undef G8_MMA
#undef G8_WAIT_V
#undef G8_WAIT_L
#undef G8_BAR
#undef G8_SCHED
}

struct DenseSched {
    static constexpr bool GATHER = false;
    int nM, nN, nwg, G, c, RB; const char* A; const char* Bt;
    DI void init(const void* A_, const void* Bt_, int M, int N, int RB_, int G_, int c_) { A = (const char*)A_; Bt = (const char*)Bt_; nM = M / BM; nN = N / BM; nwg = nM * nN; G = G_; c = c_; RB = RB_; }
    DI bool next(int i, Unit& u) const {
        const int L = i * G + c; if (L >= nwg) return false;
        int wgid = L; { const int q = nwg / 8, r = nwg % 8, xcd = wgid % 8, off = wgid / 8; wgid = (xcd < r ? xcd * (q + 1) : r * (q + 1) + (xcd - r) * q) + off; }
        const int nig = 8 * nN, gid = wgid / nig, fm = gid * 8, gsz = (nM - fm) < 8 ? (nM - fm) : 8;
        u.pm = fm + ((wgid % nig) % gsz); u.pn = (wgid % nig) / gsz; u.e = 0; u.ti = 0; u.ne = 0; u.rbase = 0; u.ix = 0; return true;
    }
    DI const char* a_base() const { return A; }
    DI unsigned a_off(const Unit&, int) const { return 0u; }
    DI const char* a_ptr(const Unit& u) const { return A + (size_t)u.pm * BM * RB; }
    DI const char* b_base(const Unit& u) const { return Bt + (size_t)u.pn * BM * RB; }
};
}
struct EpiInproj {
    static constexpr bool F8 = true;
    static constexpr bool PERM = true;
    const LAS float2* rope;
    unsigned char* q8; unsigned char* k8; unsigned char* vt8;
    LAS unsigned char* stg; int tid;
    static DI bool isv_cb(int cb) { const int kv = cb - 16; return (cb >= 16) && ((kv == 2) || (kv == 3) || (kv >= 8 && kv < 12) || (kv >= 20)); }
    DI void operator()(const f32x4 (&acc)[2][2][4][2], const g8::Unit& u, int wr, int wc, int fr, int fq) const {
        const bool lat = (u.pm * 256 < TL);
#pragma unroll
        for (int bj = 0; bj < 2; ++bj) {
            const int col0 = u.pn * 256 + bj * 128 + wc * 32 + 8 * fq;
            const int cb = col0 >> 6, kv = cb - 16;
            if (!isv_cb(cb)) continue;
            const float scale = 1.0f / W_SCALE;
            const int vrow0 = (kv < 4 ? (kv - 2) * 64 : (kv < 12 ? 128 + (kv - 8) * 64 : 384 + (kv - 20) * 64)) + (col0 & 63);
            const int pos = 32 * ((fr >> 2) & 1) + 4 * (((fr >> 3) << 2) | (fr & 3));
#pragma unroll
            for (int ai = 0; ai < 2; ++ai) {
                const int t0 = u.pm * 256 + ai * 128 + wr * 64;
                const int b = t0 < TL ? (t0 >> 12) : ((t0 - TL) >> 8);
                const int tile = t0 < TL ? ((t0 & 4095) >> 6) : (64 + (((t0 - TL) & 255) >> 6));
                unsigned char* base = vt8 + (size_t)(b * 68 + tile) * VT_TILE + (size_t)vrow0 * 64 + pos;
#pragma unroll
                for (int n = 0; n < 2; ++n)
#pragma unroll
                    for (int j = 0; j < 4; ++j)
                        *(unsigned*)(base + (4 * n + j) * 64) = pk4_fp8(acc[ai][bj][0][n][j] * scale, acc[ai][bj][1][n][j] * scale, acc[ai][bj][2][n][j] * scale, acc[ai][bj][3][n][j] * scale);
            }
        }
        if (!((u.pn < 6) || (u.pn == 7) || (u.pn == 8))) return;
        constexpr int RS = 272;
        if (wr == 0) __builtin_amdgcn_s_barrier();
#pragma unroll
        for (int ai = 0; ai < 2; ++ai)
#pragma unroll
            for (int mh = 0; mh < 2; ++mh) {
#pragma unroll
                for (int bj = 0; bj < 2; ++bj) {
                    const int col0 = u.pn * 256 + bj * 128 + wc * 32 + 8 * fq;
                    const int cb = col0 >> 6, i0 = (col0 & 63) >> 1;
                    if (isv_cb(cb)) continue;
                    const bool isq = cb < 16;
                    const bool roped = ((cb < 4) || (cb >= 8 && cb < 16) || (cb == 16) || (cb == 17) || (cb >= 28 && cb < 36)) && lat;
                    const float scale = (isq ? QSCALE : 1.0f) * (1.0f / W_SCALE);
#pragma unroll
                    for (int mm = 0; mm < 2; ++mm) {
                        const int m = mh * 2 + mm;
                        const int t = u.pm * 256 + ai * 128 + wr * 64 + m * 16 + fr;
                        f32x4 v0 = acc[ai][bj][m][0], v1 = acc[ai][bj][m][1];
                        if (roped) {
                            const int s = t & 4095;
                            const int pos = (i0 < 16) ? (s >> 6) : (s & 63);
                            const f32x4 ca = *(const LAS f32x4*)(rope + pos * 16 + (i0 & 15)), cb2 = *(const LAS f32x4*)(rope + pos * 16 + (i0 & 15) + 2);
                            f32x4 o0, o1;
                            o0[0] = v0[0] * ca[0] - v0[1] * ca[1]; o0[1] = v0[1] * ca[0] + v0[0] * ca[1];
                            o0[2] = v0[2] * ca[2] - v0[3] * ca[3]; o0[3] = v0[3] * ca[2] + v0[2] * ca[3];
                            o1[0] = v1[0] * cb2[0] - v1[1] * cb2[1]; o1[1] = v1[1] * cb2[0] + v1[0] * cb2[1];
                            o1[2] = v1[2] * cb2[2] - v1[3] * cb2[3]; o1[3] = v1[3] * cb2[2] + v1[2] * cb2[3];
                            v0 = o0; v1 = o1;
                        }
                        v0 *= scale; v1 *= scale;
                        u32x2 w; w.x = pk4_fp8(v0[0], v0[1], v0[2], v0[3]); w.y = pk4_fp8(v1[0], v1[1], v1[2], v1[3]);
                        *(LAS u32x2*)(stg + (wr * 32 + mm * 16 + fr) * RS + bj * 128 + wc * 32 + 8 * fq) = w;
                    }
                }
                asm volatile("s_waitcnt lgkmcnt(0)" ::: "memory"); __builtin_amdgcn_s_barrier(); asm volatile("" ::: "memory");
#pragma unroll
                for (int k = 0; k < 2; ++k) {
                    const int idx = tid + k * 512, rl = idx >> 4, pc = idx & 15;
                    const int cb = u.pn * 4 + (pc >> 2);
                    if (!isv_cb(cb)) {
                        const u32x4 v = *(const LAS u32x4*)(stg + rl * RS + pc * 16);
                        const int t = u.pm * 256 + ai * 128 + (rl >> 5) * 64 + mh * 32 + (rl & 31);
                        const int kv = cb - 16, ki = kv < 2 ? kv : (kv < 8 ? kv - 2 : kv - 6);
                        unsigned char* dst = (cb < 16) ? q8 + (size_t)t * 1024 + cb * 64 + (pc & 3) * 16 : k8 + (size_t)t * 1024 + ki * 64 + (pc & 3) * 16;
                        *(u32x4*)dst = v;
                    }
                }
                asm volatile("s_waitcnt lgkmcnt(0)" ::: "memory"); __builtin_amdgcn_s_barrier(); asm volatile("" ::: "memory");
            }
        if (wr == 1) __builtin_amdgcn_s_barrier();
    }
};
DI void phase_inproj(const Ctx& c, int l) {
    const Params& p = *c.p;
    g8::DenseSched S; S.init(p.ws + WS_HIN8, (const unsigned char*)(p.ws + WS_WIN) + (size_t)l * 2816 * 1024, TT, INC, DM, c.nblk, c.bid);
    {
        const float* rg = (const float*)(p.ws + WS_ROPE);
        LAS float* rl = (LAS float*)(c.smem + LDS_MAIN + 256);
        for (int i = c.tid; i < 2048; i += NTHREADS) rl[i] = rg[i];
        __syncthreads();
    }
    EpiInproj E; E.rope = (const LAS float2*)(c.smem + LDS_MAIN + 256); E.stg = (LAS unsigned char*)c.smem + LDS_MAIN + 256 + 8192; E.tid = c.tid;
    E.q8 = (unsigned char*)(p.ws + WS_Q8); E.k8 = (unsigned char*)(p.ws + WS_K8); E.vt8 = (unsigned char*)(p.ws + WS_VT8);
    g8::gemm_phase((LAS unsigned char*)c.smem, c.tid, DM, S, E);
}

struct EpiOutproj {
    static constexpr bool F8 = true;
    static constexpr bool PERM = false;
    float* xbuf; const float* modv; const float* x_in; const float* ctx_in; int l;
    DI void operator()(const f32x4 (&acc)[2][2][4][2], const g8::Unit& u, int wr, int wc, int fr, int fq) const {
        const int b = (u.pm * 256) < TL ? ((u.pm * 256) >> 12) : 8;
        const int col0 = u.pn * 256 + wc * 32 + 4 * fq;
        const float* gate = modv + (size_t)(l * 9 + b) * 6144 + 2048 + col0;
        f32x4 g[2][2];
#pragma unroll
        for (int bj = 0; bj < 2; ++bj)
#pragma unroll
            for (int n = 0; n < 2; ++n) g[bj][n] = *(const f32x4*)(gate + bj * 128 + n * 16) * (1.0f / (MIX_SCALE * W_SCALE));
#pragma unroll
        for (int ai = 0; ai < 2; ++ai)
#pragma unroll
            for (int m = 0; m < 4; ++m) {
                const int t = u.pm * 256 + ai * 128 + wr * 64 + m * 16 + fr;
                const float* xin = (t < TL ? x_in + (size_t)t * DM : ctx_in + (size_t)(t - TL) * DM) + col0;
                bf16_t* xo = (bf16_t*)xbuf + (size_t)t * DM + col0;
#pragma unroll
                for (int bj = 0; bj < 2; ++bj)
#pragma unroll
                    for (int n = 0; n < 2; ++n) {
                        const f32x4 x = (l == 0) ? *(const f32x4*)(xin + bj * 128 + n * 16) : bf4_f32(*(const u32x2*)(xo + bj * 128 + n * 16));
                        *(u32x2*)(xo + bj * 128 + n * 16) = f32_bf4(x + g[bj][n] * acc[ai][bj][m][n]);
                    }
            }
    }
};
DI void phase_outproj(const Ctx& c, int l, int nrows) {
    const Params& p = *c.p;
    g8::DenseSched S; S.init(p.ws + WS_MIX, (const unsigned char*)(p.ws + WS_WOUT) + (size_t)l * 1048576, nrows, DM, DM, c.nblk, c.bid);
    EpiOutproj E; E.xbuf = (float*)(p.ws + WS_XBUF); E.modv = (const float*)(p.ws + WS_MOD); E.x_in = p.in[I_X]; E.ctx_in = p.in[I_CTX]; E.l = l;
    g8::gemm_phase((LAS unsigned char*)c.smem, c.tid, DM, S, E);
}

struct EpiRouter {
    static constexpr bool F8 = false;
    static constexpr bool PERM = false;
    float* logit;
    DI void operator()(const f32x4 (&acc)[2][2][4][2], const g8::Unit& u, int wr, int wc, int fr, int fq) const {
#pragma unroll
        for (int ai = 0; ai < 2; ++ai)
#pragma unroll
            for (int m = 0; m < 4; ++m) {
                const int t = u.pm * 256 + ai * 128 + wr * 64 + m * 16 + fr;
#pragma unroll
                for (int bj = 0; bj < 2; ++bj)
#pragma unroll
                    for (int n = 0; n < 2; ++n) *(f32x4*)(logit + (size_t)t * NE + bj * 128 + wc * 32 + n * 16 + 4 * fq) = acc[ai][bj][m][n];
            }
    }
};
DI void phase_router(const Ctx& c, int l, int nrows) {
    const Params& p = *c.p;
    g8::DenseSched S; S.init(p.ws + WS_HBUF, (const bf16_t*)(p.ws + WS_WR) + (size_t)l * 262144, nrows, NE, DM * 2, c.nblk, c.bid);
    EpiRouter E; E.logit = (float*)(p.ws + WS_LOGIT);
    g8::gemm_phase((LAS unsigned char*)c.smem, c.tid, DM * 2, S, E);
}

struct RouterSched : g8::DenseSched {
    DI const char* b_base(const g8::Unit& u) const { const int b = (u.pm * 256) < TL ? ((u.pm * 256) >> 12) : 8; return Bt + (size_t)b * 524288 + (size_t)u.pn * 256 * RB; }
};
DI void phase_norm_router(const Ctx& c, int l, int nrows) {
    const Params& p = *c.p;
    {
        RouterSched S; S.init(p.ws + WS_XBUF, (const bf16_t*)(p.ws + WS_WRP) + (size_t)l * 9 * 262144, nrows, NE, DM * 2, c.nblk, c.bid);
        EpiRouter E; E.logit = (float*)(p.ws + WS_LOGIT);
        g8::gemm_phase((LAS unsigned char*)c.smem, c.tid, DM * 2, S, E);
    }
    int* ctr = (int*)(p.ws + WS_ROWCTR) + l * 64;
    LAS int* slot = (LAS int*)(c.smem + LDS_MAIN + 64);
    const float* modv = (const float*)(p.ws + WS_MOD);
    const float* g = p.in[I_GFFN] + l * 1024;
    const bf16_t* xbuf = (const bf16_t*)(p.ws + WS_XBUF);
    unsigned char* h8 = (unsigned char*)(p.ws + WS_H8);
    float* rstd = (float*)(p.ws + WS_RSTD);
    for (;;) {
        if (c.tid == 0) slot[0] = atomicAdd(ctr, 64);
        __syncthreads();
        const int base = slot[0];
        __syncthreads();
        if (base >= nrows) break;
#pragma unroll 1
        for (int i = 0; i < 8; ++i) {
            const int t = base + c.wid * 8 + i;
            if (t < nrows) {
                const int b = t < TL ? (t >> 12) : 8;
                const float* mv = modv + (size_t)(l * 9 + b) * 6144 + 3072;
                norm_ffn_row(xbuf + (size_t)t * DM, g, mv, mv + 1024, h8 + (size_t)t * DM, rstd + t, c.lane);
            }
        }
    }
}

DI void phase_route(const Ctx& c, int l, int nrows) {
    const Params& p = *c.p;
    const float* logit = (const float*)(p.ws + WS_LOGIT);
    const float* rb = p.in[I_RB] + l * NE;
    int* cnt = (int*)(p.ws + WS_CNT) + l * CNT_LAYER;
    int* list = (int*)(p.ws + WS_LIST);
    float* slotw = (float*)(p.ws + WS_SLOTW);
    int* einfo = (int*)(p.ws + WS_EINFO);
    LAS int* lcnt = (LAS int*)c.smem;
    LAS int* rec = (LAS int*)(c.smem + 1024);
    LAS float* recw = (LAS float*)(c.smem + 1024 + 8 * 24 * 8 * 4);
    constexpr int RMAX = 24;
    const int lane = c.lane;
    if (c.tid < 256) lcnt[c.tid] = 0;
    __syncthreads();
    const f32x4 bias = ((const f32x4*)rb)[lane];
    const float NINF = -__builtin_inff();
    int it = 0;
    const float* rstd = (const float*)(p.ws + WS_RSTD);
    const float* cbl = (const float*)(p.ws + WS_CB) + l * 9 * 256;
    for (int t = c.bid * NWAVES + c.wid; t < nrows; t += c.nblk * NWAVES, ++it) {
        const int bb = t < TL ? (t >> 12) : 8;
        const f32x4 lg = ((const f32x4*)(logit + (size_t)t * NE))[lane] * rstd[t] + ((const f32x4*)(cbl + bb * 256))[lane];
        const float s0 = 1.f / (1.f + __expf(-lg.x)), s1 = 1.f / (1.f + __expf(-lg.y)), s2 = 1.f / (1.f + __expf(-lg.z)), s3 = 1.f / (1.f + __expf(-lg.w));
        float m0 = s0 + bias.x, m1 = s1 + bias.y, m2 = s2 + bias.z, m3 = s3 + bias.w;
        float a1 = fmaxf(m0, m1), a2 = fminf(m0, m1);
        { const float b1 = fmaxf(m2, m3), b2 = fminf(m2, m3); const float n1 = fmaxf(a1, b1), n2 = fmaxf(fminf(a1, b1), fmaxf(a2, b2)); a1 = n1; a2 = n2; }
        { const float b1 = DPPF(a1, DPP_XOR1), b2 = DPPF(a2, DPP_XOR1); const float n1 = fmaxf(a1, b1), n2 = fmaxf(fminf(a1, b1), fmaxf(a2, b2)); a1 = n1; a2 = n2; }
        { const float b1 = DPPF(a1, DPP_XOR2), b2 = DPPF(a2, DPP_XOR2); const float n1 = fmaxf(a1, b1), n2 = fmaxf(fminf(a1, b1), fmaxf(a2, b2)); a1 = n1; a2 = n2; }
        { const float b1 = DPPF(a1, DPP_HMIR), b2 = DPPF(a2, DPP_HMIR); const float n1 = fmaxf(a1, b1), n2 = fmaxf(fminf(a1, b1), fmaxf(a2, b2)); a1 = n1; a2 = n2; }
        const float gs = a1 + a2;
        const int g = lane >> 3;
        int rank = 0;
#pragma unroll
        for (int j = 0; j < 8; ++j) { const float gj = rdlane_f(gs, j * 8); rank += ((gj > gs) || (gj == gs && j < g)) ? 1 : 0; }
        if (rank >= 4) { m0 = NINF; m1 = NINF; m2 = NINF; m3 = NINF; }
        float wsum = 0.f, my_w = 0.f; int my_e = 0;
#pragma unroll
        for (int k = 0; k < 8; ++k) {
            float bv = m0, bs = s0; int bi = 0;
            if (m1 > bv) { bv = m1; bs = s1; bi = 1; }
            if (m2 > bv) { bv = m2; bs = s2; bi = 2; }
            if (m3 > bv) { bv = m3; bs = s3; bi = 3; }
            float v = bv;
            v = fmaxf(v, DPPF(v, DPP_XOR1)); v = fmaxf(v, DPPF(v, DPP_XOR2)); v = fmaxf(v, DPPF(v, DPP_HMIR)); v = fmaxf(v, DPPF(v, DPP_MIR));
            const float wmx = fmaxf(fmaxf(rdlane_f(v, 0), rdlane_f(v, 16)), fmaxf(rdlane_f(v, 32), rdlane_f(v, 48)));
            const unsigned long long bal = __ballot(bv == wmx);
            const int win = __ffsll((long long)bal) - 1;
            const int sub = __builtin_amdgcn_readlane(bi, win);
            const float sw = rdlane_f(bs, win);
            if (lane == win) { if (sub == 0) m0 = NINF; else if (sub == 1) m1 = NINF; else if (sub == 2) m2 = NINF; else m3 = NINF; }
            wsum += sw;
            if (lane == k) { my_e = win * 4 + sub; my_w = sw; }
        }
        if (lane < 8 && it < RMAX) {
            const int lp = __hip_atomic_fetch_add(&lcnt[my_e], 1, __ATOMIC_RELAXED, __HIP_MEMORY_SCOPE_WORKGROUP);
            rec[(c.wid * RMAX + it) * 8 + lane] = (my_e << 16) | lp;
            recw[(c.wid * RMAX + it) * 8 + lane] = my_w / wsum * 2.5f;
        }
    }
    __syncthreads();
    if (c.tid < 256) { const int n = lcnt[c.tid]; lcnt[c.tid] = (n > 0) ? atomicAdd(&cnt[c.tid * CNT_STRIDE], n) : 0; }
    __syncthreads();
    it = 0;
    for (int t = c.bid * NWAVES + c.wid; t < nrows; t += c.nblk * NWAVES, ++it) {
        if (lane < 8 && it < RMAX) {
            const int r = rec[(c.wid * RMAX + it) * 8 + lane];
            const int e = r >> 16, pos = lcnt[e] + (r & 0xffff);
            list[(size_t)e * TT + pos] = t;
            slotw[(size_t)t * 8 + lane] = recw[(c.wid * RMAX + it) * 8 + lane];
            einfo[(size_t)t * 8 + lane] = (e << 16) | pos;
        }
    }
}

DI void moe_setup(const Ctx& c, int l, int nrows) {
    const int* cnt = (const int*)(c.p->ws + WS_CNT) + l * CNT_LAYER;
    LAS int* tstart = (LAS int*)(c.smem + LDS_MAIN + 1024);
    LAS int* roff = (LAS int*)(c.smem + LDS_MAIN + 2064);
    LAS int* cntl = (LAS int*)(c.smem + LDS_MAIN + 3104);
    LAS int* wtot = (LAS int*)(c.smem + LDS_MAIN + 4160);
    const int n = (c.tid < 256) ? cnt[c.tid * CNT_STRIDE] : 0;
    const int nt = (n + 255) >> 8;
    int vt = nt, vr = n;
    vt += DPPI(vt, DPP_SHR(1)); vr += DPPI(vr, DPP_SHR(1)); vt += DPPI(vt, DPP_SHR(2)); vr += DPPI(vr, DPP_SHR(2));
    vt += DPPI(vt, DPP_SHR(4)); vr += DPPI(vr, DPP_SHR(4)); vt += DPPI(vt, DPP_SHR(8)); vr += DPPI(vr, DPP_SHR(8));
    { const int t0 = __builtin_amdgcn_readlane(vt, 15), t1 = __builtin_amdgcn_readlane(vt, 31), t2 = __builtin_amdgcn_readlane(vt, 47);
      const int r0 = __builtin_amdgcn_readlane(vr, 15), r1 = __builtin_amdgcn_readlane(vr, 31), r2 = __builtin_amdgcn_readlane(vr, 47);
      const int row = c.lane >> 4;
      vt += (row > 0 ? t0 : 0) + (row > 1 ? t1 : 0) + (row > 2 ? t2 : 0); vr += (row > 0 ? r0 : 0) + (row > 1 ? r1 : 0) + (row > 2 ? r2 : 0); }
    if (c.lane == 63 && c.wid < 4) { wtot[c.wid] = vt; wtot[4 + c.wid] = vr; }
    __syncthreads();
    if (c.tid < 256) {
        int pt = 0, pr = 0;
        for (int w = 0; w < c.wid; ++w) { pt += wtot[w]; pr += wtot[4 + w]; }
        tstart[c.tid] = pt + vt - nt; roff[c.tid] = pr + vr - n; cntl[c.tid] = n;
        if (c.tid == 255) { tstart[256] = pt + vt; roff[256] = pr + vr; tstart[257] = pt + vt + nrows / 256; roff[257] = pr + vr + nrows; cntl[256] = nrows; }
    }
    __syncthreads();
}

constexpr int MOE_MAXU = 32, MOE_MAXG = 12;
template <bool GATHER_>
struct MoeSched {
    static constexpr bool GATHER = GATHER_;
    const LAS int* utab; const LAS unsigned* toks; int nmy;
    const char* A; const char* W; size_t wstride; int RB;
    DI bool next(int i, g8::Unit& u) const {
        if (i >= nmy) return false;
        const LAS int* e = utab + i * 8;
        u.pn = __builtin_amdgcn_readfirstlane(e[0]); u.e = __builtin_amdgcn_readfirstlane(e[1]); u.ti = __builtin_amdgcn_readfirstlane(e[2]);
        u.ne = __builtin_amdgcn_readfirstlane(e[3]); u.rbase = __builtin_amdgcn_readfirstlane(e[4]); u.pm = __builtin_amdgcn_readfirstlane(e[5]); u.ix = i;
        return true;
    }
    DI const char* a_base() const { return A; }
    DI unsigned a_off(const g8::Unit& u, int row) const { return toks[u.ix * 256 + row]; }
    DI const char* a_ptr(const g8::Unit& u) const { return A + (size_t)u.rbase * RB; }
    DI const char* b_base(const g8::Unit& u) const { return W + (size_t)u.e * wstride + (size_t)u.pn * 256 * RB; }
};
DI int moe_units(const Ctx& c, int NB, bool gather, const int* list, int rowbytes) {
    const LAS int* tstart = (const LAS int*)(c.smem + LDS_MAIN + 1024);
    const LAS int* roff = (const LAS int*)(c.smem + LDS_MAIN + 2064);
    const LAS int* cntl = (const LAS int*)(c.smem + LDS_MAIN + 3104);
    LAS int* utab = (LAS int*)(c.smem + LDS_MAIN + 4224);
    LAS unsigned* toks = (LAS unsigned*)(c.smem + LDS_MAIN + 8192);
    const int nunits = tstart[257] * NB;
    int nmy = (nunits > c.bid) ? (nunits - c.bid + c.nblk - 1) / c.nblk : 0;
    { const int cap = gather ? MOE_MAXG : MOE_MAXU; nmy = nmy > cap ? cap : nmy; }
    if (c.tid < nmy) {
        const int L = c.tid * c.nblk + c.bid;
        int w = L; { const int q = nunits / 8, r = nunits % 8, xcd = w % 8, off = w / 8; w = (xcd < r ? xcd * (q + 1) : r * (q + 1) + (xcd - r) * q) + off; }
        const int tile = w / NB;
        int lo = 0, hi = 256;
        while (lo < hi) { const int mid = (lo + hi + 1) >> 1; if (tstart[mid] <= tile) lo = mid; else hi = mid - 1; }
        const int ti = tile - tstart[lo];
        LAS int* e = utab + c.tid * 8;
        e[0] = w - tile * NB; e[1] = lo; e[2] = ti; e[3] = cntl[lo]; e[4] = roff[lo] + ti * 256; e[5] = tile;
    }
    __syncthreads();
    if (gather) {
        for (int idx = c.tid; idx < nmy * 256; idx += NTHREADS) {
            const LAS int* e = utab + (idx >> 8) * 8;
            const int ex = e[1], ne = e[3];
            int ridx = e[2] * 256 + (idx & 255); ridx = ridx < ne ? ridx : ne - 1;
            const int tok = (ex < 256) ? list[(size_t)ex * TT + ridx] : ridx;
            toks[idx] = (unsigned)tok * (unsigned)rowbytes;
        }
        __syncthreads();
    }
    return nmy;
}

#ifdef E1_DIRECT
struct EpiE1 {
    static constexpr bool F8 = true;
    static constexpr bool PERM = true;
    unsigned char* act;
    LAS unsigned char* stg; int tid;
    DI void operator()(const f32x4 (&acc)[2][2][4][2], const g8::Unit& u, int wr, int wc, int fr, int fq) const {
        constexpr float IS = 1.0f / W_SCALE;
#pragma unroll
        for (int ai = 0; ai < 2; ++ai)
#pragma unroll
            for (int m = 0; m < 4; ++m) {
                const int row = ai * 128 + wr * 64 + m * 16 + fr;
                if (u.ti * 256 + row < u.ne) {
#pragma unroll
                    for (int bj = 0; bj < 2; ++bj) {
                        const int col0 = u.pn * 256 + bj * 128 + wc * 32 + 8 * fq;
                        const f32x4 v0 = acc[ai][bj][m][0] * IS, v1 = acc[ai][bj][m][1] * IS;
                        const float a0 = v0[0] * __builtin_amdgcn_rcpf(1.f + __expf(-v0[0])) * v0[1], a1 = v0[2] * __builtin_amdgcn_rcpf(1.f + __expf(-v0[2])) * v0[3];
                        const float a2 = v1[0] * __builtin_amdgcn_rcpf(1.f + __expf(-v1[0])) * v1[1], a3 = v1[2] * __builtin_amdgcn_rcpf(1.f + __expf(-v1[2])) * v1[3];
                        *(unsigned*)(act + (size_t)(u.rbase + row) * FF + (col0 >> 1)) = pk4_fp8(a0 * ACT_SCALE, a1 * ACT_SCALE, a2 * ACT_SCALE, a3 * ACT_SCALE);
                    }
                }
            }
    }
};
#else
struct EpiE1 {
    static constexpr bool F8 = true;
    static constexpr bool PERM = true;
    unsigned char* act;
    LAS unsigned char* stg; int tid;
    DI void operator()(const f32x4 (&acc)[2][2][4][2], const g8::Unit& u, int wr, int wc, int fr, int fq) const {
        constexpr float IS = 1.0f / W_SCALE;
        constexpr int RS = 144;
        if (wr == 0) __builtin_amdgcn_s_barrier();
#pragma unroll
        for (int ai = 0; ai < 2; ++ai)
#pragma unroll
            for (int mh = 0; mh < 2; ++mh) {
#pragma unroll
                for (int mm = 0; mm < 2; ++mm) {
                    const int m = mh * 2 + mm;
                    LAS unsigned char* d = stg + (wr * 32 + mm * 16 + fr) * RS + wc * 16 + 4 * fq;
#pragma unroll
                    for (int bj = 0; bj < 2; ++bj) {
                        const f32x4 v0 = acc[ai][bj][m][0] * IS, v1 = acc[ai][bj][m][1] * IS;
                        const float a0 = v0[0] * __builtin_amdgcn_rcpf(1.f + __expf(-v0[0])) * v0[1], a1 = v0[2] * __builtin_amdgcn_rcpf(1.f + __expf(-v0[2])) * v0[3];
                        const float a2 = v1[0] * __builtin_amdgcn_rcpf(1.f + __expf(-v1[0])) * v1[1], a3 = v1[2] * __builtin_amdgcn_rcpf(1.f + __expf(-v1[2])) * v1[3];
                        *(LAS unsigned*)(d + bj * 64) = pk4_fp8(a0 * ACT_SCALE, a1 * ACT_SCALE, a2 * ACT_SCALE, a3 * ACT_SCALE);
                    }
                }
                asm volatile("s_waitcnt lgkmcnt(0)" ::: "memory"); __builtin_amdgcn_s_barrier(); asm volatile("" ::: "memory");
                {
                    const int rl = tid >> 3, pc = tid & 7;
                    const u32x4 v = *(const LAS u32x4*)(stg + rl * RS + pc * 16);
                    const int row = ai * 128 + (rl >> 5) * 64 + mh * 32 + (rl & 31);
                    if (u.ti * 256 + row < u.ne) *(u32x4*)(act + (size_t)(u.rbase + row) * FF + u.pn * 128 + pc * 16) = v;
                }
                asm volatile("s_waitcnt lgkmcnt(0)" ::: "memory"); __builtin_amdgcn_s_barrier(); asm volatile("" ::: "memory");
            }
        if (wr == 1) __builtin_amdgcn_s_barrier();
    }
};
#endif
DI void phase_e1(const Ctx& c, int l, int nrows) {
    const Params& p = *c.p;
    moe_setup(c, l, nrows);
    MoeSched<true> S;
    S.nmy = moe_units(c, 2, true, (const int*)(p.ws + WS_LIST), DM);
    S.utab = (const LAS int*)(c.smem + LDS_MAIN + 4224); S.toks = (const LAS unsigned*)(c.smem + LDS_MAIN + 8192);
    S.A = (const char*)(p.ws + WS_H8); S.W = (const char*)(p.ws + WS_WGU) + (size_t)l * 257 * 524288; S.wstride = 524288; S.RB = DM;
    EpiE1 E; E.act = (unsigned char*)(p.ws + WS_ACT); E.stg = (LAS unsigned char*)c.smem + LDS_MAIN + 8192 + MOE_MAXG * 1024; E.tid = c.tid;
    g8::gemm_phase((LAS unsigned char*)c.smem, c.tid, DM, S, E);
}

struct EpiE2 {
    static constexpr bool F8 = true;
    static constexpr bool PERM = true;
    unsigned char* ys;
    LAS unsigned char* stg; int tid;
    DI void operator()(const f32x4 (&acc)[2][2][4][2], const g8::Unit& u, int wr, int wc, int fr, int fq) const {
        constexpr float SC = 16.f / (ACT_SCALE * WD_SCALE);
        constexpr int RS = 272;
        if (wr == 0) __builtin_amdgcn_s_barrier();
#pragma unroll
        for (int ai = 0; ai < 2; ++ai)
#pragma unroll
            for (int mh = 0; mh < 2; ++mh) {
#pragma unroll
                for (int mm = 0; mm < 2; ++mm) {
                    const int m = mh * 2 + mm;
                    LAS unsigned char* d = stg + (wr * 32 + mm * 16 + fr) * RS + wc * 32 + 8 * fq;
#pragma unroll
                    for (int bj = 0; bj < 2; ++bj) {
                        const f32x4 v0 = acc[ai][bj][m][0] * SC, v1 = acc[ai][bj][m][1] * SC;
                        int w0 = 0, w1 = 0;
                        w0 = __builtin_amdgcn_cvt_pk_fp8_f32(v0[0], v0[1], w0, false); w0 = __builtin_amdgcn_cvt_pk_fp8_f32(v0[2], v0[3], w0, true);
                        w1 = __builtin_amdgcn_cvt_pk_fp8_f32(v1[0], v1[1], w1, false); w1 = __builtin_amdgcn_cvt_pk_fp8_f32(v1[2], v1[3], w1, true);
                        u32x2 o; o.x = (unsigned)w0; o.y = (unsigned)w1;
                        *(LAS u32x2*)(d + bj * 128) = o;
                    }
                }
                asm volatile("s_waitcnt lgkmcnt(0)" ::: "memory"); __builtin_amdgcn_s_barrier(); asm volatile("" ::: "memory");
#pragma unroll
                for (int k = 0; k < 2; ++k) {
                    const int idx = tid + k * 512, rl = idx >> 4, pc = idx & 15;
                    const u32x4 v = *(const LAS u32x4*)(stg + rl * RS + pc * 16);
                    const int row = ai * 128 + (rl >> 5) * 64 + mh * 32 + (rl & 31);
                    if (u.ti * 256 + row < u.ne) *(u32x4*)(ys + (size_t)(u.rbase + row) * DM + u.pn * 256 + pc * 16) = v;
                }
                asm volatile("s_waitcnt lgkmcnt(0)" ::: "memory"); __builtin_amdgcn_s_barrier(); asm volatile("" ::: "memory");
            }
        if (wr == 1) __builtin_amdgcn_s_barrier();
    }
};
DI void phase_e2(const Ctx& c, int l, int nrows) {
    const Params& p = *c.p;
    moe_setup(c, l, nrows);
    MoeSched<false> S;
    S.nmy = moe_units(c, 4, false, nullptr, 0);
    S.utab = (const LAS int*)(c.smem + LDS_MAIN + 4224); S.toks = (const LAS unsigned*)(c.smem + LDS_MAIN + 8192);
    S.A = (const char*)(p.ws + WS_ACT); S.W = (const char*)(p.ws + WS_WD) + (size_t)l * 257 * 262144; S.wstride = 262144; S.RB = FF;
    EpiE2 E; E.ys = (unsigned char*)(p.ws + WS_YS); E.stg = (LAS unsigned char*)c.smem + LDS_STG; E.tid = c.tid;
    g8::gemm_phase((LAS unsigned char*)c.smem, c.tid, FF, S, E);
}

DI void phase_combine(const Ctx& c, int l, int nrows, bool last) {
    const Params& p = *c.p;
    moe_setup(c, l, nrows);
    const LAS int* roff = (const LAS int*)(c.smem + LDS_MAIN + 2064);
    const unsigned char* ys = (const unsigned char*)(p.ws + WS_YS);
    const int* einfo = (const int*)(p.ws + WS_EINFO);
    const float* slotw = (const float*)(p.ws + WS_SLOTW);
    float* xbuf = (float*)(p.ws + WS_XBUF);
    bf16_t* hbuf = (bf16_t*)(p.ws + WS_HBUF);
    const float* modv = (const float*)(p.ws + WS_MOD);
    const int lane = c.lane;
    const int shared0 = roff[256];
    for (int t = c.bid * NWAVES + c.wid; t < nrows; t += c.nblk * NWAVES) {
        const int b = t < TL ? (t >> 12) : 8;
        const float* gate = modv + (size_t)(l * 9 + b) * 6144 + 5120 + 16 * lane;
        int myrow = 0; float myw = 0.f;
        if (lane < 8) { const int ei = einfo[(size_t)t * 8 + lane]; myrow = roff[ei >> 16] + (ei & 0xffff); myw = slotw[(size_t)t * 8 + lane] * (1.f / 16.f); }
        if (lane == 8) { myrow = shared0 + t; myw = 1.f / 16.f; }
        f32x4 v[4], a[4];
        {
            const u32x4 x0 = *(const u32x4*)((const bf16_t*)xbuf + (size_t)t * DM + 16 * lane), x1 = *(const u32x4*)((const bf16_t*)xbuf + (size_t)t * DM + 16 * lane + 8);
            v[0] = bf4_f32(u32x2{x0.x, x0.y}); v[1] = bf4_f32(u32x2{x0.z, x0.w}); v[2] = bf4_f32(u32x2{x1.x, x1.y}); v[3] = bf4_f32(u32x2{x1.z, x1.w});
        }
#pragma unroll
        for (int j = 0; j < 4; ++j) a[j] = f32x4{0.f, 0.f, 0.f, 0.f};
#pragma unroll
        for (int k = 0; k < 9; ++k) {
            const int row = __builtin_amdgcn_readlane(myrow, k); const float w = rdlane_f(myw, k);
            const u32x4 y = *(const u32x4*)(ys + (size_t)row * DM + 16 * lane);
#pragma unroll
            for (int j = 0; j < 4; ++j) {
                const unsigned word = (j == 0) ? y.x : (j == 1) ? y.y : (j == 2) ? y.z : y.w;
                const auto lo = __builtin_amdgcn_cvt_pk_f32_fp8((int)word, false), hi = __builtin_amdgcn_cvt_pk_f32_fp8((int)word, true);
                a[j].x += w * lo[0]; a[j].y += w * lo[1]; a[j].z += w * hi[0]; a[j].w += w * hi[1];
            }
        }
        float s = 0.f;
#pragma unroll
        for (int j = 0; j < 4; ++j) {
            const f32x4 g = *(const f32x4*)(gate + 4 * j);
            v[j] += g * a[j];
            s += (v[j].x * v[j].x + v[j].y * v[j].y) + (v[j].z * v[j].z + v[j].w * v[j].w);
        }
        const float rstd = rsqrtf(wave_sum(s) * (1.f / DM) + EPSV);
        if (last) {
            const float* gf = p.in[I_GFINAL] + 16 * lane;
#pragma unroll
            for (int j = 0; j < 4; ++j) {
                const f32x4 g = *(const f32x4*)(gf + 4 * j);
                *(f32x4*)(p.out + (size_t)t * DM + 16 * lane + 4 * j) = v[j] * rstd * g;
            }
        } else {
            const float* g = p.in[I_GMIX] + (l + 1) * 1024 + 16 * lane;
            const float* mv = modv + (size_t)((l + 1) * 9 + b) * 6144 + 16 * lane;
            u32x4 o8;
#pragma unroll
            for (int j = 0; j < 4; ++j) {
                *(u32x2*)((bf16_t*)xbuf + (size_t)t * DM + 16 * lane + 4 * j) = f32_bf4(v[j]);
                const f32x4 gg = *(const f32x4*)(g + 4 * j), shh = *(const f32x4*)(mv + 4 * j), scc = *(const f32x4*)(mv + 1024 + 4 * j);
                const f32x4 y = v[j] * rstd * gg * (1.f + scc) + shh;
                const unsigned w8 = pk4_fp8(y.x, y.y, y.z, y.w);
                if (j == 0) o8.x = w8; else if (j == 1) o8.y = w8; else if (j == 2) o8.z = w8; else o8.w = w8;
            }
            *(u32x4*)((unsigned char*)(p.ws + WS_HIN8) + (size_t)t * DM + 16 * lane) = o8;
        }
    }
}
DI void glds16(const void* g, LAS char* l) { __builtin_amdgcn_global_load_lds((const unsigned*)g, (LAS unsigned*)l, 16, 0, 0); }
#define VM_DRAIN() asm volatile("s_waitcnt vmcnt(0)" ::: "memory")
constexpr float FLASH_THR = 8.0f;
struct ModNone { DI bool active(int) const { return true; } DI void apply(int, f32x16&, f32x16&) const {} };
struct ModSwa {
    int nloc, kpos0, qpos, qmin, hi_;
    DI bool active(int j) const { if (j >= nloc) return true; const int k0 = kpos0 + 64 * j; return (k0 + 63 >= qmin - 128) && (k0 <= qmin + 31 + 128); }
    DI void apply(int j, f32x16& s0, f32x16& s1) const {
        if (j >= nloc) return;
        const int hi = hi_;
        const int kb = kpos0 + 64 * j + 4 * hi - qpos;
        const float NINF = -__builtin_inff();
#pragma unroll
        for (int r = 0; r < 16; ++r) {
            const int d = kb + (r & 3) + 8 * (r >> 2);
            if (d < -128 || d > 128) s0[r] = NINF;
            if (d + 32 < -128 || d + 32 > 128) s1[r] = NINF;
        }
    }
};
struct ModNa {
    int nloc, kr0, qr, qc, rs, cs, hi_;
    const LAS float* rpb;
    DI bool active(int j) const { if (j >= nloc) return true; const int kr = kr0 + j; return kr >= rs && kr < rs + 8; }
    DI void apply(int j, f32x16& s0, f32x16& s1) const {
        if (j >= nloc) return;
        const int hi = hi_;
        const int kr = kr0 + j;
        const LAS float* row = rpb + (kr - qr + 7) * 31 + 15 - qc;
        const float NINF = -__builtin_inff();
        float b0[16], b1[16];
#pragma unroll
        for (int r = 0; r < 16; ++r) { const int kc = 4 * hi + (r & 3) + 8 * (r >> 2); b0[r] = row[kc]; b1[r] = row[kc + 32]; }
#pragma unroll
        for (int r = 0; r < 16; ++r) {
            const int kc = 4 * hi + (r & 3) + 8 * (r >> 2);
            const bool ok0 = (kc >= cs) && (kc < cs + 16), ok1 = (kc + 32 >= cs) && (kc + 32 < cs + 16);
            s0[r] = ok0 ? s0[r] + b0[r] : NINF;
            s1[r] = ok1 ? s1[r] + b1[r] : NINF;
        }
    }
};


typedef __attribute__((ext_vector_type(8))) int v8i_f;
typedef __attribute__((ext_vector_type(4))) int v4i_f;
DI void mfma8(f32x16& d, const v8i_f& a, const v8i_f& b, const f32x16& c, int sc) {
    asm volatile("v_mfma_scale_f32_32x32x64_f8f6f4 %0, %1, %2, %3, %4, %4 op_sel_hi:[0,0,0]" : "=&v"(d) : "v"(a), "v"(b), "v"(c), "v"(sc));
}
DI void mfma8_acc(f32x16& d, const v8i_f& a, const v8i_f& b, int sc) {
    asm volatile("v_mfma_scale_f32_32x32x64_f8f6f4 %0, %1, %2, %0, %3, %3 op_sel_hi:[0,0,0]" : "+v"(d) : "v"(a), "v"(b), "v"(sc));
}
template <int DV> struct F8State { float m, l; f32x16 o[DV / 32]; f32x16 cinit; };

template <int DV, class Tok0, class Tile0, class Mod>
DI void pass8(const Ctx& c, int ki, int vrow0, int ntiles, Tok0 tok0, Tile0 vtile, Mod& mod, const v8i_f& qf, F8State<DV>& st) {
    constexpr int ND = DV / 32, STAGE = 4096 + DV * 64;
    const unsigned char* k8 = (const unsigned char*)(c.p->ws + WS_K8);
    const unsigned char* vt8 = (const unsigned char*)(c.p->ws + WS_VT8);
    LAS char* lds = (LAS char*)c.smem;
    const int lane = c.lane, r32 = c.r32, hi = c.hi, w = c.wid;
    int usc = 0x7F7F7F7F; asm volatile("" : "+v"(usc));
    const int prow = 16 * (w & 3) + (lane >> 2), pslot = lane & 3;
    const unsigned koff = (unsigned)(prow * 1024 + ki * 64 + ((pslot ^ ((prow >> 2) & 3)) << 4));
    const int vpiece = (DV == 128) ? w : (w & 3);
    const int vrow = 16 * vpiece + (lane >> 2);
    const unsigned voff = (unsigned)((vrow0 + vrow) * 64 + ((pslot ^ ((vrow >> 2) & 3)) << 4));
    auto issue = [&](int j, LAS char* stage) {
        if (w < 4) glds16(k8 + tok0(j) * 1024 + koff, stage + w * 1024);
        if (DV == 128 || w >= 4) glds16(vt8 + vtile(j) * (size_t)VT_TILE + voff, stage + 4096 + vpiece * 1024);
    };
    st.m = 0.f; st.l = 0.f;
#pragma unroll
    for (int r = 0; r < 16; ++r) st.cinit[r] = 0.f;
#pragma unroll
    for (int d = 0; d < ND; ++d)
#pragma unroll
        for (int r = 0; r < 16; ++r) st.o[d][r] = 0.f;
    issue(0, lds);
    VM_DRAIN();
    __syncthreads();
    const int f = (r32 >> 2) & 3;
    const int o_lo = r32 * 64 + (((2 * hi) ^ f) << 4), o_hi = r32 * 64 + (((2 * hi + 1) ^ f) << 4);
    for (int j = 0; j < ntiles; ++j) {
        if (j + 1 < ntiles) issue(j + 1, lds + ((j + 1) & 1) * STAGE);
        const LAS char* stage = lds + (j & 1) * STAGE;
        if (mod.active(j)) {
            v8i_f ka, kb;
            ka.lo = *(const LAS v4i_f*)(stage + o_lo); ka.hi = *(const LAS v4i_f*)(stage + o_hi);
            kb.lo = *(const LAS v4i_f*)(stage + 2048 + o_lo); kb.hi = *(const LAS v4i_f*)(stage + 2048 + o_hi);
            f32x16 s0, s1;
            __builtin_amdgcn_s_setprio(1); mfma8(s0, ka, qf, st.cinit, usc); mfma8(s1, kb, qf, st.cinit, usc); __builtin_amdgcn_s_setprio(0);
            v8i_f va, vb;
            va.lo = *(const LAS v4i_f*)(stage + 4096 + o_lo); va.hi = *(const LAS v4i_f*)(stage + 4096 + o_hi);
            vb.lo = *(const LAS v4i_f*)(stage + 4096 + 2048 + o_lo); vb.hi = *(const LAS v4i_f*)(stage + 4096 + 2048 + o_hi);
            asm volatile("s_nop 15\n\ts_nop 15" : "+v"(s0), "+v"(s1));
            mod.apply(j, s0, s1);
            float mx = fmaxf(fmaxf(s0[0], s0[1]), s1[0]);
            mx = fmaxf(fmaxf(mx, s1[1]), fmaxf(s0[2], s1[2]));
#pragma unroll
            for (int r = 3; r < 15; r += 2) mx = fmaxf(fmaxf(mx, s0[r]), fmaxf(s0[r + 1], fmaxf(s1[r], s1[r + 1])));
            mx = fmaxf(mx, fmaxf(s0[15], s1[15]));
            { const auto rr = __builtin_amdgcn_permlane32_swap(__float_as_uint(mx), __float_as_uint(mx), false, false); mx = fmaxf(__uint_as_float(rr[0]), __uint_as_float(rr[1])); }
            const bool seen = mx > -1e29f;
            const bool started = half_swap_sum(st.l) > 0.f;
            const bool mv = (mx > FLASH_THR) || (!started && seen);
            if (__any(mv)) {
                const float d = mv ? mx : 0.f;
                const float fs = (mv && started) ? __builtin_amdgcn_exp2f(-d) : 1.f;
                st.m += d; st.l *= fs;
                const float nm2 = -st.m;
                asm volatile("s_nop 15\n\ts_nop 15");
#pragma unroll
                for (int dd = 0; dd < ND; ++dd) asm volatile("" : "+v"(st.o[dd]));
#pragma unroll
                for (int r = 0; r < 16; ++r) { s0[r] -= d; s1[r] -= d; st.cinit[r] = nm2; }
#pragma unroll
                for (int dd = 0; dd < ND; ++dd)
#pragma unroll
                    for (int r = 0; r < 16; ++r) st.o[dd][r] *= fs;
            }
            float rs0 = 0.f, rs1 = 0.f;
#pragma unroll
            for (int r = 0; r < 16; ++r) { s0[r] = __builtin_amdgcn_exp2f(s0[r]); s1[r] = __builtin_amdgcn_exp2f(s1[r]); rs0 += s0[r]; rs1 += s1[r]; }
            st.l += rs0 + rs1;
            v8i_f pf;
#pragma unroll
            for (int idx = 0; idx < 8; ++idx) { const int r0 = (idx >> 2) * 4 + (idx & 3); pf[idx] = (int)pk4_fp8(s0[r0], s0[r0 + 8], s1[r0], s1[r0 + 8]); }
            asm volatile("s_nop 3" : "+v"(pf));
            __builtin_amdgcn_s_setprio(1); mfma8_acc(st.o[0], va, pf, usc); mfma8_acc(st.o[1], vb, pf, usc);
            if constexpr (DV == 128) {
                va.lo = *(const LAS v4i_f*)(stage + 4096 + 4096 + o_lo); va.hi = *(const LAS v4i_f*)(stage + 4096 + 4096 + o_hi);
                vb.lo = *(const LAS v4i_f*)(stage + 4096 + 6144 + o_lo); vb.hi = *(const LAS v4i_f*)(stage + 4096 + 6144 + o_hi);
                mfma8_acc(st.o[2], va, pf, usc); mfma8_acc(st.o[3], vb, pf, usc);
            }
        }
        __builtin_amdgcn_s_setprio(0);
        VM_DRAIN();
        __syncthreads();
    }
    asm volatile("s_nop 15\n\ts_nop 15");
#pragma unroll
    for (int dd = 0; dd < ND; ++dd) asm volatile("" : "+v"(st.o[dd]));
}

DI v8i_f load_q8(const Ctx& c, size_t qtok, int cb) {
    const unsigned char* q8 = (const unsigned char*)(c.p->ws + WS_Q8) + qtok * 1024 + cb * 64 + 32 * c.hi;
    v8i_f qf; qf.lo = *(const v4i_f*)q8; qf.hi = *(const v4i_f*)(q8 + 16);
    return qf;
}
template <int DV>
DI void store_o8(const F8State<DV>& st, float inv, unsigned char* __restrict__ orow, int hi) {
    const float s = inv * MIX_SCALE;
#pragma unroll
    for (int dt = 0; dt < DV / 32; ++dt)
#pragma unroll
        for (int g = 0; g < 4; ++g)
            *(unsigned*)(orow + 32 * dt + 8 * g + 4 * hi) = pk4_fp8(st.o[dt][4 * g] * s, st.o[dt][4 * g + 1] * s, st.o[dt][4 * g + 2] * s, st.o[dt][4 * g + 3] * s);
}

DI void attn_swa_item(const Ctx& c, int l, int b, int h, int qb, bool ctxq) {
    const Params& p = *c.p;
    unsigned char* mix = (unsigned char*)(p.ws + WS_MIX);
    const int kvh = h >> 1;
    const size_t qtok = ctxq ? (size_t)TL + b * CTXL + c.wid * 32 + c.r32 : (size_t)b * SEQ + qb * 256 + c.wid * 32 + c.r32;
    const v8i_f qf = load_q8(c, qtok, h);
    F8State<64> st;
    ModSwa mod; mod.hi_ = c.hi;
    int j0 = 0;
    if (ctxq) { mod.nloc = 0; mod.kpos0 = 0; }
    else { j0 = 4 * qb - 2; if (j0 < 0) j0 = 0; int j1 = 4 * qb + 5; if (j1 > 63) j1 = 63; mod.nloc = j1 - j0 + 1; mod.kpos0 = 64 * j0; }
    mod.qmin = qb * 256 + c.wid * 32; mod.qpos = mod.qmin + c.r32;
    const int nloc = mod.nloc;
    const size_t lbase = (size_t)b * SEQ + 64 * j0, cbase = (size_t)TL + b * CTXL;
    auto tok0 = [&](int j) { return j < nloc ? lbase + 64 * j : cbase + 64 * (j - nloc); };
    const size_t vt0 = (size_t)b * 68;
    auto vtile = [&](int j) { return vt0 + (j < nloc ? j0 + j : 64 + (j - nloc)); };
    pass8<64>(c, kvh, kvh * 64, nloc + 4, tok0, vtile, mod, qf, st);
    float lt = half_swap_sum(st.l);
    lt += __builtin_amdgcn_exp2f(p.in[I_SINK][l * 4 + h] * LOG2E - st.m);
    store_o8<64>(st, 1.f / lt, mix + qtok * DM + h * 64, c.hi);
}

DI void attn_na_item(const Ctx& c, int l, int b, int h, int qb, bool ctxq) {
    const Params& p = *c.p;
    unsigned char* mix = (unsigned char*)(p.ws + WS_MIX);
    LAS float* rpbl = (LAS float*)(c.smem + LDS_MAIN + 1024);
    __syncthreads();
    if (!ctxq) for (int i = c.tid; i < 465; i += NTHREADS) rpbl[i] = p.in[I_RPB][(size_t)(l * 4 + h) * 465 + i] * LOG2E;
    __syncthreads();
    const size_t qtok = ctxq ? (size_t)TL + b * CTXL + c.wid * 32 + c.r32 : (size_t)b * SEQ + qb * 256 + c.wid * 32 + c.r32;
    const v8i_f qf = load_q8(c, qtok, 4 + h);
    F8State<64> st;
    ModNa mod; mod.rpb = rpbl; mod.hi_ = c.hi;
    int kr0 = 0;
    if (ctxq) { mod.nloc = 0; mod.kr0 = 0; mod.qr = 0; mod.qc = 0; mod.rs = 0; mod.cs = 0; }
    else {
        const int r_lo = 4 * qb, r_hi = 4 * qb + 3;
        int a = r_lo - 4; a = a < 0 ? 0 : (a > 56 ? 56 : a);
        int bb = r_hi - 4; bb = bb < 0 ? 0 : (bb > 56 ? 56 : bb);
        kr0 = a; mod.kr0 = a; mod.nloc = bb + 7 - a + 1;
        mod.qr = 4 * qb + (c.wid >> 1); mod.qc = 32 * (c.wid & 1) + c.r32;
        int rs = mod.qr - 4; rs = rs < 0 ? 0 : (rs > 56 ? 56 : rs); mod.rs = rs;
        int cs = mod.qc - 8; cs = cs < 0 ? 0 : (cs > 48 ? 48 : cs); mod.cs = cs;
    }
    const int nloc = mod.nloc;
    const size_t lbase = (size_t)b * SEQ + 64 * kr0, cbase = (size_t)TL + b * CTXL;
    auto tok0 = [&](int j) { return j < nloc ? lbase + 64 * j : cbase + 64 * (j - nloc); };
    const size_t vt0 = (size_t)b * 68;
    auto vtile = [&](int j) { return vt0 + (j < nloc ? kr0 + j : 64 + (j - nloc)); };
    pass8<64>(c, 2 + h, 128 + h * 64, nloc + 4, tok0, vtile, mod, qf, st);
    const float lt = half_swap_sum(st.l);
    store_o8<64>(st, 1.f / lt, mix + qtok * DM + 256 + h * 64, c.hi);
}

DI void attn_diff_item(const Ctx& c, int l, int b, int h, int qb, bool ctxq) {
    const Params& p = *c.p;
    unsigned char* mix = (unsigned char*)(p.ws + WS_MIX);
    const size_t qtok = ctxq ? (size_t)TL + b * CTXL + c.wid * 32 + c.r32 : (size_t)b * SEQ + qb * 256 + c.wid * 32 + c.r32;
    const int nloc = ctxq ? 0 : 64;
    const size_t lbase = (size_t)b * SEQ, cbase = (size_t)TL + b * CTXL;
    auto tok0 = [&](int j) { return j < nloc ? lbase + 64 * j : cbase + 64 * (j - nloc); };
    const size_t vt0 = (size_t)b * 68;
    auto vtile = [&](int j) { return vt0 + (j < nloc ? j : 64 + (j - nloc)); };
    unsigned char* orow = mix + qtok * DM + 512 + h * 128;
    bf16_t* prow = (bf16_t*)(p.ws + WS_PARK) + qtok * 512 + h * 128;
    ModNone mod;
    F8State<128> st;
    {
        const v8i_f qf = load_q8(c, qtok, 8 + 2 * h);
        pass8<128>(c, 6 + 2 * h, 384 + h * 128, nloc + 4, tok0, vtile, mod, qf, st);
        const float inv = 1.f / half_swap_sum(st.l);
#pragma unroll
        for (int dt = 0; dt < 4; ++dt)
#pragma unroll
            for (int g = 0; g < 4; ++g) {
                u32x2 u; u.x = pk2(st.o[dt][4 * g] * inv, st.o[dt][4 * g + 1] * inv); u.y = pk2(st.o[dt][4 * g + 2] * inv, st.o[dt][4 * g + 3] * inv);
                *(u32x2*)(prow + 32 * dt + 8 * g + 4 * c.hi) = u;
            }
    }
    const v8i_f qf = load_q8(c, qtok, 8 + 2 * h + 1);
    pass8<128>(c, 6 + 2 * h + 1, 384 + h * 128, nloc + 4, tok0, vtile, mod, qf, st);
    const float lam_init = 0.8f - 0.6f * __expf(-0.3f * (float)l);
    const float d1 = wave_sum(p.in[I_LQ1][l * 64 + c.lane] * p.in[I_LK1][l * 64 + c.lane]);
    const float d2 = wave_sum(p.in[I_LQ2][l * 64 + c.lane] * p.in[I_LK2][l * 64 + c.lane]);
    const float lam = __expf(d1) - __expf(d2) + lam_init;
    const float inv2 = lam / half_swap_sum(st.l);
    float ss = 0.f;
#pragma unroll
    for (int dt = 0; dt < 4; ++dt)
#pragma unroll
        for (int g = 0; g < 4; ++g) {
            const u32x2 u = *(const u32x2*)(prow + 32 * dt + 8 * g + 4 * c.hi);
            const float a0 = bflo(u.x) - st.o[dt][4 * g] * inv2, a1 = bfhi(u.x) - st.o[dt][4 * g + 1] * inv2;
            const float a2 = bflo(u.y) - st.o[dt][4 * g + 2] * inv2, a3 = bfhi(u.y) - st.o[dt][4 * g + 3] * inv2;
            st.o[dt][4 * g] = a0; st.o[dt][4 * g + 1] = a1; st.o[dt][4 * g + 2] = a2; st.o[dt][4 * g + 3] = a3;
            ss += (a0 * a0 + a1 * a1) + (a2 * a2 + a3 * a3);
        }
    ss = half_swap_sum(ss);
    const float rn = rsqrtf(ss * (1.f / 128.f) + EPSV) * (1.f - lam_init);
    const float* sg = p.in[I_SUBLN] + l * 128;
#pragma unroll
    for (int dt = 0; dt < 4; ++dt)
#pragma unroll
        for (int g = 0; g < 4; ++g) {
            const f32x4 gg = *(const f32x4*)(sg + 32 * dt + 8 * g + 4 * c.hi);
            const float rs = rn * MIX_SCALE;
            *(unsigned*)(orow + 32 * dt + 8 * g + 4 * c.hi) = pk4_fp8(st.o[dt][4 * g] * rs * gg.x, st.o[dt][4 * g + 1] * rs * gg.y, st.o[dt][4 * g + 2] * rs * gg.z, st.o[dt][4 * g + 3] * rs * gg.w);
        }
}

DI void attn_decode(int it, int& b, int& h, int& qb, bool& ctxq) {
    if (it < 512) {
        const int xcd = it & 7, j = it >> 3;
        const int bh = xcd * 4 + (j >> 4); qb = j & 15;
        b = bh >> 2; h = bh & 3; ctxq = false;
    } else {
        const int i = it - 512;
        qb = 0; h = i & 3; b = i >> 2; ctxq = true;
    }
}
DI Ctx reopaque(const Ctx& c) {
    Ctx d = c; int t = c.tid; asm volatile("" : "+v"(t));
    d.tid = t; d.lane = t & 63; d.wid = __builtin_amdgcn_readfirstlane(t >> 6); d.r32 = t & 31; d.hi = (t >> 5) & 1;
    return d;
}
DI void phase_attn0_convert(const Ctx& c) {
    int* actr = (int*)(c.p->ws + WS_ROWCTR) + 128;
    int* cctr = (int*)(c.p->ws + WS_ROWCTR) + 192;
    LAS int* slot = (LAS int*)(c.smem + LDS_MAIN + 64);
    constexpr int NIT = 544, NATT = 3 * NIT;
    const bool prefer_conv = (c.bid & 1) != 0;
    for (;;) {
        if (c.tid == 0) {
            int k = -1, v = 0;
            if (prefer_conv) {
                v = atomicAdd(cctr, 1); if (v < CONV_NCHUNK) k = 1;
                if (k < 0) { v = atomicAdd(actr, 1); if (v < NATT) k = 0; }
            } else {
                v = atomicAdd(actr, 1); if (v < NATT) k = 0;
                if (k < 0) { v = atomicAdd(cctr, 1); if (v < CONV_NCHUNK) k = 1; }
            }
            slot[0] = k; slot[1] = v;
        }
        __syncthreads();
        const int kind = slot[0], idx = slot[1];
        __syncthreads();
        if (kind < 0) break;
        if (kind == 1) {
            convert_pairs(reopaque(c), idx * CONV_CHUNK, 1, CONV_CHUNK, [](int q) { return rmap_expert(q); });
        } else {
            const int grp = idx / NIT, it = idx - grp * NIT;
            int b, h, qb; bool ctxq; attn_decode(it, b, h, qb, ctxq);
            if (grp == 0) attn_diff_item(reopaque(c), 0, b, h, qb, ctxq);
            else if (grp == 1) attn_swa_item(reopaque(c), 0, b, h, qb, ctxq);
            else attn_na_item(reopaque(c), 0, b, h, qb, ctxq);
        }
    }
}
DI void phase_attn(const Ctx& c, int l) {
    const int NIT = 512 + ((l == 0) ? 32 : 0);
    for (int it = c.bid; it < NIT; it += c.nblk) { int b, h, qb; bool ctxq; attn_decode(it, b, h, qb, ctxq); attn_diff_item(c, l, b, h, qb, ctxq); }
    for (int it = c.bid; it < NIT; it += c.nblk) { int b, h, qb; bool ctxq; attn_decode(it, b, h, qb, ctxq); attn_swa_item(c, l, b, h, qb, ctxq); }
    for (int it = c.bid; it < NIT; it += c.nblk) { int b, h, qb; bool ctxq; attn_decode(it, b, h, qb, ctxq); attn_na_item(c, l, b, h, qb, ctxq); }
}
#ifndef WAVES_PER_SIMD
#define WAVES_PER_SIMD 2
#endif
#ifndef PROBE_REP
#define PROBE_REP 0
#endif
#ifndef DBG_MODE
#define DBG_MODE 0
#endif
DI Ctx mkctx(const Params& p, char* smem, int wave_s) {
    Ctx c; c.p = &p; c.smem = smem;
    int t = wave_s * 64 + (int)__builtin_amdgcn_mbcnt_hi(~0u, __builtin_amdgcn_mbcnt_lo(~0u, 0u)); asm volatile("" : "+v"(t));
    c.tid = t; c.lane = t & 63; c.wid = __builtin_amdgcn_readfirstlane(t >> 6); c.r32 = t & 31; c.hi = (t >> 5) & 1;
    int b = blockIdx.x, n = gridDim.x; asm volatile("" : "+s"(b), "+s"(n));
    c.bid = b; c.nblk = n;
    return c;
}
__global__ void __launch_bounds__(NTHREADS, WAVES_PER_SIMD) mega(Params p) {
    extern __shared__ __attribute__((aligned(16))) char smem[];
    Ctx c; c.p = &p; c.smem = smem; c.tid = threadIdx.x; c.lane = c.tid & 63; c.wid = c.tid >> 6; c.r32 = c.lane & 31; c.hi = c.lane >> 5;
    c.bid = blockIdx.x; c.nblk = gridDim.x;
    const int wave_s = __builtin_amdgcn_readfirstlane((int)threadIdx.x >> 6);
#define FRESH() mkctx(p, smem, wave_s)
#define GRID_SYNC() do { XcdBarrier bb_ = bar; asm volatile("" : "+s"(bb_.bar), "+s"(bb_.x)); xcd_barrier(bb_); } while (0)
    volatile LAS unsigned* xbw = (volatile LAS unsigned*)(smem + LDS_MAIN);
    if (c.tid == 0) { xbw[0] = 0u; xbw[1] = 0u; xbw[2] = 0u; xbw[3] = 0u; }
    __syncthreads();
    XcdBarrier bar = xcd_barrier_post((unsigned*)(p.ws + WS_BAR), xbw);
    asm volatile("; PHASE_MARK prologue" ::: "memory");
    phase_prologue(FRESH());
    GRID_SYNC();
#if PROBE_REP == 1
    asm volatile("; PHASE_MARK prologue" ::: "memory");
    phase_prologue(FRESH());
    GRID_SYNC();
#endif
    asm volatile("; PHASE_MARK norm" ::: "memory");
    phase_norm(FRESH(), 0, TT, true, 0);
    wrp_items(FRESH());
    GRID_SYNC();
#if PROBE_REP == 9
    phase_norm(FRESH(), 0, TT, true, 0);
    GRID_SYNC();
#endif
#if PROBE_REP == 13
#pragma unroll 1
    for (int z = 0; z < 20; ++z) { GRID_SYNC(); }
#endif
#pragma unroll 1
    for (int l = 0; l < 2; ++l) {
        const bool last = (l == 1);
        const int nrows = last ? TL : TT;
        asm volatile("; PHASE_MARK inproj" ::: "memory");
        asm volatile("; PHASE_MARK inproj" ::: "memory");
    phase_inproj(FRESH(), l);
        GRID_SYNC();
#if PROBE_REP == 2
        asm volatile("; PHASE_MARK inproj" ::: "memory");
        asm volatile("; PHASE_MARK inproj" ::: "memory");
    phase_inproj(FRESH(), l);
        GRID_SYNC();
#endif
        asm volatile("; PHASE_MARK attn" ::: "memory");
        asm volatile("; PHASE_MARK attn" ::: "memory");
        if (l == 0) phase_attn0_convert(FRESH()); else phase_attn(FRESH(), l);
        GRID_SYNC();
#if PROBE_REP == 3
        asm volatile("; PHASE_MARK attn" ::: "memory");
        asm volatile("; PHASE_MARK attn" ::: "memory");
    phase_attn(FRESH(), l);
        GRID_SYNC();
#endif
        asm volatile("; PHASE_MARK outproj" ::: "memory");
        asm volatile("; PHASE_MARK outproj" ::: "memory");
    phase_outproj(FRESH(), l, nrows);
        GRID_SYNC();
#if PROBE_REP == 7
        if (l == 0) { phase_outproj(FRESH(), l, nrows); GRID_SYNC(); }
#endif
#if DBG_MODE != 1
        asm volatile("; PHASE_MARK router" ::: "memory");
    phase_norm_router(FRESH(), l, nrows);
        GRID_SYNC();
        asm volatile("; PHASE_MARK route" ::: "memory");
        asm volatile("; PHASE_MARK route" ::: "memory");
    phase_route(FRESH(), l, nrows);
        GRID_SYNC();
        asm volatile("; PHASE_MARK e1" ::: "memory");
        asm volatile("; PHASE_MARK e1" ::: "memory");
    phase_e1(FRESH(), l, nrows);
        GRID_SYNC();
#if PROBE_REP == 4
        asm volatile("; PHASE_MARK e1" ::: "memory");
        asm volatile("; PHASE_MARK e1" ::: "memory");
    phase_e1(FRESH(), l, nrows);
        GRID_SYNC();
#endif
        asm volatile("; PHASE_MARK e2" ::: "memory");
        asm volatile("; PHASE_MARK e2" ::: "memory");
    phase_e2(FRESH(), l, nrows);
        GRID_SYNC();
#if PROBE_REP == 5
        asm volatile("; PHASE_MARK e2" ::: "memory");
        asm volatile("; PHASE_MARK e2" ::: "memory");
    phase_e2(FRESH(), l, nrows);
        GRID_SYNC();
#endif
#endif
        asm volatile("; PHASE_MARK combine" ::: "memory");
        asm volatile("; PHASE_MARK combine" ::: "memory");
    phase_combine(FRESH(), l, nrows, last);
#if PROBE_REP == 8
        if (last) { GRID_SYNC(); phase_combine(FRESH(), l, nrows, last); }
#endif
        if (!last) { GRID_SYNC(); }
    }
}

extern "C" void kernel_launch(void* const* d_in, const int* in_sizes, int n_in, void* d_out, int out_size, void* d_ws, size_t ws_size, hipStream_t stream) {
    static int grid = 0;
    if (grid == 0) {
        int dev = 0, cus = 0, per_cu = 0;
        if (n_in != 26 || ws_size < WS_END) { fprintf(stderr, "kernel_launch: unexpected n_in %d / ws %zu (need %zu)\n", n_in, ws_size, (size_t)WS_END); grid = -1; return; }
        if (hipGetDevice(&dev) != hipSuccess || hipDeviceGetAttribute(&cus, hipDeviceAttributeMultiprocessorCount, dev) != hipSuccess) { grid = -1; return; }
        if (hipFuncSetAttribute((const void*)mega, hipFuncAttributeMaxDynamicSharedMemorySize, LDS_BYTES) != hipSuccess) { grid = -1; return; }
        if (hipOccupancyMaxActiveBlocksPerMultiprocessor(&per_cu, (const void*)mega, NTHREADS, LDS_BYTES) != hipSuccess || per_cu < 1) per_cu = 1;
        (void)hipGetLastError();
        grid = cus;
    }
    if (grid < 0) return;
    (void)hipMemsetAsync((char*)d_ws + WS_BAR, 0, WS_ZERO_BYTES, stream);
    Params p{};
    for (int i = 0; i < 26; ++i) p.in[i] = (const float*)d_in[i];
    p.out = (float*)d_out; p.ws = (unsigned char*)d_ws;
    hipLaunchKernelGGL(mega, dim3(grid), dim3(NTHREADS), LDS_BYTES, stream, p);
}
```

```cpp
#include <hip/hip_runtime.h>
#include <hip/hip_bf16.h>
#include <cstdio>
#include <cstdint>

#define XB_TMO      128
#define XB_XCNT(j)  (256  + 64 * (j))
#define XB_XSUB(j)  (1280 + 64 * (j))
#define XB_XGEN(j)  (2304 + 64 * (j))
#define XB_TOP      3328
#define XB_TOPGEN   3392
#define XCD_BAR_WORDS 3456
#define XB_SPIN_CAP (1u << 22)
#define LAS __attribute__((address_space(3)))

__device__ __forceinline__ unsigned xb_ld(unsigned* p)              { return __hip_atomic_load(p, __ATOMIC_RELAXED, __HIP_MEMORY_SCOPE_AGENT); }
__device__ __forceinline__ unsigned xb_add(unsigned* p, unsigned v) { return __hip_atomic_fetch_add(p, v, __ATOMIC_RELAXED, __HIP_MEMORY_SCOPE_AGENT); }
__device__ __forceinline__ unsigned xb_xcc_id() { return (unsigned)__builtin_amdgcn_s_getreg((3 << 11) | 20) & 0xFu; }
#define XB_SPIN(cond, bar) do { unsigned _sp = 0; while (cond) { __builtin_amdgcn_s_sleep(1); \
    if ((++_sp & 255u) == 0u) { if (xb_ld(&(bar)[XB_TMO])) break; if (_sp > XB_SPIN_CAP) { atomicAdd(&(bar)[XB_TMO], 1u); break; } } } } while (0)

struct XcdBarrier {
    unsigned* bar; unsigned x;
    volatile LAS unsigned* st;
};

__device__ __forceinline__ XcdBarrier xcd_barrier_post(unsigned* bar, volatile LAS unsigned* st) {
    XcdBarrier b; b.bar = bar; b.x = xb_xcc_id(); b.st = st;
    if (threadIdx.x == 0) (void)xb_add(&bar[XB_XCNT(b.x)], 1u);
    return b;
}
__device__ __forceinline__ void xcd_barrier_complete(unsigned* bar, unsigned x, unsigned& nloc, unsigned& nx) {
    const unsigned G = gridDim.x * gridDim.y * gridDim.z;
    unsigned sum, cnt, mine, sp = 0u;
    for (;;) {
        sum = 0u; cnt = 0u; mine = 0u;
#pragma unroll
        for (unsigned j = 0; j < 16; ++j) { const unsigned c = xb_ld(&bar[XB_XCNT(j)]); sum += c; cnt += (c > 0u) ? 1u : 0u; mine = (j == x) ? c : mine; }
        if (sum == G) break;
        __builtin_amdgcn_s_sleep(1);
        if ((++sp & 255u) == 0u) { if (xb_ld(&bar[XB_TMO])) break; if (sp > XB_SPIN_CAP) { atomicAdd(&bar[XB_TMO], 1u); break; } }
    }
    nloc = mine > 0u ? mine : 1u; nx = cnt > 0u ? cnt : 1u;
}

__device__ __forceinline__ void xcd_barrier(const XcdBarrier& b) {
    asm volatile("s_waitcnt vmcnt(0)" ::: "memory");
    __syncthreads();
    if (threadIdx.x == 0) {
        unsigned* bar = b.bar;
        __builtin_amdgcn_s_waitcnt(0);
        unsigned nloc = b.st[0], nx = b.st[1];
        if (nloc == 0u) { xcd_barrier_complete(bar, b.x, nloc, nx); b.st[0] = nloc; b.st[1] = nx; }
        const unsigned old = xb_add(&bar[XB_XSUB(b.x)], 1u);
        const unsigned gen = old / nloc;
        if (old + 1u == (gen + 1u) * nloc) {
            __builtin_amdgcn_fence(__ATOMIC_RELEASE, "agent");
            asm volatile("s_waitcnt vmcnt(0)" ::: "memory");
            const unsigned og = xb_add(&bar[XB_TOP], 1u);
            const unsigned tg = og / nx;
            if (og + 1u == (tg + 1u) * nx) xb_add(&bar[XB_TOPGEN], 1u);
            else XB_SPIN(xb_ld(&bar[XB_TOPGEN]) == tg, bar);
            __builtin_amdgcn_fence(__ATOMIC_ACQUIRE, "agent");
            xb_add(&bar[XB_XGEN(b.x)], 1u);
            asm volatile("s_waitcnt vmcnt(0)" ::: "memory");
        } else {
            XB_SPIN(xb_ld(&bar[XB_XGEN(b.x)]) == gen, bar);
            __builtin_amdgcn_fence(__ATOMIC_ACQUIRE, "agent");
            asm volatile("s_waitcnt vmcnt(0)" ::: "memory");
        }
    }
    __syncthreads();
}

constexpr int DM = 1024, NB = 8, SEQ = 4096, CTXL = 256;
constexpr int TL = NB * SEQ;
constexpr int TC = NB * CTXL;
constexpr int TT = TL + TC;
constexpr int INC = 2816, QC = 1024, KVC = 1792;
constexpr int NE = 256, NEX = 257, FF = 256;
constexpr float EPSV = 1e-6f;
constexpr float LOG2E = 1.4426950408889634f;
constexpr float QSCALE = 0.125f * LOG2E;
constexpr float MIX_SCALE = 4.0f, W_SCALE = 32.0f, WD_SCALE = 16.0f, ACT_SCALE = 2.0f;
constexpr int NTHREADS = 512;
constexpr int NWAVES = 8;
constexpr int LDS_MAIN = 131072;
constexpr int LDS_AUX = 8192 + 16384 + 8192;
constexpr int LDS_BYTES = LDS_MAIN + LDS_AUX;
constexpr int LDS_STG = LDS_MAIN + 8192;
static_assert(LDS_BYTES <= 163840, "LDS");

typedef unsigned short bf16_t;
typedef __attribute__((ext_vector_type(8))) short bf16x8;
typedef __attribute__((ext_vector_type(4))) short s16x4;
typedef __attribute__((ext_vector_type(16))) float f32x16;
typedef __attribute__((ext_vector_type(2))) float f32x2;
typedef __attribute__((ext_vector_type(2))) __bf16 bf16x2v;
typedef short v4i16_t __attribute__((ext_vector_type(4)));
typedef __attribute__((ext_vector_type(4))) unsigned u32x4;
typedef __attribute__((ext_vector_type(2))) unsigned u32x2;
typedef __attribute__((ext_vector_type(4))) float f32x4;
#define DI __device__ __forceinline__
#define MFMA32(a, b, c) __builtin_amdgcn_mfma_f32_32x32x16_bf16((a), (b), (c), 0, 0, 0)

DI unsigned pk2(float lo, float hi) { f32x2 v = {lo, hi}; bf16x2v b = __builtin_convertvector(v, bf16x2v); return __builtin_bit_cast(unsigned, b); }
DI unsigned pk4_fp8(float a, float b, float c, float d) { int w = 0; w = __builtin_amdgcn_cvt_pk_fp8_f32(a, b, w, false); w = __builtin_amdgcn_cvt_pk_fp8_f32(c, d, w, true); return (unsigned)w; }
DI float bf2f(bf16_t u) { return __uint_as_float(((unsigned)u) << 16); }
DI float bflo(unsigned u) { return __uint_as_float(u << 16); }
DI float bfhi(unsigned u) { return __uint_as_float(u & 0xffff0000u); }
DI f32x4 bf4_f32(u32x2 w) { return f32x4{bflo(w.x), bfhi(w.x), bflo(w.y), bfhi(w.y)}; }
DI u32x2 f32_bf4(f32x4 v) { u32x2 o; o.x = pk2(v[0], v[1]); o.y = pk2(v[2], v[3]); return o; }
DI int crow(int reg, int hi) { return (reg & 3) + 8 * (reg >> 2) + 4 * hi; }
#define DPPI(v, CTRL) __builtin_amdgcn_update_dpp(0, (v), (CTRL), 0xf, 0xf, true)
#define DPPF(v, CTRL) __builtin_bit_cast(float, __builtin_amdgcn_update_dpp(0, __builtin_bit_cast(int, (v)), (CTRL), 0xf, 0xf, true))
#define DPP_XOR1 0xB1
#define DPP_XOR2 0x4E
#define DPP_HMIR 0x141
#define DPP_MIR  0x140
#define DPP_SHR(n) (0x110 + (n))
DI float rdlane_f(float v, int l) { return __builtin_bit_cast(float, __builtin_amdgcn_readlane(__builtin_bit_cast(int, v), l)); }
DI float wave_sum(float v) {
    v += DPPF(v, DPP_XOR1); v += DPPF(v, DPP_XOR2); v += DPPF(v, DPP_HMIR); v += DPPF(v, DPP_MIR);
    return (rdlane_f(v, 0) + rdlane_f(v, 16)) + (rdlane_f(v, 32) + rdlane_f(v, 48));
}
DI float half_swap_sum(float v) {
    const auto rr = __builtin_amdgcn_permlane32_swap(__float_as_uint(v), __float_as_uint(v), false, false);
    return __uint_as_float(rr[0]) + __uint_as_float(rr[1]);
}
DI float siluf(float v) { return v / (1.f + __expf(-v)); }

struct Params {
    const float* in[26];
    float* out;
    unsigned char* ws;
};
enum { I_X = 0, I_C, I_CTX, I_CCTX, I_WMOD, I_BMOD, I_GMIX, I_GFFN, I_WIN, I_WOUT, I_SINK, I_RPB, I_LQ1, I_LK1, I_LQ2, I_LK2, I_SUBLN,
       I_WR, I_RB, I_WG, I_WU, I_WD, I_SG, I_SU, I_SD, I_GFINAL };

constexpr size_t MiB = 1u << 20;
constexpr size_t WS_BAR = 0;
constexpr size_t WS_CNT = 16384;
constexpr int CNT_STRIDE = 64, CNT_LAYER = 257 * 64;
constexpr size_t WS_ZERO_BYTES = 163840;
constexpr size_t WS_ROPE = 196608;
constexpr size_t WS_MOD = 262144;
constexpr size_t WS_WIN = 1 * MiB;
constexpr size_t WS_WOUT = 12 * MiB;
constexpr size_t WS_WR = 16 * MiB;
constexpr size_t WS_WGU = 17 * MiB;
constexpr size_t WS_WD = WS_WGU + 514 * MiB;
constexpr size_t WS_XBUF = WS_WD + 257 * MiB;
constexpr size_t WS_HBUF = WS_XBUF + 136 * MiB;
constexpr size_t WS_SLOTW = WS_HBUF + 68 * MiB;
constexpr size_t WS_LIST = WS_SLOTW + 2 * MiB;
constexpr size_t WS_R = WS_LIST + 34 * MiB;
constexpr size_t WS_Q = WS_R;
constexpr size_t WS_KV = WS_R + 68 * MiB;
constexpr size_t WS_MIX = WS_R + 187 * MiB;
constexpr size_t WS_PARK = WS_R + 221 * MiB;
constexpr size_t WS_Q8 = WS_R + 290 * MiB;
constexpr size_t WS_K8 = WS_R + 324 * MiB;
constexpr size_t WS_VT8 = WS_R + 358 * MiB;
constexpr int VT_ROWS = 896, VT_TILE = 896 * 64;
constexpr size_t WS_LOGIT = WS_R + 256 * MiB;
constexpr size_t WS_ACT = WS_R;
constexpr size_t WS_HIN8 = WS_WGU + 300 * MiB;
constexpr size_t WS_H8 = WS_R + 80 * MiB;
constexpr size_t WS_YS = WS_R + 153 * MiB;
constexpr size_t WS_EINFO = WS_R + 512 * MiB;
constexpr size_t WS_WRP = WS_R + 460 * MiB;
constexpr size_t WS_CB = WS_R + 470 * MiB;
constexpr size_t WS_RSTD = WS_R + 471 * MiB;
constexpr size_t WS_ROWCTR = 151552;
constexpr size_t WS_END = WS_YS + 612 * MiB;
static_assert(WS_END <= 2048 * MiB, "workspace");

struct Ctx {
    const Params* p;
    char* smem;
    int tid, lane, wid, r32, hi;
    int bid, nblk;
};
DI int map_row(int type, int n) {
    if (type == 1) {
        const int hb = n >> 6, d = n & 63;
        const bool roped = (hb < 4) || (hb >= 8 && hb < 16) || (hb == 16) || (hb == 17) || (hb >= 28 && hb < 36);
        int d2 = d;
        if (roped) d2 = (d < 16) ? 2 * d : (d < 32) ? 2 * (d - 16) + 1 : (d < 48) ? 2 * (d - 16) : 2 * (d - 32) + 1;
        return (hb << 6) | d2;
    }
    if (type == 2) return 2 * n;
    if (type == 3) return 2 * n + 1;
    return n;
}

struct TItem { const float* W; int K, N, kt, nt, type; void* dst; bool f8; float ws; };
DI void tload(const Ctx& c, float (&v)[4][2][8], const TItem& it) {
    const int wid4 = c.wid & 3;
    const int k0 = it.kt * 128, n0 = it.nt * 128;
#pragma unroll
    for (int cc = 0; cc < 4; ++cc) {
        const int kc = 4 * wid4 + cc;
#pragma unroll
        for (int j = 0; j < 8; ++j)
#pragma unroll
            for (int i = 0; i < 2; ++i) v[cc][i][j] = it.W[(size_t)(k0 + kc * 8 + j) * it.N + n0 + c.lane + 64 * i];
    }
}
DI void tfinish(const Ctx& c, const float (&v)[4][2][8], const TItem& it) {
    LAS char* lds = (LAS char*)c.smem + (c.tid >> 8) * 36864;
    const int wid4 = c.wid & 3, tid8 = c.tid & 255;
    const int k0 = it.kt * 128, n0 = it.nt * 128, K = it.K;
    const float wscale = it.ws;
#pragma unroll
    for (int cc = 0; cc < 4; ++cc) {
        const int kc = 4 * wid4 + cc;
#pragma unroll
        for (int i = 0; i < 2; ++i) {
            if (it.f8) {
                u32x2 u; u.x = pk4_fp8(v[cc][i][0] * wscale, v[cc][i][1] * wscale, v[cc][i][2] * wscale, v[cc][i][3] * wscale); u.y = pk4_fp8(v[cc][i][4] * wscale, v[cc][i][5] * wscale, v[cc][i][6] * wscale, v[cc][i][7] * wscale);
                *(LAS u32x2*)(lds + (c.lane + 64 * i) * 144 + kc * 8) = u;
            } else {
                u32x4 u; u.x = pk2(v[cc][i][0], v[cc][i][1]); u.y = pk2(v[cc][i][2], v[cc][i][3]); u.z = pk2(v[cc][i][4], v[cc][i][5]); u.w = pk2(v[cc][i][6], v[cc][i][7]);
                *(LAS u32x4*)(lds + (c.lane + 64 * i) * 272 + kc * 16) = u;
            }
        }
    }
    __syncthreads();
    if (it.f8) {
        unsigned char* dst = (unsigned char*)it.dst;
#pragma unroll
        for (int j = 0; j < 4; ++j) {
            const int idx = tid8 + 256 * j, c16 = idx & 7, n = idx >> 3;
            const u32x4 u = *(LAS u32x4*)(lds + n * 144 + c16 * 16);
            const int row = map_row(it.type, n0 + n);
            *(u32x4*)(dst + (size_t)row * K + k0 + c16 * 16) = u;
        }
    } else {
        bf16_t* dst = (bf16_t*)it.dst;
#pragma unroll
        for (int j = 0; j < 8; ++j) {
            const int idx = tid8 + 256 * j, c16 = idx & 15, n = idx >> 4;
            const u32x4 u = *(LAS u32x4*)(lds + n * 272 + c16 * 16);
            const int row = map_row(it.type, n0 + n);
            *(u32x4*)(dst + (size_t)row * K + k0 + c16 * 8) = u;
        }
    }
    __syncthreads();
}

DI void mod_item(const Ctx& c, int l, int cg) {
    const Params& p = *c.p;
    LAS float* sv = (LAS float*)c.smem;
    LAS float* part = (LAS float*)(c.smem + 36864);
    for (int idx = c.tid; idx < 9 * 1024; idx += NTHREADS) {
        const int b = idx >> 10, k = idx & 1023;
        const float v = (b < 8) ? p.in[I_C][b * 1024 + k] : p.in[I_CCTX][k];
        sv[idx] = siluf(v);
    }
    __syncthreads();
    const int col = c.tid & 63, kq = c.tid >> 6;
    float acc[9];
#pragma unroll
    for (int b = 0; b < 9; ++b) acc[b] = 0.f;
    const float* wp = p.in[I_WMOD] + ((size_t)l * 1024 + kq * 128) * 6144 + cg * 64 + col;
    for (int k = 0; k < 128; k += 8) {
        float w[8];
#pragma unroll
        for (int u = 0; u < 8; ++u) w[u] = wp[(size_t)(k + u) * 6144];
#pragma unroll
        for (int u = 0; u < 8; ++u)
#pragma unroll
            for (int b = 0; b < 9; ++b) acc[b] += sv[b * 1024 + kq * 128 + k + u] * w[u];
    }
#pragma unroll
    for (int b = 0; b < 9; ++b) part[(kq * 9 + b) * 64 + col] = acc[b];
    __syncthreads();
    float* modv = (float*)(p.ws + WS_MOD);
    for (int idx = c.tid; idx < 576; idx += NTHREADS) {
        const int b = idx >> 6, cl = idx & 63;
        float s = 0.f;
#pragma unroll
        for (int q = 0; q < 8; ++q) s += part[(q * 9 + b) * 64 + cl];
        modv[(size_t)(l * 9 + b) * 6144 + cg * 64 + cl] = s + p.in[I_BMOD][l * 6144 + cg * 64 + cl];
    }
    __syncthreads();
}

DI void rope_item(const Ctx& c) {
    float2* tab = (float2*)(c.p->ws + WS_ROPE);
    for (int idx = c.tid; idx < 1024; idx += NTHREADS) {
        const int pos = idx >> 4, i = idx & 15;
        const float inv = 1.0f / powf(10000.0f, (float)i / 16.0f);
        const float ang = (float)pos * inv;
        float sn, cs; sincosf(ang, &sn, &cs);
        tab[idx] = make_float2(cs, sn);
    }
}

constexpr int PRO_PER_LAYER = 12592;
DI TItem transpose_decode(const Ctx& c, int r) {
    const Params& p = *c.p;
    const int l = r / PRO_PER_LAYER; r -= l * PRO_PER_LAYER;
    unsigned char* wgu = (unsigned char*)(p.ws + WS_WGU) + (size_t)l * 257 * 524288;
    unsigned char* wd = (unsigned char*)(p.ws + WS_WD) + (size_t)l * 257 * 262144;
    TItem t; t.f8 = true; t.ws = W_SCALE;
    if (r < 4096) { const int e = r >> 4, s = r & 15; t.W = p.in[I_WG] + (size_t)(l * 256 + e) * 262144; t.K = 1024; t.N = 256; t.kt = s >> 1; t.nt = s & 1; t.dst = wgu + (size_t)e * 524288; t.type = 2; }
    else if (r < 8192) { r -= 4096; const int e = r >> 4, s = r & 15; t.W = p.in[I_WU] + (size_t)(l * 256 + e) * 262144; t.K = 1024; t.N = 256; t.kt = s >> 1; t.nt = s & 1; t.dst = wgu + (size_t)e * 524288; t.type = 3; }
    else if (r < 12288) { r -= 8192; const int e = r >> 4, s = r & 15; t.W = p.in[I_WD] + (size_t)(l * 256 + e) * 262144; t.K = 256; t.N = 1024; t.kt = s >> 3; t.nt = s & 7; t.dst = wd + (size_t)e * 262144; t.type = 0; t.ws = WD_SCALE; }
    else {
        r -= 12288;
        if (r < 176) { t.W = p.in[I_WIN] + (size_t)l * 1024 * 2816; t.K = 1024; t.N = 2816; t.kt = r / 22; t.nt = r % 22; t.dst = (unsigned char*)(p.ws + WS_WIN) + (size_t)l * 2816 * 1024; t.type = 1; }
        else if (r < 240) { r -= 176; t.W = p.in[I_WOUT] + (size_t)l * 1048576; t.K = 1024; t.N = 1024; t.kt = r >> 3; t.nt = r & 7; t.dst = (unsigned char*)(p.ws + WS_WOUT) + (size_t)l * 1048576; t.type = 0; }
        else if (r < 256) { r -= 240; t.W = p.in[I_WR] + (size_t)l * 262144; t.K = 1024; t.N = 256; t.kt = r >> 1; t.nt = r & 1; t.dst = (bf16_t*)(p.ws + WS_WR) + (size_t)l * 262144; t.type = 0; t.f8 = false; }
        else if (r < 272) { r -= 256; t.W = p.in[I_SG] + (size_t)l * 262144; t.K = 1024; t.N = 256; t.kt = r >> 1; t.nt = r & 1; t.dst = wgu + (size_t)256 * 524288; t.type = 2; }
        else if (r < 288) { r -= 272; t.W = p.in[I_SU] + (size_t)l * 262144; t.K = 1024; t.N = 256; t.kt = r >> 1; t.nt = r & 1; t.dst = wgu + (size_t)256 * 524288; t.type = 3; }
        else { r -= 288; t.W = p.in[I_SD] + (size_t)l * 262144; t.K = 256; t.N = 1024; t.kt = r >> 3; t.nt = r & 7; t.dst = wd + (size_t)256 * 262144; t.type = 0; t.ws = WD_SCALE; }
    }
    return t;
}
template <class RMap>
DI void convert_pairs(const Ctx& c, int first, int stride, int n, RMap rmap) {
    if (n <= 0) return;
    const int half = c.tid >> 8;
    float va[4][2][8], vb[4][2][8];
    TItem ia = transpose_decode(c, rmap(first) + half), ib = ia;
    tload(c, va, ia);
    int i = 0;
    for (;;) {
        const bool m1 = i + 1 < n;
        if (m1) { ib = transpose_decode(c, rmap(first + (i + 1) * stride) + half); tload(c, vb, ib); }
        tfinish(c, va, ia);
        if (!m1) break;
        ++i;
        const bool m2 = i + 1 < n;
        if (m2) { ia = transpose_decode(c, rmap(first + (i + 1) * stride) + half); tload(c, va, ia); }
        tfinish(c, vb, ib);
        if (!m2) break;
        ++i;
    }
}
constexpr int PRO_EXPERT = 12288, PRO_SMALL = PRO_PER_LAYER - PRO_EXPERT;
constexpr int CONV_CHUNK = 8, CONV_NCHUNK = 2 * PRO_EXPERT / 2 / CONV_CHUNK;
DI int rmap_small(int q) { const int l = q / (PRO_SMALL / 2), s = q - l * (PRO_SMALL / 2); return l * PRO_PER_LAYER + PRO_EXPERT + 2 * s; }
DI int rmap_expert(int q) { const int l = q / (PRO_EXPERT / 2), s = q - l * (PRO_EXPERT / 2); return l * PRO_PER_LAYER + 2 * s; }
DI void phase_prologue(const Ctx& c) {
    for (int it = c.bid; it < 193; it += c.nblk) { if (it < 192) mod_item(c, it / 96, it % 96); else rope_item(c); }
    __syncthreads();
    constexpr int NP = PRO_SMALL;
    const int n = (NP > c.bid) ? (NP - c.bid + c.nblk - 1) / c.nblk : 0;
    convert_pairs(c, c.bid, c.nblk, n, [](int q) { return rmap_small(q); });
}

template <bool XBF>
DI void norm_mod_row(const float* __restrict__ xrow, const float* __restrict__ g, const float* __restrict__ sh, const float* __restrict__ sc, bf16_t* __restrict__ orow, unsigned char* __restrict__ o8, int lane) {
    float4 v[4]; float s = 0.f;
#pragma unroll
    for (int j = 0; j < 4; ++j) { if constexpr (XBF) { const f32x4 t4 = bf4_f32(((const u32x2*)xrow)[lane + 64 * j]); v[j] = make_float4(t4[0], t4[1], t4[2], t4[3]); } else v[j] = ((const float4*)xrow)[lane + 64 * j]; s += (v[j].x * v[j].x + v[j].y * v[j].y) + (v[j].z * v[j].z + v[j].w * v[j].w); }
    const float rstd = rsqrtf(wave_sum(s) * (1.f / DM) + EPSV);
#pragma unroll
    for (int j = 0; j < 4; ++j) {
        const float4 gg = ((const float4*)g)[lane + 64 * j], shh = ((const float4*)sh)[lane + 64 * j], scc = ((const float4*)sc)[lane + 64 * j];
        const float y0 = v[j].x * rstd * gg.x * (1.f + scc.x) + shh.x, y1 = v[j].y * rstd * gg.y * (1.f + scc.y) + shh.y;
        const float y2 = v[j].z * rstd * gg.z * (1.f + scc.z) + shh.z, y3 = v[j].w * rstd * gg.w * (1.f + scc.w) + shh.w;
        u32x2 o; o.x = pk2(y0, y1); o.y = pk2(y2, y3);
        if (orow) ((u32x2*)orow)[lane + 64 * j] = o;
        if (o8) ((unsigned*)o8)[lane + 64 * j] = pk4_fp8(y0, y1, y2, y3);
    }
}

DI void wrp_items(const Ctx& c) {
    const Params& p = *c.p;
    const float* modv = (const float*)(p.ws + WS_MOD);
    const bf16_t* wr = (const bf16_t*)(p.ws + WS_WR);
    bf16_t* wrp = (bf16_t*)(p.ws + WS_WRP);
    float* cb = (float*)(p.ws + WS_CB);
    const int lane = c.lane;
    for (int idx = c.bid * NWAVES + c.wid; idx < 2 * 9 * 256; idx += c.nblk * NWAVES) {
        const int l = idx / 2304, r = idx - l * 2304, b = r >> 8, e = r & 255;
        const float* g = p.in[I_GFFN] + l * 1024 + 16 * lane;
        const float* mv = modv + (size_t)(l * 9 + b) * 6144 + 3072 + 16 * lane;
        const bf16_t* src = wr + ((size_t)l * 256 + e) * 1024 + 16 * lane;
        const u32x4 w0 = *(const u32x4*)src, w1 = *(const u32x4*)(src + 8);
        float wv[16];
        wv[0] = bflo(w0.x); wv[1] = bfhi(w0.x); wv[2] = bflo(w0.y); wv[3] = bfhi(w0.y); wv[4] = bflo(w0.z); wv[5] = bfhi(w0.z); wv[6] = bflo(w0.w); wv[7] = bfhi(w0.w);
        wv[8] = bflo(w1.x); wv[9] = bfhi(w1.x); wv[10] = bflo(w1.y); wv[11] = bfhi(w1.y); wv[12] = bflo(w1.z); wv[13] = bfhi(w1.z); wv[14] = bflo(w1.w); wv[15] = bfhi(w1.w);
        float s = 0.f, o[16];
#pragma unroll
        for (int j = 0; j < 4; ++j) {
            const f32x4 gg = *(const f32x4*)(g + 4 * j), sh = *(const f32x4*)(mv + 4 * j), sc = *(const f32x4*)(mv + 1024 + 4 * j);
#pragma unroll
            for (int i = 0; i < 4; ++i) { o[4 * j + i] = wv[4 * j + i] * gg[i] * (1.f + sc[i]); s += sh[i] * wv[4 * j + i]; }
        }
        u32x4 o0, o1;
        o0.x = pk2(o[0], o[1]); o0.y = pk2(o[2], o[3]); o0.z = pk2(o[4], o[5]); o0.w = pk2(o[6], o[7]);
        o1.x = pk2(o[8], o[9]); o1.y = pk2(o[10], o[11]); o1.z = pk2(o[12], o[13]); o1.w = pk2(o[14], o[15]);
        bf16_t* dst = wrp + ((size_t)(l * 9 + b) * 256 + e) * 1024 + 16 * lane;
        *(u32x4*)dst = o0; *(u32x4*)(dst + 8) = o1;
        s = wave_sum(s);
        if (lane == 0) cb[(l * 9 + b) * 256 + e] = s;
    }
}
DI void norm_ffn_row(const bf16_t* __restrict__ xrow, const float* __restrict__ g, const float* __restrict__ sh, const float* __restrict__ sc, unsigned char* __restrict__ o8, float* __restrict__ rstd_out, int lane) {
    f32x4 v[4]; float s = 0.f;
#pragma unroll
    for (int j = 0; j < 4; ++j) { v[j] = bf4_f32(((const u32x2*)xrow)[lane + 64 * j]); s += (v[j][0] * v[j][0] + v[j][1] * v[j][1]) + (v[j][2] * v[j][2] + v[j][3] * v[j][3]); }
    const float rstd = rsqrtf(wave_sum(s) * (1.f / DM) + EPSV);
#pragma unroll
    for (int j = 0; j < 4; ++j) {
        const f32x4 gg = ((const f32x4*)g)[lane + 64 * j], shh = ((const f32x4*)sh)[lane + 64 * j], scc = ((const f32x4*)sc)[lane + 64 * j];
        const f32x4 y = v[j] * rstd * gg * (1.f + scc) + shh;
        ((unsigned*)o8)[lane + 64 * j] = pk4_fp8(y[0], y[1], y[2], y[3]);
    }
    if (lane == 0) *rstd_out = rstd;
}

DI void phase_norm(const Ctx& c, int l, int nrows, bool from_inputs, int which) {
    const Params& p = *c.p;
    const float* modv = (const float*)(p.ws + WS_MOD);
    const float* g = p.in[which ? I_GFFN : I_GMIX] + l * 1024;
    bf16_t* hbuf = (bf16_t*)(p.ws + WS_HBUF);
    const float* xbuf = (const float*)(p.ws + WS_XBUF);
    for (int t = c.bid * NWAVES + c.wid; t < nrows; t += c.nblk * NWAVES) {
        const float* xrow = from_inputs ? (t < TL ? p.in[I_X] + (size_t)t * DM : p.in[I_CTX] + (size_t)(t - TL) * DM) : (const float*)((const bf16_t*)xbuf + (size_t)t * DM);
        const int b = t < TL ? (t >> 12) : 8;
        const float* mv = modv + (size_t)(l * 9 + b) * 6144 + (which ? 3072 : 0);
        if (from_inputs) norm_mod_row<false>(xrow, g, mv, mv + 1024, (bf16_t*)nullptr,        (unsigned char*)(p.ws + (which ? WS_H8 : WS_HIN8)) + (size_t)t * DM, c.lane);
        else norm_mod_row<true>(xrow, g, mv, mv + 1024, hbuf + (size_t)t * DM, (unsigned char*)(p.ws + (which ? WS_H8 : WS_HIN8)) + (size_t)t * DM, c.lane);
    }
}

namespace g8 {
constexpr int BM = 256, BK = 64, HALF = 128, HTB = HALF * BK * 2;
DI int lds_byte(int r, int c) { const int st = (r >> 4) * 2 + (c >> 5), rr = r & 15, cc = c & 31, ob = rr * 64 + cc * 2; return st * 1024 + (ob ^ (((ob >> 9) & 1) << 5)); }
DI void stage_rc(int b, int& R, int& C) { const int st = b / 1024, sb = b % 1024, swz = sb ^ (((sb >> 9) & 1) << 5); R = (st >> 1) * 16 + swz / 64; C = (st & 1) * 32 + (swz % 64) / 2; }
DI int perm32(int rho) { const int n = rho >> 4, i = rho & 15; return 8 * (i >> 2) + 4 * n + (i & 3); }
struct Unit { int pm, pn, e, ti, ne, rbase, ix; };

typedef __attribute__((ext_vector_type(8))) int v8i_t;
typedef __attribute__((ext_vector_type(4))) int v4i_t;
template <class Epi, class Sched>
DI void gemm_phase(LAS unsigned char* lds, const int tid, const int RB, const Sched& S, const Epi& E) {
    constexpr bool F8 = Epi::F8;
    const int wid = __builtin_amdgcn_readfirstlane(tid >> 6), lane = tid & 63, wr = wid >> 2, wc = wid & 3, fr = lane & 15, fq = lane >> 4;
    const int nt = RB / 128;
    int Rr[2], Cc[2]; unsigned voffB[2], voffA[2];
#pragma unroll
    for (int i = 0; i < 2; ++i) { int R, C; stage_rc(tid * 16 + i * 8192, R, C); Rr[i] = R; Cc[i] = C * 2; const int Rb = Epi::PERM ? ((R & ~31) + perm32(R & 31)) : R; voffB[i] = (unsigned)(Rb * RB + C * 2); voffA[i] = (unsigned)(R * RB + C * 2); }
    constexpr bool GA = Sched::GATHER;
    int unit_scale = 0x7F7F7F7F; asm volatile("" : "+v"(unit_scale));
    const size_t kstep = (size_t)(BK * 2);
    const size_t hstep = (size_t)HALF * RB;
    const unsigned ldsw = (unsigned)wid * 1024u;
    const int aoff = F8 ? lds_byte(wr * 64 + fr, (fq >> 1) * 32 + (fq & 1) * 16) : lds_byte(wr * 64 + fr, fq * 8);
    const int boff = F8 ? lds_byte(wc * 32 + fr, (fq >> 1) * 32 + (fq & 1) * 16) : lds_byte(wc * 32 + fr, fq * 8);
#define G8_SA(b, h) (((b) * 2 + (h)) * HTB)
#define G8_SB(b, h) ((4 + (b) * 2 + (h)) * HTB)
#define G8_STAGE_B(bufoff, gbase) do { _Pragma("unroll") for (int _i = 0; _i < 2; ++_i) \
        __builtin_amdgcn_global_load_lds((const unsigned*)((const char*)(gbase) + voffB[_i]), (LAS unsigned*)(lds + (bufoff) + ldsw + _i * 8192), 16, 0, 0); } while (0)
#define G8_STAGE_A(bufoff, uptr, koff, VO, h) do { _Pragma("unroll") for (int _i = 0; _i < 2; ++_i) { \
        const char* _s = GA ? (Ab + (koff) + VO[h][_i]) : ((uptr) + (koff) + ((h) ? hstep : (size_t)0) + voffA[_i]); \
        __builtin_amdgcn_global_load_lds((const unsigned*)_s, (LAS unsigned*)(lds + (bufoff) + ldsw + _i * 8192), 16, 0, 0); } } while (0)
#define G8_LDA(dst, b, h) do { _Pragma("unroll") for (int m = 0; m < 4; ++m) { \
        if constexpr (F8) { dst##8[m].lo = *(const LAS v4i_t*)(lds + G8_SA(b, h) + aoff + m * 2048); dst##8[m].hi = *(const LAS v4i_t*)(lds + G8_SA(b, h) + aoff + m * 2048 + 16); } \
        else { _Pragma("unroll") for (int k = 0; k < 2; ++k) dst[m][k] = *(const LAS bf16x8*)(lds + G8_SA(b, h) + aoff + m * 2048 + k * 1024); } } } while (0)
#define G8_LDB(dst, b, h) do { _Pragma("unroll") for (int n = 0; n < 2; ++n) { \
        if constexpr (F8) { dst##8[n].lo = *(const LAS v4i_t*)(lds + G8_SB(b, h) + boff + n * 2048); dst##8[n].hi = *(const LAS v4i_t*)(lds + G8_SB(b, h) + boff + n * 2048 + 16); } \
        else { _Pragma("unroll") for (int k = 0; k < 2; ++k) dst[n][k] = *(const LAS bf16x8*)(lds + G8_SB(b, h) + boff + n * 2048 + k * 1024); } } } while (0)
#define G8_MMA(ai, bj, At, Bt) do { __builtin_amdgcn_s_setprio(1); _Pragma("unroll") for (int m = 0; m < 4; ++m) _Pragma("unroll") for (int n = 0; n < 2; ++n) { \
        if constexpr (F8) asm volatile("v_mfma_scale_f32_16x16x128_f8f6f4 %0, %1, %2, %0, %3, %3 op_sel_hi:[0,0,0]" : "+v"(acc[ai][bj][m][n]) : "v"(Bt##8[n]), "v"(At##8[m]), "v"(unit_scale)); \
        else { _Pragma("unroll") for (int k = 0; k < 2; ++k) acc[ai][bj][m][n] = __builtin_amdgcn_mfma_f32_16x16x32_bf16(Bt[n][k], At[m][k], acc[ai][bj][m][n], 0, 0, 0); } } \
        __builtin_amdgcn_s_setprio(0); } while (0)
#define G8_WAIT_V(n) asm volatile("s_waitcnt vmcnt(" #n ")" ::: "memory")
#define G8_WAIT_L(n) asm volatile("s_waitcnt lgkmcnt(" #n ")" ::: "memory")
#define G8_BAR __builtin_amdgcn_s_barrier()
#define G8_SCHED __builtin_amdgcn_sched_barrier(0)
    Unit cur, nxt; int ui = 0;
    if (!S.next(0, cur)) return;
    f32x4 acc[2][2][4][2];
#pragma unroll
    for (int a = 0; a < 2; ++a)
#pragma unroll
        for (int b = 0; b < 2; ++b)
#pragma unroll
            for (int m = 0; m < 4; ++m)
#pragma unroll
                for (int n = 0; n < 2; ++n) acc[a][b][m][n] = (f32x4){0.f, 0.f, 0.f, 0.f};
    if constexpr (F8) asm volatile("s_nop 3" ::: "memory");
    bf16x8 At[F8 ? 1 : 4][2], B0[F8 ? 1 : 2][2], B1[F8 ? 1 : 2][2];
    v8i_t At8[F8 ? 4 : 1], B08[F8 ? 2 : 1], B18[F8 ? 2 : 1];
    unsigned vAc[2][2], vAn[2][2];
#pragma unroll
    for (int h = 0; h < 2; ++h)
#pragma unroll
        for (int i = 0; i < 2; ++i) vAc[h][i] = GA ? (S.a_off(cur, h * 128 + Rr[i]) + (unsigned)Cc[i]) : 0u;
    const char* Ab = S.a_base();
    const char* cA = GA ? Ab : S.a_ptr(cur);
    const char* cB = S.b_base(cur);
    G8_STAGE_B(G8_SB(0, 0), cB); G8_STAGE_A(G8_SA(0, 0), cA, 0, vAc, 0); G8_STAGE_B(G8_SB(0, 1), cB + hstep); G8_STAGE_A(G8_SA(0, 1), cA, 0, vAc, 1);
    if (wr == 1) G8_BAR;
    G8_WAIT_V(4); G8_BAR;
    G8_STAGE_B(G8_SB(1, 0), cB + kstep); G8_STAGE_A(G8_SA(1, 0), cA, kstep, vAc, 0); G8_STAGE_B(G8_SB(1, 1), cB + hstep + kstep);
    G8_WAIT_V(6); G8_BAR;
    for (;;) {
        const bool has_next = S.next(ui + 1, nxt);
        const char* nB = has_next ? S.b_base(nxt) : cB;
        const char* nA = GA ? Ab : (has_next ? S.a_ptr(nxt) : cA);
#pragma unroll
        for (int h = 0; h < 2; ++h)
#pragma unroll
            for (int i = 0; i < 2; ++i) vAn[h][i] = GA ? (has_next ? (S.a_off(nxt, h * 128 + Rr[i]) + (unsigned)Cc[i]) : vAc[h][i]) : 0u;
#pragma unroll 1
        for (int t = 0; t < nt; t += 2) {
            const bool last = (t == nt - 2);
            const size_t ka1 = (size_t)(t + 1) * kstep;
            const size_t ka2 = last ? (size_t)0 : (size_t)(t + 2) * kstep;
            const size_t ka3 = ka2 + kstep;
            const char* b2 = last ? nB : cB + (size_t)(t + 2) * kstep;
            const char* b3 = b2 + kstep;
            unsigned v2[2][2];
#pragma unroll
            for (int h = 0; h < 2; ++h)
#pragma unroll
                for (int i = 0; i < 2; ++i) v2[h][i] = GA ? (last ? vAn[h][i] : vAc[h][i]) : 0u;
            const char* a2p = last ? nA : cA;
            G8_LDB(B0, 0, 0); G8_SCHED; G8_LDA(At, 0, 0); G8_STAGE_A(G8_SA(1, 1), cA, ka1, vAc, 1);
            G8_WAIT_L(8); G8_BAR; G8_WAIT_L(0); G8_MMA(0, 0, At, B0); G8_BAR; G8_SCHED;
            G8_LDB(B1, 0, 1); G8_STAGE_B(G8_SB(0, 0), b2);
            G8_BAR; G8_WAIT_L(0); G8_MMA(0, 1, At, B1); G8_BAR;
            G8_LDA(At, 0, 1); G8_STAGE_A(G8_SA(0, 0), a2p, ka2, v2, 0);
            G8_BAR; G8_WAIT_L(0); G8_MMA(1, 0, At, B0); G8_BAR; G8_SCHED;
            G8_STAGE_B(G8_SB(0, 1), b2 + hstep);
            G8_WAIT_V(6); G8_BAR; G8_MMA(1, 1, At, B1); G8_BAR;
            G8_LDB(B0, 1, 0); G8_SCHED; G8_LDA(At, 1, 0); G8_STAGE_A(G8_SA(0, 1), a2p, ka2, v2, 1);
            G8_WAIT_L(8); G8_BAR; G8_WAIT_L(0); G8_MMA(0, 0, At, B0); G8_BAR; G8_SCHED;
            G8_LDB(B1, 1, 1); G8_STAGE_B(G8_SB(1, 0), b3);
            G8_BAR; G8_WAIT_L(0); G8_MMA(0, 1, At, B1); G8_BAR;
            G8_LDA(At, 1, 1); G8_STAGE_A(G8_SA(1, 0), a2p, ka3, v2, 0);
            G8_BAR; G8_WAIT_L(0); G8_MMA(1, 0, At, B0); G8_BAR; G8_SCHED;
            G8_STAGE_B(G8_SB(1, 1), b3 + hstep);
            G8_WAIT_V(6); G8_BAR; G8_MMA(1, 1, At, B1); G8_BAR;
        }
        if constexpr (F8) asm volatile("s_nop 15\n\ts_nop 15" ::: "memory");
        E(acc, cur, wr, wc, fr, fq);
        if (!has_next) break;
#pragma unroll
        for (int a = 0; a < 2; ++a)
#pragma unroll
            for (int b = 0; b < 2; ++b)
#pragma unroll
                for (int m = 0; m < 4; ++m)
#pragma unroll
                    for (int n = 0; n < 2; ++n) acc[a][b][m][n] = (f32x4){0.f, 0.f, 0.f, 0.f};
        if constexpr (F8) asm volatile("s_nop 3" ::: "memory");
        cur = nxt; cB = nB; cA = nA; ++ui;
#pragma unroll
        for (int h = 0; h < 2; ++h)
#pragma unroll
            for (int i = 0; i < 2; ++i) vAc[h][i] = vAn[h][i];
    }
    G8_WAIT_V(0);
    if (wr == 0) G8_BAR;
    G8_BAR;
#undef G8_SA
#undef G8_SB
#undef G8_STAGE_A
#undef G8_STAGE_B
#undef G8_LDA
#undef G8_LDB
#undef G8_MMA
#undef G8_WAIT_V
#undef G8_WAIT_L
#undef G8_BAR
#undef G8_SCHED
}

struct DenseSched {
    static constexpr bool GATHER = false;
    int nM, nN, nwg, G, c, RB; const char* A; const char* Bt;
    DI void init(const void* A_, const void* Bt_, int M, int N, int RB_, int G_, int c_) { A = (const char*)A_; Bt = (const char*)Bt_; nM = M / BM; nN = N / BM; nwg = nM * nN; G = G_; c = c_; RB = RB_; }
    DI bool next(int i, Unit& u) const {
        const int L = i * G + c; if (L >= nwg) return false;
        int wgid = L; { const int q = nwg / 8, r = nwg % 8, xcd = wgid % 8, off = wgid / 8; wgid = (xcd < r ? xcd * (q + 1) : r * (q + 1) + (xcd - r) * q) + off; }
        const int nig = 8 * nN, gid = wgid / nig, fm = gid * 8, gsz = (nM - fm) < 8 ? (nM - fm) : 8;
        u.pm = fm + ((wgid % nig) % gsz); u.pn = (wgid % nig) / gsz; u.e = 0; u.ti = 0; u.ne = 0; u.rbase = 0; u.ix = 0; return true;
    }
    DI const char* a_base() const { return A; }
    DI unsigned a_off(const Unit&, int) const { return 0u; }
    DI const char* a_ptr(const Unit& u) const { return A + (size_t)u.pm * BM * RB; }
    DI const char* b_base(const Unit& u) const { return Bt + (size_t)u.pn * BM * RB; }
};
}
struct EpiInproj {
    static constexpr bool F8 = true;
    static constexpr bool PERM = true;
    const LAS float2* rope;
    unsigned char* q8; unsigned char* k8; unsigned char* vt8;
    LAS unsigned char* stg; int tid;
    static DI bool isv_cb(int cb) { const int kv = cb - 16; return (cb >= 16) && ((kv == 2) || (kv == 3) || (kv >= 8 && kv < 12) || (kv >= 20)); }
    DI void operator()(const f32x4 (&acc)[2][2][4][2], const g8::Unit& u, int wr, int wc, int fr, int fq) const {
        const bool lat = (u.pm * 256 < TL);
#pragma unroll
        for (int bj = 0; bj < 2; ++bj) {
            const int col0 = u.pn * 256 + bj * 128 + wc * 32 + 8 * fq;
            const int cb = col0 >> 6, kv = cb - 16;
            if (!isv_cb(cb)) continue;
            const float scale = 1.0f / W_SCALE;
            const int vrow0 = (kv < 4 ? (kv - 2) * 64 : (kv < 12 ? 128 + (kv - 8) * 64 : 384 + (kv - 20) * 64)) + (col0 & 63);
            const int pos = 32 * ((fr >> 2) & 1) + 4 * (((fr >> 3) << 2) | (fr & 3));
#pragma unroll
            for (int ai = 0; ai < 2; ++ai) {
                const int t0 = u.pm * 256 + ai * 128 + wr * 64;
                const int b = t0 < TL ? (t0 >> 12) : ((t0 - TL) >> 8);
                const int tile = t0 < TL ? ((t0 & 4095) >> 6) : (64 + (((t0 - TL) & 255) >> 6));
                unsigned char* base = vt8 + (size_t)(b * 68 + tile) * VT_TILE + (size_t)vrow0 * 64 + pos;
#pragma unroll
                for (int n = 0; n < 2; ++n)
#pragma unroll
                    for (int j = 0; j < 4; ++j)
                        *(unsigned*)(base + (4 * n + j) * 64) = pk4_fp8(acc[ai][bj][0][n][j] * scale, acc[ai][bj][1][n][j] * scale, acc[ai][bj][2][n][j] * scale, acc[ai][bj][3][n][j] * scale);
            }
        }
        if (!((u.pn < 6) || (u.pn == 7) || (u.pn == 8))) return;
        constexpr int RS = 272;
        if (wr == 0) __builtin_amdgcn_s_barrier();
#pragma unroll
        for (int ai = 0; ai < 2; ++ai)
#pragma unroll
            for (int mh = 0; mh < 2; ++mh) {
#pragma unroll
                for (int bj = 0; bj < 2; ++bj) {
                    const int col0 = u.pn * 256 + bj * 128 + wc * 32 + 8 * fq;
                    const int cb = col0 >> 6, i0 = (col0 & 63) >> 1;
                    if (isv_cb(cb)) continue;
                    const bool isq = cb < 16;
                    const bool roped = ((cb < 4) || (cb >= 8 && cb < 16) || (cb == 16) || (cb == 17) || (cb >= 28 && cb < 36)) && lat;
                    const float scale = (isq ? QSCALE : 1.0f) * (1.0f / W_SCALE);
#pragma unroll
                    for (int mm = 0; mm < 2; ++mm) {
                        const int m = mh * 2 + mm;
                        const int t = u.pm * 256 + ai * 128 + wr * 64 + m * 16 + fr;
                        f32x4 v0 = acc[ai][bj][m][0], v1 = acc[ai][bj][m][1];
                        if (roped) {
                            const int s = t & 4095;
                            const int pos = (i0 < 16) ? (s >> 6) : (s & 63);
                            const f32x4 ca = *(const LAS f32x4*)(rope + pos * 16 + (i0 & 15)), cb2 = *(const LAS f32x4*)(rope + pos * 16 + (i0 & 15) + 2);
                            f32x4 o0, o1;
                            o0[0] = v0[0] * ca[0] - v0[1] * ca[1]; o0[1] = v0[1] * ca[0] + v0[0] * ca[1];
                            o0[2] = v0[2] * ca[2] - v0[3] * ca[3]; o0[3] = v0[3] * ca[2] + v0[2] * ca[3];
                            o1[0] = v1[0] * cb2[0] - v1[1] * cb2[1]; o1[1] = v1[1] * cb2[0] + v1[0] * cb2[1];
                            o1[2] = v1[2] * cb2[2] - v1[3] * cb2[3]; o1[3] = v1[3] * cb2[2] + v1[2] * cb2[3];
                            v0 = o0; v1 = o1;
                        }
                        v0 *= scale; v1 *= scale;
                        u32x2 w; w.x = pk4_fp8(v0[0], v0[1], v0[2], v0[3]); w.y = pk4_fp8(v1[0], v1[1], v1[2], v1[3]);
                        *(LAS u32x2*)(stg + (wr * 32 + mm * 16 + fr) * RS + bj * 128 + wc * 32 + 8 * fq) = w;
                    }
                }
                asm volatile("s_waitcnt lgkmcnt(0)" ::: "memory"); __builtin_amdgcn_s_barrier(); asm volatile("" ::: "memory");
#pragma unroll
                for (int k = 0; k < 2; ++k) {
                    const int idx = tid + k * 512, rl = idx >> 4, pc = idx & 15;
                    const int cb = u.pn * 4 + (pc >> 2);
                    if (!isv_cb(cb)) {
                        const u32x4 v = *(const LAS u32x4*)(stg + rl * RS + pc * 16);
                        const int t = u.pm * 256 + ai * 128 + (rl >> 5) * 64 + mh * 32 + (rl & 31);
                        const int kv = cb - 16, ki = kv < 2 ? kv : (kv < 8 ? kv - 2 : kv - 6);
                        unsigned char* dst = (cb < 16) ? q8 + (size_t)t * 1024 + cb * 64 + (pc & 3) * 16 : k8 + (size_t)t * 1024 + ki * 64 + (pc & 3) * 16;
                        *(u32x4*)dst = v;
                    }
                }
                asm volatile("s_waitcnt lgkmcnt(0)" ::: "memory"); __builtin_amdgcn_s_barrier(); asm volatile("" ::: "memory");
            }
        if (wr == 1) __builtin_amdgcn_s_barrier();
    }
};
DI void phase_inproj(const Ctx& c, int l) {
    const Params& p = *c.p;
    g8::DenseSched S; S.init(p.ws + WS_HIN8, (const unsigned char*)(p.ws + WS_WIN) + (size_t)l * 2816 * 1024, TT, INC, DM, c.nblk, c.bid);
    {
        const float* rg = (const float*)(p.ws + WS_ROPE);
        LAS float* rl = (LAS float*)(c.smem + LDS_MAIN + 256);
        for (int i = c.tid; i < 2048; i += NTHREADS) rl[i] = rg[i];
        __syncthreads();
    }
    EpiInproj E; E.rope = (const LAS float2*)(c.smem + LDS_MAIN + 256); E.stg = (LAS unsigned char*)c.smem + LDS_MAIN + 256 + 8192; E.tid = c.tid;
    E.q8 = (unsigned char*)(p.ws + WS_Q8); E.k8 = (unsigned char*)(p.ws + WS_K8); E.vt8 = (unsigned char*)(p.ws + WS_VT8);
    g8::gemm_phase((LAS unsigned char*)c.smem, c.tid, DM, S, E);
}

struct EpiOutproj {
    static constexpr bool F8 = true;
    static constexpr bool PERM = false;
    float* xbuf; const float* modv; const float* x_in; const float* ctx_in; int l;
    DI void operator()(const f32x4 (&acc)[2][2][4][2], const g8::Unit& u, int wr, int wc, int fr, int fq) const {
        const int b = (u.pm * 256) < TL ? ((u.pm * 256) >> 12) : 8;
        const int col0 = u.pn * 256 + wc * 32 + 4 * fq;
        const float* gate = modv + (size_t)(l * 9 + b) * 6144 + 2048 + col0;
        f32x4 g[2][2];
#pragma unroll
        for (int bj = 0; bj < 2; ++bj)
#pragma unroll
            for (int n = 0; n < 2; ++n) g[bj][n] = *(const f32x4*)(gate + bj * 128 + n * 16) * (1.0f / (MIX_SCALE * W_SCALE));
#pragma unroll
        for (int ai = 0; ai < 2; ++ai)
#pragma unroll
            for (int m = 0; m < 4; ++m) {
                const int t = u.pm * 256 + ai * 128 + wr * 64 + m * 16 + fr;
                const float* xin = (t < TL ? x_in + (size_t)t * DM : ctx_in + (size_t)(t - TL) * DM) + col0;
                bf16_t* xo = (bf16_t*)xbuf + (size_t)t * DM + col0;
#pragma unroll
                for (int bj = 0; bj < 2; ++bj)
#pragma unroll
                    for (int n = 0; n < 2; ++n) {
                        const f32x4 x = (l == 0) ? *(const f32x4*)(xin + bj * 128 + n * 16) : bf4_f32(*(const u32x2*)(xo + bj * 128 + n * 16));
                        *(u32x2*)(xo + bj * 128 + n * 16) = f32_bf4(x + g[bj][n] * acc[ai][bj][m][n]);
                    }
            }
    }
};
DI void phase_outproj(const Ctx& c, int l, int nrows) {
    const Params& p = *c.p;
    g8::DenseSched S; S.init(p.ws + WS_MIX, (const unsigned char*)(p.ws + WS_WOUT) + (size_t)l * 1048576, nrows, DM, DM, c.nblk, c.bid);
    EpiOutproj E; E.xbuf = (float*)(p.ws + WS_XBUF); E.modv = (const float*)(p.ws + WS_MOD); E.x_in = p.in[I_X]; E.ctx_in = p.in[I_CTX]; E.l = l;
    g8::gemm_phase((LAS unsigned char*)c.smem, c.tid, DM, S, E);
}

struct EpiRouter {
    static constexpr bool F8 = false;
    static constexpr bool PERM = false;
    float* logit;
    DI void operator()(const f32x4 (&acc)[2][2][4][2], const g8::Unit& u, int wr, int wc, int fr, int fq) const {
#pragma unroll
        for (int ai = 0; ai < 2; ++ai)
#pragma unroll
            for (int m = 0; m < 4; ++m) {
                const int t = u.pm * 256 + ai * 128 + wr * 64 + m * 16 + fr;
#pragma unroll
                for (int bj = 0; bj < 2; ++bj)
#pragma unroll
                    for (int n = 0; n < 2; ++n) *(f32x4*)(logit + (size_t)t * NE + bj * 128 + wc * 32 + n * 16 + 4 * fq) = acc[ai][bj][m][n];
            }
    }
};
DI void phase_router(const Ctx& c, int l, int nrows) {
    const Params& p = *c.p;
    g8::DenseSched S; S.init(p.ws + WS_HBUF, (const bf16_t*)(p.ws + WS_WR) + (size_t)l * 262144, nrows, NE, DM * 2, c.nblk, c.bid);
    EpiRouter E; E.logit = (float*)(p.ws + WS_LOGIT);
    g8::gemm_phase((LAS unsigned char*)c.smem, c.tid, DM * 2, S, E);
}

struct RouterSched : g8::DenseSched {
    DI const char* b_base(const g8::Unit& u) const { const int b = (u.pm * 256) < TL ? ((u.pm * 256) >> 12) : 8; return Bt + (size_t)b * 524288 + (size_t)u.pn * 256 * RB; }
};
DI void phase_norm_router(const Ctx& c, int l, int nrows) {
    const Params& p = *c.p;
    {
        RouterSched S; S.init(p.ws + WS_XBUF, (const bf16_t*)(p.ws + WS_WRP) + (size_t)l * 9 * 262144, nrows, NE, DM * 2, c.nblk, c.bid);
        EpiRouter E; E.logit = (float*)(p.ws + WS_LOGIT);
        g8::gemm_phase((LAS unsigned char*)c.smem, c.tid, DM * 2, S, E);
    }
    int* ctr = (int*)(p.ws + WS_ROWCTR) + l * 64;
    LAS int* slot = (LAS int*)(c.smem + LDS_MAIN + 64);
    const float* modv = (const float*)(p.ws + WS_MOD);
    const float* g = p.in[I_GFFN] + l * 1024;
    const bf16_t* xbuf = (const bf16_t*)(p.ws + WS_XBUF);
    unsigned char* h8 = (unsigned char*)(p.ws + WS_H8);
    float* rstd = (float*)(p.ws + WS_RSTD);
    for (;;) {
        if (c.tid == 0) slot[0] = atomicAdd(ctr, 64);
        __syncthreads();
        const int base = slot[0];
        __syncthreads();
        if (base >= nrows) break;
#pragma unroll 1
        for (int i = 0; i < 8; ++i) {
            const int t = base + c.wid * 8 + i;
            if (t < nrows) {
                const int b = t < TL ? (t >> 12) : 8;
                const float* mv = modv + (size_t)(l * 9 + b) * 6144 + 3072;
                norm_ffn_row(xbuf + (size_t)t * DM, g, mv, mv + 1024, h8 + (size_t)t * DM, rstd + t, c.lane);
            }
        }
    }
}

DI void phase_route(const Ctx& c, int l, int nrows) {
    const Params& p = *c.p;
    const float* logit = (const float*)(p.ws + WS_LOGIT);
    const float* rb = p.in[I_RB] + l * NE;
    int* cnt = (int*)(p.ws + WS_CNT) + l * CNT_LAYER;
    int* list = (int*)(p.ws + WS_LIST);
    float* slotw = (float*)(p.ws + WS_SLOTW);
    int* einfo = (int*)(p.ws + WS_EINFO);
    LAS int* lcnt = (LAS int*)c.smem;
    LAS int* rec = (LAS int*)(c.smem + 1024);
    LAS float* recw = (LAS float*)(c.smem + 1024 + 8 * 24 * 8 * 4);
    constexpr int RMAX = 24;
    const int lane = c.lane;
    if (c.tid < 256) lcnt[c.tid] = 0;
    __syncthreads();
    const f32x4 bias = ((const f32x4*)rb)[lane];
    const float NINF = -__builtin_inff();
    int it = 0;
    const float* rstd = (const float*)(p.ws + WS_RSTD);
    const float* cbl = (const float*)(p.ws + WS_CB) + l * 9 * 256;
    for (int t = c.bid * NWAVES + c.wid; t < nrows; t += c.nblk * NWAVES, ++it) {
        const int bb = t < TL ? (t >> 12) : 8;
        const f32x4 lg = ((const f32x4*)(logit + (size_t)t * NE))[lane] * rstd[t] + ((const f32x4*)(cbl + bb * 256))[lane];
        const float s0 = 1.f / (1.f + __expf(-lg.x)), s1 = 1.f / (1.f + __expf(-lg.y)), s2 = 1.f / (1.f + __expf(-lg.z)), s3 = 1.f / (1.f + __expf(-lg.w));
        float m0 = s0 + bias.x, m1 = s1 + bias.y, m2 = s2 + bias.z, m3 = s3 + bias.w;
        float a1 = fmaxf(m0, m1), a2 = fminf(m0, m1);
        { const float b1 = fmaxf(m2, m3), b2 = fminf(m2, m3); const float n1 = fmaxf(a1, b1), n2 = fmaxf(fminf(a1, b1), fmaxf(a2, b2)); a1 = n1; a2 = n2; }
        { const float b1 = DPPF(a1, DPP_XOR1), b2 = DPPF(a2, DPP_XOR1); const float n1 = fmaxf(a1, b1), n2 = fmaxf(fminf(a1, b1), fmaxf(a2, b2)); a1 = n1; a2 = n2; }
        { const float b1 = DPPF(a1, DPP_XOR2), b2 = DPPF(a2, DPP_XOR2); const float n1 = fmaxf(a1, b1), n2 = fmaxf(fminf(a1, b1), fmaxf(a2, b2)); a1 = n1; a2 = n2; }
        { const float b1 = DPPF(a1, DPP_HMIR), b2 = DPPF(a2, DPP_HMIR); const float n1 = fmaxf(a1, b1), n2 = fmaxf(fminf(a1, b1), fmaxf(a2, b2)); a1 = n1; a2 = n2; }
        const float gs = a1 + a2;
        const int g = lane >> 3;
        int rank = 0;
#pragma unroll
        for (int j = 0; j < 8; ++j) { const float gj = rdlane_f(gs, j * 8); rank += ((gj > gs) || (gj == gs && j < g)) ? 1 : 0; }
        if (rank >= 4) { m0 = NINF; m1 = NINF; m2 = NINF; m3 = NINF; }
        float wsum = 0.f, my_w = 0.f; int my_e = 0;
#pragma unroll
        for (int k = 0; k < 8; ++k) {
            float bv = m0, bs = s0; int bi = 0;
            if (m1 > bv) { bv = m1; bs = s1; bi = 1; }
            if (m2 > bv) { bv = m2; bs = s2; bi = 2; }
            if (m3 > bv) { bv = m3; bs = s3; bi = 3; }
            float v = bv;
            v = fmaxf(v, DPPF(v, DPP_XOR1)); v = fmaxf(v, DPPF(v, DPP_XOR2)); v = fmaxf(v, DPPF(v, DPP_HMIR)); v = fmaxf(v, DPPF(v, DPP_MIR));
            const float wmx = fmaxf(fmaxf(rdlane_f(v, 0), rdlane_f(v, 16)), fmaxf(rdlane_f(v, 32), rdlane_f(v, 48)));
            const unsigned long long bal = __ballot(bv == wmx);
            const int win = __ffsll((long long)bal) - 1;
            const int sub = __builtin_amdgcn_readlane(bi, win);
            const float sw = rdlane_f(bs, win);
            if (lane == win) { if (sub == 0) m0 = NINF; else if (sub == 1) m1 = NINF; else if (sub == 2) m2 = NINF; else m3 = NINF; }
            wsum += sw;
            if (lane == k) { my_e = win * 4 + sub; my_w = sw; }
        }
        if (lane < 8 && it < RMAX) {
            const int lp = __hip_atomic_fetch_add(&lcnt[my_e], 1, __ATOMIC_RELAXED, __HIP_MEMORY_SCOPE_WORKGROUP);
            rec[(c.wid * RMAX + it) * 8 + lane] = (my_e << 16) | lp;
            recw[(c.wid * RMAX + it) * 8 + lane] = my_w / wsum * 2.5f;
        }
    }
    __syncthreads();
    if (c.tid < 256) { const int n = lcnt[c.tid]; lcnt[c.tid] = (n > 0) ? atomicAdd(&cnt[c.tid * CNT_STRIDE], n) : 0; }
    __syncthreads();
    it = 0;
    for (int t = c.bid * NWAVES + c.wid; t < nrows; t += c.nblk * NWAVES, ++it) {
        if (lane < 8 && it < RMAX) {
            const int r = rec[(c.wid * RMAX + it) * 8 + lane];
            const int e = r >> 16, pos = lcnt[e] + (r & 0xffff);
            list[(size_t)e * TT + pos] = t;
            slotw[(size_t)t * 8 + lane] = recw[(c.wid * RMAX + it) * 8 + lane];
            einfo[(size_t)t * 8 + lane] = (e << 16) | pos;
        }
    }
}

DI void moe_setup(const Ctx& c, int l, int nrows) {
    const int* cnt = (const int*)(c.p->ws + WS_CNT) + l * CNT_LAYER;
    LAS int* tstart = (LAS int*)(c.smem + LDS_MAIN + 1024);
    LAS int* roff = (LAS int*)(c.smem + LDS_MAIN + 2064);
    LAS int* cntl = (LAS int*)(c.smem + LDS_MAIN + 3104);
    LAS int* wtot = (LAS int*)(c.smem + LDS_MAIN + 4160);
    const int n = (c.tid < 256) ? cnt[c.tid * CNT_STRIDE] : 0;
    const int nt = (n + 255) >> 8;
    int vt = nt, vr = n;
    vt += DPPI(vt, DPP_SHR(1)); vr += DPPI(vr, DPP_SHR(1)); vt += DPPI(vt, DPP_SHR(2)); vr += DPPI(vr, DPP_SHR(2));
    vt += DPPI(vt, DPP_SHR(4)); vr += DPPI(vr, DPP_SHR(4)); vt += DPPI(vt, DPP_SHR(8)); vr += DPPI(vr, DPP_SHR(8));
    { const int t0 = __builtin_amdgcn_readlane(vt, 15), t1 = __builtin_amdgcn_readlane(vt, 31), t2 = __builtin_amdgcn_readlane(vt, 47);
      const int r0 = __builtin_amdgcn_readlane(vr, 15), r1 = __builtin_amdgcn_readlane(vr, 31), r2 = __builtin_amdgcn_readlane(vr, 47);
      const int row = c.lane >> 4;
      vt += (row > 0 ? t0 : 0) + (row > 1 ? t1 : 0) + (row > 2 ? t2 : 0); vr += (row > 0 ? r0 : 0) + (row > 1 ? r1 : 0) + (row > 2 ? r2 : 0); }
    if (c.lane == 63 && c.wid < 4) { wtot[c.wid] = vt; wtot[4 + c.wid] = vr; }
    __syncthreads();
    if (c.tid < 256) {
        int pt = 0, pr = 0;
        for (int w = 0; w < c.wid; ++w) { pt += wtot[w]; pr += wtot[4 + w]; }
        tstart[c.tid] = pt + vt - nt; roff[c.tid] = pr + vr - n; cntl[c.tid] = n;
        if (c.tid == 255) { tstart[256] = pt + vt; roff[256] = pr + vr; tstart[257] = pt + vt + nrows / 256; roff[257] = pr + vr + nrows; cntl[256] = nrows; }
    }
    __syncthreads();
}

constexpr int MOE_MAXU = 32, MOE_MAXG = 12;
template <bool GATHER_>
struct MoeSched {
    static constexpr bool GATHER = GATHER_;
    const LAS int* utab; const LAS unsigned* toks; int nmy;
    const char* A; const char* W; size_t wstride; int RB;
    DI bool next(int i, g8::Unit& u) const {
        if (i >= nmy) return false;
        const LAS int* e = utab + i * 8;
        u.pn = __builtin_amdgcn_readfirstlane(e[0]); u.e = __builtin_amdgcn_readfirstlane(e[1]); u.ti = __builtin_amdgcn_readfirstlane(e[2]);
        u.ne = __builtin_amdgcn_readfirstlane(e[3]); u.rbase = __builtin_amdgcn_readfirstlane(e[4]); u.pm = __builtin_amdgcn_readfirstlane(e[5]); u.ix = i;
        return true;
    }
    DI const char* a_base() const { return A; }
    DI unsigned a_off(const g8::Unit& u, int row) const { return toks[u.ix * 256 + row]; }
    DI const char* a_ptr(const g8::Unit& u) const { return A + (size_t)u.rbase * RB; }
    DI const char* b_base(const g8::Unit& u) const { return W + (size_t)u.e * wstride + (size_t)u.pn * 256 * RB; }
};
DI int moe_units(const Ctx& c, int NB, bool gather, const int* list, int rowbytes) {
    const LAS int* tstart = (const LAS int*)(c.smem + LDS_MAIN + 1024);
    const LAS int* roff = (const LAS int*)(c.smem + LDS_MAIN + 2064);
    const LAS int* cntl = (const LAS int*)(c.smem + LDS_MAIN + 3104);
    LAS int* utab = (LAS int*)(c.smem + LDS_MAIN + 4224);
    LAS unsigned* toks = (LAS unsigned*)(c.smem + LDS_MAIN + 8192);
    const int nunits = tstart[257] * NB;
    int nmy = (nunits > c.bid) ? (nunits - c.bid + c.nblk - 1) / c.nblk : 0;
    { const int cap = gather ? MOE_MAXG : MOE_MAXU; nmy = nmy > cap ? cap : nmy; }
    if (c.tid < nmy) {
        const int L = c.tid * c.nblk + c.bid;
        int w = L; { const int q = nunits / 8, r = nunits % 8, xcd = w % 8, off = w / 8; w = (xcd < r ? xcd * (q + 1) : r * (q + 1) + (xcd - r) * q) + off; }
        const int tile = w / NB;
        int lo = 0, hi = 256;
        while (lo < hi) { const int mid = (lo + hi + 1) >> 1; if (tstart[mid] <= tile) lo = mid; else hi = mid - 1; }
        const int ti = tile - tstart[lo];
        LAS int* e = utab + c.tid * 8;
        e[0] = w - tile * NB; e[1] = lo; e[2] = ti; e[3] = cntl[lo]; e[4] = roff[lo] + ti * 256; e[5] = tile;
    }
    __syncthreads();
    if (gather) {
        for (int idx = c.tid; idx < nmy * 256; idx += NTHREADS) {
            const LAS int* e = utab + (idx >> 8) * 8;
            const int ex = e[1], ne = e[3];
            int ridx = e[2] * 256 + (idx & 255); ridx = ridx < ne ? ridx : ne - 1;
            const int tok = (ex < 256) ? list[(size_t)ex * TT + ridx] : ridx;
            toks[idx] = (unsigned)tok * (unsigned)rowbytes;
        }
        __syncthreads();
    }
    return nmy;
}

#ifdef E1_DIRECT
struct EpiE1 {
    static constexpr bool F8 = true;
    static constexpr bool PERM = true;
    unsigned char* act;
    LAS unsigned char* stg; int tid;
    DI void operator()(const f32x4 (&acc)[2][2][4][2], const g8::Unit& u, int wr, int wc, int fr, int fq) const {
        constexpr float IS = 1.0f / W_SCALE;
#pragma unroll
        for (int ai = 0; ai < 2; ++ai)
#pragma unroll
            for (int m = 0; m < 4; ++m) {
                const int row = ai * 128 + wr * 64 + m * 16 + fr;
                if (u.ti * 256 + row < u.ne) {
#pragma unroll
                    for (int bj = 0; bj < 2; ++bj) {
                        const int col0 = u.pn * 256 + bj * 128 + wc * 32 + 8 * fq;
                        const f32x4 v0 = acc[ai][bj][m][0] * IS, v1 = acc[ai][bj][m][1] * IS;
                        const float a0 = v0[0] * __builtin_amdgcn_rcpf(1.f + __expf(-v0[0])) * v0[1], a1 = v0[2] * __builtin_amdgcn_rcpf(1.f + __expf(-v0[2])) * v0[3];
                        const float a2 = v1[0] * __builtin_amdgcn_rcpf(1.f + __expf(-v1[0])) * v1[1], a3 = v1[2] * __builtin_amdgcn_rcpf(1.f + __expf(-v1[2])) * v1[3];
                        *(unsigned*)(act + (size_t)(u.rbase + row) * FF + (col0 >> 1)) = pk4_fp8(a0 * ACT_SCALE, a1 * ACT_SCALE, a2 * ACT_SCALE, a3 * ACT_SCALE);
                    }
                }
            }
    }
};
#else
struct EpiE1 {
    static constexpr bool F8 = true;
    static constexpr bool PERM = true;
    unsigned char* act;
    LAS unsigned char* stg; int tid;
    DI void operator()(const f32x4 (&acc)[2][2][4][2], const g8::Unit& u, int wr, int wc, int fr, int fq) const {
        constexpr float IS = 1.0f / W_SCALE;
        constexpr int RS = 144;
        if (wr == 0) __builtin_amdgcn_s_barrier();
#pragma unroll
        for (int ai = 0; ai < 2; ++ai)
#pragma unroll
            for (int mh = 0; mh < 2; ++mh) {
#pragma unroll
                for (int mm = 0; mm < 2; ++mm) {
                    const int m = mh * 2 + mm;
                    LAS unsigned char* d = stg + (wr * 32 + mm * 16 + fr) * RS + wc * 16 + 4 * fq;
#pragma unroll
                    for (int bj = 0; bj < 2; ++bj) {
                        const f32x4 v0 = acc[ai][bj][m][0] * IS, v1 = acc[ai][bj][m][1] * IS;
                        const float a0 = v0[0] * __builtin_amdgcn_rcpf(1.f + __expf(-v0[0])) * v0[1], a1 = v0[2] * __builtin_amdgcn_rcpf(1.f + __expf(-v0[2])) * v0[3];
                        const float a2 = v1[0] * __builtin_amdgcn_rcpf(1.f + __expf(-v1[0])) * v1[1], a3 = v1[2] * __builtin_amdgcn_rcpf(1.f + __expf(-v1[2])) * v1[3];
                        *(LAS unsigned*)(d + bj * 64) = pk4_fp8(a0 * ACT_SCALE, a1 * ACT_SCALE, a2 * ACT_SCALE, a3 * ACT_SCALE);
                    }
                }
                asm volatile("s_waitcnt lgkmcnt(0)" ::: "memory"); __builtin_amdgcn_s_barrier(); asm volatile("" ::: "memory");
                {
                    const int rl = tid >> 3, pc = tid & 7;
                    const u32x4 v = *(const LAS u32x4*)(stg + rl * RS + pc * 16);
                    const int row = ai * 128 + (rl >> 5) * 64 + mh * 32 + (rl & 31);
                    if (u.ti * 256 + row < u.ne) *(u32x4*)(act + (size_t)(u.rbase + row) * FF + u.pn * 128 + pc * 16) = v;
                }
                asm volatile("s_waitcnt lgkmcnt(0)" ::: "memory"); __builtin_amdgcn_s_barrier(); asm volatile("" ::: "memory");
            }
        if (wr == 1) __builtin_amdgcn_s_barrier();
    }
};
#endif
DI void phase_e1(const Ctx& c, int l, int nrows) {
    const Params& p = *c.p;
    moe_setup(c, l, nrows);
    MoeSched<true> S;
    S.nmy = moe_units(c, 2, true, (const int*)(p.ws + WS_LIST), DM);
    S.utab = (const LAS int*)(c.smem + LDS_MAIN + 4224); S.toks = (const LAS unsigned*)(c.smem + LDS_MAIN + 8192);
    S.A = (const char*)(p.ws + WS_H8); S.W = (const char*)(p.ws + WS_WGU) + (size_t)l * 257 * 524288; S.wstride = 524288; S.RB = DM;
    EpiE1 E; E.act = (unsigned char*)(p.ws + WS_ACT); E.stg = (LAS unsigned char*)c.smem + LDS_MAIN + 8192 + MOE_MAXG * 1024; E.tid = c.tid;
    g8::gemm_phase((LAS unsigned char*)c.smem, c.tid, DM, S, E);
}

struct EpiE2 {
    static constexpr bool F8 = true;
    static constexpr bool PERM = true;
    unsigned char* ys;
    LAS unsigned char* stg; int tid;
    DI void operator()(const f32x4 (&acc)[2][2][4][2], const g8::Unit& u, int wr, int wc, int fr, int fq) const {
        constexpr float SC = 16.f / (ACT_SCALE * WD_SCALE);
        constexpr int RS = 272;
        if (wr == 0) __builtin_amdgcn_s_barrier();
#pragma unroll
        for (int ai = 0; ai < 2; ++ai)
#pragma unroll
            for (int mh = 0; mh < 2; ++mh) {
#pragma unroll
                for (int mm = 0; mm < 2; ++mm) {
                    const int m = mh * 2 + mm;
                    LAS unsigned char* d = stg + (wr * 32 + mm * 16 + fr) * RS + wc * 32 + 8 * fq;
#pragma unroll
                    for (int bj = 0; bj < 2; ++bj) {
                        const f32x4 v0 = acc[ai][bj][m][0] * SC, v1 = acc[ai][bj][m][1] * SC;
                        int w0 = 0, w1 = 0;
                        w0 = __builtin_amdgcn_cvt_pk_fp8_f32(v0[0], v0[1], w0, false); w0 = __builtin_amdgcn_cvt_pk_fp8_f32(v0[2], v0[3], w0, true);
                        w1 = __builtin_amdgcn_cvt_pk_fp8_f32(v1[0], v1[1], w1, false); w1 = __builtin_amdgcn_cvt_pk_fp8_f32(v1[2], v1[3], w1, true);
                        u32x2 o; o.x = (unsigned)w0; o.y = (unsigned)w1;
                        *(LAS u32x2*)(d + bj * 128) = o;
                    }
                }
                asm volatile("s_waitcnt lgkmcnt(0)" ::: "memory"); __builtin_amdgcn_s_barrier(); asm volatile("" ::: "memory");
#pragma unroll
                for (int k = 0; k < 2; ++k) {
                    const int idx = tid + k * 512, rl = idx >> 4, pc = idx & 15;
                    const u32x4 v = *(const LAS u32x4*)(stg + rl * RS + pc * 16);
                    const int row = ai * 128 + (rl >> 5) * 64 + mh * 32 + (rl & 31);
                    if (u.ti * 256 + row < u.ne) *(u32x4*)(ys + (size_t)(u.rbase + row) * DM + u.pn * 256 + pc * 16) = v;
                }
                asm volatile("s_waitcnt lgkmcnt(0)" ::: "memory"); __builtin_amdgcn_s_barrier(); asm volatile("" ::: "memory");
            }
        if (wr == 1) __builtin_amdgcn_s_barrier();
    }
};
DI void phase_e2(const Ctx& c, int l, int nrows) {
    const Params& p = *c.p;
    moe_setup(c, l, nrows);
    MoeSched<false> S;
    S.nmy = moe_units(c, 4, false, nullptr, 0);
    S.utab = (const LAS int*)(c.smem + LDS_MAIN + 4224); S.toks = (const LAS unsigned*)(c.smem + LDS_MAIN + 8192);
    S.A = (const char*)(p.ws + WS_ACT); S.W = (const char*)(p.ws + WS_WD) + (size_t)l * 257 * 262144; S.wstride = 262144; S.RB = FF;
    EpiE2 E; E.ys = (unsigned char*)(p.ws + WS_YS); E.stg = (LAS unsigned char*)c.smem + LDS_STG; E.tid = c.tid;
    g8::gemm_phase((LAS unsigned char*)c.smem, c.tid, FF, S, E);
}

DI void phase_combine(const Ctx& c, int l, int nrows, bool last) {
    const Params& p = *c.p;
    moe_setup(c, l, nrows);
    const LAS int* roff = (const LAS int*)(c.smem + LDS_MAIN + 2064);
    const unsigned char* ys = (const unsigned char*)(p.ws + WS_YS);
    const int* einfo = (const int*)(p.ws + WS_EINFO);
    const float* slotw = (const float*)(p.ws + WS_SLOTW);
    float* xbuf = (float*)(p.ws + WS_XBUF);
    bf16_t* hbuf = (bf16_t*)(p.ws + WS_HBUF);
    const float* modv = (const float*)(p.ws + WS_MOD);
    const int lane = c.lane;
    const int shared0 = roff[256];
    for (int t = c.bid * NWAVES + c.wid; t < nrows; t += c.nblk * NWAVES) {
        const int b = t < TL ? (t >> 12) : 8;
        const float* gate = modv + (size_t)(l * 9 + b) * 6144 + 5120 + 16 * lane;
        int myrow = 0; float myw = 0.f;
        if (lane < 8) { const int ei = einfo[(size_t)t * 8 + lane]; myrow = roff[ei >> 16] + (ei & 0xffff); myw = slotw[(size_t)t * 8 + lane] * (1.f / 16.f); }
        if (lane == 8) { myrow = shared0 + t; myw = 1.f / 16.f; }
        f32x4 v[4], a[4];
        {
            const u32x4 x0 = *(const u32x4*)((const bf16_t*)xbuf + (size_t)t * DM + 16 * lane), x1 = *(const u32x4*)((const bf16_t*)xbuf + (size_t)t * DM + 16 * lane + 8);
            v[0] = bf4_f32(u32x2{x0.x, x0.y}); v[1] = bf4_f32(u32x2{x0.z, x0.w}); v[2] = bf4_f32(u32x2{x1.x, x1.y}); v[3] = bf4_f32(u32x2{x1.z, x1.w});
        }
#pragma unroll
        for (int j = 0; j < 4; ++j) a[j] = f32x4{0.f, 0.f, 0.f, 0.f};
#pragma unroll
        for (int k = 0; k < 9; ++k) {
            const int row = __builtin_amdgcn_readlane(myrow, k); const float w = rdlane_f(myw, k);
            const u32x4 y = *(const u32x4*)(ys + (size_t)row * DM + 16 * lane);
#pragma unroll
            for (int j = 0; j < 4; ++j) {
                const unsigned word = (j == 0) ? y.x : (j == 1) ? y.y : (j == 2) ? y.z : y.w;
                const auto lo = __builtin_amdgcn_cvt_pk_f32_fp8((int)word, false), hi = __builtin_amdgcn_cvt_pk_f32_fp8((int)word, true);
                a[j].x += w * lo[0]; a[j].y += w * lo[1]; a[j].z += w * hi[0]; a[j].w += w * hi[1];
            }
        }
        float s = 0.f;
#pragma unroll
        for (int j = 0; j < 4; ++j) {
            const f32x4 g = *(const f32x4*)(gate + 4 * j);
            v[j] += g * a[j];
            s += (v[j].x * v[j].x + v[j].y * v[j].y) + (v[j].z * v[j].z + v[j].w * v[j].w);
        }
        const float rstd = rsqrtf(wave_sum(s) * (1.f / DM) + EPSV);
        if (last) {
            const float* gf = p.in[I_GFINAL] + 16 * lane;
#pragma unroll
            for (int j = 0; j < 4; ++j) {
                const f32x4 g = *(const f32x4*)(gf + 4 * j);
                *(f32x4*)(p.out + (size_t)t * DM + 16 * lane + 4 * j) = v[j] * rstd * g;
            }
        } else {
            const float* g = p.in[I_GMIX] + (l + 1) * 1024 + 16 * lane;
            const float* mv = modv + (size_t)((l + 1) * 9 + b) * 6144 + 16 * lane;
            u32x4 o8;
#pragma unroll
            for (int j = 0; j < 4; ++j) {
                *(u32x2*)((bf16_t*)xbuf + (size_t)t * DM + 16 * lane + 4 * j) = f32_bf4(v[j]);
                const f32x4 gg = *(const f32x4*)(g + 4 * j), shh = *(const f32x4*)(mv + 4 * j), scc = *(const f32x4*)(mv + 1024 + 4 * j);
                const f32x4 y = v[j] * rstd * gg * (1.f + scc) + shh;
                const unsigned w8 = pk4_fp8(y.x, y.y, y.z, y.w);
                if (j == 0) o8.x = w8; else if (j == 1) o8.y = w8; else if (j == 2) o8.z = w8; else o8.w = w8;
            }
            *(u32x4*)((unsigned char*)(p.ws + WS_HIN8) + (size_t)t * DM + 16 * lane) = o8;
        }
    }
}
DI void glds16(const void* g, LAS char* l) { __builtin_amdgcn_global_load_lds((const unsigned*)g, (LAS unsigned*)l, 16, 0, 0); }
#define VM_DRAIN() asm volatile("s_waitcnt vmcnt(0)" ::: "memory")
constexpr float FLASH_THR = 8.0f;
struct ModNone { DI bool active(int) const { return true; } DI void apply(int, f32x16&, f32x16&) const {} };
struct ModSwa {
    int nloc, kpos0, qpos, qmin, hi_;
    DI bool active(int j) const { if (j >= nloc) return true; const int k0 = kpos0 + 64 * j; return (k0 + 63 >= qmin - 128) && (k0 <= qmin + 31 + 128); }
    DI void apply(int j, f32x16& s0, f32x16& s1) const {
        if (j >= nloc) return;
        const int hi = hi_;
        const int kb = kpos0 + 64 * j + 4 * hi - qpos;
        const float NINF = -__builtin_inff();
#pragma unroll
        for (int r = 0; r < 16; ++r) {
            const int d = kb + (r & 3) + 8 * (r >> 2);
            if (d < -128 || d > 128) s0[r] = NINF;
            if (d + 32 < -128 || d + 32 > 128) s1[r] = NINF;
        }
    }
};
struct ModNa {
    int nloc, kr0, qr, qc, rs, cs, hi_;
    const LAS float* rpb;
    DI bool active(int j) const { if (j >= nloc) return true; const int kr = kr0 + j; return kr >= rs && kr < rs + 8; }
    DI void apply(int j, f32x16& s0, f32x16& s1) const {
        if (j >= nloc) return;
        const int hi = hi_;
        const int kr = kr0 + j;
        const LAS float* row = rpb + (kr - qr + 7) * 31 + 15 - qc;
        const float NINF = -__builtin_inff();
        float b0[16], b1[16];
#pragma unroll
        for (int r = 0; r < 16; ++r) { const int kc = 4 * hi + (r & 3) + 8 * (r >> 2); b0[r] = row[kc]; b1[r] = row[kc + 32]; }
#pragma unroll
        for (int r = 0; r < 16; ++r) {
            const int kc = 4 * hi + (r & 3) + 8 * (r >> 2);
            const bool ok0 = (kc >= cs) && (kc < cs + 16), ok1 = (kc + 32 >= cs) && (kc + 32 < cs + 16);
            s0[r] = ok0 ? s0[r] + b0[r] : NINF;
            s1[r] = ok1 ? s1[r] + b1[r] : NINF;
        }
    }
};


typedef __attribute__((ext_vector_type(8))) int v8i_f;
typedef __attribute__((ext_vector_type(4))) int v4i_f;
DI void mfma8(f32x16& d, const v8i_f& a, const v8i_f& b, const f32x16& c, int sc) {
    asm volatile("v_mfma_scale_f32_32x32x64_f8f6f4 %0, %1, %2, %3, %4, %4 op_sel_hi:[0,0,0]" : "=&v"(d) : "v"(a), "v"(b), "v"(c), "v"(sc));
}
DI void mfma8_acc(f32x16& d, const v8i_f& a, const v8i_f& b, int sc) {
    asm volatile("v_mfma_scale_f32_32x32x64_f8f6f4 %0, %1, %2, %0, %3, %3 op_sel_hi:[0,0,0]" : "+v"(d) : "v"(a), "v"(b), "v"(sc));
}
template <int DV> struct F8State { float m, l; f32x16 o[DV / 32]; f32x16 cinit; };

template <int DV, class Tok0, class Tile0, class Mod>
DI void pass8(const Ctx& c, int ki, int vrow0, int ntiles, Tok0 tok0, Tile0 vtile, Mod& mod, const v8i_f& qf, F8State<DV>& st) {
    constexpr int ND = DV / 32, STAGE = 4096 + DV * 64;
    const unsigned char* k8 = (const unsigned char*)(c.p->ws + WS_K8);
    const unsigned char* vt8 = (const unsigned char*)(c.p->ws + WS_VT8);
    LAS char* lds = (LAS char*)c.smem;
    const int lane = c.lane, r32 = c.r32, hi = c.hi, w = c.wid;
    int usc = 0x7F7F7F7F; asm volatile("" : "+v"(usc));
    const int prow = 16 * (w & 3) + (lane >> 2), pslot = lane & 3;
    const unsigned koff = (unsigned)(prow * 1024 + ki * 64 + ((pslot ^ ((prow >> 2) & 3)) << 4));
    const int vpiece = (DV == 128) ? w : (w & 3);
    const int vrow = 16 * vpiece + (lane >> 2);
    const unsigned voff = (unsigned)((vrow0 + vrow) * 64 + ((pslot ^ ((vrow >> 2) & 3)) << 4));
    auto issue = [&](int j, LAS char* stage) {
        if (w < 4) glds16(k8 + tok0(j) * 1024 + koff, stage + w * 1024);
        if (DV == 128 || w >= 4) glds16(vt8 + vtile(j) * (size_t)VT_TILE + voff, stage + 4096 + vpiece * 1024);
    };
    st.m = 0.f; st.l = 0.f;
#pragma unroll
    for (int r = 0; r < 16; ++r) st.cinit[r] = 0.f;
#pragma unroll
    for (int d = 0; d < ND; ++d)
#pragma unroll
        for (int r = 0; r < 16; ++r) st.o[d][r] = 0.f;
    issue(0, lds);
    VM_DRAIN();
    __syncthreads();
    const int f = (r32 >> 2) & 3;
    const int o_lo = r32 * 64 + (((2 * hi) ^ f) << 4), o_hi = r32 * 64 + (((2 * hi + 1) ^ f) << 4);
    if (__builtin_amdgcn_readfirstlane(w) >= 4) __builtin_amdgcn_s_setprio(1);
    for (int j = 0; j < ntiles; ++j) {
        if (j + 1 < ntiles) issue(j + 1, lds + ((j + 1) & 1) * STAGE);
        const LAS char* stage = lds + (j & 1) * STAGE;
        if (mod.active(j)) {
            v8i_f ka, kb;
            ka.lo = *(const LAS v4i_f*)(stage + o_lo); ka.hi = *(const LAS v4i_f*)(stage + o_hi);
            kb.lo = *(const LAS v4i_f*)(stage + 2048 + o_lo); kb.hi = *(const LAS v4i_f*)(stage + 2048 + o_hi);
            f32x16 s0, s1;
            mfma8(s0, ka, qf, st.cinit, usc); mfma8(s1, kb, qf, st.cinit, usc);
            v8i_f va, vb;
            va.lo = *(const LAS v4i_f*)(stage + 4096 + o_lo); va.hi = *(const LAS v4i_f*)(stage + 4096 + o_hi);
            vb.lo = *(const LAS v4i_f*)(stage + 4096 + 2048 + o_lo); vb.hi = *(const LAS v4i_f*)(stage + 4096 + 2048 + o_hi);
            asm volatile("s_nop 15\n\ts_nop 15" : "+v"(s0), "+v"(s1));
            mod.apply(j, s0, s1);
            float mx = fmaxf(fmaxf(s0[0], s0[1]), s1[0]);
            mx = fmaxf(fmaxf(mx, s1[1]), fmaxf(s0[2], s1[2]));
#pragma unroll
            for (int r = 3; r < 15; r += 2) mx = fmaxf(fmaxf(mx, s0[r]), fmaxf(s0[r + 1], fmaxf(s1[r], s1[r + 1])));
            mx = fmaxf(mx, fmaxf(s0[15], s1[15]));
            { const auto rr = __builtin_amdgcn_permlane32_swap(__float_as_uint(mx), __float_as_uint(mx), false, false); mx = fmaxf(__uint_as_float(rr[0]), __uint_as_float(rr[1])); }
            const bool seen = mx > -1e29f;
            const bool started = half_swap_sum(st.l) > 0.f;
            const bool mv = (mx > FLASH_THR) || (!started && seen);
            if (__any(mv)) {
                const float d = mv ? mx : 0.f;
                const float fs = (mv && started) ? __builtin_amdgcn_exp2f(-d) : 1.f;
                st.m += d; st.l *= fs;
                const float nm2 = -st.m;
                asm volatile("s_nop 15\n\ts_nop 15");
#pragma unroll
                for (int dd = 0; dd < ND; ++dd) asm volatile("" : "+v"(st.o[dd]));
#pragma unroll
                for (int r = 0; r < 16; ++r) { s0[r] -= d; s1[r] -= d; st.cinit[r] = nm2; }
#pragma unroll
                for (int dd = 0; dd < ND; ++dd)
#pragma unroll
                    for (int r = 0; r < 16; ++r) st.o[dd][r] *= fs;
            }
            float rs0 = 0.f, rs1 = 0.f;
#pragma unroll
            for (int r = 0; r < 16; ++r) { s0[r] = __builtin_amdgcn_exp2f(s0[r]); s1[r] = __builtin_amdgcn_exp2f(s1[r]); rs0 += s0[r]; rs1 += s1[r]; }
            st.l += rs0 + rs1;
            v8i_f pf;
#pragma unroll
            for (int idx = 0; idx < 8; ++idx) { const int r0 = (idx >> 2) * 4 + (idx & 3); pf[idx] = (int)pk4_fp8(s0[r0], s0[r0 + 8], s1[r0], s1[r0 + 8]); }
            asm volatile("s_nop 3" : "+v"(pf));
            mfma8_acc(st.o[0], va, pf, usc); mfma8_acc(st.o[1], vb, pf, usc);
            if constexpr (DV == 128) {
                va.lo = *(const LAS v4i_f*)(stage + 4096 + 4096 + o_lo); va.hi = *(const LAS v4i_f*)(stage + 4096 + 4096 + o_hi);
                vb.lo = *(const LAS v4i_f*)(stage + 4096 + 6144 + o_lo); vb.hi = *(const LAS v4i_f*)(stage + 4096 + 6144 + o_hi);
                mfma8_acc(st.o[2], va, pf, usc); mfma8_acc(st.o[3], vb, pf, usc);
            }
        }
        VM_DRAIN();
        __syncthreads();
    }
    __builtin_amdgcn_s_setprio(0);
    asm volatile("s_nop 15\n\ts_nop 15");
#pragma unroll
    for (int dd = 0; dd < ND; ++dd) asm volatile("" : "+v"(st.o[dd]));
}

DI v8i_f load_q8(const Ctx& c, size_t qtok, int cb) {
    const unsigned char* q8 = (const unsigned char*)(c.p->ws + WS_Q8) + qtok * 1024 + cb * 64 + 32 * c.hi;
    v8i_f qf; qf.lo = *(const v4i_f*)q8; qf.hi = *(const v4i_f*)(q8 + 16);
    return qf;
}
template <int DV>
DI void store_o8(const F8State<DV>& st, float inv, unsigned char* __restrict__ orow, int hi) {
    const float s = inv * MIX_SCALE;
#pragma unroll
    for (int dt = 0; dt < DV / 32; ++dt)
#pragma unroll
        for (int g = 0; g < 4; ++g)
            *(unsigned*)(orow + 32 * dt + 8 * g + 4 * hi) = pk4_fp8(st.o[dt][4 * g] * s, st.o[dt][4 * g + 1] * s, st.o[dt][4 * g + 2] * s, st.o[dt][4 * g + 3] * s);
}

DI void attn_swa_item(const Ctx& c, int l, int b, int h, int qb, bool ctxq) {
    const Params& p = *c.p;
    unsigned char* mix = (unsigned char*)(p.ws + WS_MIX);
    const int kvh = h >> 1;
    const size_t qtok = ctxq ? (size_t)TL + b * CTXL + c.wid * 32 + c.r32 : (size_t)b * SEQ + qb * 256 + c.wid * 32 + c.r32;
    const v8i_f qf = load_q8(c, qtok, h);
    F8State<64> st;
    ModSwa mod; mod.hi_ = c.hi;
    int j0 = 0;
    if (ctxq) { mod.nloc = 0; mod.kpos0 = 0; }
    else { j0 = 4 * qb - 2; if (j0 < 0) j0 = 0; int j1 = 4 * qb + 5; if (j1 > 63) j1 = 63; mod.nloc = j1 - j0 + 1; mod.kpos0 = 64 * j0; }
    mod.qmin = qb * 256 + c.wid * 32; mod.qpos = mod.qmin + c.r32;
    const int nloc = mod.nloc;
    const size_t lbase = (size_t)b * SEQ + 64 * j0, cbase = (size_t)TL + b * CTXL;
    auto tok0 = [&](int j) { return j < nloc ? lbase + 64 * j : cbase + 64 * (j - nloc); };
    const size_t vt0 = (size_t)b * 68;
    auto vtile = [&](int j) { return vt0 + (j < nloc ? j0 + j : 64 + (j - nloc)); };
    pass8<64>(c, kvh, kvh * 64, nloc + 4, tok0, vtile, mod, qf, st);
    float lt = half_swap_sum(st.l);
    lt += __builtin_amdgcn_exp2f(p.in[I_SINK][l * 4 + h] * LOG2E - st.m);
    store_o8<64>(st, 1.f / lt, mix + qtok * DM + h * 64, c.hi);
}

DI void attn_na_item(const Ctx& c, int l, int b, int h, int qb, bool ctxq) {
    const Params& p = *c.p;
    unsigned char* mix = (unsigned char*)(p.ws + WS_MIX);
    LAS float* rpbl = (LAS float*)(c.smem + LDS_MAIN + 1024);
    __syncthreads();
    if (!ctxq) for (int i = c.tid; i < 465; i += NTHREADS) rpbl[i] = p.in[I_RPB][(size_t)(l * 4 + h) * 465 + i] * LOG2E;
    __syncthreads();
    const size_t qtok = ctxq ? (size_t)TL + b * CTXL + c.wid * 32 + c.r32 : (size_t)b * SEQ + qb * 256 + c.wid * 32 + c.r32;
    const v8i_f qf = load_q8(c, qtok, 4 + h);
    F8State<64> st;
    ModNa mod; mod.rpb = rpbl; mod.hi_ = c.hi;
    int kr0 = 0;
    if (ctxq) { mod.nloc = 0; mod.kr0 = 0; mod.qr = 0; mod.qc = 0; mod.rs = 0; mod.cs = 0; }
    else {
        const int r_lo = 4 * qb, r_hi = 4 * qb + 3;
        int a = r_lo - 4; a = a < 0 ? 0 : (a > 56 ? 56 : a);
        int bb = r_hi - 4; bb = bb < 0 ? 0 : (bb > 56 ? 56 : bb);
        kr0 = a; mod.kr0 = a; mod.nloc = bb + 7 - a + 1;
        mod.qr = 4 * qb + (c.wid >> 1); mod.qc = 32 * (c.wid & 1) + c.r32;
        int rs = mod.qr - 4; rs = rs < 0 ? 0 : (rs > 56 ? 56 : rs); mod.rs = rs;
        int cs = mod.qc - 8; cs = cs < 0 ? 0 : (cs > 48 ? 48 : cs); mod.cs = cs;
    }
    const int nloc = mod.nloc;
    const size_t lbase = (size_t)b * SEQ + 64 * kr0, cbase = (size_t)TL + b * CTXL;
    auto tok0 = [&](int j) { return j < nloc ? lbase + 64 * j : cbase + 64 * (j - nloc); };
    const size_t vt0 = (size_t)b * 68;
    auto vtile = [&](int j) { return vt0 + (j < nloc ? kr0 + j : 64 + (j - nloc)); };
    pass8<64>(c, 2 + h, 128 + h * 64, nloc + 4, tok0, vtile, mod, qf, st);
    const float lt = half_swap_sum(st.l);
    store_o8<64>(st, 1.f / lt, mix + qtok * DM + 256 + h * 64, c.hi);
}

DI void attn_diff_item(const Ctx& c, int l, int b, int h, int qb, bool ctxq) {
    const Params& p = *c.p;
    unsigned char* mix = (unsigned char*)(p.ws + WS_MIX);
    const size_t qtok = ctxq ? (size_t)TL + b * CTXL + c.wid * 32 + c.r32 : (size_t)b * SEQ + qb * 256 + c.wid * 32 + c.r32;
    const int nloc = ctxq ? 0 : 64;
    const size_t lbase = (size_t)b * SEQ, cbase = (size_t)TL + b * CTXL;
    auto tok0 = [&](int j) { return j < nloc ? lbase + 64 * j : cbase + 64 * (j - nloc); };
    const size_t vt0 = (size_t)b * 68;
    auto vtile = [&](int j) { return vt0 + (j < nloc ? j : 64 + (j - nloc)); };
    unsigned char* orow = mix + qtok * DM + 512 + h * 128;
    bf16_t* prow = (bf16_t*)(p.ws + WS_PARK) + qtok * 512 + h * 128;
    ModNone mod;
    F8State<128> st;
    {
        const v8i_f qf = load_q8(c, qtok, 8 + 2 * h);
        pass8<128>(c, 6 + 2 * h, 384 + h * 128, nloc + 4, tok0, vtile, mod, qf, st);
        const float inv = 1.f / half_swap_sum(st.l);
#pragma unroll
        for (int dt = 0; dt < 4; ++dt)
#pragma unroll
            for (int g = 0; g < 4; ++g) {
                u32x2 u; u.x = pk2(st.o[dt][4 * g] * inv, st.o[dt][4 * g + 1] * inv); u.y = pk2(st.o[dt][4 * g + 2] * inv, st.o[dt][4 * g + 3] * inv);
                *(u32x2*)(prow + 32 * dt + 8 * g + 4 * c.hi) = u;
            }
    }
    const v8i_f qf = load_q8(c, qtok, 8 + 2 * h + 1);
    pass8<128>(c, 6 + 2 * h + 1, 384 + h * 128, nloc + 4, tok0, vtile, mod, qf, st);
    const float lam_init = 0.8f - 0.6f * __expf(-0.3f * (float)l);
    const float d1 = wave_sum(p.in[I_LQ1][l * 64 + c.lane] * p.in[I_LK1][l * 64 + c.lane]);
    const float d2 = wave_sum(p.in[I_LQ2][l * 64 + c.lane] * p.in[I_LK2][l * 64 + c.lane]);
    const float lam = __expf(d1) - __expf(d2) + lam_init;
    const float inv2 = lam / half_swap_sum(st.l);
    float ss = 0.f;
#pragma unroll
    for (int dt = 0; dt < 4; ++dt)
#pragma unroll
        for (int g = 0; g < 4; ++g) {
            const u32x2 u = *(const u32x2*)(prow + 32 * dt + 8 * g + 4 * c.hi);
            const float a0 = bflo(u.x) - st.o[dt][4 * g] * inv2, a1 = bfhi(u.x) - st.o[dt][4 * g + 1] * inv2;
            const float a2 = bflo(u.y) - st.o[dt][4 * g + 2] * inv2, a3 = bfhi(u.y) - st.o[dt][4 * g + 3] * inv2;
            st.o[dt][4 * g] = a0; st.o[dt][4 * g + 1] = a1; st.o[dt][4 * g + 2] = a2; st.o[dt][4 * g + 3] = a3;
            ss += (a0 * a0 + a1 * a1) + (a2 * a2 + a3 * a3);
        }
    ss = half_swap_sum(ss);
    const float rn = rsqrtf(ss * (1.f / 128.f) + EPSV) * (1.f - lam_init);
    const float* sg = p.in[I_SUBLN] + l * 128;
#pragma unroll
    for (int dt = 0; dt < 4; ++dt)
#pragma unroll
        for (int g = 0; g < 4; ++g) {
            const f32x4 gg = *(const f32x4*)(sg + 32 * dt + 8 * g + 4 * c.hi);
            const float rs = rn * MIX_SCALE;
            *(unsigned*)(orow + 32 * dt + 8 * g + 4 * c.hi) = pk4_fp8(st.o[dt][4 * g] * rs * gg.x, st.o[dt][4 * g + 1] * rs * gg.y, st.o[dt][4 * g + 2] * rs * gg.z, st.o[dt][4 * g + 3] * rs * gg.w);
        }
}

DI void attn_decode(int it, int& b, int& h, int& qb, bool& ctxq) {
    if (it < 512) {
        const int xcd = it & 7, j = it >> 3;
        const int bh = xcd * 4 + (j >> 4); qb = j & 15;
        b = bh >> 2; h = bh & 3; ctxq = false;
    } else {
        const int i = it - 512;
        qb = 0; h = i & 3; b = i >> 2; ctxq = true;
    }
}
DI Ctx reopaque(const Ctx& c) {
    Ctx d = c; int t = c.tid; asm volatile("" : "+v"(t));
    d.tid = t; d.lane = t & 63; d.wid = __builtin_amdgcn_readfirstlane(t >> 6); d.r32 = t & 31; d.hi = (t >> 5) & 1;
    return d;
}
DI void phase_attn0_convert(const Ctx& c) {
    int* actr = (int*)(c.p->ws + WS_ROWCTR) + 128;
    int* cctr = (int*)(c.p->ws + WS_ROWCTR) + 192;
    LAS int* slot = (LAS int*)(c.smem + LDS_MAIN + 64);
    constexpr int NIT = 544, NATT = 3 * NIT;
    const bool prefer_conv = (c.bid & 1) != 0;
    for (;;) {
        if (c.tid == 0) {
            int k = -1, v = 0;
            if (prefer_conv) {
                v = atomicAdd(cctr, 1); if (v < CONV_NCHUNK) k = 1;
                if (k < 0) { v = atomicAdd(actr, 1); if (v < NATT) k = 0; }
            } else {
                v = atomicAdd(actr, 1); if (v < NATT) k = 0;
                if (k < 0) { v = atomicAdd(cctr, 1); if (v < CONV_NCHUNK) k = 1; }
            }
            slot[0] = k; slot[1] = v;
        }
        __syncthreads();
        const int kind = slot[0], idx = slot[1];
        __syncthreads();
        if (kind < 0) break;
        if (kind == 1) {
            convert_pairs(reopaque(c), idx * CONV_CHUNK, 1, CONV_CHUNK, [](int q) { return rmap_expert(q); });
        } else {
            const int grp = idx / NIT, it = idx - grp * NIT;
            int b, h, qb; bool ctxq; attn_decode(it, b, h, qb, ctxq);
            if (grp == 0) attn_diff_item(reopaque(c), 0, b, h, qb, ctxq);
            else if (grp == 1) attn_swa_item(reopaque(c), 0, b, h, qb, ctxq);
            else attn_na_item(reopaque(c), 0, b, h, qb, ctxq);
        }
    }
}
DI void phase_attn(const Ctx& c, int l) {
    const int NIT = 512 + ((l == 0) ? 32 : 0);
    for (int it = c.bid; it < NIT; it += c.nblk) { int b, h, qb; bool ctxq; attn_decode(it, b, h, qb, ctxq); attn_diff_item(c, l, b, h, qb, ctxq); }
    for (int it = c.bid; it < NIT; it += c.nblk) { int b, h, qb; bool ctxq; attn_decode(it, b, h, qb, ctxq); attn_swa_item(c, l, b, h, qb, ctxq); }
    for (int it = c.bid; it < NIT; it += c.nblk) { int b, h, qb; bool ctxq; attn_decode(it, b, h, qb, ctxq); attn_na_item(c, l, b, h, qb, ctxq); }
}
#ifndef WAVES_PER_SIMD
#define WAVES_PER_SIMD 2
#endif
#ifndef PROBE_REP
#define PROBE_REP 0
#endif
#ifndef DBG_MODE
#define DBG_MODE 0
#endif
DI Ctx mkctx(const Params& p, char* smem, int wave_s) {
    Ctx c; c.p = &p; c.smem = smem;
    int t = wave_s * 64 + (int)__builtin_amdgcn_mbcnt_hi(~0u, __builtin_amdgcn_mbcnt_lo(~0u, 0u)); asm volatile("" : "+v"(t));
    c.tid = t; c.lane = t & 63; c.wid = __builtin_amdgcn_readfirstlane(t >> 6); c.r32 = t & 31; c.hi = (t >> 5) & 1;
    int b = blockIdx.x, n = gridDim.x; asm volatile("" : "+s"(b), "+s"(n));
    c.bid = b; c.nblk = n;
    return c;
}
__global__ void __launch_bounds__(NTHREADS, WAVES_PER_SIMD) mega(Params p) {
    extern __shared__ __attribute__((aligned(16))) char smem[];
    Ctx c; c.p = &p; c.smem = smem; c.tid = threadIdx.x; c.lane = c.tid & 63; c.wid = c.tid >> 6; c.r32 = c.lane & 31; c.hi = c.lane >> 5;
    c.bid = blockIdx.x; c.nblk = gridDim.x;
    const int wave_s = __builtin_amdgcn_readfirstlane((int)threadIdx.x >> 6);
#define FRESH() mkctx(p, smem, wave_s)
#define GRID_SYNC() do { XcdBarrier bb_ = bar; asm volatile("" : "+s"(bb_.bar), "+s"(bb_.x)); xcd_barrier(bb_); } while (0)
    volatile LAS unsigned* xbw = (volatile LAS unsigned*)(smem + LDS_MAIN);
    if (c.tid == 0) { xbw[0] = 0u; xbw[1] = 0u; xbw[2] = 0u; xbw[3] = 0u; }
    __syncthreads();
    XcdBarrier bar = xcd_barrier_post((unsigned*)(p.ws + WS_BAR), xbw);
    asm volatile("; PHASE_MARK prologue" ::: "memory");
    phase_prologue(FRESH());
    GRID_SYNC();
#if PROBE_REP == 1
    asm volatile("; PHASE_MARK prologue" ::: "memory");
    phase_prologue(FRESH());
    GRID_SYNC();
#endif
    asm volatile("; PHASE_MARK norm" ::: "memory");
    phase_norm(FRESH(), 0, TT, true, 0);
    wrp_items(FRESH());
    GRID_SYNC();
#if PROBE_REP == 9
    phase_norm(FRESH(), 0, TT, true, 0);
    GRID_SYNC();
#endif
#if PROBE_REP == 13
#pragma unroll 1
    for (int z = 0; z < 20; ++z) { GRID_SYNC(); }
#endif
#pragma unroll 1
    for (int l = 0; l < 2; ++l) {
        const bool last = (l == 1);
        const int nrows = last ? TL : TT;
        asm volatile("; PHASE_MARK inproj" ::: "memory");
        asm volatile("; PHASE_MARK inproj" ::: "memory");
    phase_inproj(FRESH(), l);
        GRID_SYNC();
#if PROBE_REP == 2
        asm volatile("; PHASE_MARK inproj" ::: "memory");
        asm volatile("; PHASE_MARK inproj" ::: "memory");
    phase_inproj(FRESH(), l);
        GRID_SYNC();
#endif
        asm volatile("; PHASE_MARK attn" ::: "memory");
        asm volatile("; PHASE_MARK attn" ::: "memory");
        if (l == 0) phase_attn0_convert(FRESH()); else phase_attn(FRESH(), l);
        GRID_SYNC();
#if PROBE_REP == 3
        asm volatile("; PHASE_MARK attn" ::: "memory");
        asm volatile("; PHASE_MARK attn" ::: "memory");
    phase_attn(FRESH(), l);
        GRID_SYNC();
#endif
        asm volatile("; PHASE_MARK outproj" ::: "memory");
        asm volatile("; PHASE_MARK outproj" ::: "memory");
    phase_outproj(FRESH(), l, nrows);
        GRID_SYNC();
#if PROBE_REP == 7
        if (l == 0) { phase_outproj(FRESH(), l, nrows); GRID_SYNC(); }
#endif
#if DBG_MODE != 1
        asm volatile("; PHASE_MARK router" ::: "memory");
    phase_norm_router(FRESH(), l, nrows);
        GRID_SYNC();
        asm volatile("; PHASE_MARK route" ::: "memory");
        asm volatile("; PHASE_MARK route" ::: "memory");
    phase_route(FRESH(), l, nrows);
        GRID_SYNC();
        asm volatile("; PHASE_MARK e1" ::: "memory");
        asm volatile("; PHASE_MARK e1" ::: "memory");
    phase_e1(FRESH(), l, nrows);
        GRID_SYNC();
#if PROBE_REP == 4
        asm volatile("; PHASE_MARK e1" ::: "memory");
        asm volatile("; PHASE_MARK e1" ::: "memory");
    phase_e1(FRESH(), l, nrows);
        GRID_SYNC();
#endif
        asm volatile("; PHASE_MARK e2" ::: "memory");
        asm volatile("; PHASE_MARK e2" ::: "memory");
    phase_e2(FRESH(), l, nrows);
        GRID_SYNC();
#if PROBE_REP == 5
        asm volatile("; PHASE_MARK e2" ::: "memory");
        asm volatile("; PHASE_MARK e2" ::: "memory");
    phase_e2(FRESH(), l, nrows);
        GRID_SYNC();
#endif
#endif
        asm volatile("; PHASE_MARK combine" ::: "memory");
        asm volatile("; PHASE_MARK combine" ::: "memory");
    phase_combine(FRESH(), l, nrows, last);
#if PROBE_REP == 8
        if (last) { GRID_SYNC(); phase_combine(FRESH(), l, nrows, last); }
#endif
        if (!last) { GRID_SYNC(); }
    }
}

extern "C" void kernel_launch(void* const* d_in, const int* in_sizes, int n_in, void* d_out, int out_size, void* d_ws, size_t ws_size, hipStream_t stream) {
    static int grid = 0;
    if (grid == 0) {
        int dev = 0, cus = 0, per_cu = 0;
        if (n_in != 26 || ws_size < WS_END) { fprintf(stderr, "kernel_launch: unexpected n_in %d / ws %zu (need %zu)\n", n_in, ws_size, (size_t)WS_END); grid = -1; return; }
        if (hipGetDevice(&dev) != hipSuccess || hipDeviceGetAttribute(&cus, hipDeviceAttributeMultiprocessorCount, dev) != hipSuccess) { grid = -1; return; }
        if (hipFuncSetAttribute((const void*)mega, hipFuncAttributeMaxDynamicSharedMemorySize, LDS_BYTES) != hipSuccess) { grid = -1; return; }
        if (hipOccupancyMaxActiveBlocksPerMultiprocessor(&per_cu, (const void*)mega, NTHREADS, LDS_BYTES) != hipSuccess || per_cu < 1) per_cu = 1;
        (void)hipGetLastError();
        grid = cus;
    }
    if (grid < 0) return;
    (void)hipMemsetAsync((char*)d_ws + WS_BAR, 0, WS_ZERO_BYTES, stream);
    Params p{};
    for (int i = 0; i < 26; ++i) p.in[i] = (const float*)d_in[i];
    p.out = (float*)d_out; p.ws = (unsigned char*)d_ws;
    hipLaunchKernelGGL(mega, dim3(grid), dim3(NTHREADS), LDS_BYTES, stream, p);
}
```

```cpp
#include <hip/hip_runtime.h>
#include <hip/hip_bf16.h>
#include <cstdio>
#include <cstdint>

#define XB_TMO      128
#define XB_XCNT(j)  (256  + 64 * (j))
#define XB_XSUB(j)  (1280 + 64 * (j))
#define XB_XGEN(j)  (2304 + 64 * (j))
#define XB_TOP      3328
#define XB_TOPGEN   3392
#define XCD_BAR_WORDS 3456
#define XB_SPIN_CAP (1u << 22)
#define LAS __attribute__((address_space(3)))

__device__ __forceinline__ unsigned xb_ld(unsigned* p)              { return __hip_atomic_load(p, __ATOMIC_RELAXED, __HIP_MEMORY_SCOPE_AGENT); }
__device__ __forceinline__ unsigned xb_add(unsigned* p, unsigned v) { return __hip_atomic_fetch_add(p, v, __ATOMIC_RELAXED, __HIP_MEMORY_SCOPE_AGENT); }
__device__ __forceinline__ unsigned xb_xcc_id() { return (unsigned)__builtin_amdgcn_s_getreg((3 << 11) | 20) & 0xFu; }
#define XB_SPIN(cond, bar) do { unsigned _sp = 0; while (cond) { __builtin_amdgcn_s_sleep(1); \
    if ((++_sp & 255u) == 0u) { if (xb_ld(&(bar)[XB_TMO])) break; if (_sp > XB_SPIN_CAP) { atomicAdd(&(bar)[XB_TMO], 1u); break; } } } } while (0)

struct XcdBarrier {
    unsigned* bar; unsigned x;
    volatile LAS unsigned* st;
};

__device__ __forceinline__ XcdBarrier xcd_barrier_post(unsigned* bar, volatile LAS unsigned* st) {
    XcdBarrier b; b.bar = bar; b.x = xb_xcc_id(); b.st = st;
    if (threadIdx.x == 0) (void)xb_add(&bar[XB_XCNT(b.x)], 1u);
    return b;
}
__device__ __forceinline__ void xcd_barrier_complete(unsigned* bar, unsigned x, unsigned& nloc, unsigned& nx) {
    const unsigned G = gridDim.x * gridDim.y * gridDim.z;
    unsigned sum, cnt, mine, sp = 0u;
    for (;;) {
        sum = 0u; cnt = 0u; mine = 0u;
#pragma unroll
        for (unsigned j = 0; j < 16; ++j) { const unsigned c = xb_ld(&bar[XB_XCNT(j)]); sum += c; cnt += (c > 0u) ? 1u : 0u; mine = (j == x) ? c : mine; }
        if (sum == G) break;
        __builtin_amdgcn_s_sleep(1);
        if ((++sp & 255u) == 0u) { if (xb_ld(&bar[XB_TMO])) break; if (sp > XB_SPIN_CAP) { atomicAdd(&bar[XB_TMO], 1u); break; } }
    }
    nloc = mine > 0u ? mine : 1u; nx = cnt > 0u ? cnt : 1u;
}

__device__ __forceinline__ void xcd_barrier(const XcdBarrier& b) {
    asm volatile("s_waitcnt vmcnt(0)" ::: "memory");
    __syncthreads();
    if (threadIdx.x == 0) {
        unsigned* bar = b.bar;
        __builtin_amdgcn_s_waitcnt(0);
        unsigned nloc = b.st[0], nx = b.st[1];
        if (nloc == 0u) { xcd_barrier_complete(bar, b.x, nloc, nx); b.st[0] = nloc; b.st[1] = nx; }
        const unsigned old = xb_add(&bar[XB_XSUB(b.x)], 1u);
        const unsigned gen = old / nloc;
        if (old + 1u == (gen + 1u) * nloc) {
            __builtin_amdgcn_fence(__ATOMIC_RELEASE, "agent");
            asm volatile("s_waitcnt vmcnt(0)" ::: "memory");
            const unsigned og = xb_add(&bar[XB_TOP], 1u);
            const unsigned tg = og / nx;
            if (og + 1u == (tg + 1u) * nx) xb_add(&bar[XB_TOPGEN], 1u);
            else XB_SPIN(xb_ld(&bar[XB_TOPGEN]) == tg, bar);
            __builtin_amdgcn_fence(__ATOMIC_ACQUIRE, "agent");
            xb_add(&bar[XB_XGEN(b.x)], 1u);
            asm volatile("s_waitcnt vmcnt(0)" ::: "memory");
        } else {
            XB_SPIN(xb_ld(&bar[XB_XGEN(b.x)]) == gen, bar);
            __builtin_amdgcn_fence(__ATOMIC_ACQUIRE, "agent");
            asm volatile("s_waitcnt vmcnt(0)" ::: "memory");
        }
    }
    __syncthreads();
}

constexpr int DM = 1024, NB = 8, SEQ = 4096, CTXL = 256;
constexpr int TL = NB * SEQ;
constexpr int TC = NB * CTXL;
constexpr int TT = TL + TC;
constexpr int INC = 2816, QC = 1024, KVC = 1792;
constexpr int NE = 256, NEX = 257, FF = 256;
constexpr float EPSV = 1e-6f;
constexpr float LOG2E = 1.4426950408889634f;
constexpr float QSCALE = 0.125f * LOG2E;
constexpr float MIX_SCALE = 4.0f, W_SCALE = 32.0f, WD_SCALE = 16.0f, ACT_SCALE = 2.0f;
constexpr int NTHREADS = 512;
constexpr int NWAVES = 8;
constexpr int LDS_MAIN = 131072;
constexpr int LDS_AUX = 8192 + 16384 + 8192;
constexpr int LDS_BYTES = LDS_MAIN + LDS_AUX;
constexpr int LDS_STG = LDS_MAIN + 8192;
static_assert(LDS_BYTES <= 163840, "LDS");

typedef unsigned short bf16_t;
typedef __attribute__((ext_vector_type(8))) short bf16x8;
typedef __attribute__((ext_vector_type(4))) short s16x4;
typedef __attribute__((ext_vector_type(16))) float f32x16;
typedef __attribute__((ext_vector_type(2))) float f32x2;
typedef __attribute__((ext_vector_type(2))) __bf16 bf16x2v;
typedef short v4i16_t __attribute__((ext_vector_type(4)));
typedef __attribute__((ext_vector_type(4))) unsigned u32x4;
typedef __attribute__((ext_vector_type(2))) unsigned u32x2;
typedef __attribute__((ext_vector_type(4))) float f32x4;
#define DI __device__ __forceinline__
#define MFMA32(a, b, c) __builtin_amdgcn_mfma_f32_32x32x16_bf16((a), (b), (c), 0, 0, 0)

DI unsigned pk2(float lo, float hi) { f32x2 v = {lo, hi}; bf16x2v b = __builtin_convertvector(v, bf16x2v); return __builtin_bit_cast(unsigned, b); }
DI unsigned pk4_fp8(float a, float b, float c, float d) { int w = 0; w = __builtin_amdgcn_cvt_pk_fp8_f32(a, b, w, false); w = __builtin_amdgcn_cvt_pk_fp8_f32(c, d, w, true); return (unsigned)w; }
DI float bf2f(bf16_t u) { return __uint_as_float(((unsigned)u) << 16); }
DI float bflo(unsigned u) { return __uint_as_float(u << 16); }
DI float bfhi(unsigned u) { return __uint_as_float(u & 0xffff0000u); }
DI f32x4 bf4_f32(u32x2 w) { return f32x4{bflo(w.x), bfhi(w.x), bflo(w.y), bfhi(w.y)}; }
DI u32x2 f32_bf4(f32x4 v) { u32x2 o; o.x = pk2(v[0], v[1]); o.y = pk2(v[2], v[3]); return o; }
DI int crow(int reg, int hi) { return (reg & 3) + 8 * (reg >> 2) + 4 * hi; }
#define DPPI(v, CTRL) __builtin_amdgcn_update_dpp(0, (v), (CTRL), 0xf, 0xf, true)
#define DPPF(v, CTRL) __builtin_bit_cast(float, __builtin_amdgcn_update_dpp(0, __builtin_bit_cast(int, (v)), (CTRL), 0xf, 0xf, true))
#define DPP_XOR1 0xB1
#define DPP_XOR2 0x4E
#define DPP_HMIR 0x141
#define DPP_MIR  0x140
#define DPP_SHR(n) (0x110 + (n))
DI float rdlane_f(float v, int l) { return __builtin_bit_cast(float, __builtin_amdgcn_readlane(__builtin_bit_cast(int, v), l)); }
DI float wave_sum(float v) {
    v += DPPF(v, DPP_XOR1); v += DPPF(v, DPP_XOR2); v += DPPF(v, DPP_HMIR); v += DPPF(v, DPP_MIR);
    return (rdlane_f(v, 0) + rdlane_f(v, 16)) + (rdlane_f(v, 32) + rdlane_f(v, 48));
}
DI float half_swap_sum(float v) {
    const auto rr = __builtin_amdgcn_permlane32_swap(__float_as_uint(v), __float_as_uint(v), false, false);
    return __uint_as_float(rr[0]) + __uint_as_float(rr[1]);
}
DI float siluf(float v) { return v / (1.f + __expf(-v)); }

struct Params {
    const float* in[26];
    float* out;
    unsigned char* ws;
};
enum { I_X = 0, I_C, I_CTX, I_CCTX, I_WMOD, I_BMOD, I_GMIX, I_GFFN, I_WIN, I_WOUT, I_SINK, I_RPB, I_LQ1, I_LK1, I_LQ2, I_LK2, I_SUBLN,
       I_WR, I_RB, I_WG, I_WU, I_WD, I_SG, I_SU, I_SD, I_GFINAL };

constexpr size_t MiB = 1u << 20;
constexpr size_t WS_BAR = 0;
constexpr size_t WS_CNT = 16384;
constexpr int CNT_STRIDE = 64, CNT_LAYER = 257 * 64;
constexpr size_t WS_ZERO_BYTES = 163840;
constexpr size_t WS_ROPE = 196608;
constexpr size_t WS_MOD = 262144;
constexpr size_t WS_WIN = 1 * MiB;
constexpr size_t WS_WOUT = 12 * MiB;
constexpr size_t WS_WR = 16 * MiB;
constexpr size_t WS_WGU = 17 * MiB;
constexpr size_t WS_WD = WS_WGU + 514 * MiB;
constexpr size_t WS_XBUF = WS_WD + 257 * MiB;
constexpr size_t WS_HBUF = WS_XBUF + 136 * MiB;
constexpr size_t WS_SLOTW = WS_HBUF + 68 * MiB;
constexpr size_t WS_LIST = WS_SLOTW + 2 * MiB;
constexpr size_t WS_R = WS_LIST + 34 * MiB;
constexpr size_t WS_Q = WS_R;
constexpr size_t WS_KV = WS_R + 68 * MiB;
constexpr size_t WS_MIX = WS_R + 187 * MiB;
constexpr size_t WS_PARK = WS_R + 221 * MiB;
constexpr size_t WS_Q8 = WS_R + 290 * MiB;
constexpr size_t WS_K8 = WS_R + 324 * MiB;
constexpr size_t WS_VT8 = WS_R + 358 * MiB;
constexpr int VT_ROWS = 896, VT_TILE = 896 * 64;
constexpr size_t WS_LOGIT = WS_R + 256 * MiB;
constexpr size_t WS_ACT = WS_R;
constexpr size_t WS_HIN8 = WS_WGU + 300 * MiB;
constexpr size_t WS_H8 = WS_R + 80 * MiB;
constexpr size_t WS_YS = WS_R + 153 * MiB;
constexpr size_t WS_EINFO = WS_R + 512 * MiB;
constexpr size_t WS_WRP = WS_R + 460 * MiB;
constexpr size_t WS_CB = WS_R + 470 * MiB;
constexpr size_t WS_RSTD = WS_R + 471 * MiB;
constexpr size_t WS_ROWCTR = 151552;
constexpr size_t WS_END = WS_YS + 612 * MiB;
static_assert(WS_END <= 2048 * MiB, "workspace");

struct Ctx {
    const Params* p;
    char* smem;
    int tid, lane, wid, r32, hi;
    int bid, nblk;
};
DI int map_row(int type, int n) {
    if (type == 1) {
        const int hb = n >> 6, d = n & 63;
        const bool roped = (hb < 4) || (hb >= 8 && hb < 16) || (hb == 16) || (hb == 17) || (hb >= 28 && hb < 36);
        int d2 = d;
        if (roped) d2 = (d < 16) ? 2 * d : (d < 32) ? 2 * (d - 16) + 1 : (d < 48) ? 2 * (d - 16) : 2 * (d - 32) + 1;
        return (hb << 6) | d2;
    }
    if (type == 2) return 2 * n;
    if (type == 3) return 2 * n + 1;
    return n;
}

struct TItem { const float* W; int K, N, kt, nt, type; void* dst; bool f8; float ws; };
DI void tload(const Ctx& c, float (&v)[4][2][8], const TItem& it) {
    const int wid4 = c.wid & 3;
    const int k0 = it.kt * 128, n0 = it.nt * 128;
#pragma unroll
    for (int cc = 0; cc < 4; ++cc) {
        const int kc = 4 * wid4 + cc;
#pragma unroll
        for (int j = 0; j < 8; ++j)
#pragma unroll
            for (int i = 0; i < 2; ++i) v[cc][i][j] = __builtin_nontemporal_load(&it.W[(size_t)(k0 + kc * 8 + j) * it.N + n0 + c.lane + 64 * i]);
    }
}
DI void tfinish(const Ctx& c, const float (&v)[4][2][8], const TItem& it) {
    LAS char* lds = (LAS char*)c.smem + (c.tid >> 8) * 36864;
    const int wid4 = c.wid & 3, tid8 = c.tid & 255;
    const int k0 = it.kt * 128, n0 = it.nt * 128, K = it.K;
    const float wscale = it.ws;
#pragma unroll
    for (int cc = 0; cc < 4; ++cc) {
        const int kc = 4 * wid4 + cc;
#pragma unroll
        for (int i = 0; i < 2; ++i) {
            if (it.f8) {
                u32x2 u; u.x = pk4_fp8(v[cc][i][0] * wscale, v[cc][i][1] * wscale, v[cc][i][2] * wscale, v[cc][i][3] * wscale); u.y = pk4_fp8(v[cc][i][4] * wscale, v[cc][i][5] * wscale, v[cc][i][6] * wscale, v[cc][i][7] * wscale);
                *(LAS u32x2*)(lds + (c.lane + 64 * i) * 144 + kc * 8) = u;
            } else {
                u32x4 u; u.x = pk2(v[cc][i][0], v[cc][i][1]); u.y = pk2(v[cc][i][2], v[cc][i][3]); u.z = pk2(v[cc][i][4], v[cc][i][5]); u.w = pk2(v[cc][i][6], v[cc][i][7]);
                *(LAS u32x4*)(lds + (c.lane + 64 * i) * 272 + kc * 16) = u;
            }
        }
    }
    __syncthreads();
    if (it.f8) {
        unsigned char* dst = (unsigned char*)it.dst;
#pragma unroll
        for (int j = 0; j < 4; ++j) {
            const int idx = tid8 + 256 * j, c16 = idx & 7, n = idx >> 3;
            const u32x4 u = *(LAS u32x4*)(lds + n * 144 + c16 * 16);
            const int row = map_row(it.type, n0 + n);
            __builtin_nontemporal_store(u, (u32x4*)(dst + (size_t)row * K + k0 + c16 * 16));
        }
    } else {
        bf16_t* dst = (bf16_t*)it.dst;
#pragma unroll
        for (int j = 0; j < 8; ++j) {
            const int idx = tid8 + 256 * j, c16 = idx & 15, n = idx >> 4;
            const u32x4 u = *(LAS u32x4*)(lds + n * 272 + c16 * 16);
            const int row = map_row(it.type, n0 + n);
            *(u32x4*)(dst + (size_t)row * K + k0 + c16 * 8) = u;
        }
    }
    __syncthreads();
}

DI void mod_item(const Ctx& c, int l, int cg) {
    const Params& p = *c.p;
    LAS float* sv = (LAS float*)c.smem;
    LAS float* part = (LAS float*)(c.smem + 36864);
    for (int idx = c.tid; idx < 9 * 1024; idx += NTHREADS) {
        const int b = idx >> 10, k = idx & 1023;
        const float v = (b < 8) ? p.in[I_C][b * 1024 + k] : p.in[I_CCTX][k];
        sv[idx] = siluf(v);
    }
    __syncthreads();
    const int col = c.tid & 63, kq = c.tid >> 6;
    float acc[9];
#pragma unroll
    for (int b = 0; b < 9; ++b) acc[b] = 0.f;
    const float* wp = p.in[I_WMOD] + ((size_t)l * 1024 + kq * 128) * 6144 + cg * 64 + col;
    for (int k = 0; k < 128; k += 8) {
        float w[8];
#pragma unroll
        for (int u = 0; u < 8; ++u) w[u] = wp[(size_t)(k + u) * 6144];
#pragma unroll
        for (int u = 0; u < 8; ++u)
#pragma unroll
            for (int b = 0; b < 9; ++b) acc[b] += sv[b * 1024 + kq * 128 + k + u] * w[u];
    }
#pragma unroll
    for (int b = 0; b < 9; ++b) part[(kq * 9 + b) * 64 + col] = acc[b];
    __syncthreads();
    float* modv = (float*)(p.ws + WS_MOD);
    for (int idx = c.tid; idx < 576; idx += NTHREADS) {
        const int b = idx >> 6, cl = idx & 63;
        float s = 0.f;
#pragma unroll
        for (int q = 0; q < 8; ++q) s += part[(q * 9 + b) * 64 + cl];
        modv[(size_t)(l * 9 + b) * 6144 + cg * 64 + cl] = s + p.in[I_BMOD][l * 6144 + cg * 64 + cl];
    }
    __syncthreads();
}

DI void rope_item(const Ctx& c) {
    float2* tab = (float2*)(c.p->ws + WS_ROPE);
    for (int idx = c.tid; idx < 1024; idx += NTHREADS) {
        const int pos = idx >> 4, i = idx & 15;
        const float inv = 1.0f / powf(10000.0f, (float)i / 16.0f);
        const float ang = (float)pos * inv;
        float sn, cs; sincosf(ang, &sn, &cs);
        tab[idx] = make_float2(cs, sn);
    }
}

constexpr int PRO_PER_LAYER = 12592;
DI TItem transpose_decode(const Ctx& c, int r) {
    const Params& p = *c.p;
    const int l = r / PRO_PER_LAYER; r -= l * PRO_PER_LAYER;
    unsigned char* wgu = (unsigned char*)(p.ws + WS_WGU) + (size_t)l * 257 * 524288;
    unsigned char* wd = (unsigned char*)(p.ws + WS_WD) + (size_t)l * 257 * 262144;
    TItem t; t.f8 = true; t.ws = W_SCALE;
    if (r < 4096) { const int e = r >> 4, s = r & 15; t.W = p.in[I_WG] + (size_t)(l * 256 + e) * 262144; t.K = 1024; t.N = 256; t.kt = s >> 1; t.nt = s & 1; t.dst = wgu + (size_t)e * 524288; t.type = 2; }
    else if (r < 8192) { r -= 4096; const int e = r >> 4, s = r & 15; t.W = p.in[I_WU] + (size_t)(l * 256 + e) * 262144; t.K = 1024; t.N = 256; t.kt = s >> 1; t.nt = s & 1; t.dst = wgu + (size_t)e * 524288; t.type = 3; }
    else if (r < 12288) { r -= 8192; const int e = r >> 4, s = r & 15; t.W = p.in[I_WD] + (size_t)(l * 256 + e) * 262144; t.K = 256; t.N = 1024; t.kt = s >> 3; t.nt = s & 7; t.dst = wd + (size_t)e * 262144; t.type = 0; t.ws = WD_SCALE; }
    else {
        r -= 12288;
        if (r < 176) { t.W = p.in[I_WIN] + (size_t)l * 1024 * 2816; t.K = 1024; t.N = 2816; t.kt = r / 22; t.nt = r % 22; t.dst = (unsigned char*)(p.ws + WS_WIN) + (size_t)l * 2816 * 1024; t.type = 1; }
        else if (r < 240) { r -= 176; t.W = p.in[I_WOUT] + (size_t)l * 1048576; t.K = 1024; t.N = 1024; t.kt = r >> 3; t.nt = r & 7; t.dst = (unsigned char*)(p.ws + WS_WOUT) + (size_t)l * 1048576; t.type = 0; }
        else if (r < 256) { r -= 240; t.W = p.in[I_WR] + (size_t)l * 262144; t.K = 1024; t.N = 256; t.kt = r >> 1; t.nt = r & 1; t.dst = (bf16_t*)(p.ws + WS_WR) + (size_t)l * 262144; t.type = 0; t.f8 = false; }
        else if (r < 272) { r -= 256; t.W = p.in[I_SG] + (size_t)l * 262144; t.K = 1024; t.N = 256; t.kt = r >> 1; t.nt = r & 1; t.dst = wgu + (size_t)256 * 524288; t.type = 2; }
        else if (r < 288) { r -= 272; t.W = p.in[I_SU] + (size_t)l * 262144; t.K = 1024; t.N = 256; t.kt = r >> 1; t.nt = r & 1; t.dst = wgu + (size_t)256 * 524288; t.type = 3; }
        else { r -= 288; t.W = p.in[I_SD] + (size_t)l * 262144; t.K = 256; t.N = 1024; t.kt = r >> 3; t.nt = r & 7; t.dst = wd + (size_t)256 * 262144; t.type = 0; t.ws = WD_SCALE; }
    }
    return t;
}
template <class RMap>
DI void convert_pairs(const Ctx& c, int first, int stride, int n, RMap rmap) {
    if (n <= 0) return;
    const int half = c.tid >> 8;
    float va[4][2][8], vb[4][2][8];
    TItem ia = transpose_decode(c, rmap(first) + half), ib = ia;
    tload(c, va, ia);
    int i = 0;
    for (;;) {
        const bool m1 = i + 1 < n;
        if (m1) { ib = transpose_decode(c, rmap(first + (i + 1) * stride) + half); tload(c, vb, ib); }
        tfinish(c, va, ia);
        if (!m1) break;
        ++i;
        const bool m2 = i + 1 < n;
        if (m2) { ia = transpose_decode(c, rmap(first + (i + 1) * stride) + half); tload(c, va, ia); }
        tfinish(c, vb, ib);
        if (!m2) break;
        ++i;
    }
}
constexpr int PRO_EXPERT = 12288, PRO_SMALL = PRO_PER_LAYER - PRO_EXPERT;
constexpr int CONV_CHUNK = 8, CONV_NCHUNK = 2 * PRO_EXPERT / 2 / CONV_CHUNK;
DI int rmap_small(int q) { const int l = q / (PRO_SMALL / 2), s = q - l * (PRO_SMALL / 2); return l * PRO_PER_LAYER + PRO_EXPERT + 2 * s; }
DI int rmap_expert(int q) { const int l = q / (PRO_EXPERT / 2), s = q - l * (PRO_EXPERT / 2); return l * PRO_PER_LAYER + 2 * s; }
DI void phase_prologue(const Ctx& c) {
    for (int it = c.bid; it < 193; it += c.nblk) { if (it < 192) mod_item(c, it / 96, it % 96); else rope_item(c); }
    __syncthreads();
    constexpr int NP = PRO_SMALL;
    const int n = (NP > c.bid) ? (NP - c.bid + c.nblk - 1) / c.nblk : 0;
    convert_pairs(c, c.bid, c.nblk, n, [](int q) { return rmap_small(q); });
}

template <bool XBF>
DI void norm_mod_row(const float* __restrict__ xrow, const float* __restrict__ g, const float* __restrict__ sh, const float* __restrict__ sc, bf16_t* __restrict__ orow, unsigned char* __restrict__ o8, int lane) {
    float4 v[4]; float s = 0.f;
#pragma unroll
    for (int j = 0; j < 4; ++j) { if constexpr (XBF) { const f32x4 t4 = bf4_f32(((const u32x2*)xrow)[lane + 64 * j]); v[j] = make_float4(t4[0], t4[1], t4[2], t4[3]); } else v[j] = ((const float4*)xrow)[lane + 64 * j]; s += (v[j].x * v[j].x + v[j].y * v[j].y) + (v[j].z * v[j].z + v[j].w * v[j].w); }
    const float rstd = rsqrtf(wave_sum(s) * (1.f / DM) + EPSV);
#pragma unroll
    for (int j = 0; j < 4; ++j) {
        const float4 gg = ((const float4*)g)[lane + 64 * j], shh = ((const float4*)sh)[lane + 64 * j], scc = ((const float4*)sc)[lane + 64 * j];
        const float y0 = v[j].x * rstd * gg.x * (1.f + scc.x) + shh.x, y1 = v[j].y * rstd * gg.y * (1.f + scc.y) + shh.y;
        const float y2 = v[j].z * rstd * gg.z * (1.f + scc.z) + shh.z, y3 = v[j].w * rstd * gg.w * (1.f + scc.w) + shh.w;
        u32x2 o; o.x = pk2(y0, y1); o.y = pk2(y2, y3);
        if (orow) ((u32x2*)orow)[lane + 64 * j] = o;
        if (o8) ((unsigned*)o8)[lane + 64 * j] = pk4_fp8(y0, y1, y2, y3);
    }
}

DI void wrp_items(const Ctx& c) {
    const Params& p = *c.p;
    const float* modv = (const float*)(p.ws + WS_MOD);
    const bf16_t* wr = (const bf16_t*)(p.ws + WS_WR);
    bf16_t* wrp = (bf16_t*)(p.ws + WS_WRP);
    float* cb = (float*)(p.ws + WS_CB);
    const int lane = c.lane;
    for (int idx = c.bid * NWAVES + c.wid; idx < 2 * 9 * 256; idx += c.nblk * NWAVES) {
        const int l = idx / 2304, r = idx - l * 2304, b = r >> 8, e = r & 255;
        const float* g = p.in[I_GFFN] + l * 1024 + 16 * lane;
        const float* mv = modv + (size_t)(l * 9 + b) * 6144 + 3072 + 16 * lane;
        const bf16_t* src = wr + ((size_t)l * 256 + e) * 1024 + 16 * lane;
        const u32x4 w0 = *(const u32x4*)src, w1 = *(const u32x4*)(src + 8);
        float wv[16];
        wv[0] = bflo(w0.x); wv[1] = bfhi(w0.x); wv[2] = bflo(w0.y); wv[3] = bfhi(w0.y); wv[4] = bflo(w0.z); wv[5] = bfhi(w0.z); wv[6] = bflo(w0.w); wv[7] = bfhi(w0.w);
        wv[8] = bflo(w1.x); wv[9] = bfhi(w1.x); wv[10] = bflo(w1.y); wv[11] = bfhi(w1.y); wv[12] = bflo(w1.z); wv[13] = bfhi(w1.z); wv[14] = bflo(w1.w); wv[15] = bfhi(w1.w);
        float s = 0.f, o[16];
#pragma unroll
        for (int j = 0; j < 4; ++j) {
            const f32x4 gg = *(const f32x4*)(g + 4 * j), sh = *(const f32x4*)(mv + 4 * j), sc = *(const f32x4*)(mv + 1024 + 4 * j);
#pragma unroll
            for (int i = 0; i < 4; ++i) { o[4 * j + i] = wv[4 * j + i] * gg[i] * (1.f + sc[i]); s += sh[i] * wv[4 * j + i]; }
        }
        u32x4 o0, o1;
        o0.x = pk2(o[0], o[1]); o0.y = pk2(o[2], o[3]); o0.z = pk2(o[4], o[5]); o0.w = pk2(o[6], o[7]);
        o1.x = pk2(o[8], o[9]); o1.y = pk2(o[10], o[11]); o1.z = pk2(o[12], o[13]); o1.w = pk2(o[14], o[15]);
        bf16_t* dst = wrp + ((size_t)(l * 9 + b) * 256 + e) * 1024 + 16 * lane;
        *(u32x4*)dst = o0; *(u32x4*)(dst + 8) = o1;
        s = wave_sum(s);
        if (lane == 0) cb[(l * 9 + b) * 256 + e] = s;
    }
}
DI void norm_ffn_row(const bf16_t* __restrict__ xrow, const float* __restrict__ g, const float* __restrict__ sh, const float* __restrict__ sc, unsigned char* __restrict__ o8, float* __restrict__ rstd_out, int lane) {
    f32x4 v[4]; float s = 0.f;
#pragma unroll
    for (int j = 0; j < 4; ++j) { v[j] = bf4_f32(((const u32x2*)xrow)[lane + 64 * j]); s += (v[j][0] * v[j][0] + v[j][1] * v[j][1]) + (v[j][2] * v[j][2] + v[j][3] * v[j][3]); }
    const float rstd = rsqrtf(wave_sum(s) * (1.f / DM) + EPSV);
#pragma unroll
    for (int j = 0; j < 4; ++j) {
        const f32x4 gg = ((const f32x4*)g)[lane + 64 * j], shh = ((const f32x4*)sh)[lane + 64 * j], scc = ((const f32x4*)sc)[lane + 64 * j];
        const f32x4 y = v[j] * rstd * gg * (1.f + scc) + shh;
        ((unsigned*)o8)[lane + 64 * j] = pk4_fp8(y[0], y[1], y[2], y[3]);
    }
    if (lane == 0) *rstd_out = rstd;
}

DI void phase_norm(const Ctx& c, int l, int nrows, bool from_inputs, int which) {
    const Params& p = *c.p;
    const float* modv = (const float*)(p.ws + WS_MOD);
    const float* g = p.in[which ? I_GFFN : I_GMIX] + l * 1024;
    bf16_t* hbuf = (bf16_t*)(p.ws + WS_HBUF);
    const float* xbuf = (const float*)(p.ws + WS_XBUF);
    for (int t = c.bid * NWAVES + c.wid; t < nrows; t += c.nblk * NWAVES) {
        const float* xrow = from_inputs ? (t < TL ? p.in[I_X] + (size_t)t * DM : p.in[I_CTX] + (size_t)(t - TL) * DM) : (const float*)((const bf16_t*)xbuf + (size_t)t * DM);
        const int b = t < TL ? (t >> 12) : 8;
        const float* mv = modv + (size_t)(l * 9 + b) * 6144 + (which ? 3072 : 0);
        if (from_inputs) norm_mod_row<false>(xrow, g, mv, mv + 1024, (bf16_t*)nullptr,        (unsigned char*)(p.ws + (which ? WS_H8 : WS_HIN8)) + (size_t)t * DM, c.lane);
        else norm_mod_row<true>(xrow, g, mv, mv + 1024, hbuf + (size_t)t * DM, (unsigned char*)(p.ws + (which ? WS_H8 : WS_HIN8)) + (size_t)t * DM, c.lane);
    }
}

namespace g8 {
constexpr int BM = 256, BK = 64, HALF = 128, HTB = HALF * BK * 2;
DI int lds_byte(int r, int c) { const int st = (r >> 4) * 2 + (c >> 5), rr = r & 15, cc = c & 31, ob = rr * 64 + cc * 2; return st * 1024 + (ob ^ (((ob >> 9) & 1) << 5)); }
DI void stage_rc(int b, int& R, int& C) { const int st = b / 1024, sb = b % 1024, swz = sb ^ (((sb >> 9) & 1) << 5); R = (st >> 1) * 16 + swz / 64; C = (st & 1) * 32 + (swz % 64) / 2; }
DI int perm32(int rho) { const int n = rho >> 4, i = rho & 15; return 8 * (i >> 2) + 4 * n + (i & 3); }
struct Unit { int pm, pn, e, ti, ne, rbase, ix; };

typedef __attribute__((ext_vector_type(8))) int v8i_t;
typedef __attribute__((ext_vector_type(4))) int v4i_t;
template <class Epi, class Sched>
DI void gemm_phase(LAS unsigned char* lds, const int tid, const int RB, const Sched& S, const Epi& E) {
    constexpr bool F8 = Epi::F8;
    const int wid = __builtin_amdgcn_readfirstlane(tid >> 6), lane = tid & 63, wr = wid >> 2, wc = wid & 3, fr = lane & 15, fq = lane >> 4;
    const int nt = RB / 128;
    int Rr[2], Cc[2]; unsigned voffB[2], voffA[2];
#pragma unroll
    for (int i = 0; i < 2; ++i) { int R, C; stage_rc(tid * 16 + i * 8192, R, C); Rr[i] = R; Cc[i] = C * 2; const int Rb = Epi::PERM ? ((R & ~31) + perm32(R & 31)) : R; voffB[i] = (unsigned)(Rb * RB + C * 2); voffA[i] = (unsigned)(R * RB + C * 2); }
    constexpr bool GA = Sched::GATHER;
    int unit_scale = 0x7F7F7F7F; asm volatile("" : "+v"(unit_scale));
    const size_t kstep = (size_t)(BK * 2);
    const size_t hstep = (size_t)HALF * RB;
    const unsigned ldsw = (unsigned)wid * 1024u;
    const int aoff = F8 ? lds_byte(wr * 64 + fr, (fq >> 1) * 32 + (fq & 1) * 16) : lds_byte(wr * 64 + fr, fq * 8);
    const int boff = F8 ? lds_byte(wc * 32 + fr, (fq >> 1) * 32 + (fq & 1) * 16) : lds_byte(wc * 32 + fr, fq * 8);
#define G8_SA(b, h) (((b) * 2 + (h)) * HTB)
#define G8_SB(b, h) ((4 + (b) * 2 + (h)) * HTB)
#define G8_STAGE_B(bufoff, gbase) do { _Pragma("unroll") for (int _i = 0; _i < 2; ++_i) \
        __builtin_amdgcn_global_load_lds((const unsigned*)((const char*)(gbase) + voffB[_i]), (LAS unsigned*)(lds + (bufoff) + ldsw + _i * 8192), 16, 0, 0); } while (0)
#define G8_STAGE_A(bufoff, uptr, koff, VO, h) do { _Pragma("unroll") for (int _i = 0; _i < 2; ++_i) { \
        const char* _s = GA ? (Ab + (koff) + VO[h][_i]) : ((uptr) + (koff) + ((h) ? hstep : (size_t)0) + voffA[_i]); \
        __builtin_amdgcn_global_load_lds((const unsigned*)_s, (LAS unsigned*)(lds + (bufoff) + ldsw + _i * 8192), 16, 0, 0); } } while (0)
#define G8_LDA(dst, b, h) do { _Pragma("unroll") for (int m = 0; m < 4; ++m) { \
        if constexpr (F8) { dst##8[m].lo = *(const LAS v4i_t*)(lds + G8_SA(b, h) + aoff + m * 2048); dst##8[m].hi = *(const LAS v4i_t*)(lds + G8_SA(b, h) + aoff + m * 2048 + 16); } \
        else { _Pragma("unroll") for (int k = 0; k < 2; ++k) dst[m][k] = *(const LAS bf16x8*)(lds + G8_SA(b, h) + aoff + m * 2048 + k * 1024); } } } while (0)
#define G8_LDB(dst, b, h) do { _Pragma("unroll") for (int n = 0; n < 2; ++n) { \
        if constexpr (F8) { dst##8[n].lo = *(const LAS v4i_t*)(lds + G8_SB(b, h) + boff + n * 2048); dst##8[n].hi = *(const LAS v4i_t*)(lds + G8_SB(b, h) + boff + n * 2048 + 16); } \
        else { _Pragma("unroll") for (int k = 0; k < 2; ++k) dst[n][k] = *(const LAS bf16x8*)(lds + G8_SB(b, h) + boff + n * 2048 + k * 1024); } } } while (0)
#define G8_MMA(ai, bj, At, Bt) do { __builtin_amdgcn_s_setprio(1); _Pragma("unroll") for (int m = 0; m < 4; ++m) _Pragma("unroll") for (int n = 0; n < 2; ++n) { \
        if constexpr (F8) asm volatile("v_mfma_scale_f32_16x16x128_f8f6f4 %0, %1, %2, %0, %3, %3 op_sel_hi:[0,0,0]" : "+v"(acc[ai][bj][m][n]) : "v"(Bt##8[n]), "v"(At##8[m]), "v"(unit_scale)); \
        else { _Pragma("unroll") for (int k = 0; k < 2; ++k) acc[ai][bj][m][n] = __builtin_amdgcn_mfma_f32_16x16x32_bf16(Bt[n][k], At[m][k], acc[ai][bj][m][n], 0, 0, 0); } } \
        __builtin_amdgcn_s_setprio(0); } while (0)
#define G8_WAIT_V(n) asm volatile("s_waitcnt vmcnt(" #n ")" ::: "memory")
#define G8_WAIT_L(n) asm volatile("s_waitcnt lgkmcnt(" #n ")" ::: "memory")
#define G8_BAR __builtin_amdgcn_s_barrier()
#define G8_SCHED __builtin_amdgcn_sched_barrier(0)
    Unit cur, nxt; int ui = 0;
    if (!S.next(0, cur)) return;
    f32x4 acc[2][2][4][2];
#pragma unroll
    for (int a = 0; a < 2; ++a)
#pragma unroll
        for (int b = 0; b < 2; ++b)
#pragma unroll
            for (int m = 0; m < 4; ++m)
#pragma unroll
                for (int n = 0; n < 2; ++n) acc[a][b][m][n] = (f32x4){0.f, 0.f, 0.f, 0.f};
    if constexpr (F8) asm volatile("s_nop 3" ::: "memory");
    bf16x8 At[F8 ? 1 : 4][2], B0[F8 ? 1 : 2][2], B1[F8 ? 1 : 2][2];
    v8i_t At8[F8 ? 4 : 1], B08[F8 ? 2 : 1], B18[F8 ? 2 : 1];
    unsigned vAc[2][2], vAn[2][2];
#pragma unroll
    for (int h = 0; h < 2; ++h)
#pragma unroll
        for (int i = 0; i < 2; ++i) vAc[h][i] = GA ? (S.a_off(cur, h * 128 + Rr[i]) + (unsigned)Cc[i]) : 0u;
    const char* Ab = S.a_base();
    const char* cA = GA ? Ab : S.a_ptr(cur);
    const char* cB = S.b_base(cur);
    G8_STAGE_B(G8_SB(0, 0), cB); G8_STAGE_A(G8_SA(0, 0), cA, 0, vAc, 0); G8_STAGE_B(G8_SB(0, 1), cB + hstep); G8_STAGE_A(G8_SA(0, 1), cA, 0, vAc, 1);
    if (wr == 1) G8_BAR;
    G8_WAIT_V(4); G8_BAR;
    G8_STAGE_B(G8_SB(1, 0), cB + kstep); G8_STAGE_A(G8_SA(1, 0), cA, kstep, vAc, 0); G8_STAGE_B(G8_SB(1, 1), cB + hstep + kstep);
    G8_WAIT_V(6); G8_BAR;
    for (;;) {
        const bool has_next = S.next(ui + 1, nxt);
        const char* nB = has_next ? S.b_base(nxt) : cB;
        const char* nA = GA ? Ab : (has_next ? S.a_ptr(nxt) : cA);
#pragma unroll
        for (int h = 0; h < 2; ++h)
#pragma unroll
            for (int i = 0; i < 2; ++i) vAn[h][i] = GA ? (has_next ? (S.a_off(nxt, h * 128 + Rr[i]) + (unsigned)Cc[i]) : vAc[h][i]) : 0u;
#pragma unroll 1
        for (int t = 0; t < nt; t += 2) {
            const bool last = (t == nt - 2);
            const size_t ka1 = (size_t)(t + 1) * kstep;
            const size_t ka2 = last ? (size_t)0 : (size_t)(t + 2) * kstep;
            const size_t ka3 = ka2 + kstep;
            const char* b2 = last ? nB : cB + (size_t)(t + 2) * kstep;
            const char* b3 = b2 + kstep;
            unsigned v2[2][2];
#pragma unroll
            for (int h = 0; h < 2; ++h)
#pragma unroll
                for (int i = 0; i < 2; ++i) v2[h][i] = GA ? (last ? vAn[h][i] : vAc[h][i]) : 0u;
            const char* a2p = last ? nA : cA;
            G8_LDB(B0, 0, 0); G8_SCHED; G8_LDA(At, 0, 0); G8_STAGE_A(G8_SA(1, 1), cA, ka1, vAc, 1);
            G8_WAIT_L(8); G8_BAR; G8_WAIT_L(0); G8_MMA(0, 0, At, B0); G8_BAR; G8_SCHED;
            G8_LDB(B1, 0, 1); G8_STAGE_B(G8_SB(0, 0), b2);
            G8_BAR; G8_WAIT_L(0); G8_MMA(0, 1, At, B1); G8_BAR;
            G8_LDA(At, 0, 1); G8_STAGE_A(G8_SA(0, 0), a2p, ka2, v2, 0);
            G8_BAR; G8_WAIT_L(0); G8_MMA(1, 0, At, B0); G8_BAR; G8_SCHED;
            G8_STAGE_B(G8_SB(0, 1), b2 + hstep);
            G8_WAIT_V(6); G8_BAR; G8_MMA(1, 1, At, B1); G8_BAR;
            G8_LDB(B0, 1, 0); G8_SCHED; G8_LDA(At, 1, 0); G8_STAGE_A(G8_SA(0, 1), a2p, ka2, v2, 1);
            G8_WAIT_L(8); G8_BAR; G8_WAIT_L(0); G8_MMA(0, 0, At, B0); G8_BAR; G8_SCHED;
            G8_LDB(B1, 1, 1); G8_STAGE_B(G8_SB(1, 0), b3);
            G8_BAR; G8_WAIT_L(0); G8_MMA(0, 1, At, B1); G8_BAR;
            G8_LDA(At, 1, 1); G8_STAGE_A(G8_SA(1, 0), a2p, ka3, v2, 0);
            G8_BAR; G8_WAIT_L(0); G8_MMA(1, 0, At, B0); G8_BAR; G8_SCHED;
            G8_STAGE_B(G8_SB(1, 1), b3 + hstep);
            G8_WAIT_V(6); G8_BAR; G8_MMA(1, 1, At, B1); G8_BAR;
        }
        if constexpr (F8) asm volatile("s_nop 15\n\ts_nop 15" ::: "memory");
        E(acc, cur, wr, wc, fr, fq);
        if (!has_next) break;
#pragma unroll
        for (int a = 0; a < 2; ++a)
#pragma unroll
            for (int b = 0; b < 2; ++b)
#pragma unroll
                for (int m = 0; m < 4; ++m)
#pragma unroll
                    for (int n = 0; n < 2; ++n) acc[a][b][m][n] = (f32x4){0.f, 0.f, 0.f, 0.f};
        if constexpr (F8) asm volatile("s_nop 3" ::: "memory");
        cur = nxt; cB = nB; cA = nA; ++ui;
#pragma unroll
        for (int h = 0; h < 2; ++h)
#pragma unroll
            for (int i = 0; i < 2; ++i) vAc[h][i] = vAn[h][i];
    }
    G8_WAIT_V(0);
    if (wr == 0) G8_BAR;
    G8_BAR;
#undef G8_SA
#undef G8_SB
#undef G8_STAGE_A
#undef G8_STAGE_B
#undef G8_LDA
#undef G8_LDB
#undef G8_MMA
#undef G8_WAIT_V
#undef G8_WAIT_L
#undef G8_BAR
#undef G8_SCHED
}

struct DenseSched {
    static constexpr bool GATHER = false;
    int nM, nN, nwg, G, c, RB; const char* A; const char* Bt;
    DI void init(const void* A_, const void* Bt_, int M, int N, int RB_, int G_, int c_) { A = (const char*)A_; Bt = (const char*)Bt_; nM = M / BM; nN = N / BM; nwg = nM * nN; G = G_; c = c_; RB = RB_; }
    DI bool next(int i, Unit& u) const {
        const int L = i * G + c; if (L >= nwg) return false;
        int wgid = L; { const int q = nwg / 8, r = nwg % 8, xcd = wgid % 8, off = wgid / 8; wgid = (xcd < r ? xcd * (q + 1) : r * (q + 1) + (xcd - r) * q) + off; }
        const int nig = 8 * nN, gid = wgid / nig, fm = gid * 8, gsz = (nM - fm) < 8 ? (nM - fm) : 8;
        u.pm = fm + ((wgid % nig) % gsz); u.pn = (wgid % nig) / gsz; u.e = 0; u.ti = 0; u.ne = 0; u.rbase = 0; u.ix = 0; return true;
    }
    DI const char* a_base() const { return A; }
    DI unsigned a_off(const Unit&, int) const { return 0u; }
    DI const char* a_ptr(const Unit& u) const { return A + (size_t)u.pm * BM * RB; }
    DI const char* b_base(const Unit& u) const { return Bt + (size_t)u.pn * BM * RB; }
};
}
struct EpiInproj {
    static constexpr bool F8 = true;
    static constexpr bool PERM = true;
    const LAS float2* rope;
    unsigned char* q8; unsigned char* k8; unsigned char* vt8;
    LAS unsigned char* stg; int tid;
    static DI bool isv_cb(int cb) { const int kv = cb - 16; return (cb >= 16) && ((kv == 2) || (kv == 3) || (kv >= 8 && kv < 12) || (kv >= 20)); }
    DI void operator()(const f32x4 (&acc)[2][2][4][2], const g8::Unit& u, int wr, int wc, int fr, int fq) const {
        const bool lat = (u.pm * 256 < TL);
#pragma unroll
        for (int bj = 0; bj < 2; ++bj) {
            const int col0 = u.pn * 256 + bj * 128 + wc * 32 + 8 * fq;
            const int cb = col0 >> 6, kv = cb - 16;
            if (!isv_cb(cb)) continue;
            const float scale = 1.0f / W_SCALE;
            const int vrow0 = (kv < 4 ? (kv - 2) * 64 : (kv < 12 ? 128 + (kv - 8) * 64 : 384 + (kv - 20) * 64)) + (col0 & 63);
            const int pos = 32 * ((fr >> 2) & 1) + 4 * (((fr >> 3) << 2) | (fr & 3));
#pragma unroll
            for (int ai = 0; ai < 2; ++ai) {
                const int t0 = u.pm * 256 + ai * 128 + wr * 64;
                const int b = t0 < TL ? (t0 >> 12) : ((t0 - TL) >> 8);
                const int tile = t0 < TL ? ((t0 & 4095) >> 6) : (64 + (((t0 - TL) & 255) >> 6));
                unsigned char* base = vt8 + (size_t)(b * 68 + tile) * VT_TILE + (size_t)vrow0 * 64 + pos;
#pragma unroll
                for (int n = 0; n < 2; ++n)
#pragma unroll
                    for (int j = 0; j < 4; ++j)
                        *(unsigned*)(base + (4 * n + j) * 64) = pk4_fp8(acc[ai][bj][0][n][j] * scale, acc[ai][bj][1][n][j] * scale, acc[ai][bj][2][n][j] * scale, acc[ai][bj][3][n][j] * scale);
            }
        }
        if (!((u.pn < 6) || (u.pn == 7) || (u.pn == 8))) return;
        constexpr int RS = 272;
        if (wr == 0) __builtin_amdgcn_s_barrier();
#pragma unroll
        for (int ai = 0; ai < 2; ++ai)
#pragma unroll
            for (int mh = 0; mh < 2; ++mh) {
#pragma unroll
                for (int bj = 0; bj < 2; ++bj) {
                    const int col0 = u.pn * 256 + bj * 128 + wc * 32 + 8 * fq;
                    const int cb = col0 >> 6, i0 = (col0 & 63) >> 1;
                    if (isv_cb(cb)) continue;
                    const bool isq = cb < 16;
                    const bool roped = ((cb < 4) || (cb >= 8 && cb < 16) || (cb == 16) || (cb == 17) || (cb >= 28 && cb < 36)) && lat;
                    const float scale = (isq ? QSCALE : 1.0f) * (1.0f / W_SCALE);
#pragma unroll
                    for (int mm = 0; mm < 2; ++mm) {
                        const int m = mh * 2 + mm;
                        const int t = u.pm * 256 + ai * 128 + wr * 64 + m * 16 + fr;
                        f32x4 v0 = acc[ai][bj][m][0], v1 = acc[ai][bj][m][1];
                        if (roped) {
                            const int s = t & 4095;
                            const int pos = (i0 < 16) ? (s >> 6) : (s & 63);
                            const f32x4 ca = *(const LAS f32x4*)(rope + pos * 16 + (i0 & 15)), cb2 = *(const LAS f32x4*)(rope + pos * 16 + (i0 & 15) + 2);
                            f32x4 o0, o1;
                            o0[0] = v0[0] * ca[0] - v0[1] * ca[1]; o0[1] = v0[1] * ca[0] + v0[0] * ca[1];
                            o0[2] = v0[2] * ca[2] - v0[3] * ca[3]; o0[3] = v0[3] * ca[2] + v0[2] * ca[3];
                            o1[0] = v1[0] * cb2[0] - v1[1] * cb2[1]; o1[1] = v1[1] * cb2[0] + v1[0] * cb2[1];
                            o1[2] = v1[2] * cb2[2] - v1[3] * cb2[3]; o1[3] = v1[3] * cb2[2] + v1[2] * cb2[3];
                            v0 = o0; v1 = o1;
                        }
                        v0 *= scale; v1 *= scale;
                        u32x2 w; w.x = pk4_fp8(v0[0], v0[1], v0[2], v0[3]); w.y = pk4_fp8(v1[0], v1[1], v1[2], v1[3]);
                        *(LAS u32x2*)(stg + (wr * 32 + mm * 16 + fr) * RS + bj * 128 + wc * 32 + 8 * fq) = w;
                    }
                }
                asm volatile("s_waitcnt lgkmcnt(0)" ::: "memory"); __builtin_amdgcn_s_barrier(); asm volatile("" ::: "memory");
#pragma unroll
                for (int k = 0; k < 2; ++k) {
                    const int idx = tid + k * 512, rl = idx >> 4, pc = idx & 15;
                    const int cb = u.pn * 4 + (pc >> 2);
                    if (!isv_cb(cb)) {
                        const u32x4 v = *(const LAS u32x4*)(stg + rl * RS + pc * 16);
                        const int t = u.pm * 256 + ai * 128 + (rl >> 5) * 64 + mh * 32 + (rl & 31);
                        const int kv = cb - 16, ki = kv < 2 ? kv : (kv < 8 ? kv - 2 : kv - 6);
                        unsigned char* dst = (cb < 16) ? q8 + (size_t)t * 1024 + cb * 64 + (pc & 3) * 16 : k8 + (size_t)t * 1024 + ki * 64 + (pc & 3) * 16;
                        *(u32x4*)dst = v;
                    }
                }
                asm volatile("s_waitcnt lgkmcnt(0)" ::: "memory"); __builtin_amdgcn_s_barrier(); asm volatile("" ::: "memory");
            }
        if (wr == 1) __builtin_amdgcn_s_barrier();
    }
};
DI void phase_inproj(const Ctx& c, int l) {
    const Params& p = *c.p;
    g8::DenseSched S; S.init(p.ws + WS_HIN8, (const unsigned char*)(p.ws + WS_WIN) + (size_t)l * 2816 * 1024, TT, INC, DM, c.nblk, c.bid);
    {
        const float* rg = (const float*)(p.ws + WS_ROPE);
        LAS float* rl = (LAS float*)(c.smem + LDS_MAIN + 256);
        for (int i = c.tid; i < 2048; i += NTHREADS) rl[i] = rg[i];
        __syncthreads();
    }
    EpiInproj E; E.rope = (const LAS float2*)(c.smem + LDS_MAIN + 256); E.stg = (LAS unsigned char*)c.smem + LDS_MAIN + 256 + 8192; E.tid = c.tid;
    E.q8 = (unsigned char*)(p.ws + WS_Q8); E.k8 = (unsigned char*)(p.ws + WS_K8); E.vt8 = (unsigned char*)(p.ws + WS_VT8);
    g8::gemm_phase((LAS unsigned char*)c.smem, c.tid, DM, S, E);
}

struct EpiOutproj {
    static constexpr bool F8 = true;
    static constexpr bool PERM = false;
    float* xbuf; const float* modv; const float* x_in; const float* ctx_in; int l;
    DI void operator()(const f32x4 (&acc)[2][2][4][2], const g8::Unit& u, int wr, int wc, int fr, int fq) const {
        const int b = (u.pm * 256) < TL ? ((u.pm * 256) >> 12) : 8;
        const int col0 = u.pn * 256 + wc * 32 + 4 * fq;
        const float* gate = modv + (size_t)(l * 9 + b) * 6144 + 2048 + col0;
        f32x4 g[2][2];
#pragma unroll
        for (int bj = 0; bj < 2; ++bj)
#pragma unroll
            for (int n = 0; n < 2; ++n) g[bj][n] = *(const f32x4*)(gate + bj * 128 + n * 16) * (1.0f / (MIX_SCALE * W_SCALE));
#pragma unroll
        for (int ai = 0; ai < 2; ++ai)
#pragma unroll
            for (int m = 0; m < 4; ++m) {
                const int t = u.pm * 256 + ai * 128 + wr * 64 + m * 16 + fr;
                const float* xin = (t < TL ? x_in + (size_t)t * DM : ctx_in + (size_t)(t - TL) * DM) + col0;
                bf16_t* xo = (bf16_t*)xbuf + (size_t)t * DM + col0;
#pragma unroll
                for (int bj = 0; bj < 2; ++bj)
#pragma unroll
                    for (int n = 0; n < 2; ++n) {
                        const f32x4 x = (l == 0) ? *(const f32x4*)(xin + bj * 128 + n * 16) : bf4_f32(*(const u32x2*)(xo + bj * 128 + n * 16));
                        *(u32x2*)(xo + bj * 128 + n * 16) = f32_bf4(x + g[bj][n] * acc[ai][bj][m][n]);
                    }
            }
    }
};
DI void phase_outproj(const Ctx& c, int l, int nrows) {
    const Params& p = *c.p;
    g8::DenseSched S; S.init(p.ws + WS_MIX, (const unsigned char*)(p.ws + WS_WOUT) + (size_t)l * 1048576, nrows, DM, DM, c.nblk, c.bid);
    EpiOutproj E; E.xbuf = (float*)(p.ws + WS_XBUF); E.modv = (const float*)(p.ws + WS_MOD); E.x_in = p.in[I_X]; E.ctx_in = p.in[I_CTX]; E.l = l;
    g8::gemm_phase((LAS unsigned char*)c.smem, c.tid, DM, S, E);
}

struct EpiRouter {
    static constexpr bool F8 = false;
    static constexpr bool PERM = false;
    float* logit;
    DI void operator()(const f32x4 (&acc)[2][2][4][2], const g8::Unit& u, int wr, int wc, int fr, int fq) const {
#pragma unroll
        for (int ai = 0; ai < 2; ++ai)
#pragma unroll
            for (int m = 0; m < 4; ++m) {
                const int t = u.pm * 256 + ai * 128 + wr * 64 + m * 16 + fr;
#pragma unroll
                for (int bj = 0; bj < 2; ++bj)
#pragma unroll
                    for (int n = 0; n < 2; ++n) *(f32x4*)(logit + (size_t)t * NE + bj * 128 + wc * 32 + n * 16 + 4 * fq) = acc[ai][bj][m][n];
            }
    }
};
DI void phase_router(const Ctx& c, int l, int nrows) {
    const Params& p = *c.p;
    g8::DenseSched S; S.init(p.ws + WS_HBUF, (const bf16_t*)(p.ws + WS_WR) + (size_t)l * 262144, nrows, NE, DM * 2, c.nblk, c.bid);
    EpiRouter E; E.logit = (float*)(p.ws + WS_LOGIT);
    g8::gemm_phase((LAS unsigned char*)c.smem, c.tid, DM * 2, S, E);
}

struct RouterSched : g8::DenseSched {
    DI const char* b_base(const g8::Unit& u) const { const int b = (u.pm * 256) < TL ? ((u.pm * 256) >> 12) : 8; return Bt + (size_t)b * 524288 + (size_t)u.pn * 256 * RB; }
};
DI void phase_norm_router(const Ctx& c, int l, int nrows) {
    const Params& p = *c.p;
    {
        RouterSched S; S.init(p.ws + WS_XBUF, (const bf16_t*)(p.ws + WS_WRP) + (size_t)l * 9 * 262144, nrows, NE, DM * 2, c.nblk, c.bid);
        EpiRouter E; E.logit = (float*)(p.ws + WS_LOGIT);
        g8::gemm_phase((LAS unsigned char*)c.smem, c.tid, DM * 2, S, E);
    }
    int* ctr = (int*)(p.ws + WS_ROWCTR) + l * 64;
    LAS int* slot = (LAS int*)(c.smem + LDS_MAIN + 64);
    const float* modv = (const float*)(p.ws + WS_MOD);
    const float* g = p.in[I_GFFN] + l * 1024;
    const bf16_t* xbuf = (const bf16_t*)(p.ws + WS_XBUF);
    unsigned char* h8 = (unsigned char*)(p.ws + WS_H8);
    float* rstd = (float*)(p.ws + WS_RSTD);
    for (;;) {
        if (c.tid == 0) slot[0] = atomicAdd(ctr, 64);
        __syncthreads();
        const int base = slot[0];
        __syncthreads();
        if (base >= nrows) break;
#pragma unroll 1
        for (int i = 0; i < 8; ++i) {
            const int t = base + c.wid * 8 + i;
            if (t < nrows) {
                const int b = t < TL ? (t >> 12) : 8;
                const float* mv = modv + (size_t)(l * 9 + b) * 6144 + 3072;
                norm_ffn_row(xbuf + (size_t)t * DM, g, mv, mv + 1024, h8 + (size_t)t * DM, rstd + t, c.lane);
            }
        }
    }
}

DI void phase_route(const Ctx& c, int l, int nrows) {
    const Params& p = *c.p;
    const float* logit = (const float*)(p.ws + WS_LOGIT);
    const float* rb = p.in[I_RB] + l * NE;
    int* cnt = (int*)(p.ws + WS_CNT) + l * CNT_LAYER;
    int* list = (int*)(p.ws + WS_LIST);
    float* slotw = (float*)(p.ws + WS_SLOTW);
    int* einfo = (int*)(p.ws + WS_EINFO);
    LAS int* lcnt = (LAS int*)c.smem;
    LAS int* rec = (LAS int*)(c.smem + 1024);
    LAS float* recw = (LAS float*)(c.smem + 1024 + 8 * 24 * 8 * 4);
    constexpr int RMAX = 24;
    const int lane = c.lane;
    if (c.tid < 256) lcnt[c.tid] = 0;
    __syncthreads();
    const f32x4 bias = ((const f32x4*)rb)[lane];
    const float NINF = -__builtin_inff();
    int it = 0;
    const float* rstd = (const float*)(p.ws + WS_RSTD);
    const float* cbl = (const float*)(p.ws + WS_CB) + l * 9 * 256;
    for (int t = c.bid * NWAVES + c.wid; t < nrows; t += c.nblk * NWAVES, ++it) {
        const int bb = t < TL ? (t >> 12) : 8;
        const f32x4 lg = ((const f32x4*)(logit + (size_t)t * NE))[lane] * rstd[t] + ((const f32x4*)(cbl + bb * 256))[lane];
        const float s0 = 1.f / (1.f + __expf(-lg.x)), s1 = 1.f / (1.f + __expf(-lg.y)), s2 = 1.f / (1.f + __expf(-lg.z)), s3 = 1.f / (1.f + __expf(-lg.w));
        float m0 = s0 + bias.x, m1 = s1 + bias.y, m2 = s2 + bias.z, m3 = s3 + bias.w;
        float a1 = fmaxf(m0, m1), a2 = fminf(m0, m1);
        { const float b1 = fmaxf(m2, m3), b2 = fminf(m2, m3); const float n1 = fmaxf(a1, b1), n2 = fmaxf(fminf(a1, b1), fmaxf(a2, b2)); a1 = n1; a2 = n2; }
        { const float b1 = DPPF(a1, DPP_XOR1), b2 = DPPF(a2, DPP_XOR1); const float n1 = fmaxf(a1, b1), n2 = fmaxf(fminf(a1, b1), fmaxf(a2, b2)); a1 = n1; a2 = n2; }
        { const float b1 = DPPF(a1, DPP_XOR2), b2 = DPPF(a2, DPP_XOR2); const float n1 = fmaxf(a1, b1), n2 = fmaxf(fminf(a1, b1), fmaxf(a2, b2)); a1 = n1; a2 = n2; }
        { const float b1 = DPPF(a1, DPP_HMIR), b2 = DPPF(a2, DPP_HMIR); const float n1 = fmaxf(a1, b1), n2 = fmaxf(fminf(a1, b1), fmaxf(a2, b2)); a1 = n1; a2 = n2; }
        const float gs = a1 + a2;
        const int g = lane >> 3;
        int rank = 0;
#pragma unroll
        for (int j = 0; j < 8; ++j) { const float gj = rdlane_f(gs, j * 8); rank += ((gj > gs) || (gj == gs && j < g)) ? 1 : 0; }
        if (rank >= 4) { m0 = NINF; m1 = NINF; m2 = NINF; m3 = NINF; }
        float wsum = 0.f, my_w = 0.f; int my_e = 0;
#pragma unroll
        for (int k = 0; k < 8; ++k) {
            float bv = m0, bs = s0; int bi = 0;
            if (m1 > bv) { bv = m1; bs = s1; bi = 1; }
            if (m2 > bv) { bv = m2; bs = s2; bi = 2; }
            if (m3 > bv) { bv = m3; bs = s3; bi = 3; }
            float v = bv;
            v = fmaxf(v, DPPF(v, DPP_XOR1)); v = fmaxf(v, DPPF(v, DPP_XOR2)); v = fmaxf(v, DPPF(v, DPP_HMIR)); v = fmaxf(v, DPPF(v, DPP_MIR));
            const float wmx = fmaxf(fmaxf(rdlane_f(v, 0), rdlane_f(v, 16)), fmaxf(rdlane_f(v, 32), rdlane_f(v, 48)));
            const unsigned long long bal = __ballot(bv == wmx);
            const int win = __ffsll((long long)bal) - 1;
            const int sub = __builtin_amdgcn_readlane(bi, win);
            const float sw = rdlane_f(bs, win);
            if (lane == win) { if (sub == 0) m0 = NINF; else if (sub == 1) m1 = NINF; else if (sub == 2) m2 = NINF; else m3 = NINF; }
            wsum += sw;
            if (lane == k) { my_e = win * 4 + sub; my_w = sw; }
        }
        if (lane < 8 && it < RMAX) {
            const int lp = __hip_atomic_fetch_add(&lcnt[my_e], 1, __ATOMIC_RELAXED, __HIP_MEMORY_SCOPE_WORKGROUP);
            rec[(c.wid * RMAX + it) * 8 + lane] = (my_e << 16) | lp;
            recw[(c.wid * RMAX + it) * 8 + lane] = my_w / wsum * 2.5f;
        }
    }
    __syncthreads();
    if (c.tid < 256) { const int n = lcnt[c.tid]; lcnt[c.tid] = (n > 0) ? atomicAdd(&cnt[c.tid * CNT_STRIDE], n) : 0; }
    __syncthreads();
    it = 0;
    for (int t = c.bid * NWAVES + c.wid; t < nrows; t += c.nblk * NWAVES, ++it) {
        if (lane < 8 && it < RMAX) {
            const int r = rec[(c.wid * RMAX + it) * 8 + lane];
            const int e = r >> 16, pos = lcnt[e] + (r & 0xffff);
            list[(size_t)e * TT + pos] = t;
            slotw[(size_t)t * 8 + lane] = recw[(c.wid * RMAX + it) * 8 + lane];
            einfo[(size_t)t * 8 + lane] = (e << 16) | pos;
        }
    }
}

DI void moe_setup(const Ctx& c, int l, int nrows) {
    const int* cnt = (const int*)(c.p->ws + WS_CNT) + l * CNT_LAYER;
    LAS int* tstart = (LAS int*)(c.smem + LDS_MAIN + 1024);
    LAS int* roff = (LAS int*)(c.smem + LDS_MAIN + 2064);
    LAS int* cntl = (LAS int*)(c.smem + LDS_MAIN + 3104);
    LAS int* wtot = (LAS int*)(c.smem + LDS_MAIN + 4160);
    const int n = (c.tid < 256) ? cnt[c.tid * CNT_STRIDE] : 0;
    const int nt = (n + 255) >> 8;
    int vt = nt, vr = n;
    vt += DPPI(vt, DPP_SHR(1)); vr += DPPI(vr, DPP_SHR(1)); vt += DPPI(vt, DPP_SHR(2)); vr += DPPI(vr, DPP_SHR(2));
    vt += DPPI(vt, DPP_SHR(4)); vr += DPPI(vr, DPP_SHR(4)); vt += DPPI(vt, DPP_SHR(8)); vr += DPPI(vr, DPP_SHR(8));
    { const int t0 = __builtin_amdgcn_readlane(vt, 15), t1 = __builtin_amdgcn_readlane(vt, 31), t2 = __builtin_amdgcn_readlane(vt, 47);
      const int r0 = __builtin_amdgcn_readlane(vr, 15), r1 = __builtin_amdgcn_readlane(vr, 31), r2 = __builtin_amdgcn_readlane(vr, 47);
      const int row = c.lane >> 4;
      vt += (row > 0 ? t0 : 0) + (row > 1 ? t1 : 0) + (row > 2 ? t2 : 0); vr += (row > 0 ? r0 : 0) + (row > 1 ? r1 : 0) + (row > 2 ? r2 : 0); }
    if (c.lane == 63 && c.wid < 4) { wtot[c.wid] = vt; wtot[4 + c.wid] = vr; }
    __syncthreads();
    if (c.tid < 256) {
        int pt = 0, pr = 0;
        for (int w = 0; w < c.wid; ++w) { pt += wtot[w]; pr += wtot[4 + w]; }
        tstart[c.tid] = pt + vt - nt; roff[c.tid] = pr + vr - n; cntl[c.tid] = n;
        if (c.tid == 255) { tstart[256] = pt + vt; roff[256] = pr + vr; tstart[257] = pt + vt + nrows / 256; roff[257] = pr + vr + nrows; cntl[256] = nrows; }
    }
    __syncthreads();
}

constexpr int MOE_MAXU = 32, MOE_MAXG = 12;
template <bool GATHER_>
struct MoeSched {
    static constexpr bool GATHER = GATHER_;
    const LAS int* utab; const LAS unsigned* toks; int nmy;
    const char* A; const char* W; size_t wstride; int RB;
    DI bool next(int i, g8::Unit& u) const {
        if (i >= nmy) return false;
        const LAS int* e = utab + i * 8;
        u.pn = __builtin_amdgcn_readfirstlane(e[0]); u.e = __builtin_amdgcn_readfirstlane(e[1]); u.ti = __builtin_amdgcn_readfirstlane(e[2]);
        u.ne = __builtin_amdgcn_readfirstlane(e[3]); u.rbase = __builtin_amdgcn_readfirstlane(e[4]); u.pm = __builtin_amdgcn_readfirstlane(e[5]); u.ix = i;
        return true;
    }
    DI const char* a_base() const { return A; }
    DI unsigned a_off(const g8::Unit& u, int row) const { return toks[u.ix * 256 + row]; }
    DI const char* a_ptr(const g8::Unit& u) const { return A + (size_t)u.rbase * RB; }
    DI const char* b_base(const g8::Unit& u) const { return W + (size_t)u.e * wstride + (size_t)u.pn * 256 * RB; }
};
DI int moe_units(const Ctx& c, int NB, bool gather, const int* list, int rowbytes) {
    const LAS int* tstart = (const LAS int*)(c.smem + LDS_MAIN + 1024);
    const LAS int* roff = (const LAS int*)(c.smem + LDS_MAIN + 2064);
    const LAS int* cntl = (const LAS int*)(c.smem + LDS_MAIN + 3104);
    LAS int* utab = (LAS int*)(c.smem + LDS_MAIN + 4224);
    LAS unsigned* toks = (LAS unsigned*)(c.smem + LDS_MAIN + 8192);
    const int nunits = tstart[257] * NB;
    int nmy = (nunits > c.bid) ? (nunits - c.bid + c.nblk - 1) / c.nblk : 0;
    { const int cap = gather ? MOE_MAXG : MOE_MAXU; nmy = nmy > cap ? cap : nmy; }
    if (c.tid < nmy) {
        const int L = c.tid * c.nblk + c.bid;
        int w = L; { const int q = nunits / 8, r = nunits % 8, xcd = w % 8, off = w / 8; w = (xcd < r ? xcd * (q + 1) : r * (q + 1) + (xcd - r) * q) + off; }
        const int tile = w / NB;
        int lo = 0, hi = 256;
        while (lo < hi) { const int mid = (lo + hi + 1) >> 1; if (tstart[mid] <= tile) lo = mid; else hi = mid - 1; }
        const int ti = tile - tstart[lo];
        LAS int* e = utab + c.tid * 8;
        e[0] = w - tile * NB; e[1] = lo; e[2] = ti; e[3] = cntl[lo]; e[4] = roff[lo] + ti * 256; e[5] = tile;
    }
    __syncthreads();
    if (gather) {
        for (int idx = c.tid; idx < nmy * 256; idx += NTHREADS) {
            const LAS int* e = utab + (idx >> 8) * 8;
            const int ex = e[1], ne = e[3];
            int ridx = e[2] * 256 + (idx & 255); ridx = ridx < ne ? ridx : ne - 1;
            const int tok = (ex < 256) ? list[(size_t)ex * TT + ridx] : ridx;
            toks[idx] = (unsigned)tok * (unsigned)rowbytes;
        }
        __syncthreads();
    }
    return nmy;
}

#ifdef E1_DIRECT
struct EpiE1 {
    static constexpr bool F8 = true;
    static constexpr bool PERM = true;
    unsigned char* act;
    LAS unsigned char* stg; int tid;
    DI void operator()(const f32x4 (&acc)[2][2][4][2], const g8::Unit& u, int wr, int wc, int fr, int fq) const {
        constexpr float IS = 1.0f / W_SCALE;
#pragma unroll
        for (int ai = 0; ai < 2; ++ai)
#pragma unroll
            for (int m = 0; m < 4; ++m) {
                const int row = ai * 128 + wr * 64 + m * 16 + fr;
                if (u.ti * 256 + row < u.ne) {
#pragma unroll
                    for (int bj = 0; bj < 2; ++bj) {
                        const int col0 = u.pn * 256 + bj * 128 + wc * 32 + 8 * fq;
                        const f32x4 v0 = acc[ai][bj][m][0] * IS, v1 = acc[ai][bj][m][1] * IS;
                        const float a0 = v0[0] * __builtin_amdgcn_rcpf(1.f + __expf(-v0[0])) * v0[1], a1 = v0[2] * __builtin_amdgcn_rcpf(1.f + __expf(-v0[2])) * v0[3];
                        const float a2 = v1[0] * __builtin_amdgcn_rcpf(1.f + __expf(-v1[0])) * v1[1], a3 = v1[2] * __builtin_amdgcn_rcpf(1.f + __expf(-v1[2])) * v1[3];
                        *(unsigned*)(act + (size_t)(u.rbase + row) * FF + (col0 >> 1)) = pk4_fp8(a0 * ACT_SCALE, a1 * ACT_SCALE, a2 * ACT_SCALE, a3 * ACT_SCALE);
                    }
                }
            }
    }
};
#else
struct EpiE1 {
    static constexpr bool F8 = true;
    static constexpr bool PERM = true;
    unsigned char* act;
    LAS unsigned char* stg; int tid;
    DI void operator()(const f32x4 (&acc)[2][2][4][2], const g8::Unit& u, int wr, int wc, int fr, int fq) const {
        constexpr float IS = 1.0f / W_SCALE;
        constexpr int RS = 144;
        if (wr == 0) __builtin_amdgcn_s_barrier();
#pragma unroll
        for (int ai = 0; ai < 2; ++ai)
#pragma unroll
            for (int mh = 0; mh < 2; ++mh) {
#pragma unroll
                for (int mm = 0; mm < 2; ++mm) {
                    const int m = mh * 2 + mm;
                    LAS unsigned char* d = stg + (wr * 32 + mm * 16 + fr) * RS + wc * 16 + 4 * fq;
#pragma unroll
                    for (int bj = 0; bj < 2; ++bj) {
                        const f32x4 v0 = acc[ai][bj][m][0] * IS, v1 = acc[ai][bj][m][1] * IS;
                        const float a0 = v0[0] * __builtin_amdgcn_rcpf(1.f + __expf(-v0[0])) * v0[1], a1 = v0[2] * __builtin_amdgcn_rcpf(1.f + __expf(-v0[2])) * v0[3];
                        const float a2 = v1[0] * __builtin_amdgcn_rcpf(1.f + __expf(-v1[0])) * v1[1], a3 = v1[2] * __builtin_amdgcn_rcpf(1.f + __expf(-v1[2])) * v1[3];
                        *(LAS unsigned*)(d + bj * 64) = pk4_fp8(a0 * ACT_SCALE, a1 * ACT_SCALE, a2 * ACT_SCALE, a3 * ACT_SCALE);
                    }
                }
                asm volatile("s_waitcnt lgkmcnt(0)" ::: "memory"); __builtin_amdgcn_s_barrier(); asm volatile("" ::: "memory");
                {
                    const int rl = tid >> 3, pc = tid & 7;
                    const u32x4 v = *(const LAS u32x4*)(stg + rl * RS + pc * 16);
                    const int row = ai * 128 + (rl >> 5) * 64 + mh * 32 + (rl & 31);
                    if (u.ti * 256 + row < u.ne) __builtin_nontemporal_store(v, (u32x4*)(act + (size_t)(u.rbase + row) * FF + u.pn * 128 + pc * 16));
                }
                asm volatile("s_waitcnt lgkmcnt(0)" ::: "memory"); __builtin_amdgcn_s_barrier(); asm volatile("" ::: "memory");
            }
        if (wr == 1) __builtin_amdgcn_s_barrier();
    }
};
#endif
DI void phase_e1(const Ctx& c, int l, int nrows) {
    const Params& p = *c.p;
    moe_setup(c, l, nrows);
    MoeSched<true> S;
    S.nmy = moe_units(c, 2, true, (const int*)(p.ws + WS_LIST), DM);
    S.utab = (const LAS int*)(c.smem + LDS_MAIN + 4224); S.toks = (const LAS unsigned*)(c.smem + LDS_MAIN + 8192);
    S.A = (const char*)(p.ws + WS_H8); S.W = (const char*)(p.ws + WS_WGU) + (size_t)l * 257 * 524288; S.wstride = 524288; S.RB = DM;
    EpiE1 E; E.act = (unsigned char*)(p.ws + WS_ACT); E.stg = (LAS unsigned char*)c.smem + LDS_MAIN + 8192 + MOE_MAXG * 1024; E.tid = c.tid;
    g8::gemm_phase((LAS unsigned char*)c.smem, c.tid, DM, S, E);
}

struct EpiE2 {
    static constexpr bool F8 = true;
    static constexpr bool PERM = true;
    unsigned char* ys;
    LAS unsigned char* stg; int tid;
    DI void operator()(const f32x4 (&acc)[2][2][4][2], const g8::Unit& u, int wr, int wc, int fr, int fq) const {
        constexpr float SC = 16.f / (ACT_SCALE * WD_SCALE);
        constexpr int RS = 272;
        if (wr == 0) __builtin_amdgcn_s_barrier();
#pragma unroll
        for (int ai = 0; ai < 2; ++ai)
#pragma unroll
            for (int mh = 0; mh < 2; ++mh) {
#pragma unroll
                for (int mm = 0; mm < 2; ++mm) {
                    const int m = mh * 2 + mm;
                    LAS unsigned char* d = stg + (wr * 32 + mm * 16 + fr) * RS + wc * 32 + 8 * fq;
#pragma unroll
                    for (int bj = 0; bj < 2; ++bj) {
                        const f32x4 v0 = acc[ai][bj][m][0] * SC, v1 = acc[ai][bj][m][1] * SC;
                        int w0 = 0, w1 = 0;
                        w0 = __builtin_amdgcn_cvt_pk_fp8_f32(v0[0], v0[1], w0, false); w0 = __builtin_amdgcn_cvt_pk_fp8_f32(v0[2], v0[3], w0, true);
                        w1 = __builtin_amdgcn_cvt_pk_fp8_f32(v1[0], v1[1], w1, false); w1 = __builtin_amdgcn_cvt_pk_fp8_f32(v1[2], v1[3], w1, true);
                        u32x2 o; o.x = (unsigned)w0; o.y = (unsigned)w1;
                        *(LAS u32x2*)(d + bj * 128) = o;
                    }
                }
                asm volatile("s_waitcnt lgkmcnt(0)" ::: "memory"); __builtin_amdgcn_s_barrier(); asm volatile("" ::: "memory");
#pragma unroll
                for (int k = 0; k < 2; ++k) {
                    const int idx = tid + k * 512, rl = idx >> 4, pc = idx & 15;
                    const u32x4 v = *(const LAS u32x4*)(stg + rl * RS + pc * 16);
                    const int row = ai * 128 + (rl >> 5) * 64 + mh * 32 + (rl & 31);
                    if (u.ti * 256 + row < u.ne) __builtin_nontemporal_store(v, (u32x4*)(ys + (size_t)(u.rbase + row) * DM + u.pn * 256 + pc * 16));
                }
                asm volatile("s_waitcnt lgkmcnt(0)" ::: "memory"); __builtin_amdgcn_s_barrier(); asm volatile("" ::: "memory");
            }
        if (wr == 1) __builtin_amdgcn_s_barrier();
    }
};
DI void phase_e2(const Ctx& c, int l, int nrows) {
    const Params& p = *c.p;
    moe_setup(c, l, nrows);
    MoeSched<false> S;
    S.nmy = moe_units(c, 4, false, nullptr, 0);
    S.utab = (const LAS int*)(c.smem + LDS_MAIN + 4224); S.toks = (const LAS unsigned*)(c.smem + LDS_MAIN + 8192);
    S.A = (const char*)(p.ws + WS_ACT); S.W = (const char*)(p.ws + WS_WD) + (size_t)l * 257 * 262144; S.wstride = 262144; S.RB = FF;
    EpiE2 E; E.ys = (unsigned char*)(p.ws + WS_YS); E.stg = (LAS unsigned char*)c.smem + LDS_STG; E.tid = c.tid;
    g8::gemm_phase((LAS unsigned char*)c.smem, c.tid, FF, S, E);
}

DI void phase_combine(const Ctx& c, int l, int nrows, bool last) {
    const Params& p = *c.p;
    moe_setup(c, l, nrows);
    const LAS int* roff = (const LAS int*)(c.smem + LDS_MAIN + 2064);
    const unsigned char* ys = (const unsigned char*)(p.ws + WS_YS);
    const int* einfo = (const int*)(p.ws + WS_EINFO);
    const float* slotw = (const float*)(p.ws + WS_SLOTW);
    float* xbuf = (float*)(p.ws + WS_XBUF);
    bf16_t* hbuf = (bf16_t*)(p.ws + WS_HBUF);
    const float* modv = (const float*)(p.ws + WS_MOD);
    const int lane = c.lane;
    const int shared0 = roff[256];
    for (int t = c.bid * NWAVES + c.wid; t < nrows; t += c.nblk * NWAVES) {
        const int b = t < TL ? (t >> 12) : 8;
        const float* gate = modv + (size_t)(l * 9 + b) * 6144 + 5120 + 16 * lane;
        int myrow = 0; float myw = 0.f;
        if (lane < 8) { const int ei = einfo[(size_t)t * 8 + lane]; myrow = roff[ei >> 16] + (ei & 0xffff); myw = slotw[(size_t)t * 8 + lane] * (1.f / 16.f); }
        if (lane == 8) { myrow = shared0 + t; myw = 1.f / 16.f; }
        f32x4 v[4], a[4];
        {
            const u32x4 x0 = *(const u32x4*)((const bf16_t*)xbuf + (size_t)t * DM + 16 * lane), x1 = *(const u32x4*)((const bf16_t*)xbuf + (size_t)t * DM + 16 * lane + 8);
            v[0] = bf4_f32(u32x2{x0.x, x0.y}); v[1] = bf4_f32(u32x2{x0.z, x0.w}); v[2] = bf4_f32(u32x2{x1.x, x1.y}); v[3] = bf4_f32(u32x2{x1.z, x1.w});
        }
#pragma unroll
        for (int j = 0; j < 4; ++j) a[j] = f32x4{0.f, 0.f, 0.f, 0.f};
#pragma unroll
        for (int k = 0; k < 9; ++k) {
            const int row = __builtin_amdgcn_readlane(myrow, k); const float w = rdlane_f(myw, k);
            const u32x4 y = *(const u32x4*)(ys + (size_t)row * DM + 16 * lane);
#pragma unroll
            for (int j = 0; j < 4; ++j) {
                const unsigned word = (j == 0) ? y.x : (j == 1) ? y.y : (j == 2) ? y.z : y.w;
                const auto lo = __builtin_amdgcn_cvt_pk_f32_fp8((int)word, false), hi = __builtin_amdgcn_cvt_pk_f32_fp8((int)word, true);
                a[j].x += w * lo[0]; a[j].y += w * lo[1]; a[j].z += w * hi[0]; a[j].w += w * hi[1];
            }
        }
        float s = 0.f;
#pragma unroll
        for (int j = 0; j < 4; ++j) {
            const f32x4 g = *(const f32x4*)(gate + 4 * j);
            v[j] += g * a[j];
            s += (v[j].x * v[j].x + v[j].y * v[j].y) + (v[j].z * v[j].z + v[j].w * v[j].w);
        }
        const float rstd = rsqrtf(wave_sum(s) * (1.f / DM) + EPSV);
        if (last) {
            const float* gf = p.in[I_GFINAL] + 16 * lane;
#pragma unroll
            for (int j = 0; j < 4; ++j) {
                const f32x4 g = *(const f32x4*)(gf + 4 * j);
                *(f32x4*)(p.out + (size_t)t * DM + 16 * lane + 4 * j) = v[j] * rstd * g;
            }
        } else {
            const float* g = p.in[I_GMIX] + (l + 1) * 1024 + 16 * lane;
            const float* mv = modv + (size_t)((l + 1) * 9 + b) * 6144 + 16 * lane;
            u32x4 o8;
#pragma unroll
            for (int j = 0; j < 4; ++j) {
                *(u32x2*)((bf16_t*)xbuf + (size_t)t * DM + 16 * lane + 4 * j) = f32_bf4(v[j]);
                const f32x4 gg = *(const f32x4*)(g + 4 * j), shh = *(const f32x4*)(mv + 4 * j), scc = *(const f32x4*)(mv + 1024 + 4 * j);
                const f32x4 y = v[j] * rstd * gg * (1.f + scc) + shh;
                const unsigned w8 = pk4_fp8(y.x, y.y, y.z, y.w);
                if (j == 0) o8.x = w8; else if (j == 1) o8.y = w8; else if (j == 2) o8.z = w8; else o8.w = w8;
            }
            *(u32x4*)((unsigned char*)(p.ws + WS_HIN8) + (size_t)t * DM + 16 * lane) = o8;
        }
    }
}
DI void glds16(const void* g, LAS char* l) { __builtin_amdgcn_global_load_lds((const unsigned*)g, (LAS unsigned*)l, 16, 0, 0); }
#define VM_DRAIN() asm volatile("s_waitcnt vmcnt(0)" ::: "memory")
constexpr float FLASH_THR = 8.0f;
struct ModNone { DI bool active(int) const { return true; } DI void apply(int, f32x16&, f32x16&) const {} };
struct ModSwa {
    int nloc, kpos0, qpos, qmin, hi_;
    DI bool active(int j) const { if (j >= nloc) return true; const int k0 = kpos0 + 64 * j; return (k0 + 63 >= qmin - 128) && (k0 <= qmin + 31 + 128); }
    DI void apply(int j, f32x16& s0, f32x16& s1) const {
        if (j >= nloc) return;
        const int hi = hi_;
        const int kb = kpos0 + 64 * j + 4 * hi - qpos;
        const float NINF = -__builtin_inff();
#pragma unroll
        for (int r = 0; r < 16; ++r) {
            const int d = kb + (r & 3) + 8 * (r >> 2);
            if (d < -128 || d > 128) s0[r] = NINF;
            if (d + 32 < -128 || d + 32 > 128) s1[r] = NINF;
        }
    }
};
struct ModNa {
    int nloc, kr0, qr, qc, rs, cs, hi_;
    const LAS float* rpb;
    DI bool active(int j) const { if (j >= nloc) return true; const int kr = kr0 + j; return kr >= rs && kr < rs + 8; }
    DI void apply(int j, f32x16& s0, f32x16& s1) const {
        if (j >= nloc) return;
        const int hi = hi_;
        const int kr = kr0 + j;
        const LAS float* row = rpb + (kr - qr + 7) * 31 + 15 - qc;
        const float NINF = -__builtin_inff();
        float b0[16], b1[16];
#pragma unroll
        for (int r = 0; r < 16; ++r) { const int kc = 4 * hi + (r & 3) + 8 * (r >> 2); b0[r] = row[kc]; b1[r] = row[kc + 32]; }
#pragma unroll
        for (int r = 0; r < 16; ++r) {
            const int kc = 4 * hi + (r & 3) + 8 * (r >> 2);
            const bool ok0 = (kc >= cs) && (kc < cs + 16), ok1 = (kc + 32 >= cs) && (kc + 32 < cs + 16);
            s0[r] = ok0 ? s0[r] + b0[r] : NINF;
            s1[r] = ok1 ? s1[r] + b1[r] : NINF;
        }
    }
};


typedef __attribute__((ext_vector_type(8))) int v8i_f;
typedef __attribute__((ext_vector_type(4))) int v4i_f;
DI void mfma8(f32x16& d, const v8i_f& a, const v8i_f& b, const f32x16& c, int sc) {
    asm volatile("v_mfma_scale_f32_32x32x64_f8f6f4 %0, %1, %2, %3, %4, %4 op_sel_hi:[0,0,0]" : "=&v"(d) : "v"(a), "v"(b), "v"(c), "v"(sc));
}
DI void mfma8_acc(f32x16& d, const v8i_f& a, const v8i_f& b, int sc) {
    asm volatile("v_mfma_scale_f32_32x32x64_f8f6f4 %0, %1, %2, %0, %3, %3 op_sel_hi:[0,0,0]" : "+v"(d) : "v"(a), "v"(b), "v"(sc));
}
template <int DV> struct F8State { float m, l; f32x16 o[DV / 32]; f32x16 cinit; };

template <int DV, class Tok0, class Tile0, class Mod>
DI void pass8(const Ctx& c, int ki, int vrow0, int ntiles, Tok0 tok0, Tile0 vtile, Mod& mod, const v8i_f& qf, F8State<DV>& st) {
    constexpr int ND = DV / 32, STAGE = 4096 + DV * 64;
    const unsigned char* k8 = (const unsigned char*)(c.p->ws + WS_K8);
    const unsigned char* vt8 = (const unsigned char*)(c.p->ws + WS_VT8);
    LAS char* lds = (LAS char*)c.smem;
    const int lane = c.lane, r32 = c.r32, hi = c.hi, w = c.wid;
    int usc = 0x7F7F7F7F; asm volatile("" : "+v"(usc));
    const int prow = 16 * (w & 3) + (lane >> 2), pslot = lane & 3;
    const unsigned koff = (unsigned)(prow * 1024 + ki * 64 + ((pslot ^ ((prow >> 2) & 3)) << 4));
    const int vpiece = (DV == 128) ? w : (w & 3);
    const int vrow = 16 * vpiece + (lane >> 2);
    const unsigned voff = (unsigned)((vrow0 + vrow) * 64 + ((pslot ^ ((vrow >> 2) & 3)) << 4));
    auto issue = [&](int j, LAS char* stage) {
        if (w < 4) glds16(k8 + tok0(j) * 1024 + koff, stage + w * 1024);
        if (DV == 128 || w >= 4) glds16(vt8 + vtile(j) * (size_t)VT_TILE + voff, stage + 4096 + vpiece * 1024);
    };
    st.m = 0.f; st.l = 0.f;
#pragma unroll
    for (int r = 0; r < 16; ++r) st.cinit[r] = 0.f;
#pragma unroll
    for (int d = 0; d < ND; ++d)
#pragma unroll
        for (int r = 0; r < 16; ++r) st.o[d][r] = 0.f;
    issue(0, lds);
    VM_DRAIN();
    __syncthreads();
    const int f = (r32 >> 2) & 3;
    const int o_lo = r32 * 64 + (((2 * hi) ^ f) << 4), o_hi = r32 * 64 + (((2 * hi + 1) ^ f) << 4);
    if (__builtin_amdgcn_readfirstlane(w) >= 4) __builtin_amdgcn_s_setprio(1);
    for (int j = 0; j < ntiles; ++j) {
        if (j + 1 < ntiles) issue(j + 1, lds + ((j + 1) & 1) * STAGE);
        const LAS char* stage = lds + (j & 1) * STAGE;
        if (mod.active(j)) {
            v8i_f ka, kb;
            ka.lo = *(const LAS v4i_f*)(stage + o_lo); ka.hi = *(const LAS v4i_f*)(stage + o_hi);
            kb.lo = *(const LAS v4i_f*)(stage + 2048 + o_lo); kb.hi = *(const LAS v4i_f*)(stage + 2048 + o_hi);
            f32x16 s0, s1;
            mfma8(s0, ka, qf, st.cinit, usc); mfma8(s1, kb, qf, st.cinit, usc);
            v8i_f va, vb;
            va.lo = *(const LAS v4i_f*)(stage + 4096 + o_lo); va.hi = *(const LAS v4i_f*)(stage + 4096 + o_hi);
            vb.lo = *(const LAS v4i_f*)(stage + 4096 + 2048 + o_lo); vb.hi = *(const LAS v4i_f*)(stage + 4096 + 2048 + o_hi);
            asm volatile("s_nop 15\n\ts_nop 15" : "+v"(s0), "+v"(s1));
            mod.apply(j, s0, s1);
            float mx = fmaxf(fmaxf(s0[0], s0[1]), s1[0]);
            mx = fmaxf(fmaxf(mx, s1[1]), fmaxf(s0[2], s1[2]));
#pragma unroll
            for (int r = 3; r < 15; r += 2) mx = fmaxf(fmaxf(mx, s0[r]), fmaxf(s0[r + 1], fmaxf(s1[r], s1[r + 1])));
            mx = fmaxf(mx, fmaxf(s0[15], s1[15]));
            { const auto rr = __builtin_amdgcn_permlane32_swap(__float_as_uint(mx), __float_as_uint(mx), false, false); mx = fmaxf(__uint_as_float(rr[0]), __uint_as_float(rr[1])); }
            const bool seen = mx > -1e29f;
            const bool started = half_swap_sum(st.l) > 0.f;
            const bool mv = (mx > FLASH_THR) || (!started && seen);
            if (__any(mv)) {
                const float d = mv ? mx : 0.f;
                const float fs = (mv && started) ? __builtin_amdgcn_exp2f(-d) : 1.f;
                st.m += d; st.l *= fs;
                const float nm2 = -st.m;
                asm volatile("s_nop 15\n\ts_nop 15");
#pragma unroll
                for (int dd = 0; dd < ND; ++dd) asm volatile("" : "+v"(st.o[dd]));
#pragma unroll
                for (int r = 0; r < 16; ++r) { s0[r] -= d; s1[r] -= d; st.cinit[r] = nm2; }
#pragma unroll
                for (int dd = 0; dd < ND; ++dd)
#pragma unroll
                    for (int r = 0; r < 16; ++r) st.o[dd][r] *= fs;
            }
            float rs0 = 0.f, rs1 = 0.f;
#pragma unroll
            for (int r = 0; r < 16; ++r) { s0[r] = __builtin_amdgcn_exp2f(s0[r]); s1[r] = __builtin_amdgcn_exp2f(s1[r]); rs0 += s0[r]; rs1 += s1[r]; }
            st.l += rs0 + rs1;
            v8i_f pf;
#pragma unroll
            for (int idx = 0; idx < 8; ++idx) { const int r0 = (idx >> 2) * 4 + (idx & 3); pf[idx] = (int)pk4_fp8(s0[r0], s0[r0 + 8], s1[r0], s1[r0 + 8]); }
            asm volatile("s_nop 3" : "+v"(pf));
            mfma8_acc(st.o[0], va, pf, usc); mfma8_acc(st.o[1], vb, pf, usc);
            if constexpr (DV == 128) {
                va.lo = *(const LAS v4i_f*)(stage + 4096 + 4096 + o_lo); va.hi = *(const LAS v4i_f*)(stage + 4096 + 4096 + o_hi);
                vb.lo = *(const LAS v4i_f*)(stage + 4096 + 6144 + o_lo); vb.hi = *(const LAS v4i_f*)(stage + 4096 + 6144 + o_hi);
                mfma8_acc(st.o[2], va, pf, usc); mfma8_acc(st.o[3], vb, pf, usc);
            }
        }
        VM_DRAIN();
        __syncthreads();
    }
    __builtin_amdgcn_s_setprio(0);
    asm volatile("s_nop 15\n\ts_nop 15");
#pragma unroll
    for (int dd = 0; dd < ND; ++dd) asm volatile("" : "+v"(st.o[dd]));
}

DI v8i_f load_q8(const Ctx& c, size_t qtok, int cb) {
    const unsigned char* q8 = (const unsigned char*)(c.p->ws + WS_Q8) + qtok * 1024 + cb * 64 + 32 * c.hi;
    v8i_f qf; qf.lo = *(const v4i_f*)q8; qf.hi = *(const v4i_f*)(q8 + 16);
    return qf;
}
template <int DV>
DI void store_o8(const F8State<DV>& st, float inv, unsigned char* __restrict__ orow, int hi) {
    const float s = inv * MIX_SCALE;
#pragma unroll
    for (int dt = 0; dt < DV / 32; ++dt)
#pragma unroll
        for (int g = 0; g < 4; ++g)
            *(unsigned*)(orow + 32 * dt + 8 * g + 4 * hi) = pk4_fp8(st.o[dt][4 * g] * s, st.o[dt][4 * g + 1] * s, st.o[dt][4 * g + 2] * s, st.o[dt][4 * g + 3] * s);
}

DI void attn_swa_item(const Ctx& c, int l, int b, int h, int qb, bool ctxq) {
    const Params& p = *c.p;
    unsigned char* mix = (unsigned char*)(p.ws + WS_MIX);
    const int kvh = h >> 1;
    const size_t qtok = ctxq ? (size_t)TL + b * CTXL + c.wid * 32 + c.r32 : (size_t)b * SEQ + qb * 256 + c.wid * 32 + c.r32;
    const v8i_f qf = load_q8(c, qtok, h);
    F8State<64> st;
    ModSwa mod; mod.hi_ = c.hi;
    int j0 = 0;
    if (ctxq) { mod.nloc = 0; mod.kpos0 = 0; }
    else { j0 = 4 * qb - 2; if (j0 < 0) j0 = 0; int j1 = 4 * qb + 5; if (j1 > 63) j1 = 63; mod.nloc = j1 - j0 + 1; mod.kpos0 = 64 * j0; }
    mod.qmin = qb * 256 + c.wid * 32; mod.qpos = mod.qmin + c.r32;
    const int nloc = mod.nloc;
    const size_t lbase = (size_t)b * SEQ + 64 * j0, cbase = (size_t)TL + b * CTXL;
    auto tok0 = [&](int j) { return j < nloc ? lbase + 64 * j : cbase + 64 * (j - nloc); };
    const size_t vt0 = (size_t)b * 68;
    auto vtile = [&](int j) { return vt0 + (j < nloc ? j0 + j : 64 + (j - nloc)); };
    pass8<64>(c, kvh, kvh * 64, nloc + 4, tok0, vtile, mod, qf, st);
    float lt = half_swap_sum(st.l);
    lt += __builtin_amdgcn_exp2f(p.in[I_SINK][l * 4 + h] * LOG2E - st.m);
    store_o8<64>(st, 1.f / lt, mix + qtok * DM + h * 64, c.hi);
}

DI void attn_na_item(const Ctx& c, int l, int b, int h, int qb, bool ctxq) {
    const Params& p = *c.p;
    unsigned char* mix = (unsigned char*)(p.ws + WS_MIX);
    LAS float* rpbl = (LAS float*)(c.smem + LDS_MAIN + 1024);
    __syncthreads();
    if (!ctxq) for (int i = c.tid; i < 465; i += NTHREADS) rpbl[i] = p.in[I_RPB][(size_t)(l * 4 + h) * 465 + i] * LOG2E;
    __syncthreads();
    const size_t qtok = ctxq ? (size_t)TL + b * CTXL + c.wid * 32 + c.r32 : (size_t)b * SEQ + qb * 256 + c.wid * 32 + c.r32;
    const v8i_f qf = load_q8(c, qtok, 4 + h);
    F8State<64> st;
    ModNa mod; mod.rpb = rpbl; mod.hi_ = c.hi;
    int kr0 = 0;
    if (ctxq) { mod.nloc = 0; mod.kr0 = 0; mod.qr = 0; mod.qc = 0; mod.rs = 0; mod.cs = 0; }
    else {
        const int r_lo = 4 * qb, r_hi = 4 * qb + 3;
        int a = r_lo - 4; a = a < 0 ? 0 : (a > 56 ? 56 : a);
        int bb = r_hi - 4; bb = bb < 0 ? 0 : (bb > 56 ? 56 : bb);
        kr0 = a; mod.kr0 = a; mod.nloc = bb + 7 - a + 1;
        mod.qr = 4 * qb + (c.wid >> 1); mod.qc = 32 * (c.wid & 1) + c.r32;
        int rs = mod.qr - 4; rs = rs < 0 ? 0 : (rs > 56 ? 56 : rs); mod.rs = rs;
        int cs = mod.qc - 8; cs = cs < 0 ? 0 : (cs > 48 ? 48 : cs); mod.cs = cs;
    }
    const int nloc = mod.nloc;
    const size_t lbase = (size_t)b * SEQ + 64 * kr0, cbase = (size_t)TL + b * CTXL;
    auto tok0 = [&](int j) { return j < nloc ? lbase + 64 * j : cbase + 64 * (j - nloc); };
    const size_t vt0 = (size_t)b * 68;
    auto vtile = [&](int j) { return vt0 + (j < nloc ? kr0 + j : 64 + (j - nloc)); };
    pass8<64>(c, 2 + h, 128 + h * 64, nloc + 4, tok0, vtile, mod, qf, st);
    const float lt = half_swap_sum(st.l);
    store_o8<64>(st, 1.f / lt, mix + qtok * DM + 256 + h * 64, c.hi);
}

DI void attn_diff_item(const Ctx& c, int l, int b, int h, int qb, bool ctxq) {
    const Params& p = *c.p;
    unsigned char* mix = (unsigned char*)(p.ws + WS_MIX);
    const size_t qtok = ctxq ? (size_t)TL + b * CTXL + c.wid * 32 + c.r32 : (size_t)b * SEQ + qb * 256 + c.wid * 32 + c.r32;
    const int nloc = ctxq ? 0 : 64;
    const size_t lbase = (size_t)b * SEQ, cbase = (size_t)TL + b * CTXL;
    auto tok0 = [&](int j) { return j < nloc ? lbase + 64 * j : cbase + 64 * (j - nloc); };
    const size_t vt0 = (size_t)b * 68;
    auto vtile = [&](int j) { return vt0 + (j < nloc ? j : 64 + (j - nloc)); };
    unsigned char* orow = mix + qtok * DM + 512 + h * 128;
    bf16_t* prow = (bf16_t*)(p.ws + WS_PARK) + qtok * 512 + h * 128;
    ModNone mod;
    F8State<128> st;
    {
        const v8i_f qf = load_q8(c, qtok, 8 + 2 * h);
        pass8<128>(c, 6 + 2 * h, 384 + h * 128, nloc + 4, tok0, vtile, mod, qf, st);
        const float inv = 1.f / half_swap_sum(st.l);
#pragma unroll
        for (int dt = 0; dt < 4; ++dt)
#pragma unroll
            for (int g = 0; g < 4; ++g) {
                u32x2 u; u.x = pk2(st.o[dt][4 * g] * inv, st.o[dt][4 * g + 1] * inv); u.y = pk2(st.o[dt][4 * g + 2] * inv, st.o[dt][4 * g + 3] * inv);
                *(u32x2*)(prow + 32 * dt + 8 * g + 4 * c.hi) = u;
            }
    }
    const v8i_f qf = load_q8(c, qtok, 8 + 2 * h + 1);
    pass8<128>(c, 6 + 2 * h + 1, 384 + h * 128, nloc + 4, tok0, vtile, mod, qf, st);
    const float lam_init = 0.8f - 0.6f * __expf(-0.3f * (float)l);
    const float d1 = wave_sum(p.in[I_LQ1][l * 64 + c.lane] * p.in[I_LK1][l * 64 + c.lane]);
    const float d2 = wave_sum(p.in[I_LQ2][l * 64 + c.lane] * p.in[I_LK2][l * 64 + c.lane]);
    const float lam = __expf(d1) - __expf(d2) + lam_init;
    const float inv2 = lam / half_swap_sum(st.l);
    float ss = 0.f;
#pragma unroll
    for (int dt = 0; dt < 4; ++dt)
#pragma unroll
        for (int g = 0; g < 4; ++g) {
            const u32x2 u = *(const u32x2*)(prow + 32 * dt + 8 * g + 4 * c.hi);
            const float a0 = bflo(u.x) - st.o[dt][4 * g] * inv2, a1 = bfhi(u.x) - st.o[dt][4 * g + 1] * inv2;
            const float a2 = bflo(u.y) - st.o[dt][4 * g + 2] * inv2, a3 = bfhi(u.y) - st.o[dt][4 * g + 3] * inv2;
            st.o[dt][4 * g] = a0; st.o[dt][4 * g + 1] = a1; st.o[dt][4 * g + 2] = a2; st.o[dt][4 * g + 3] = a3;
            ss += (a0 * a0 + a1 * a1) + (a2 * a2 + a3 * a3);
        }
    ss = half_swap_sum(ss);
    const float rn = rsqrtf(ss * (1.f / 128.f) + EPSV) * (1.f - lam_init);
    const float* sg = p.in[I_SUBLN] + l * 128;
#pragma unroll
    for (int dt = 0; dt < 4; ++dt)
#pragma unroll
        for (int g = 0; g < 4; ++g) {
            const f32x4 gg = *(const f32x4*)(sg + 32 * dt + 8 * g + 4 * c.hi);
            const float rs = rn * MIX_SCALE;
            *(unsigned*)(orow + 32 * dt + 8 * g + 4 * c.hi) = pk4_fp8(st.o[dt][4 * g] * rs * gg.x, st.o[dt][4 * g + 1] * rs * gg.y, st.o[dt][4 * g + 2] * rs * gg.z, st.o[dt][4 * g + 3] * rs * gg.w);
        }
}

DI void attn_decode(int it, int& b, int& h, int& qb, bool& ctxq) {
    if (it < 512) {
        const int xcd = it & 7, j = it >> 3;
        const int bh = xcd * 4 + (j >> 4); qb = j & 15;
        b = bh >> 2; h = bh & 3; ctxq = false;
    } else {
        const int i = it - 512;
        qb = 0; h = i & 3; b = i >> 2; ctxq = true;
    }
}
DI Ctx reopaque(const Ctx& c) {
    Ctx d = c; int t = c.tid; asm volatile("" : "+v"(t));
    d.tid = t; d.lane = t & 63; d.wid = __builtin_amdgcn_readfirstlane(t >> 6); d.r32 = t & 31; d.hi = (t >> 5) & 1;
    return d;
}
DI void phase_attn0_convert(const Ctx& c) {
    int* actr = (int*)(c.p->ws + WS_ROWCTR) + 128;
    int* cctr = (int*)(c.p->ws + WS_ROWCTR) + 192;
    LAS int* slot = (LAS int*)(c.smem + LDS_MAIN + 64);
    constexpr int NIT = 544, NATT = 3 * NIT;
    const bool prefer_conv = (c.bid & 1) != 0;
    for (;;) {
        if (c.tid == 0) {
            int k = -1, v = 0;
            if (prefer_conv) {
                v = atomicAdd(cctr, 1); if (v < CONV_NCHUNK) k = 1;
                if (k < 0) { v = atomicAdd(actr, 1); if (v < NATT) k = 0; }
            } else {
                v = atomicAdd(actr, 1); if (v < NATT) k = 0;
                if (k < 0) { v = atomicAdd(cctr, 1); if (v < CONV_NCHUNK) k = 1; }
            }
            slot[0] = k; slot[1] = v;
        }
        __syncthreads();
        const int kind = slot[0], idx = slot[1];
        __syncthreads();
        if (kind < 0) break;
        if (kind == 1) {
            convert_pairs(reopaque(c), idx * CONV_CHUNK, 1, CONV_CHUNK, [](int q) { return rmap_expert(q); });
        } else {
            const int grp = idx / NIT, it = idx - grp * NIT;
            int b, h, qb; bool ctxq; attn_decode(it, b, h, qb, ctxq);
            if (grp == 0) attn_diff_item(reopaque(c), 0, b, h, qb, ctxq);
            else if (grp == 1) attn_swa_item(reopaque(c), 0, b, h, qb, ctxq);
            else attn_na_item(reopaque(c), 0, b, h, qb, ctxq);
        }
    }
}
DI void phase_attn(const Ctx& c, int l) {
    const int NIT = 512 + ((l == 0) ? 32 : 0);
    for (int it = c.bid; it < NIT; it += c.nblk) { int b, h, qb; bool ctxq; attn_decode(it, b, h, qb, ctxq); attn_diff_item(c, l, b, h, qb, ctxq); }
    for (int it = c.bid; it < NIT; it += c.nblk) { int b, h, qb; bool ctxq; attn_decode(it, b, h, qb, ctxq); attn_swa_item(c, l, b, h, qb, ctxq); }
    for (int it = c.bid; it < NIT; it += c.nblk) { int b, h, qb; bool ctxq; attn_decode(it, b, h, qb, ctxq); attn_na_item(c, l, b, h, qb, ctxq); }
}
#ifndef WAVES_PER_SIMD
#define WAVES_PER_SIMD 2
#endif
#ifndef PROBE_REP
#define PROBE_REP 0
#endif
#ifndef DBG_MODE
#define DBG_MODE 0
#endif
DI Ctx mkctx(const Params& p, char* smem, int wave_s) {
    Ctx c; c.p = &p; c.smem = smem;
    int t = wave_s * 64 + (int)__builtin_amdgcn_mbcnt_hi(~0u, __builtin_amdgcn_mbcnt_lo(~0u, 0u)); asm volatile("" : "+v"(t));
    c.tid = t; c.lane = t & 63; c.wid = __builtin_amdgcn_readfirstlane(t >> 6); c.r32 = t & 31; c.hi = (t >> 5) & 1;
    int b = blockIdx.x, n = gridDim.x; asm volatile("" : "+s"(b), "+s"(n));
    c.bid = b; c.nblk = n;
    return c;
}
__global__ void __launch_bounds__(NTHREADS, WAVES_PER_SIMD) mega(Params p) {
    extern __shared__ __attribute__((aligned(16))) char smem[];
    Ctx c; c.p = &p; c.smem = smem; c.tid = threadIdx.x; c.lane = c.tid & 63; c.wid = c.tid >> 6; c.r32 = c.lane & 31; c.hi = c.lane >> 5;
    c.bid = blockIdx.x; c.nblk = gridDim.x;
    const int wave_s = __builtin_amdgcn_readfirstlane((int)threadIdx.x >> 6);
#define FRESH() mkctx(p, smem, wave_s)
#define GRID_SYNC() do { XcdBarrier bb_ = bar; asm volatile("" : "+s"(bb_.bar), "+s"(bb_.x)); xcd_barrier(bb_); } while (0)
    volatile LAS unsigned* xbw = (volatile LAS unsigned*)(smem + LDS_MAIN);
    if (c.tid == 0) { xbw[0] = 0u; xbw[1] = 0u; xbw[2] = 0u; xbw[3] = 0u; }
    __syncthreads();
    XcdBarrier bar = xcd_barrier_post((unsigned*)(p.ws + WS_BAR), xbw);
    asm volatile("; PHASE_MARK prologue" ::: "memory");
    phase_prologue(FRESH());
    GRID_SYNC();
#if PROBE_REP == 1
    asm volatile("; PHASE_MARK prologue" ::: "memory");
    phase_prologue(FRESH());
    GRID_SYNC();
#endif
    asm volatile("; PHASE_MARK norm" ::: "memory");
    phase_norm(FRESH(), 0, TT, true, 0);
    wrp_items(FRESH());
    GRID_SYNC();
#if PROBE_REP == 9
    phase_norm(FRESH(), 0, TT, true, 0);
    GRID_SYNC();
#endif
#if PROBE_REP == 13
#pragma unroll 1
    for (int z = 0; z < 20; ++z) { GRID_SYNC(); }
#endif
#pragma unroll 1
    for (int l = 0; l < 2; ++l) {
        const bool last = (l == 1);
        const int nrows = last ? TL : TT;
        asm volatile("; PHASE_MARK inproj" ::: "memory");
        asm volatile("; PHASE_MARK inproj" ::: "memory");
    phase_inproj(FRESH(), l);
        GRID_SYNC();
#if PROBE_REP == 2
        asm volatile("; PHASE_MARK inproj" ::: "memory");
        asm volatile("; PHASE_MARK inproj" ::: "memory");
    phase_inproj(FRESH(), l);
        GRID_SYNC();
#endif
        asm volatile("; PHASE_MARK attn" ::: "memory");
        asm volatile("; PHASE_MARK attn" ::: "memory");
        if (l == 0) phase_attn0_convert(FRESH()); else phase_attn(FRESH(), l);
        GRID_SYNC();
#if PROBE_REP == 3
        asm volatile("; PHASE_MARK attn" ::: "memory");
        asm volatile("; PHASE_MARK attn" ::: "memory");
    phase_attn(FRESH(), l);
        GRID_SYNC();
#endif
        asm volatile("; PHASE_MARK outproj" ::: "memory");
        asm volatile("; PHASE_MARK outproj" ::: "memory");
    phase_outproj(FRESH(), l, nrows);
        GRID_SYNC();
#if PROBE_REP == 7
        if (l == 0) { phase_outproj(FRESH(), l, nrows); GRID_SYNC(); }
#endif
#if DBG_MODE != 1
        asm volatile("; PHASE_MARK router" ::: "memory");
    phase_norm_router(FRESH(), l, nrows);
        GRID_SYNC();
        asm volatile("; PHASE_MARK route" ::: "memory");
        asm volatile("; PHASE_MARK route" ::: "memory");
    phase_route(FRESH(), l, nrows);
        GRID_SYNC();
        asm volatile("; PHASE_MARK e1" ::: "memory");
        asm volatile("; PHASE_MARK e1" ::: "memory");
    phase_e1(FRESH(), l, nrows);
        GRID_SYNC();
#if PROBE_REP == 4
        asm volatile("; PHASE_MARK e1" ::: "memory");
        asm volatile("; PHASE_MARK e1" ::: "memory");
    phase_e1(FRESH(), l, nrows);
        GRID_SYNC();
#endif
        asm volatile("; PHASE_MARK e2" ::: "memory");
        asm volatile("; PHASE_MARK e2" ::: "memory");
    phase_e2(FRESH(), l, nrows);
        GRID_SYNC();
#if PROBE_REP == 5
        asm volatile("; PHASE_MARK e2" ::: "memory");
        asm volatile("; PHASE_MARK e2" ::: "memory");
    phase_e2(FRESH(), l, nrows);
        GRID_SYNC();
#endif
#endif
        asm volatile("; PHASE_MARK combine" ::: "memory");
        asm volatile("; PHASE_MARK combine" ::: "memory");
    phase_combine(FRESH(), l, nrows, last);
#if PROBE_REP == 8
        if (last) { GRID_SYNC(); phase_combine(FRESH(), l, nrows, last); }
#endif
        if (!last) { GRID_SYNC(); }
    }
}

extern "C" void kernel_launch(void* const* d_in, const int* in_sizes, int n_in, void* d_out, int out_size, void* d_ws, size_t ws_size, hipStream_t stream) {
    static int grid = 0;
    if (grid == 0) {
        int dev = 0, cus = 0, per_cu = 0;
        if (n_in != 26 || ws_size < WS_END) { fprintf(stderr, "kernel_launch: unexpected n_in %d / ws %zu (need %zu)\n", n_in, ws_size, (size_t)WS_END); grid = -1; return; }
        if (hipGetDevice(&dev) != hipSuccess || hipDeviceGetAttribute(&cus, hipDeviceAttributeMultiprocessorCount, dev) != hipSuccess) { grid = -1; return; }
        if (hipFuncSetAttribute((const void*)mega, hipFuncAttributeMaxDynamicSharedMemorySize, LDS_BYTES) != hipSuccess) { grid = -1; return; }
        if (hipOccupancyMaxActiveBlocksPerMultiprocessor(&per_cu, (const void*)mega, NTHREADS, LDS_BYTES) != hipSuccess || per_cu < 1) per_cu = 1;
        (void)hipGetLastError();
        grid = cus;
    }
    if (grid < 0) return;
    (void)hipMemsetAsync((char*)d_ws + WS_BAR, 0, WS_ZERO_BYTES, stream);
    Params p{};
    for (int i = 0; i < 26; ++i) p.in[i] = (const float*)d_in[i];
    p.out = (float*)d_out; p.ws = (unsigned char*)d_ws;
    hipLaunchKernelGGL(mega, dim3(grid), dim3(NTHREADS), LDS_BYTES, stream, p);
}
```

```cpp
#include <hip/hip_runtime.h>
#include <hip/hip_bf16.h>
#include <cstdio>
#include <cstdint>

#define XB_TMO      128
#define XB_XCNT(j)  (256  + 64 * (j))
#define XB_XSUB(j)  (1280 + 64 * (j))
#define XB_XGEN(j)  (2304 + 64 * (j))
#define XB_TOP      3328
#define XB_TOPGEN   3392
#define XCD_BAR_WORDS 3456
#define XB_SPIN_CAP (1u << 22)
#define LAS __attribute__((address_space(3)))

__device__ __forceinline__ unsigned xb_ld(unsigned* p)              { return __hip_atomic_load(p, __ATOMIC_RELAXED, __HIP_MEMORY_SCOPE_AGENT); }
__device__ __forceinline__ unsigned xb_add(unsigned* p, unsigned v) { return __hip_atomic_fetch_add(p, v, __ATOMIC_RELAXED, __HIP_MEMORY_SCOPE_AGENT); }
__device__ __forceinline__ unsigned xb_xcc_id() { return (unsigned)__builtin_amdgcn_s_getreg((3 << 11) | 20) & 0xFu; }
#define XB_SPIN(cond, bar) do { unsigned _sp = 0; while (cond) { __builtin_amdgcn_s_sleep(1); \
    if ((++_sp & 255u) == 0u) { if (xb_ld(&(bar)[XB_TMO])) break; if (_sp > XB_SPIN_CAP) { atomicAdd(&(bar)[XB_TMO], 1u); break; } } } } while (0)

struct XcdBarrier {
    unsigned* bar; unsigned x;
    volatile LAS unsigned* st;
};

__device__ __forceinline__ XcdBarrier xcd_barrier_post(unsigned* bar, volatile LAS unsigned* st) {
    XcdBarrier b; b.bar = bar; b.x = xb_xcc_id(); b.st = st;
    if (threadIdx.x == 0) (void)xb_add(&bar[XB_XCNT(b.x)], 1u);
    return b;
}
__device__ __forceinline__ void xcd_barrier_complete(unsigned* bar, unsigned x, unsigned& nloc, unsigned& nx) {
    const unsigned G = gridDim.x * gridDim.y * gridDim.z;
    unsigned sum, cnt, mine, sp = 0u;
    for (;;) {
        sum = 0u; cnt = 0u; mine = 0u;
#pragma unroll
        for (unsigned j = 0; j < 16; ++j) { const unsigned c = xb_ld(&bar[XB_XCNT(j)]); sum += c; cnt += (c > 0u) ? 1u : 0u; mine = (j == x) ? c : mine; }
        if (sum == G) break;
        __builtin_amdgcn_s_sleep(1);
        if ((++sp & 255u) == 0u) { if (xb_ld(&bar[XB_TMO])) break; if (sp > XB_SPIN_CAP) { atomicAdd(&bar[XB_TMO], 1u); break; } }
    }
    nloc = mine > 0u ? mine : 1u; nx = cnt > 0u ? cnt : 1u;
}

__device__ __forceinline__ void xcd_barrier(const XcdBarrier& b) {
    asm volatile("s_waitcnt vmcnt(0)" ::: "memory");
    __syncthreads();
    if (threadIdx.x == 0) {
        unsigned* bar = b.bar;
        __builtin_amdgcn_s_waitcnt(0);
        unsigned nloc = b.st[0], nx = b.st[1];
        if (nloc == 0u) { xcd_barrier_complete(bar, b.x, nloc, nx); b.st[0] = nloc; b.st[1] = nx; }
        const unsigned old = xb_add(&bar[XB_XSUB(b.x)], 1u);
        const unsigned gen = old / nloc;
        if (old + 1u == (gen + 1u) * nloc) {
            __builtin_amdgcn_fence(__ATOMIC_RELEASE, "agent");
            asm volatile("s_waitcnt vmcnt(0)" ::: "memory");
            const unsigned og = xb_add(&bar[XB_TOP], 1u);
            const unsigned tg = og / nx;
            if (og + 1u == (tg + 1u) * nx) xb_add(&bar[XB_TOPGEN], 1u);
            else XB_SPIN(xb_ld(&bar[XB_TOPGEN]) == tg, bar);
            __builtin_amdgcn_fence(__ATOMIC_ACQUIRE, "agent");
            xb_add(&bar[XB_XGEN(b.x)], 1u);
            asm volatile("s_waitcnt vmcnt(0)" ::: "memory");
        } else {
            XB_SPIN(xb_ld(&bar[XB_XGEN(b.x)]) == gen, bar);
            __builtin_amdgcn_fence(__ATOMIC_ACQUIRE, "agent");
            asm volatile("s_waitcnt vmcnt(0)" ::: "memory");
        }
    }
    __syncthreads();
}

constexpr int DM = 1024, NB = 8, SEQ = 4096, CTXL = 256;
constexpr int TL = NB * SEQ;
constexpr int TC = NB * CTXL;
constexpr int TT = TL + TC;
constexpr int INC = 2816, QC = 1024, KVC = 1792;
constexpr int NE = 256, NEX = 257, FF = 256;
constexpr float EPSV = 1e-6f;
constexpr float LOG2E = 1.4426950408889634f;
constexpr float QSCALE = 0.125f * LOG2E;
constexpr float MIX_SCALE = 4.0f, W_SCALE = 32.0f, WD_SCALE = 16.0f, ACT_SCALE = 2.0f;
constexpr int NTHREADS = 512;
constexpr int NWAVES = 8;
constexpr int LDS_MAIN = 131072;
constexpr int LDS_AUX = 8192 + 16384 + 8192;
constexpr int LDS_BYTES = LDS_MAIN + LDS_AUX;
constexpr int LDS_STG = LDS_MAIN + 8192;
static_assert(LDS_BYTES <= 163840, "LDS");

typedef unsigned short bf16_t;
typedef __attribute__((ext_vector_type(8))) short bf16x8;
typedef __attribute__((ext_vector_type(4))) short s16x4;
typedef __attribute__((ext_vector_type(16))) float f32x16;
typedef __attribute__((ext_vector_type(2))) float f32x2;
typedef __attribute__((ext_vector_type(2))) __bf16 bf16x2v;
typedef short v4i16_t __attribute__((ext_vector_type(4)));
typedef __attribute__((ext_vector_type(4))) unsigned u32x4;
typedef __attribute__((ext_vector_type(2))) unsigned u32x2;
typedef __attribute__((ext_vector_type(4))) float f32x4;
#define DI __device__ __forceinline__
#define MFMA32(a, b, c) __builtin_amdgcn_mfma_f32_32x32x16_bf16((a), (b), (c), 0, 0, 0)

DI unsigned pk2(float lo, float hi) { f32x2 v = {lo, hi}; bf16x2v b = __builtin_convertvector(v, bf16x2v); return __builtin_bit_cast(unsigned, b); }
DI unsigned pk4_fp8(float a, float b, float c, float d) { int w = 0; w = __builtin_amdgcn_cvt_pk_fp8_f32(a, b, w, false); w = __builtin_amdgcn_cvt_pk_fp8_f32(c, d, w, true); return (unsigned)w; }
DI float bf2f(bf16_t u) { return __uint_as_float(((unsigned)u) << 16); }
DI float bflo(unsigned u) { return __uint_as_float(u << 16); }
DI float bfhi(unsigned u) { return __uint_as_float(u & 0xffff0000u); }
DI f32x4 bf4_f32(u32x2 w) { return f32x4{bflo(w.x), bfhi(w.x), bflo(w.y), bfhi(w.y)}; }
DI u32x2 f32_bf4(f32x4 v) { u32x2 o; o.x = pk2(v[0], v[1]); o.y = pk2(v[2], v[3]); return o; }
DI int crow(int reg, int hi) { return (reg & 3) + 8 * (reg >> 2) + 4 * hi; }
#define DPPI(v, CTRL) __builtin_amdgcn_update_dpp(0, (v), (CTRL), 0xf, 0xf, true)
#define DPPF(v, CTRL) __builtin_bit_cast(float, __builtin_amdgcn_update_dpp(0, __builtin_bit_cast(int, (v)), (CTRL), 0xf, 0xf, true))
#define DPP_XOR1 0xB1
#define DPP_XOR2 0x4E
#define DPP_HMIR 0x141
#define DPP_MIR  0x140
#define DPP_SHR(n) (0x110 + (n))
DI float rdlane_f(float v, int l) { return __builtin_bit_cast(float, __builtin_amdgcn_readlane(__builtin_bit_cast(int, v), l)); }
DI float wave_sum(float v) {
    v += DPPF(v, DPP_XOR1); v += DPPF(v, DPP_XOR2); v += DPPF(v, DPP_HMIR); v += DPPF(v, DPP_MIR);
    return (rdlane_f(v, 0) + rdlane_f(v, 16)) + (rdlane_f(v, 32) + rdlane_f(v, 48));
}
DI float half_swap_sum(float v) {
    const auto rr = __builtin_amdgcn_permlane32_swap(__float_as_uint(v), __float_as_uint(v), false, false);
    return __uint_as_float(rr[0]) + __uint_as_float(rr[1]);
}
DI float siluf(float v) { return v / (1.f + __expf(-v)); }

struct Params {
    const float* in[26];
    float* out;
    unsigned char* ws;
};
enum { I_X = 0, I_C, I_CTX, I_CCTX, I_WMOD, I_BMOD, I_GMIX, I_GFFN, I_WIN, I_WOUT, I_SINK, I_RPB, I_LQ1, I_LK1, I_LQ2, I_LK2, I_SUBLN,
       I_WR, I_RB, I_WG, I_WU, I_WD, I_SG, I_SU, I_SD, I_GFINAL };

constexpr size_t MiB = 1u << 20;
constexpr size_t WS_BAR = 0;
constexpr size_t WS_CNT = 16384;
constexpr int CNT_STRIDE = 64, CNT_LAYER = 257 * 64;
constexpr size_t WS_ZERO_BYTES = 163840;
constexpr size_t WS_ROPE = 196608;
constexpr size_t WS_MOD = 262144;
constexpr size_t WS_WIN = 1 * MiB;
constexpr size_t WS_WOUT = 12 * MiB;
constexpr size_t WS_WR = 16 * MiB;
constexpr size_t WS_WGU = 17 * MiB;
constexpr size_t WS_WD = WS_WGU + 514 * MiB;
constexpr size_t WS_XBUF = WS_WD + 257 * MiB;
constexpr size_t WS_HBUF = WS_XBUF + 136 * MiB;
constexpr size_t WS_SLOTW = WS_HBUF + 68 * MiB;
constexpr size_t WS_LIST = WS_SLOTW + 2 * MiB;
constexpr size_t WS_R = WS_LIST + 34 * MiB;
constexpr size_t WS_Q = WS_R;
constexpr size_t WS_KV = WS_R + 68 * MiB;
constexpr size_t WS_MIX = WS_R + 187 * MiB;
constexpr size_t WS_PARK = WS_R + 221 * MiB;
constexpr size_t WS_Q8 = WS_R + 290 * MiB;
constexpr size_t WS_K8 = WS_R + 324 * MiB;
constexpr size_t WS_VT8 = WS_R + 358 * MiB;
constexpr int VT_ROWS = 896, VT_TILE = 896 * 64;
constexpr size_t WS_LOGIT = WS_R + 256 * MiB;
constexpr size_t WS_ACT = WS_R;
constexpr size_t WS_HIN8 = WS_WGU + 300 * MiB;
constexpr size_t WS_H8 = WS_R + 80 * MiB;
constexpr size_t WS_YS = WS_R + 153 * MiB;
constexpr size_t WS_EINFO = WS_R + 512 * MiB;
constexpr size_t WS_WRP = WS_R + 460 * MiB;
constexpr size_t WS_CB = WS_R + 470 * MiB;
constexpr size_t WS_RSTD = WS_R + 471 * MiB;
constexpr size_t WS_ROWCTR = 151552;
constexpr size_t WS_END = WS_YS + 612 * MiB;
static_assert(WS_END <= 2048 * MiB, "workspace");

struct Ctx {
    const Params* p;
    char* smem;
    int tid, lane, wid, r32, hi;
    int bid, nblk;
};
DI int map_row(int type, int n) {
    if (type == 1) {
        const int hb = n >> 6, d = n & 63;
        const bool roped = (hb < 4) || (hb >= 8 && hb < 16) || (hb == 16) || (hb == 17) || (hb >= 28 && hb < 36);
        int d2 = d;
        if (roped) d2 = (d < 16) ? 2 * d : (d < 32) ? 2 * (d - 16) + 1 : (d < 48) ? 2 * (d - 16) : 2 * (d - 32) + 1;
        return (hb << 6) | d2;
    }
    if (type == 2) return 2 * n;
    if (type == 3) return 2 * n + 1;
    return n;
}

struct TItem { const float* W; int K, N, kt, nt, type; void* dst; bool f8; float ws; };
DI void tload(const Ctx& c, float (&v)[4][2][8], const TItem& it) {
    const int wid4 = c.wid & 3;
    const int k0 = it.kt * 128, n0 = it.nt * 128;
#pragma unroll
    for (int cc = 0; cc < 4; ++cc) {
        const int kc = 4 * wid4 + cc;
#pragma unroll
        for (int j = 0; j < 8; ++j)
#pragma unroll
            for (int i = 0; i < 2; ++i) v[cc][i][j] = __builtin_nontemporal_load(&it.W[(size_t)(k0 + kc * 8 + j) * it.N + n0 + c.lane + 64 * i]);
    }
}
DI void tfinish(const Ctx& c, const float (&v)[4][2][8], const TItem& it) {
    LAS char* lds = (LAS char*)c.smem + (c.tid >> 8) * 36864;
    const int wid4 = c.wid & 3, tid8 = c.tid & 255;
    const int k0 = it.kt * 128, n0 = it.nt * 128, K = it.K;
    const float wscale = it.ws;
#pragma unroll
    for (int cc = 0; cc < 4; ++cc) {
        const int kc = 4 * wid4 + cc;
#pragma unroll
        for (int i = 0; i < 2; ++i) {
            if (it.f8) {
                u32x2 u; u.x = pk4_fp8(v[cc][i][0] * wscale, v[cc][i][1] * wscale, v[cc][i][2] * wscale, v[cc][i][3] * wscale); u.y = pk4_fp8(v[cc][i][4] * wscale, v[cc][i][5] * wscale, v[cc][i][6] * wscale, v[cc][i][7] * wscale);
                *(LAS u32x2*)(lds + (c.lane + 64 * i) * 144 + kc * 8) = u;
            } else {
                u32x4 u; u.x = pk2(v[cc][i][0], v[cc][i][1]); u.y = pk2(v[cc][i][2], v[cc][i][3]); u.z = pk2(v[cc][i][4], v[cc][i][5]); u.w = pk2(v[cc][i][6], v[cc][i][7]);
                *(LAS u32x4*)(lds + (c.lane + 64 * i) * 272 + kc * 16) = u;
            }
        }
    }
    __syncthreads();
    if (it.f8) {
        unsigned char* dst = (unsigned char*)it.dst;
#pragma unroll
        for (int j = 0; j < 4; ++j) {
            const int idx = tid8 + 256 * j, c16 = idx & 7, n = idx >> 3;
            const u32x4 u = *(LAS u32x4*)(lds + n * 144 + c16 * 16);
            const int row = map_row(it.type, n0 + n);
            __builtin_nontemporal_store(u, (u32x4*)(dst + (size_t)row * K + k0 + c16 * 16));
        }
    } else {
        bf16_t* dst = (bf16_t*)it.dst;
#pragma unroll
        for (int j = 0; j < 8; ++j) {
            const int idx = tid8 + 256 * j, c16 = idx & 15, n = idx >> 4;
            const u32x4 u = *(LAS u32x4*)(lds + n * 272 + c16 * 16);
            const int row = map_row(it.type, n0 + n);
            *(u32x4*)(dst + (size_t)row * K + k0 + c16 * 8) = u;
        }
    }
    __syncthreads();
}

DI void mod_item(const Ctx& c, int l, int cg) {
    const Params& p = *c.p;
    LAS float* sv = (LAS float*)c.smem;
    LAS float* part = (LAS float*)(c.smem + 36864);
    for (int idx = c.tid; idx < 9 * 1024; idx += NTHREADS) {
        const int b = idx >> 10, k = idx & 1023;
        const float v = (b < 8) ? p.in[I_C][b * 1024 + k] : p.in[I_CCTX][k];
        sv[idx] = siluf(v);
    }
    __syncthreads();
    const int col = c.tid & 63, kq = c.tid >> 6;
    float acc[9];
#pragma unroll
    for (int b = 0; b < 9; ++b) acc[b] = 0.f;
    const float* wp = p.in[I_WMOD] + ((size_t)l * 1024 + kq * 128) * 6144 + cg * 64 + col;
    for (int k = 0; k < 128; k += 8) {
        float w[8];
#pragma unroll
        for (int u = 0; u < 8; ++u) w[u] = wp[(size_t)(k + u) * 6144];
#pragma unroll
        for (int u = 0; u < 8; ++u)
#pragma unroll
            for (int b = 0; b < 9; ++b) acc[b] += sv[b * 1024 + kq * 128 + k + u] * w[u];
    }
#pragma unroll
    for (int b = 0; b < 9; ++b) part[(kq * 9 + b) * 64 + col] = acc[b];
    __syncthreads();
    float* modv = (float*)(p.ws + WS_MOD);
    for (int idx = c.tid; idx < 576; idx += NTHREADS) {
        const int b = idx >> 6, cl = idx & 63;
        float s = 0.f;
#pragma unroll
        for (int q = 0; q < 8; ++q) s += part[(q * 9 + b) * 64 + cl];
        modv[(size_t)(l * 9 + b) * 6144 + cg * 64 + cl] = s + p.in[I_BMOD][l * 6144 + cg * 64 + cl];
    }
    __syncthreads();
}

DI void rope_item(const Ctx& c) {
    float2* tab = (float2*)(c.p->ws + WS_ROPE);
    for (int idx = c.tid; idx < 1024; idx += NTHREADS) {
        const int pos = idx >> 4, i = idx & 15;
        const float inv = 1.0f / powf(10000.0f, (float)i / 16.0f);
        const float ang = (float)pos * inv;
        float sn, cs; sincosf(ang, &sn, &cs);
        tab[idx] = make_float2(cs, sn);
    }
}

constexpr int PRO_PER_LAYER = 12592;
DI TItem transpose_decode(const Ctx& c, int r) {
    const Params& p = *c.p;
    const int l = r / PRO_PER_LAYER; r -= l * PRO_PER_LAYER;
    unsigned char* wgu = (unsigned char*)(p.ws + WS_WGU) + (size_t)l * 257 * 524288;
    unsigned char* wd = (unsigned char*)(p.ws + WS_WD) + (size_t)l * 257 * 262144;
    TItem t; t.f8 = true; t.ws = W_SCALE;
    if (r < 4096) { const int e = r >> 4, s = r & 15; t.W = p.in[I_WG] + (size_t)(l * 256 + e) * 262144; t.K = 1024; t.N = 256; t.kt = s >> 1; t.nt = s & 1; t.dst = wgu + (size_t)e * 524288; t.type = 2; }
    else if (r < 8192) { r -= 4096; const int e = r >> 4, s = r & 15; t.W = p.in[I_WU] + (size_t)(l * 256 + e) * 262144; t.K = 1024; t.N = 256; t.kt = s >> 1; t.nt = s & 1; t.dst = wgu + (size_t)e * 524288; t.type = 3; }
    else if (r < 12288) { r -= 8192; const int e = r >> 4, s = r & 15; t.W = p.in[I_WD] + (size_t)(l * 256 + e) * 262144; t.K = 256; t.N = 1024; t.kt = s >> 3; t.nt = s & 7; t.dst = wd + (size_t)e * 262144; t.type = 0; t.ws = WD_SCALE; }
    else {
        r -= 12288;
        if (r < 176) { t.W = p.in[I_WIN] + (size_t)l * 1024 * 2816; t.K = 1024; t.N = 2816; t.kt = r / 22; t.nt = r % 22; t.dst = (unsigned char*)(p.ws + WS_WIN) + (size_t)l * 2816 * 1024; t.type = 1; }
        else if (r < 240) { r -= 176; t.W = p.in[I_WOUT] + (size_t)l * 1048576; t.K = 1024; t.N = 1024; t.kt = r >> 3; t.nt = r & 7; t.dst = (unsigned char*)(p.ws + WS_WOUT) + (size_t)l * 1048576; t.type = 0; }
        else if (r < 256) { r -= 240; t.W = p.in[I_WR] + (size_t)l * 262144; t.K = 1024; t.N = 256; t.kt = r >> 1; t.nt = r & 1; t.dst = (bf16_t*)(p.ws + WS_WR) + (size_t)l * 262144; t.type = 0; t.f8 = false; }
        else if (r < 272) { r -= 256; t.W = p.in[I_SG] + (size_t)l * 262144; t.K = 1024; t.N = 256; t.kt = r >> 1; t.nt = r & 1; t.dst = wgu + (size_t)256 * 524288; t.type = 2; }
        else if (r < 288) { r -= 272; t.W = p.in[I_SU] + (size_t)l * 262144; t.K = 1024; t.N = 256; t.kt = r >> 1; t.nt = r & 1; t.dst = wgu + (size_t)256 * 524288; t.type = 3; }
        else { r -= 288; t.W = p.in[I_SD] + (size_t)l * 262144; t.K = 256; t.N = 1024; t.kt = r >> 3; t.nt = r & 7; t.dst = wd + (size_t)256 * 262144; t.type = 0; t.ws = WD_SCALE; }
    }
    return t;
}
template <class RMap>
DI void convert_pairs(const Ctx& c, int first, int stride, int n, RMap rmap) {
    if (n <= 0) return;
    const int half = c.tid >> 8;
    float va[4][2][8], vb[4][2][8];
    TItem ia = transpose_decode(c, rmap(first) + half), ib = ia;
    tload(c, va, ia);
    int i = 0;
    for (;;) {
        const bool m1 = i + 1 < n;
        if (m1) { ib = transpose_decode(c, rmap(first + (i + 1) * stride) + half); tload(c, vb, ib); }
        tfinish(c, va, ia);
        if (!m1) break;
        ++i;
        const bool m2 = i + 1 < n;
        if (m2) { ia = transpose_decode(c, rmap(first + (i + 1) * stride) + half); tload(c, va, ia); }
        tfinish(c, vb, ib);
        if (!m2) break;
        ++i;
    }
}
constexpr int PRO_EXPERT = 12288, PRO_SMALL = PRO_PER_LAYER - PRO_EXPERT;
constexpr int CONV_CHUNK = 8, CONV_NCHUNK = 2 * PRO_EXPERT / 2 / CONV_CHUNK;
DI int rmap_small(int q) { const int l = q / (PRO_SMALL / 2), s = q - l * (PRO_SMALL / 2); return l * PRO_PER_LAYER + PRO_EXPERT + 2 * s; }
DI int rmap_expert(int q) { const int l = q / (PRO_EXPERT / 2), s = q - l * (PRO_EXPERT / 2); return l * PRO_PER_LAYER + 2 * s; }
DI void phase_prologue(const Ctx& c) {
    for (int it = c.bid; it < 193; it += c.nblk) { if (it < 192) mod_item(c, it / 96, it % 96); else rope_item(c); }
    __syncthreads();
    constexpr int NP = PRO_SMALL;
    const int n = (NP > c.bid) ? (NP - c.bid + c.nblk - 1) / c.nblk : 0;
    convert_pairs(c, c.bid, c.nblk, n, [](int q) { return rmap_small(q); });
}

template <bool XBF>
DI void norm_mod_row(const float* __restrict__ xrow, const float* __restrict__ g, const float* __restrict__ sh, const float* __restrict__ sc, bf16_t* __restrict__ orow, unsigned char* __restrict__ o8, int lane) {
    float4 v[4]; float s = 0.f;
#pragma unroll
    for (int j = 0; j < 4; ++j) { if constexpr (XBF) { const f32x4 t4 = bf4_f32(((const u32x2*)xrow)[lane + 64 * j]); v[j] = make_float4(t4[0], t4[1], t4[2], t4[3]); } else v[j] = ((const float4*)xrow)[lane + 64 * j]; s += (v[j].x * v[j].x + v[j].y * v[j].y) + (v[j].z * v[j].z + v[j].w * v[j].w); }
    const float rstd = rsqrtf(wave_sum(s) * (1.f / DM) + EPSV);
#pragma unroll
    for (int j = 0; j < 4; ++j) {
        const float4 gg = ((const float4*)g)[lane + 64 * j], shh = ((const float4*)sh)[lane + 64 * j], scc = ((const float4*)sc)[lane + 64 * j];
        const float y0 = v[j].x * rstd * gg.x * (1.f + scc.x) + shh.x, y1 = v[j].y * rstd * gg.y * (1.f + scc.y) + shh.y;
        const float y2 = v[j].z * rstd * gg.z * (1.f + scc.z) + shh.z, y3 = v[j].w * rstd * gg.w * (1.f + scc.w) + shh.w;
        u32x2 o; o.x = pk2(y0, y1); o.y = pk2(y2, y3);
        if (orow) ((u32x2*)orow)[lane + 64 * j] = o;
        if (o8) ((unsigned*)o8)[lane + 64 * j] = pk4_fp8(y0, y1, y2, y3);
    }
}

DI void wrp_items(const Ctx& c) {
    const Params& p = *c.p;
    const float* modv = (const float*)(p.ws + WS_MOD);
    const bf16_t* wr = (const bf16_t*)(p.ws + WS_WR);
    bf16_t* wrp = (bf16_t*)(p.ws + WS_WRP);
    float* cb = (float*)(p.ws + WS_CB);
    const int lane = c.lane;
    for (int idx = c.bid * NWAVES + c.wid; idx < 2 * 9 * 256; idx += c.nblk * NWAVES) {
        const int l = idx / 2304, r = idx - l * 2304, b = r >> 8, e = r & 255;
        const float* g = p.in[I_GFFN] + l * 1024 + 16 * lane;
        const float* mv = modv + (size_t)(l * 9 + b) * 6144 + 3072 + 16 * lane;
        const bf16_t* src = wr + ((size_t)l * 256 + e) * 1024 + 16 * lane;
        const u32x4 w0 = *(const u32x4*)src, w1 = *(const u32x4*)(src + 8);
        float wv[16];
        wv[0] = bflo(w0.x); wv[1] = bfhi(w0.x); wv[2] = bflo(w0.y); wv[3] = bfhi(w0.y); wv[4] = bflo(w0.z); wv[5] = bfhi(w0.z); wv[6] = bflo(w0.w); wv[7] = bfhi(w0.w);
        wv[8] = bflo(w1.x); wv[9] = bfhi(w1.x); wv[10] = bflo(w1.y); wv[11] = bfhi(w1.y); wv[12] = bflo(w1.z); wv[13] = bfhi(w1.z); wv[14] = bflo(w1.w); wv[15] = bfhi(w1.w);
        float s = 0.f, o[16];
#pragma unroll
        for (int j = 0; j < 4; ++j) {
            const f32x4 gg = *(const f32x4*)(g + 4 * j), sh = *(const f32x4*)(mv + 4 * j), sc = *(const f32x4*)(mv + 1024 + 4 * j);
#pragma unroll
            for (int i = 0; i < 4; ++i) { o[4 * j + i] = wv[4 * j + i] * gg[i] * (1.f + sc[i]); s += sh[i] * wv[4 * j + i]; }
        }
        u32x4 o0, o1;
        o0.x = pk2(o[0], o[1]); o0.y = pk2(o[2], o[3]); o0.z = pk2(o[4], o[5]); o0.w = pk2(o[6], o[7]);
        o1.x = pk2(o[8], o[9]); o1.y = pk2(o[10], o[11]); o1.z = pk2(o[12], o[13]); o1.w = pk2(o[14], o[15]);
        bf16_t* dst = wrp + ((size_t)(l * 9 + b) * 256 + e) * 1024 + 16 * lane;
        *(u32x4*)dst = o0; *(u32x4*)(dst + 8) = o1;
        s = wave_sum(s);
        if (lane == 0) cb[(l * 9 + b) * 256 + e] = s;
    }
}
DI void norm_ffn_row(const bf16_t* __restrict__ xrow, const float* __restrict__ g, const float* __restrict__ sh, const float* __restrict__ sc, unsigned char* __restrict__ o8, float* __restrict__ rstd_out, int lane) {
    f32x4 v[4]; float s = 0.f;
#pragma unroll
    for (int j = 0; j < 4; ++j) { v[j] = bf4_f32(((const u32x2*)xrow)[lane + 64 * j]); s += (v[j][0] * v[j][0] + v[j][1] * v[j][1]) + (v[j][2] * v[j][2] + v[j][3] * v[j][3]); }
    const float rstd = rsqrtf(wave_sum(s) * (1.f / DM) + EPSV);
#pragma unroll
    for (int j = 0; j < 4; ++j) {
        const f32x4 gg = ((const f32x4*)g)[lane + 64 * j], shh = ((const f32x4*)sh)[lane + 64 * j], scc = ((const f32x4*)sc)[lane + 64 * j];
        const f32x4 y = v[j] * rstd * gg * (1.f + scc) + shh;
        ((unsigned*)o8)[lane + 64 * j] = pk4_fp8(y[0], y[1], y[2], y[3]);
    }
    if (lane == 0) *rstd_out = rstd;
}

DI void phase_norm(const Ctx& c, int l, int nrows, bool from_inputs, int which) {
    const Params& p = *c.p;
    const float* modv = (const float*)(p.ws + WS_MOD);
    const float* g = p.in[which ? I_GFFN : I_GMIX] + l * 1024;
    bf16_t* hbuf = (bf16_t*)(p.ws + WS_HBUF);
    const float* xbuf = (const float*)(p.ws + WS_XBUF);
    for (int t = c.bid * NWAVES + c.wid; t < nrows; t += c.nblk * NWAVES) {
        const float* xrow = from_inputs ? (t < TL ? p.in[I_X] + (size_t)t * DM : p.in[I_CTX] + (size_t)(t - TL) * DM) : (const float*)((const bf16_t*)xbuf + (size_t)t * DM);
        const int b = t < TL ? (t >> 12) : 8;
        const float* mv = modv + (size_t)(l * 9 + b) * 6144 + (which ? 3072 : 0);
        if (from_inputs) norm_mod_row<false>(xrow, g, mv, mv + 1024, (bf16_t*)nullptr,        (unsigned char*)(p.ws + (which ? WS_H8 : WS_HIN8)) + (size_t)t * DM, c.lane);
        else norm_mod_row<true>(xrow, g, mv, mv + 1024, hbuf + (size_t)t * DM, (unsigned char*)(p.ws + (which ? WS_H8 : WS_HIN8)) + (size_t)t * DM, c.lane);
    }
}

namespace g8 {
constexpr int BM = 256, BK = 64, HALF = 128, HTB = HALF * BK * 2;
DI int lds_byte(int r, int c) { const int st = (r >> 4) * 2 + (c >> 5), rr = r & 15, cc = c & 31, ob = rr * 64 + cc * 2; return st * 1024 + (ob ^ (((ob >> 9) & 1) << 5)); }
DI void stage_rc(int b, int& R, int& C) { const int st = b / 1024, sb = b % 1024, swz = sb ^ (((sb >> 9) & 1) << 5); R = (st >> 1) * 16 + swz / 64; C = (st & 1) * 32 + (swz % 64) / 2; }
DI int perm32(int rho) { const int n = rho >> 4, i = rho & 15; return 8 * (i >> 2) + 4 * n + (i & 3); }
struct Unit { int pm, pn, e, ti, ne, rbase, ix; };

typedef __attribute__((ext_vector_type(8))) int v8i_t;
typedef __attribute__((ext_vector_type(4))) int v4i_t;
template <class Epi, class Sched>
DI void gemm_phase(LAS unsigned char* lds, const int tid, const int RB, const Sched& S, const Epi& E) {
    constexpr bool F8 = Epi::F8;
    const int wid = __builtin_amdgcn_readfirstlane(tid >> 6), lane = tid & 63, wr = wid >> 2, wc = wid & 3, fr = lane & 15, fq = lane >> 4;
    const int nt = RB / 128;
    int Rr[2], Cc[2]; unsigned voffB[2], voffA[2];
#pragma unroll
    for (int i = 0; i < 2; ++i) { int R, C; stage_rc(tid * 16 + i * 8192, R, C); Rr[i] = R; Cc[i] = C * 2; const int Rb = Epi::PERM ? ((R & ~31) + perm32(R & 31)) : R; voffB[i] = (unsigned)(Rb * RB + C * 2); voffA[i] = (unsigned)(R * RB + C * 2); }
    constexpr bool GA = Sched::GATHER;
    int unit_scale = 0x7F7F7F7F; asm volatile("" : "+v"(unit_scale));
    const size_t kstep = (size_t)(BK * 2);
    const size_t hstep = (size_t)HALF * RB;
    const unsigned ldsw = (unsigned)wid * 1024u;
    const int aoff = F8 ? lds_byte(wr * 64 + fr, (fq >> 1) * 32 + (fq & 1) * 16) : lds_byte(wr * 64 + fr, fq * 8);
    const int boff = F8 ? lds_byte(wc * 32 + fr, (fq >> 1) * 32 + (fq & 1) * 16) : lds_byte(wc * 32 + fr, fq * 8);
#define G8_SA(b, h) (((b) * 2 + (h)) * HTB)
#define G8_SB(b, h) ((4 + (b) * 2 + (h)) * HTB)
#define G8_STAGE_B(bufoff, gbase) do { _Pragma("unroll") for (int _i = 0; _i < 2; ++_i) \
        __builtin_amdgcn_global_load_lds((const unsigned*)((const char*)(gbase) + voffB[_i]), (LAS unsigned*)(lds + (bufoff) + ldsw + _i * 8192), 16, 0, 0); } while (0)
#define G8_STAGE_A(bufoff, uptr, koff, VO, h) do { _Pragma("unroll") for (int _i = 0; _i < 2; ++_i) { \
        const char* _s = GA ? (Ab + (koff) + VO[h][_i]) : ((uptr) + (koff) + ((h) ? hstep : (size_t)0) + voffA[_i]); \
        __builtin_amdgcn_global_load_lds((const unsigned*)_s, (LAS unsigned*)(lds + (bufoff) + ldsw + _i * 8192), 16, 0, 0); } } while (0)
#define G8_LDA(dst, b, h) do { _Pragma("unroll") for (int m = 0; m < 4; ++m) { \
        if constexpr (F8) { dst##8[m].lo = *(const LAS v4i_t*)(lds + G8_SA(b, h) + aoff + m * 2048); dst##8[m].hi = *(const LAS v4i_t*)(lds + G8_SA(b, h) + aoff + m * 2048 + 16); } \
        else { _Pragma("unroll") for (int k = 0; k < 2; ++k) dst[m][k] = *(const LAS bf16x8*)(lds + G8_SA(b, h) + aoff + m * 2048 + k * 1024); } } } while (0)
#define G8_LDB(dst, b, h) do { _Pragma("unroll") for (int n = 0; n < 2; ++n) { \
        if constexpr (F8) { dst##8[n].lo = *(const LAS v4i_t*)(lds + G8_SB(b, h) + boff + n * 2048); dst##8[n].hi = *(const LAS v4i_t*)(lds + G8_SB(b, h) + boff + n * 2048 + 16); } \
        else { _Pragma("unroll") for (int k = 0; k < 2; ++k) dst[n][k] = *(const LAS bf16x8*)(lds + G8_SB(b, h) + boff + n * 2048 + k * 1024); } } } while (0)
#define G8_MMA(ai, bj, At, Bt) do { __builtin_amdgcn_s_setprio(1); _Pragma("unroll") for (int m = 0; m < 4; ++m) _Pragma("unroll") for (int n = 0; n < 2; ++n) { \
        if constexpr (F8) asm volatile("v_mfma_scale_f32_16x16x128_f8f6f4 %0, %1, %2, %0, %3, %3 op_sel_hi:[0,0,0]" : "+v"(acc[ai][bj][m][n]) : "v"(Bt##8[n]), "v"(At##8[m]), "v"(unit_scale)); \
        else { _Pragma("unroll") for (int k = 0; k < 2; ++k) acc[ai][bj][m][n] = __builtin_amdgcn_mfma_f32_16x16x32_bf16(Bt[n][k], At[m][k], acc[ai][bj][m][n], 0, 0, 0); } } \
        __builtin_amdgcn_s_setprio(0); } while (0)
#define G8_WAIT_V(n) asm volatile("s_waitcnt vmcnt(" #n ")" ::: "memory")
#define G8_WAIT_L(n) asm volatile("s_waitcnt lgkmcnt(" #n ")" ::: "memory")
#define G8_BAR __builtin_amdgcn_s_barrier()
#define G8_SCHED __builtin_amdgcn_sched_barrier(0)
    Unit cur, nxt; int ui = 0;
    if (!S.next(0, cur)) return;
    f32x4 acc[2][2][4][2];
#pragma unroll
    for (int a = 0; a < 2; ++a)
#pragma unroll
        for (int b = 0; b < 2; ++b)
#pragma unroll
            for (int m = 0; m < 4; ++m)
#pragma unroll
                for (int n = 0; n < 2; ++n) acc[a][b][m][n] = (f32x4){0.f, 0.f, 0.f, 0.f};
    if constexpr (F8) asm volatile("s_nop 3" ::: "memory");
    bf16x8 At[F8 ? 1 : 4][2], B0[F8 ? 1 : 2][2], B1[F8 ? 1 : 2][2];
    v8i_t At8[F8 ? 4 : 1], B08[F8 ? 2 : 1], B18[F8 ? 2 : 1];
    unsigned vAc[2][2], vAn[2][2];
#pragma unroll
    for (int h = 0; h < 2; ++h)
#pragma unroll
        for (int i = 0; i < 2; ++i) vAc[h][i] = GA ? (S.a_off(cur, h * 128 + Rr[i]) + (unsigned)Cc[i]) : 0u;
    const char* Ab = S.a_base();
    const char* cA = GA ? Ab : S.a_ptr(cur);
    const char* cB = S.b_base(cur);
    G8_STAGE_B(G8_SB(0, 0), cB); G8_STAGE_A(G8_SA(0, 0), cA, 0, vAc, 0); G8_STAGE_B(G8_SB(0, 1), cB + hstep); G8_STAGE_A(G8_SA(0, 1), cA, 0, vAc, 1);
    if (wr == 1) G8_BAR;
    G8_WAIT_V(4); G8_BAR;
    G8_STAGE_B(G8_SB(1, 0), cB + kstep); G8_STAGE_A(G8_SA(1, 0), cA, kstep, vAc, 0); G8_STAGE_B(G8_SB(1, 1), cB + hstep + kstep);
    G8_WAIT_V(6); G8_BAR;
    for (;;) {
        const bool has_next = S.next(ui + 1, nxt);
        const char* nB = has_next ? S.b_base(nxt) : cB;
        const char* nA = GA ? Ab : (has_next ? S.a_ptr(nxt) : cA);
#pragma unroll
        for (int h = 0; h < 2; ++h)
#pragma unroll
            for (int i = 0; i < 2; ++i) vAn[h][i] = GA ? (has_next ? (S.a_off(nxt, h * 128 + Rr[i]) + (unsigned)Cc[i]) : vAc[h][i]) : 0u;
#pragma unroll 1
        for (int t = 0; t < nt; t += 2) {
            const bool last = (t == nt - 2);
            const size_t ka1 = (size_t)(t + 1) * kstep;
            const size_t ka2 = last ? (size_t)0 : (size_t)(t + 2) * kstep;
            const size_t ka3 = ka2 + kstep;
            const char* b2 = last ? nB : cB + (size_t)(t + 2) * kstep;
            const char* b3 = b2 + kstep;
            unsigned v2[2][2];
#pragma unroll
            for (int h = 0; h < 2; ++h)
#pragma unroll
                for (int i = 0; i < 2; ++i) v2[h][i] = GA ? (last ? vAn[h][i] : vAc[h][i]) : 0u;
            const char* a2p = last ? nA : cA;
            G8_LDB(B0, 0, 0); G8_SCHED; G8_LDA(At, 0, 0); G8_STAGE_A(G8_SA(1, 1), cA, ka1, vAc, 1);
            G8_WAIT_L(8); G8_BAR; G8_WAIT_L(0); G8_MMA(0, 0, At, B0); G8_BAR; G8_SCHED;
            G8_LDB(B1, 0, 1); G8_STAGE_B(G8_SB(0, 0), b2);
            G8_BAR; G8_WAIT_L(0); G8_MMA(0, 1, At, B1); G8_BAR;
            G8_LDA(At, 0, 1); G8_STAGE_A(G8_SA(0, 0), a2p, ka2, v2, 0);
            G8_BAR; G8_WAIT_L(0); G8_MMA(1, 0, At, B0); G8_BAR; G8_SCHED;
            G8_STAGE_B(G8_SB(0, 1), b2 + hstep);
            G8_WAIT_V(6); G8_BAR; G8_MMA(1, 1, At, B1); G8_BAR;
            G8_LDB(B0, 1, 0); G8_SCHED; G8_LDA(At, 1, 0); G8_STAGE_A(G8_SA(0, 1), a2p, ka2, v2, 1);
            G8_WAIT_L(8); G8_BAR; G8_WAIT_L(0); G8_MMA(0, 0, At, B0); G8_BAR; G8_SCHED;
            G8_LDB(B1, 1, 1); G8_STAGE_B(G8_SB(1, 0), b3);
            G8_BAR; G8_WAIT_L(0); G8_MMA(0, 1, At, B1); G8_BAR;
            G8_LDA(At, 1, 1); G8_STAGE_A(G8_SA(1, 0), a2p, ka3, v2, 0);
            G8_BAR; G8_WAIT_L(0); G8_MMA(1, 0, At, B0); G8_BAR; G8_SCHED;
            G8_STAGE_B(G8_SB(1, 1), b3 + hstep);
            G8_WAIT_V(6); G8_BAR; G8_MMA(1, 1, At, B1); G8_BAR;
        }
        if constexpr (F8) asm volatile("s_nop 15\n\ts_nop 15" ::: "memory");
        E(acc, cur, wr, wc, fr, fq);
        if (!has_next) break;
#pragma unroll
        for (int a = 0; a < 2; ++a)
#pragma unroll
            for (int b = 0; b < 2; ++b)
#pragma unroll
                for (int m = 0; m < 4; ++m)
#pragma unroll
                    for (int n = 0; n < 2; ++n) acc[a][b][m][n] = (f32x4){0.f, 0.f, 0.f, 0.f};
        if constexpr (F8) asm volatile("s_nop 3" ::: "memory");
        cur = nxt; cB = nB; cA = nA; ++ui;
#pragma unroll
        for (int h = 0; h < 2; ++h)
#pragma unroll
            for (int i = 0; i < 2; ++i) vAc[h][i] = vAn[h][i];
    }
    G8_WAIT_V(0);
    if (wr == 0) G8_BAR;
    G8_BAR;
#undef G8_SA
#undef G8_SB
#undef G8_STAGE_A
#undef G8_STAGE_B
#undef G8_LDA
#undef G8_LDB
#undef G8_MMA
#undef G8_WAIT_V
#undef G8_WAIT_L
#undef G8_BAR
#undef G8_SCHED
}

struct DenseSched {
    static constexpr bool GATHER = false;
    int nM, nN, nwg, G, c, RB; const char* A; const char* Bt;
    DI void init(const void* A_, const void* Bt_, int M, int N, int RB_, int G_, int c_) { A = (const char*)A_; Bt = (const char*)Bt_; nM = M / BM; nN = N / BM; nwg = nM * nN; G = G_; c = c_; RB = RB_; }
    DI bool next(int i, Unit& u) const {
        const int L = i * G + c; if (L >= nwg) return false;
        int wgid = L; { const int q = nwg / 8, r = nwg % 8, xcd = wgid % 8, off = wgid / 8; wgid = (xcd < r ? xcd * (q + 1) : r * (q + 1) + (xcd - r) * q) + off; }
        const int nig = 8 * nN, gid = wgid / nig, fm = gid * 8, gsz = (nM - fm) < 8 ? (nM - fm) : 8;
        u.pm = fm + ((wgid % nig) % gsz); u.pn = (wgid % nig) / gsz; u.e = 0; u.ti = 0; u.ne = 0; u.rbase = 0; u.ix = 0; return true;
    }
    DI const char* a_base() const { return A; }
    DI unsigned a_off(const Unit&, int) const { return 0u; }
    DI const char* a_ptr(const Unit& u) const { return A + (size_t)u.pm * BM * RB; }
    DI const char* b_base(const Unit& u) const { return Bt + (size_t)u.pn * BM * RB; }
};
}
struct EpiInproj {
    static constexpr bool F8 = true;
    static constexpr bool PERM = true;
    const LAS float2* rope;
    unsigned char* q8; unsigned char* k8; unsigned char* vt8;
    LAS unsigned char* stg; int tid;
    static DI bool isv_cb(int cb) { const int kv = cb - 16; return (cb >= 16) && ((kv == 2) || (kv == 3) || (kv >= 8 && kv < 12) || (kv >= 20)); }
    DI void operator()(const f32x4 (&acc)[2][2][4][2], const g8::Unit& u, int wr, int wc, int fr, int fq) const {
        const bool lat = (u.pm * 256 < TL);
#pragma unroll
        for (int bj = 0; bj < 2; ++bj) {
            const int col0 = u.pn * 256 + bj * 128 + wc * 32 + 8 * fq;
            const int cb = col0 >> 6, kv = cb - 16;
            if (!isv_cb(cb)) continue;
            const float scale = 1.0f / W_SCALE;
            const int vrow0 = (kv < 4 ? (kv - 2) * 64 : (kv < 12 ? 128 + (kv - 8) * 64 : 384 + (kv - 20) * 64)) + (col0 & 63);
            const int pos = 32 * ((fr >> 2) & 1) + 4 * (((fr >> 3) << 2) | (fr & 3));
#pragma unroll
            for (int ai = 0; ai < 2; ++ai) {
                const int t0 = u.pm * 256 + ai * 128 + wr * 64;
                const int b = t0 < TL ? (t0 >> 12) : ((t0 - TL) >> 8);
                const int tile = t0 < TL ? ((t0 & 4095) >> 6) : (64 + (((t0 - TL) & 255) >> 6));
                unsigned char* base = vt8 + (size_t)(b * 68 + tile) * VT_TILE + (size_t)vrow0 * 64 + pos;
#pragma unroll
                for (int n = 0; n < 2; ++n)
#pragma unroll
                    for (int j = 0; j < 4; ++j)
                        *(unsigned*)(base + (4 * n + j) * 64) = pk4_fp8(acc[ai][bj][0][n][j] * scale, acc[ai][bj][1][n][j] * scale, acc[ai][bj][2][n][j] * scale, acc[ai][bj][3][n][j] * scale);
            }
        }
        if (!((u.pn < 6) || (u.pn == 7) || (u.pn == 8))) return;
        constexpr int RS = 272;
        if (wr == 0) __builtin_amdgcn_s_barrier();
#pragma unroll
        for (int ai = 0; ai < 2; ++ai)
#pragma unroll
            for (int mh = 0; mh < 2; ++mh) {
#pragma unroll
                for (int bj = 0; bj < 2; ++bj) {
                    const int col0 = u.pn * 256 + bj * 128 + wc * 32 + 8 * fq;
                    const int cb = col0 >> 6, i0 = (col0 & 63) >> 1;
                    if (isv_cb(cb)) continue;
                    const bool isq = cb < 16;
                    const bool roped = ((cb < 4) || (cb >= 8 && cb < 16) || (cb == 16) || (cb == 17) || (cb >= 28 && cb < 36)) && lat;
                    const float scale = (isq ? QSCALE : 1.0f) * (1.0f / W_SCALE);
#pragma unroll
                    for (int mm = 0; mm < 2; ++mm) {
                        const int m = mh * 2 + mm;
                        const int t = u.pm * 256 + ai * 128 + wr * 64 + m * 16 + fr;
                        f32x4 v0 = acc[ai][bj][m][0], v1 = acc[ai][bj][m][1];
                        if (roped) {
                            const int s = t & 4095;
                            const int pos = (i0 < 16) ? (s >> 6) : (s & 63);
                            const f32x4 ca = *(const LAS f32x4*)(rope + pos * 16 + (i0 & 15)), cb2 = *(const LAS f32x4*)(rope + pos * 16 + (i0 & 15) + 2);
                            f32x4 o0, o1;
                            o0[0] = v0[0] * ca[0] - v0[1] * ca[1]; o0[1] = v0[1] * ca[0] + v0[0] * ca[1];
                            o0[2] = v0[2] * ca[2] - v0[3] * ca[3]; o0[3] = v0[3] * ca[2] + v0[2] * ca[3];
                            o1[0] = v1[0] * cb2[0] - v1[1] * cb2[1]; o1[1] = v1[1] * cb2[0] + v1[0] * cb2[1];
                            o1[2] = v1[2] * cb2[2] - v1[3] * cb2[3]; o1[3] = v1[3] * cb2[2] + v1[2] * cb2[3];
                            v0 = o0; v1 = o1;
                        }
                        v0 *= scale; v1 *= scale;
                        u32x2 w; w.x = pk4_fp8(v0[0], v0[1], v0[2], v0[3]); w.y = pk4_fp8(v1[0], v1[1], v1[2], v1[3]);
                        *(LAS u32x2*)(stg + (wr * 32 + mm * 16 + fr) * RS + bj * 128 + wc * 32 + 8 * fq) = w;
                    }
                }
                asm volatile("s_waitcnt lgkmcnt(0)" ::: "memory"); __builtin_amdgcn_s_barrier(); asm volatile("" ::: "memory");
#pragma unroll
                for (int k = 0; k < 2; ++k) {
                    const int idx = tid + k * 512, rl = idx >> 4, pc = idx & 15;
                    const int cb = u.pn * 4 + (pc >> 2);
                    if (!isv_cb(cb)) {
                        const u32x4 v = *(const LAS u32x4*)(stg + rl * RS + pc * 16);
                        const int t = u.pm * 256 + ai * 128 + (rl >> 5) * 64 + mh * 32 + (rl & 31);
                        const int kv = cb - 16, ki = kv < 2 ? kv : (kv < 8 ? kv - 2 : kv - 6);
                        unsigned char* dst = (cb < 16) ? q8 + (size_t)t * 1024 + cb * 64 + (pc & 3) * 16 : k8 + (size_t)t * 1024 + ki * 64 + (pc & 3) * 16;
                        *(u32x4*)dst = v;
                    }
                }
                asm volatile("s_waitcnt lgkmcnt(0)" ::: "memory"); __builtin_amdgcn_s_barrier(); asm volatile("" ::: "memory");
            }
        if (wr == 1) __builtin_amdgcn_s_barrier();
    }
};
DI void phase_inproj(const Ctx& c, int l) {
    const Params& p = *c.p;
    g8::DenseSched S; S.init(p.ws + WS_HIN8, (const unsigned char*)(p.ws + WS_WIN) + (size_t)l * 2816 * 1024, TT, INC, DM, c.nblk, c.bid);
    {
        const float* rg = (const float*)(p.ws + WS_ROPE);
        LAS float* rl = (LAS float*)(c.smem + LDS_MAIN + 256);
        for (int i = c.tid; i < 2048; i += NTHREADS) rl[i] = rg[i];
        __syncthreads();
    }
    EpiInproj E; E.rope = (const LAS float2*)(c.smem + LDS_MAIN + 256); E.stg = (LAS unsigned char*)c.smem + LDS_MAIN + 256 + 8192; E.tid = c.tid;
    E.q8 = (unsigned char*)(p.ws + WS_Q8); E.k8 = (unsigned char*)(p.ws + WS_K8); E.vt8 = (unsigned char*)(p.ws + WS_VT8);
    g8::gemm_phase((LAS unsigned char*)c.smem, c.tid, DM, S, E);
}

struct EpiOutproj {
    static constexpr bool F8 = true;
    static constexpr bool PERM = false;
    float* xbuf; const float* modv; const float* x_in; const float* ctx_in; int l;
    DI void operator()(const f32x4 (&acc)[2][2][4][2], const g8::Unit& u, int wr, int wc, int fr, int fq) const {
        const int b = (u.pm * 256) < TL ? ((u.pm * 256) >> 12) : 8;
        const int col0 = u.pn * 256 + wc * 32 + 4 * fq;
        const float* gate = modv + (size_t)(l * 9 + b) * 6144 + 2048 + col0;
        f32x4 g[2][2];
#pragma unroll
        for (int bj = 0; bj < 2; ++bj)
#pragma unroll
            for (int n = 0; n < 2; ++n) g[bj][n] = *(const f32x4*)(gate + bj * 128 + n * 16) * (1.0f / (MIX_SCALE * W_SCALE));
#pragma unroll
        for (int ai = 0; ai < 2; ++ai)
#pragma unroll
            for (int m = 0; m < 4; ++m) {
                const int t = u.pm * 256 + ai * 128 + wr * 64 + m * 16 + fr;
                const float* xin = (t < TL ? x_in + (size_t)t * DM : ctx_in + (size_t)(t - TL) * DM) + col0;
                bf16_t* xo = (bf16_t*)xbuf + (size_t)t * DM + col0;
#pragma unroll
                for (int bj = 0; bj < 2; ++bj)
#pragma unroll
                    for (int n = 0; n < 2; ++n) {
                        const f32x4 x = (l == 0) ? *(const f32x4*)(xin + bj * 128 + n * 16) : bf4_f32(*(const u32x2*)(xo + bj * 128 + n * 16));
                        *(u32x2*)(xo + bj * 128 + n * 16) = f32_bf4(x + g[bj][n] * acc[ai][bj][m][n]);
                    }
            }
    }
};
DI void phase_outproj(const Ctx& c, int l, int nrows) {
    const Params& p = *c.p;
    g8::DenseSched S; S.init(p.ws + WS_MIX, (const unsigned char*)(p.ws + WS_WOUT) + (size_t)l * 1048576, nrows, DM, DM, c.nblk, c.bid);
    EpiOutproj E; E.xbuf = (float*)(p.ws + WS_XBUF); E.modv = (const float*)(p.ws + WS_MOD); E.x_in = p.in[I_X]; E.ctx_in = p.in[I_CTX]; E.l = l;
    g8::gemm_phase((LAS unsigned char*)c.smem, c.tid, DM, S, E);
}

struct EpiRouter {
    static constexpr bool F8 = false;
    static constexpr bool PERM = false;
    float* logit;
    DI void operator()(const f32x4 (&acc)[2][2][4][2], const g8::Unit& u, int wr, int wc, int fr, int fq) const {
#pragma unroll
        for (int ai = 0; ai < 2; ++ai)
#pragma unroll
            for (int m = 0; m < 4; ++m) {
                const int t = u.pm * 256 + ai * 128 + wr * 64 + m * 16 + fr;
#pragma unroll
                for (int bj = 0; bj < 2; ++bj)
#pragma unroll
                    for (int n = 0; n < 2; ++n) *(f32x4*)(logit + (size_t)t * NE + bj * 128 + wc * 32 + n * 16 + 4 * fq) = acc[ai][bj][m][n];
            }
    }
};
DI void phase_router(const Ctx& c, int l, int nrows) {
    const Params& p = *c.p;
    g8::DenseSched S; S.init(p.ws + WS_HBUF, (const bf16_t*)(p.ws + WS_WR) + (size_t)l * 262144, nrows, NE, DM * 2, c.nblk, c.bid);
    EpiRouter E; E.logit = (float*)(p.ws + WS_LOGIT);
    g8::gemm_phase((LAS unsigned char*)c.smem, c.tid, DM * 2, S, E);
}

struct RouterSched : g8::DenseSched {
    DI const char* b_base(const g8::Unit& u) const { const int b = (u.pm * 256) < TL ? ((u.pm * 256) >> 12) : 8; return Bt + (size_t)b * 524288 + (size_t)u.pn * 256 * RB; }
};
DI void phase_norm_router(const Ctx& c, int l, int nrows) {
    const Params& p = *c.p;
    {
        RouterSched S; S.init(p.ws + WS_XBUF, (const bf16_t*)(p.ws + WS_WRP) + (size_t)l * 9 * 262144, nrows, NE, DM * 2, c.nblk, c.bid);
        EpiRouter E; E.logit = (float*)(p.ws + WS_LOGIT);
        g8::gemm_phase((LAS unsigned char*)c.smem, c.tid, DM * 2, S, E);
    }
    int* ctr = (int*)(p.ws + WS_ROWCTR) + l * 64;
    LAS int* slot = (LAS int*)(c.smem + LDS_MAIN + 64);
    const float* modv = (const float*)(p.ws + WS_MOD);
    const float* g = p.in[I_GFFN] + l * 1024;
    const bf16_t* xbuf = (const bf16_t*)(p.ws + WS_XBUF);
    unsigned char* h8 = (unsigned char*)(p.ws + WS_H8);
    float* rstd = (float*)(p.ws + WS_RSTD);
    for (;;) {
        if (c.tid == 0) slot[0] = atomicAdd(ctr, 64);
        __syncthreads();
        const int base = slot[0];
        __syncthreads();
        if (base >= nrows) break;
#pragma unroll 1
        for (int i = 0; i < 8; ++i) {
            const int t = base + c.wid * 8 + i;
            if (t < nrows) {
                const int b = t < TL ? (t >> 12) : 8;
                const float* mv = modv + (size_t)(l * 9 + b) * 6144 + 3072;
                norm_ffn_row(xbuf + (size_t)t * DM, g, mv, mv + 1024, h8 + (size_t)t * DM, rstd + t, c.lane);
            }
        }
    }
}

DI void phase_route(const Ctx& c, int l, int nrows) {
    const Params& p = *c.p;
    const float* logit = (const float*)(p.ws + WS_LOGIT);
    const float* rb = p.in[I_RB] + l * NE;
    int* cnt = (int*)(p.ws + WS_CNT) + l * CNT_LAYER;
    int* list = (int*)(p.ws + WS_LIST);
    float* slotw = (float*)(p.ws + WS_SLOTW);
    int* einfo = (int*)(p.ws + WS_EINFO);
    LAS int* lcnt = (LAS int*)c.smem;
    LAS int* rec = (LAS int*)(c.smem + 1024);
    LAS float* recw = (LAS float*)(c.smem + 1024 + 8 * 24 * 8 * 4);
    constexpr int RMAX = 24;
    const int lane = c.lane;
    if (c.tid < 256) lcnt[c.tid] = 0;
    __syncthreads();
    const f32x4 bias = ((const f32x4*)rb)[lane];
    const float NINF = -__builtin_inff();
    int it = 0;
    const float* rstd = (const float*)(p.ws + WS_RSTD);
    const float* cbl = (const float*)(p.ws + WS_CB) + l * 9 * 256;
    for (int t = c.bid * NWAVES + c.wid; t < nrows; t += c.nblk * NWAVES, ++it) {
        const int bb = t < TL ? (t >> 12) : 8;
        const f32x4 lg = ((const f32x4*)(logit + (size_t)t * NE))[lane] * rstd[t] + ((const f32x4*)(cbl + bb * 256))[lane];
        const float s0 = 1.f / (1.f + __expf(-lg.x)), s1 = 1.f / (1.f + __expf(-lg.y)), s2 = 1.f / (1.f + __expf(-lg.z)), s3 = 1.f / (1.f + __expf(-lg.w));
        float m0 = s0 + bias.x, m1 = s1 + bias.y, m2 = s2 + bias.z, m3 = s3 + bias.w;
        float a1 = fmaxf(m0, m1), a2 = fminf(m0, m1);
        { const float b1 = fmaxf(m2, m3), b2 = fminf(m2, m3); const float n1 = fmaxf(a1, b1), n2 = fmaxf(fminf(a1, b1), fmaxf(a2, b2)); a1 = n1; a2 = n2; }
        { const float b1 = DPPF(a1, DPP_XOR1), b2 = DPPF(a2, DPP_XOR1); const float n1 = fmaxf(a1, b1), n2 = fmaxf(fminf(a1, b1), fmaxf(a2, b2)); a1 = n1; a2 = n2; }
        { const float b1 = DPPF(a1, DPP_XOR2), b2 = DPPF(a2, DPP_XOR2); const float n1 = fmaxf(a1, b1), n2 = fmaxf(fminf(a1, b1), fmaxf(a2, b2)); a1 = n1; a2 = n2; }
        { const float b1 = DPPF(a1, DPP_HMIR), b2 = DPPF(a2, DPP_HMIR); const float n1 = fmaxf(a1, b1), n2 = fmaxf(fminf(a1, b1), fmaxf(a2, b2)); a1 = n1; a2 = n2; }
        const float gs = a1 + a2;
        const int g = lane >> 3;
        int rank = 0;
#pragma unroll
        for (int j = 0; j < 8; ++j) { const float gj = rdlane_f(gs, j * 8); rank += ((gj > gs) || (gj == gs && j < g)) ? 1 : 0; }
        if (rank >= 4) { m0 = NINF; m1 = NINF; m2 = NINF; m3 = NINF; }
        float wsum = 0.f, my_w = 0.f; int my_e = 0;
#pragma unroll
        for (int k = 0; k < 8; ++k) {
            float bv = m0, bs = s0; int bi = 0;
            if (m1 > bv) { bv = m1; bs = s1; bi = 1; }
            if (m2 > bv) { bv = m2; bs = s2; bi = 2; }
            if (m3 > bv) { bv = m3; bs = s3; bi = 3; }
            float v = bv;
            v = fmaxf(v, DPPF(v, DPP_XOR1)); v = fmaxf(v, DPPF(v, DPP_XOR2)); v = fmaxf(v, DPPF(v, DPP_HMIR)); v = fmaxf(v, DPPF(v, DPP_MIR));
            const float wmx = fmaxf(fmaxf(rdlane_f(v, 0), rdlane_f(v, 16)), fmaxf(rdlane_f(v, 32), rdlane_f(v, 48)));
            const unsigned long long bal = __ballot(bv == wmx);
            const int win = __ffsll((long long)bal) - 1;
            const int sub = __builtin_amdgcn_readlane(bi, win);
            const float sw = rdlane_f(bs, win);
            if (lane == win) { if (sub == 0) m0 = NINF; else if (sub == 1) m1 = NINF; else if (sub == 2) m2 = NINF; else m3 = NINF; }
            wsum += sw;
            if (lane == k) { my_e = win * 4 + sub; my_w = sw; }
        }
        if (lane < 8 && it < RMAX) {
            const int lp = __hip_atomic_fetch_add(&lcnt[my_e], 1, __ATOMIC_RELAXED, __HIP_MEMORY_SCOPE_WORKGROUP);
            rec[(c.wid * RMAX + it) * 8 + lane] = (my_e << 16) | lp;
            recw[(c.wid * RMAX + it) * 8 + lane] = my_w / wsum * 2.5f;
        }
    }
    __syncthreads();
    if (c.tid < 256) { const int n = lcnt[c.tid]; lcnt[c.tid] = (n > 0) ? atomicAdd(&cnt[c.tid * CNT_STRIDE], n) : 0; }
    __syncthreads();
    it = 0;
    for (int t = c.bid * NWAVES + c.wid; t < nrows; t += c.nblk * NWAVES, ++it) {
        if (lane < 8 && it < RMAX) {
            const int r = rec[(c.wid * RMAX + it) * 8 + lane];
            const int e = r >> 16, pos = lcnt[e] + (r & 0xffff);
            list[(size_t)e * TT + pos] = t;
            slotw[(size_t)t * 8 + lane] = recw[(c.wid * RMAX + it) * 8 + lane];
            einfo[(size_t)t * 8 + lane] = (e << 16) | pos;
        }
    }
}

DI void moe_setup(const Ctx& c, int l, int nrows) {
    const int* cnt = (const int*)(c.p->ws + WS_CNT) + l * CNT_LAYER;
    LAS int* tstart = (LAS int*)(c.smem + LDS_MAIN + 1024);
    LAS int* roff = (LAS int*)(c.smem + LDS_MAIN + 2064);
    LAS int* cntl = (LAS int*)(c.smem + LDS_MAIN + 3104);
    LAS int* wtot = (LAS int*)(c.smem + LDS_MAIN + 4160);
    const int n = (c.tid < 256) ? cnt[c.tid * CNT_STRIDE] : 0;
    const int nt = (n + 255) >> 8;
    int vt = nt, vr = n;
    vt += DPPI(vt, DPP_SHR(1)); vr += DPPI(vr, DPP_SHR(1)); vt += DPPI(vt, DPP_SHR(2)); vr += DPPI(vr, DPP_SHR(2));
    vt += DPPI(vt, DPP_SHR(4)); vr += DPPI(vr, DPP_SHR(4)); vt += DPPI(vt, DPP_SHR(8)); vr += DPPI(vr, DPP_SHR(8));
    { const int t0 = __builtin_amdgcn_readlane(vt, 15), t1 = __builtin_amdgcn_readlane(vt, 31), t2 = __builtin_amdgcn_readlane(vt, 47);
      const int r0 = __builtin_amdgcn_readlane(vr, 15), r1 = __builtin_amdgcn_readlane(vr, 31), r2 = __builtin_amdgcn_readlane(vr, 47);
      const int row = c.lane >> 4;
      vt += (row > 0 ? t0 : 0) + (row > 1 ? t1 : 0) + (row > 2 ? t2 : 0); vr += (row > 0 ? r0 : 0) + (row > 1 ? r1 : 0) + (row > 2 ? r2 : 0); }
    if (c.lane == 63 && c.wid < 4) { wtot[c.wid] = vt; wtot[4 + c.wid] = vr; }
    __syncthreads();
    if (c.tid < 256) {
        int pt = 0, pr = 0;
        for (int w = 0; w < c.wid; ++w) { pt += wtot[w]; pr += wtot[4 + w]; }
        tstart[c.tid] = pt + vt - nt; roff[c.tid] = pr + vr - n; cntl[c.tid] = n;
        if (c.tid == 255) { tstart[256] = pt + vt; roff[256] = pr + vr; tstart[257] = pt + vt + nrows / 256; roff[257] = pr + vr + nrows; cntl[256] = nrows; }
    }
    __syncthreads();
}

constexpr int MOE_MAXU = 32, MOE_MAXG = 12;
template <bool GATHER_>
struct MoeSched {
    static constexpr bool GATHER = GATHER_;
    const LAS int* utab; const LAS unsigned* toks; int nmy;
    const char* A; const char* W; size_t wstride; int RB;
    DI bool next(int i, g8::Unit& u) const {
        if (i >= nmy) return false;
        const LAS int* e = utab + i * 8;
        u.pn = __builtin_amdgcn_readfirstlane(e[0]); u.e = __builtin_amdgcn_readfirstlane(e[1]); u.ti = __builtin_amdgcn_readfirstlane(e[2]);
        u.ne = __builtin_amdgcn_readfirstlane(e[3]); u.rbase = __builtin_amdgcn_readfirstlane(e[4]); u.pm = __builtin_amdgcn_readfirstlane(e[5]); u.ix = i;
        return true;
    }
    DI const char* a_base() const { return A; }
    DI unsigned a_off(const g8::Unit& u, int row) const { return toks[u.ix * 256 + row]; }
    DI const char* a_ptr(const g8::Unit& u) const { return A + (size_t)u.rbase * RB; }
    DI const char* b_base(const g8::Unit& u) const { return W + (size_t)u.e * wstride + (size_t)u.pn * 256 * RB; }
};
DI int moe_units(const Ctx& c, int NB, bool gather, const int* list, int rowbytes) {
    const LAS int* tstart = (const LAS int*)(c.smem + LDS_MAIN + 1024);
    const LAS int* roff = (const LAS int*)(c.smem + LDS_MAIN + 2064);
    const LAS int* cntl = (const LAS int*)(c.smem + LDS_MAIN + 3104);
    LAS int* utab = (LAS int*)(c.smem + LDS_MAIN + 4224);
    LAS unsigned* toks = (LAS unsigned*)(c.smem + LDS_MAIN + 8192);
    const int nunits = tstart[257] * NB;
    int nmy = (nunits > c.bid) ? (nunits - c.bid + c.nblk - 1) / c.nblk : 0;
    { const int cap = gather ? MOE_MAXG : MOE_MAXU; nmy = nmy > cap ? cap : nmy; }
    if (c.tid < nmy) {
        const int L = c.tid * c.nblk + c.bid;
        int w = L; { const int q = nunits / 8, r = nunits % 8, xcd = w % 8, off = w / 8; w = (xcd < r ? xcd * (q + 1) : r * (q + 1) + (xcd - r) * q) + off; }
        const int tile = w / NB;
        int lo = 0, hi = 256;
        while (lo < hi) { const int mid = (lo + hi + 1) >> 1; if (tstart[mid] <= tile) lo = mid; else hi = mid - 1; }
        const int ti = tile - tstart[lo];
        LAS int* e = utab + c.tid * 8;
        e[0] = w - tile * NB; e[1] = lo; e[2] = ti; e[3] = cntl[lo]; e[4] = roff[lo] + ti * 256; e[5] = tile;
    }
    __syncthreads();
    if (gather) {
        for (int idx = c.tid; idx < nmy * 256; idx += NTHREADS) {
            const LAS int* e = utab + (idx >> 8) * 8;
            const int ex = e[1], ne = e[3];
            int ridx = e[2] * 256 + (idx & 255); ridx = ridx < ne ? ridx : ne - 1;
            const int tok = (ex < 256) ? list[(size_t)ex * TT + ridx] : ridx;
            toks[idx] = (unsigned)tok * (unsigned)rowbytes;
        }
        __syncthreads();
    }
    return nmy;
}

#ifdef E1_DIRECT
struct EpiE1 {
    static constexpr bool F8 = true;
    static constexpr bool PERM = true;
    unsigned char* act;
    LAS unsigned char* stg; int tid;
    DI void operator()(const f32x4 (&acc)[2][2][4][2], const g8::Unit& u, int wr, int wc, int fr, int fq) const {
        constexpr float IS = 1.0f / W_SCALE;
#pragma unroll
        for (int ai = 0; ai < 2; ++ai)
#pragma unroll
            for (int m = 0; m < 4; ++m) {
                const int row = ai * 128 + wr * 64 + m * 16 + fr;
                if (u.ti * 256 + row < u.ne) {
#pragma unroll
                    for (int bj = 0; bj < 2; ++bj) {
                        const int col0 = u.pn * 256 + bj * 128 + wc * 32 + 8 * fq;
                        const f32x4 v0 = acc[ai][bj][m][0] * IS, v1 = acc[ai][bj][m][1] * IS;
                        const float a0 = v0[0] * __builtin_amdgcn_rcpf(1.f + __expf(-v0[0])) * v0[1], a1 = v0[2] * __builtin_amdgcn_rcpf(1.f + __expf(-v0[2])) * v0[3];
                        const float a2 = v1[0] * __builtin_amdgcn_rcpf(1.f + __expf(-v1[0])) * v1[1], a3 = v1[2] * __builtin_amdgcn_rcpf(1.f + __expf(-v1[2])) * v1[3];
                        *(unsigned*)(act + (size_t)(u.rbase + row) * FF + (col0 >> 1)) = pk4_fp8(a0 * ACT_SCALE, a1 * ACT_SCALE, a2 * ACT_SCALE, a3 * ACT_SCALE);
                    }
                }
            }
    }
};
#else
struct EpiE1 {
    static constexpr bool F8 = true;
    static constexpr bool PERM = true;
    unsigned char* act;
    LAS unsigned char* stg; int tid;
    DI void operator()(const f32x4 (&acc)[2][2][4][2], const g8::Unit& u, int wr, int wc, int fr, int fq) const {
        constexpr float IS = 1.0f / W_SCALE;
        constexpr int RS = 144;
        if (wr == 0) __builtin_amdgcn_s_barrier();
#pragma unroll
        for (int ai = 0; ai < 2; ++ai)
#pragma unroll
            for (int mh = 0; mh < 2; ++mh) {
#pragma unroll
                for (int mm = 0; mm < 2; ++mm) {
                    const int m = mh * 2 + mm;
                    LAS unsigned char* d = stg + (wr * 32 + mm * 16 + fr) * RS + wc * 16 + 4 * fq;
#pragma unroll
                    for (int bj = 0; bj < 2; ++bj) {
                        const f32x4 v0 = acc[ai][bj][m][0] * IS, v1 = acc[ai][bj][m][1] * IS;
                        const float a0 = v0[0] * __builtin_amdgcn_rcpf(1.f + __expf(-v0[0])) * v0[1], a1 = v0[2] * __builtin_amdgcn_rcpf(1.f + __expf(-v0[2])) * v0[3];
                        const float a2 = v1[0] * __builtin_amdgcn_rcpf(1.f + __expf(-v1[0])) * v1[1], a3 = v1[2] * __builtin_amdgcn_rcpf(1.f + __expf(-v1[2])) * v1[3];
                        *(LAS unsigned*)(d + bj * 64) = pk4_fp8(a0 * ACT_SCALE, a1 * ACT_SCALE, a2 * ACT_SCALE, a3 * ACT_SCALE);
                    }
                }
                asm volatile("s_waitcnt lgkmcnt(0)" ::: "memory"); __builtin_amdgcn_s_barrier(); asm volatile("" ::: "memory");
                {
                    const int rl = tid >> 3, pc = tid & 7;
                    const u32x4 v = *(const LAS u32x4*)(stg + rl * RS + pc * 16);
                    const int row = ai * 128 + (rl >> 5) * 64 + mh * 32 + (rl & 31);
                    if (u.ti * 256 + row < u.ne) __builtin_nontemporal_store(v, (u32x4*)(act + (size_t)(u.rbase + row) * FF + u.pn * 128 + pc * 16));
                }
                asm volatile("s_waitcnt lgkmcnt(0)" ::: "memory"); __builtin_amdgcn_s_barrier(); asm volatile("" ::: "memory");
            }
        if (wr == 1) __builtin_amdgcn_s_barrier();
    }
};
#endif
DI void phase_e1(const Ctx& c, int l, int nrows) {
    const Params& p = *c.p;
    moe_setup(c, l, nrows);
    MoeSched<true> S;
    S.nmy = moe_units(c, 2, true, (const int*)(p.ws + WS_LIST), DM);
    S.utab = (const LAS int*)(c.smem + LDS_MAIN + 4224); S.toks = (const LAS unsigned*)(c.smem + LDS_MAIN + 8192);
    S.A = (const char*)(p.ws + WS_H8); S.W = (const char*)(p.ws + WS_WGU) + (size_t)l * 257 * 524288; S.wstride = 524288; S.RB = DM;
    EpiE1 E; E.act = (unsigned char*)(p.ws + WS_ACT); E.stg = (LAS unsigned char*)c.smem + LDS_MAIN + 8192 + MOE_MAXG * 1024; E.tid = c.tid;
    g8::gemm_phase((LAS unsigned char*)c.smem, c.tid, DM, S, E);
}

struct EpiE2 {
    static constexpr bool F8 = true;
    static constexpr bool PERM = true;
    unsigned char* ys;
    LAS unsigned char* stg; int tid;
    DI void operator()(const f32x4 (&acc)[2][2][4][2], const g8::Unit& u, int wr, int wc, int fr, int fq) const {
        constexpr float SC = 16.f / (ACT_SCALE * WD_SCALE);
        constexpr int RS = 272;
        if (wr == 0) __builtin_amdgcn_s_barrier();
#pragma unroll
        for (int ai = 0; ai < 2; ++ai)
#pragma unroll
            for (int mh = 0; mh < 2; ++mh) {
#pragma unroll
                for (int mm = 0; mm < 2; ++mm) {
                    const int m = mh * 2 + mm;
                    LAS unsigned char* d = stg + (wr * 32 + mm * 16 + fr) * RS + wc * 32 + 8 * fq;
#pragma unroll
                    for (int bj = 0; bj < 2; ++bj) {
                        const f32x4 v0 = acc[ai][bj][m][0] * SC, v1 = acc[ai][bj][m][1] * SC;
                        int w0 = 0, w1 = 0;
                        w0 = __builtin_amdgcn_cvt_pk_fp8_f32(v0[0], v0[1], w0, false); w0 = __builtin_amdgcn_cvt_pk_fp8_f32(v0[2], v0[3], w0, true);
                        w1 = __builtin_amdgcn_cvt_pk_fp8_f32(v1[0], v1[1], w1, false); w1 = __builtin_amdgcn_cvt_pk_fp8_f32(v1[2], v1[3], w1, true);
                        u32x2 o; o.x = (unsigned)w0; o.y = (unsigned)w1;
                        *(LAS u32x2*)(d + bj * 128) = o;
                    }
                }
                asm volatile("s_waitcnt lgkmcnt(0)" ::: "memory"); __builtin_amdgcn_s_barrier(); asm volatile("" ::: "memory");
#pragma unroll
                for (int k = 0; k < 2; ++k) {
                    const int idx = tid + k * 512, rl = idx >> 4, pc = idx & 15;
                    const u32x4 v = *(const LAS u32x4*)(stg + rl * RS + pc * 16);
                    const int row = ai * 128 + (rl >> 5) * 64 + mh * 32 + (rl & 31);
                    if (u.ti * 256 + row < u.ne) __builtin_nontemporal_store(v, (u32x4*)(ys + (size_t)(u.rbase + row) * DM + u.pn * 256 + pc * 16));
                }
                asm volatile("s_waitcnt lgkmcnt(0)" ::: "memory"); __builtin_amdgcn_s_barrier(); asm volatile("" ::: "memory");
            }
        if (wr == 1) __builtin_amdgcn_s_barrier();
    }
};
DI void phase_e2(const Ctx& c, int l, int nrows) {
    const Params& p = *c.p;
    moe_setup(c, l, nrows);
    MoeSched<false> S;
    S.nmy = moe_units(c, 4, false, nullptr, 0);
    S.utab = (const LAS int*)(c.smem + LDS_MAIN + 4224); S.toks = (const LAS unsigned*)(c.smem + LDS_MAIN + 8192);
    S.A = (const char*)(p.ws + WS_ACT); S.W = (const char*)(p.ws + WS_WD) + (size_t)l * 257 * 262144; S.wstride = 262144; S.RB = FF;
    EpiE2 E; E.ys = (unsigned char*)(p.ws + WS_YS); E.stg = (LAS unsigned char*)c.smem + LDS_STG; E.tid = c.tid;
    g8::gemm_phase((LAS unsigned char*)c.smem, c.tid, FF, S, E);
}

DI void phase_combine(const Ctx& c, int l, int nrows, bool last) {
    const Params& p = *c.p;
    moe_setup(c, l, nrows);
    const LAS int* roff = (const LAS int*)(c.smem + LDS_MAIN + 2064);
    const unsigned char* ys = (const unsigned char*)(p.ws + WS_YS);
    const int* einfo = (const int*)(p.ws + WS_EINFO);
    const float* slotw = (const float*)(p.ws + WS_SLOTW);
    float* xbuf = (float*)(p.ws + WS_XBUF);
    bf16_t* hbuf = (bf16_t*)(p.ws + WS_HBUF);
    const float* modv = (const float*)(p.ws + WS_MOD);
    const int lane = c.lane;
    const int shared0 = roff[256];
    for (int t = c.bid * NWAVES + c.wid; t < nrows; t += c.nblk * NWAVES) {
        const int b = t < TL ? (t >> 12) : 8;
        const float* gate = modv + (size_t)(l * 9 + b) * 6144 + 5120 + 16 * lane;
        int myrow = 0; float myw = 0.f;
        if (lane < 8) { const int ei = einfo[(size_t)t * 8 + lane]; myrow = roff[ei >> 16] + (ei & 0xffff); myw = slotw[(size_t)t * 8 + lane] * (1.f / 16.f); }
        if (lane == 8) { myrow = shared0 + t; myw = 1.f / 16.f; }
        f32x4 v[4], a[4];
        {
            const u32x4 x0 = *(const u32x4*)((const bf16_t*)xbuf + (size_t)t * DM + 16 * lane), x1 = *(const u32x4*)((const bf16_t*)xbuf + (size_t)t * DM + 16 * lane + 8);
            v[0] = bf4_f32(u32x2{x0.x, x0.y}); v[1] = bf4_f32(u32x2{x0.z, x0.w}); v[2] = bf4_f32(u32x2{x1.x, x1.y}); v[3] = bf4_f32(u32x2{x1.z, x1.w});
        }
#pragma unroll
        for (int j = 0; j < 4; ++j) a[j] = f32x4{0.f, 0.f, 0.f, 0.f};
#pragma unroll
        for (int k = 0; k < 9; ++k) {
            const int row = __builtin_amdgcn_readlane(myrow, k); const float w = rdlane_f(myw, k);
            const u32x4 y = *(const u32x4*)(ys + (size_t)row * DM + 16 * lane);
#pragma unroll
            for (int j = 0; j < 4; ++j) {
                const unsigned word = (j == 0) ? y.x : (j == 1) ? y.y : (j == 2) ? y.z : y.w;
                const auto lo = __builtin_amdgcn_cvt_pk_f32_fp8((int)word, false), hi = __builtin_amdgcn_cvt_pk_f32_fp8((int)word, true);
                a[j].x += w * lo[0]; a[j].y += w * lo[1]; a[j].z += w * hi[0]; a[j].w += w * hi[1];
            }
        }
        float s = 0.f;
#pragma unroll
        for (int j = 0; j < 4; ++j) {
            const f32x4 g = *(const f32x4*)(gate + 4 * j);
            v[j] += g * a[j];
            s += (v[j].x * v[j].x + v[j].y * v[j].y) + (v[j].z * v[j].z + v[j].w * v[j].w);
        }
        const float rstd = rsqrtf(wave_sum(s) * (1.f / DM) + EPSV);
        if (last) {
            const float* gf = p.in[I_GFINAL] + 16 * lane;
#pragma unroll
            for (int j = 0; j < 4; ++j) {
                const f32x4 g = *(const f32x4*)(gf + 4 * j);
                *(f32x4*)(p.out + (size_t)t * DM + 16 * lane + 4 * j) = v[j] * rstd * g;
            }
        } else {
            const float* g = p.in[I_GMIX] + (l + 1) * 1024 + 16 * lane;
            const float* mv = modv + (size_t)((l + 1) * 9 + b) * 6144 + 16 * lane;
            u32x4 o8;
#pragma unroll
            for (int j = 0; j < 4; ++j) {
                *(u32x2*)((bf16_t*)xbuf + (size_t)t * DM + 16 * lane + 4 * j) = f32_bf4(v[j]);
                const f32x4 gg = *(const f32x4*)(g + 4 * j), shh = *(const f32x4*)(mv + 4 * j), scc = *(const f32x4*)(mv + 1024 + 4 * j);
                const f32x4 y = v[j] * rstd * gg * (1.f + scc) + shh;
                const unsigned w8 = pk4_fp8(y.x, y.y, y.z, y.w);
                if (j == 0) o8.x = w8; else if (j == 1) o8.y = w8; else if (j == 2) o8.z = w8; else o8.w = w8;
            }
            *(u32x4*)((unsigned char*)(p.ws + WS_HIN8) + (size_t)t * DM + 16 * lane) = o8;
        }
    }
}
DI void glds16(const void* g, LAS char* l) { __builtin_amdgcn_global_load_lds((const unsigned*)g, (LAS unsigned*)l, 16, 0, 0); }
#define VM_DRAIN() asm volatile("s_waitcnt vmcnt(0)" ::: "memory")
constexpr float FLASH_THR = 8.0f;
struct ModNone { DI bool active(int) const { return true; } DI void apply(int, f32x16&, f32x16&) const {} };
struct ModSwa {
    int nloc, kpos0, qpos, qmin, hi_;
    DI bool active(int j) const { if (j >= nloc) return true; const int k0 = kpos0 + 64 * j; return (k0 + 63 >= qmin - 128) && (k0 <= qmin + 31 + 128); }
    DI void apply(int j, f32x16& s0, f32x16& s1) const {
        if (j >= nloc) return;
        const int hi = hi_;
        const int kb = kpos0 + 64 * j + 4 * hi - qpos;
        const float NINF = -__builtin_inff();
#pragma unroll
        for (int r = 0; r < 16; ++r) {
            const int d = kb + (r & 3) + 8 * (r >> 2);
            if (d < -128 || d > 128) s0[r] = NINF;
            if (d + 32 < -128 || d + 32 > 128) s1[r] = NINF;
        }
    }
};
struct ModNa {
    int nloc, kr0, qr, qc, rs, cs, hi_;
    const LAS float* rpb;
    DI bool active(int j) const { if (j >= nloc) return true; const int kr = kr0 + j; return kr >= rs && kr < rs + 8; }
    DI void apply(int j, f32x16& s0, f32x16& s1) const {
        if (j >= nloc) return;
        const int hi = hi_;
        const int kr = kr0 + j;
        const LAS float* row = rpb + (kr - qr + 7) * 31 + 15 - qc;
        const float NINF = -__builtin_inff();
        float b0[16], b1[16];
#pragma unroll
        for (int r = 0; r < 16; ++r) { const int kc = 4 * hi + (r & 3) + 8 * (r >> 2); b0[r] = row[kc]; b1[r] = row[kc + 32]; }
#pragma unroll
        for (int r = 0; r < 16; ++r) {
            const int kc = 4 * hi + (r & 3) + 8 * (r >> 2);
            const bool ok0 = (kc >= cs) && (kc < cs + 16), ok1 = (kc + 32 >= cs) && (kc + 32 < cs + 16);
            s0[r] = ok0 ? s0[r] + b0[r] : NINF;
            s1[r] = ok1 ? s1[r] + b1[r] : NINF;
        }
    }
};


typedef __attribute__((ext_vector_type(8))) int v8i_f;
typedef __attribute__((ext_vector_type(4))) int v4i_f;
DI void mfma8(f32x16& d, const v8i_f& a, const v8i_f& b, const f32x16& c, int sc) {
    asm volatile("v_mfma_scale_f32_32x32x64_f8f6f4 %0, %1, %2, %3, %4, %4 op_sel_hi:[0,0,0]" : "=&v"(d) : "v"(a), "v"(b), "v"(c), "v"(sc));
}
DI void mfma8_acc(f32x16& d, const v8i_f& a, const v8i_f& b, int sc) {
    asm volatile("v_mfma_scale_f32_32x32x64_f8f6f4 %0, %1, %2, %0, %3, %3 op_sel_hi:[0,0,0]" : "+v"(d) : "v"(a), "v"(b), "v"(sc));
}
template <int DV> struct F8State { float m, l; f32x16 o[DV / 32]; f32x16 cinit; };

template <int DV, class Tok0, class Tile0, class Mod>
DI void pass8(const Ctx& c, int ki, int vrow0, int ntiles, Tok0 tok0, Tile0 vtile, Mod& mod, const v8i_f& qf, F8State<DV>& st) {
    constexpr int ND = DV / 32, STAGE = 4096 + DV * 64;
    const unsigned char* k8 = (const unsigned char*)(c.p->ws + WS_K8);
    const unsigned char* vt8 = (const unsigned char*)(c.p->ws + WS_VT8);
    LAS char* lds = (LAS char*)c.smem;
    const int lane = c.lane, r32 = c.r32, hi = c.hi, w = c.wid;
    int usc = 0x7F7F7F7F; asm volatile("" : "+v"(usc));
    const int prow = 16 * (w & 3) + (lane >> 2), pslot = lane & 3;
    const unsigned koff = (unsigned)(prow * 1024 + ki * 64 + ((pslot ^ ((prow >> 2) & 3)) << 4));
    const int vpiece = (DV == 128) ? w : (w & 3);
    const int vrow = 16 * vpiece + (lane >> 2);
    const unsigned voff = (unsigned)((vrow0 + vrow) * 64 + ((pslot ^ ((vrow >> 2) & 3)) << 4));
    auto issue = [&](int j, LAS char* stage) {
        if (w < 4) glds16(k8 + tok0(j) * 1024 + koff, stage + w * 1024);
        if (DV == 128 || w >= 4) glds16(vt8 + vtile(j) * (size_t)VT_TILE + voff, stage + 4096 + vpiece * 1024);
    };
    st.m = 0.f; st.l = 0.f;
#pragma unroll
    for (int r = 0; r < 16; ++r) st.cinit[r] = 0.f;
#pragma unroll
    for (int d = 0; d < ND; ++d)
#pragma unroll
        for (int r = 0; r < 16; ++r) st.o[d][r] = 0.f;
    issue(0, lds);
    VM_DRAIN();
    __syncthreads();
    const int f = (r32 >> 2) & 3;
    const int o_lo = r32 * 64 + (((2 * hi) ^ f) << 4), o_hi = r32 * 64 + (((2 * hi + 1) ^ f) << 4);
    if (__builtin_amdgcn_readfirstlane(w) >= 4) __builtin_amdgcn_s_setprio(1);
    for (int j = 0; j < ntiles; ++j) {
        if (j + 1 < ntiles) issue(j + 1, lds + ((j + 1) & 1) * STAGE);
        const LAS char* stage = lds + (j & 1) * STAGE;
        if (mod.active(j)) {
            v8i_f ka, kb;
            ka.lo = *(const LAS v4i_f*)(stage + o_lo); ka.hi = *(const LAS v4i_f*)(stage + o_hi);
            kb.lo = *(const LAS v4i_f*)(stage + 2048 + o_lo); kb.hi = *(const LAS v4i_f*)(stage + 2048 + o_hi);
            f32x16 s0, s1;
            mfma8(s0, ka, qf, st.cinit, usc); mfma8(s1, kb, qf, st.cinit, usc);
            v8i_f va, vb;
            va.lo = *(const LAS v4i_f*)(stage + 4096 + o_lo); va.hi = *(const LAS v4i_f*)(stage + 4096 + o_hi);
            vb.lo = *(const LAS v4i_f*)(stage + 4096 + 2048 + o_lo); vb.hi = *(const LAS v4i_f*)(stage + 4096 + 2048 + o_hi);
            asm volatile("s_nop 15\n\ts_nop 15" : "+v"(s0), "+v"(s1));
            mod.apply(j, s0, s1);
            float mx = fmaxf(fmaxf(s0[0], s0[1]), s1[0]);
            mx = fmaxf(fmaxf(mx, s1[1]), fmaxf(s0[2], s1[2]));
#pragma unroll
            for (int r = 3; r < 15; r += 2) mx = fmaxf(fmaxf(mx, s0[r]), fmaxf(s0[r + 1], fmaxf(s1[r], s1[r + 1])));
            mx = fmaxf(mx, fmaxf(s0[15], s1[15]));
            { const auto rr = __builtin_amdgcn_permlane32_swap(__float_as_uint(mx), __float_as_uint(mx), false, false); mx = fmaxf(__uint_as_float(rr[0]), __uint_as_float(rr[1])); }
            const bool seen = mx > -1e29f;
            const bool started = half_swap_sum(st.l) > 0.f;
            const bool mv = (mx > FLASH_THR) || (!started && seen);
            if (__any(mv)) {
                const float d = mv ? mx : 0.f;
                const float fs = (mv && started) ? __builtin_amdgcn_exp2f(-d) : 1.f;
                st.m += d; st.l *= fs;
                const float nm2 = -st.m;
                asm volatile("s_nop 15\n\ts_nop 15");
#pragma unroll
                for (int dd = 0; dd < ND; ++dd) asm volatile("" : "+v"(st.o[dd]));
#pragma unroll
                for (int r = 0; r < 16; ++r) { s0[r] -= d; s1[r] -= d; st.cinit[r] = nm2; }
#pragma unroll
                for (int dd = 0; dd < ND; ++dd)
#pragma unroll
                    for (int r = 0; r < 16; ++r) st.o[dd][r] *= fs;
            }
            float rs0 = 0.f, rs1 = 0.f;
#pragma unroll
            for (int r = 0; r < 16; ++r) { s0[r] = __builtin_amdgcn_exp2f(s0[r]); s1[r] = __builtin_amdgcn_exp2f(s1[r]); rs0 += s0[r]; rs1 += s1[r]; }
            st.l += rs0 + rs1;
            v8i_f pf;
#pragma unroll
            for (int idx = 0; idx < 8; ++idx) { const int r0 = (idx >> 2) * 4 + (idx & 3); pf[idx] = (int)pk4_fp8(s0[r0], s0[r0 + 8], s1[r0], s1[r0 + 8]); }
            asm volatile("s_nop 3" : "+v"(pf));
            mfma8_acc(st.o[0], va, pf, usc); mfma8_acc(st.o[1], vb, pf, usc);
            if constexpr (DV == 128) {
                va.lo = *(const LAS v4i_f*)(stage + 4096 + 4096 + o_lo); va.hi = *(const LAS v4i_f*)(stage + 4096 + 4096 + o_hi);
                vb.lo = *(const LAS v4i_f*)(stage + 4096 + 6144 + o_lo); vb.hi = *(const LAS v4i_f*)(stage + 4096 + 6144 + o_hi);
                mfma8_acc(st.o[2], va, pf, usc); mfma8_acc(st.o[3], vb, pf, usc);
            }
        }
        VM_DRAIN();
        __syncthreads();
    }
    __builtin_amdgcn_s_setprio(0);
    asm volatile("s_nop 15\n\ts_nop 15");
#pragma unroll
    for (int dd = 0; dd < ND; ++dd) asm volatile("" : "+v"(st.o[dd]));
}

DI v8i_f load_q8(const Ctx& c, size_t qtok, int cb) {
    const unsigned char* q8 = (const unsigned char*)(c.p->ws + WS_Q8) + qtok * 1024 + cb * 64 + 32 * c.hi;
    v8i_f qf; qf.lo = *(const v4i_f*)q8; qf.hi = *(const v4i_f*)(q8 + 16);
    return qf;
}
template <int DV>
DI void store_o8(const F8State<DV>& st, float inv, unsigned char* __restrict__ orow, int hi) {
    const float s = inv * MIX_SCALE;
#pragma unroll
    for (int dt = 0; dt < DV / 32; ++dt)
#pragma unroll
        for (int g = 0; g < 4; ++g)
            *(unsigned*)(orow + 32 * dt + 8 * g + 4 * hi) = pk4_fp8(st.o[dt][4 * g] * s, st.o[dt][4 * g + 1] * s, st.o[dt][4 * g + 2] * s, st.o[dt][4 * g + 3] * s);
}

DI void attn_swa_item(const Ctx& c, int l, int b, int h, int qb, bool ctxq) {
    const Params& p = *c.p;
    unsigned char* mix = (unsigned char*)(p.ws + WS_MIX);
    const int kvh = h >> 1;
    const size_t qtok = ctxq ? (size_t)TL + b * CTXL + c.wid * 32 + c.r32 : (size_t)b * SEQ + qb * 256 + c.wid * 32 + c.r32;
    const v8i_f qf = load_q8(c, qtok, h);
    F8State<64> st;
    ModSwa mod; mod.hi_ = c.hi;
    int j0 = 0;
    if (ctxq) { mod.nloc = 0; mod.kpos0 = 0; }
    else { j0 = 4 * qb - 2; if (j0 < 0) j0 = 0; int j1 = 4 * qb + 5; if (j1 > 63) j1 = 63; mod.nloc = j1 - j0 + 1; mod.kpos0 = 64 * j0; }
    mod.qmin = qb * 256 + c.wid * 32; mod.qpos = mod.qmin + c.r32;
    const int nloc = mod.nloc;
    const size_t lbase = (size_t)b * SEQ + 64 * j0, cbase = (size_t)TL + b * CTXL;
    auto tok0 = [&](int j) { return j < nloc ? lbase + 64 * j : cbase + 64 * (j - nloc); };
    const size_t vt0 = (size_t)b * 68;
    auto vtile = [&](int j) { return vt0 + (j < nloc ? j0 + j : 64 + (j - nloc)); };
    pass8<64>(c, kvh, kvh * 64, nloc + 4, tok0, vtile, mod, qf, st);
    float lt = half_swap_sum(st.l);
    lt += __builtin_amdgcn_exp2f(p.in[I_SINK][l * 4 + h] * LOG2E - st.m);
    store_o8<64>(st, 1.f / lt, mix + qtok * DM + h * 64, c.hi);
}

DI void attn_na_item(const Ctx& c, int l, int b, int h, int qb, bool ctxq) {
    const Params& p = *c.p;
    unsigned char* mix = (unsigned char*)(p.ws + WS_MIX);
    LAS float* rpbl = (LAS float*)(c.smem + LDS_MAIN + 1024);
    __syncthreads();
    if (!ctxq) for (int i = c.tid; i < 465; i += NTHREADS) rpbl[i] = p.in[I_RPB][(size_t)(l * 4 + h) * 465 + i] * LOG2E;
    __syncthreads();
    const size_t qtok = ctxq ? (size_t)TL + b * CTXL + c.wid * 32 + c.r32 : (size_t)b * SEQ + qb * 256 + c.wid * 32 + c.r32;
    const v8i_f qf = load_q8(c, qtok, 4 + h);
    F8State<64> st;
    ModNa mod; mod.rpb = rpbl; mod.hi_ = c.hi;
    int kr0 = 0;
    if (ctxq) { mod.nloc = 0; mod.kr0 = 0; mod.qr = 0; mod.qc = 0; mod.rs = 0; mod.cs = 0; }
    else {
        const int r_lo = 4 * qb, r_hi = 4 * qb + 3;
        int a = r_lo - 4; a = a < 0 ? 0 : (a > 56 ? 56 : a);
        int bb = r_hi - 4; bb = bb < 0 ? 0 : (bb > 56 ? 56 : bb);
        kr0 = a; mod.kr0 = a; mod.nloc = bb + 7 - a + 1;
        mod.qr = 4 * qb + (c.wid >> 1); mod.qc = 32 * (c.wid & 1) + c.r32;
        int rs = mod.qr - 4; rs = rs < 0 ? 0 : (rs > 56 ? 56 : rs); mod.rs = rs;
        int cs = mod.qc - 8; cs = cs < 0 ? 0 : (cs > 48 ? 48 : cs); mod.cs = cs;
    }
    const int nloc = mod.nloc;
    const size_t lbase = (size_t)b * SEQ + 64 * kr0, cbase = (size_t)TL + b * CTXL;
    auto tok0 = [&](int j) { return j < nloc ? lbase + 64 * j : cbase + 64 * (j - nloc); };
    const size_t vt0 = (size_t)b * 68;
    auto vtile = [&](int j) { return vt0 + (j < nloc ? kr0 + j : 64 + (j - nloc)); };
    pass8<64>(c, 2 + h, 128 + h * 64, nloc + 4, tok0, vtile, mod, qf, st);
    const float lt = half_swap_sum(st.l);
    store_o8<64>(st, 1.f / lt, mix + qtok * DM + 256 + h * 64, c.hi);
}

DI void attn_diff_item(const Ctx& c, int l, int b, int h, int qb, bool ctxq) {
    const Params& p = *c.p;
    unsigned char* mix = (unsigned char*)(p.ws + WS_MIX);
    const size_t qtok = ctxq ? (size_t)TL + b * CTXL + c.wid * 32 + c.r32 : (size_t)b * SEQ + qb * 256 + c.wid * 32 + c.r32;
    const int nloc = ctxq ? 0 : 64;
    const size_t lbase = (size_t)b * SEQ, cbase = (size_t)TL + b * CTXL;
    auto tok0 = [&](int j) { return j < nloc ? lbase + 64 * j : cbase + 64 * (j - nloc); };
    const size_t vt0 = (size_t)b * 68;
    auto vtile = [&](int j) { return vt0 + (j < nloc ? j : 64 + (j - nloc)); };
    unsigned char* orow = mix + qtok * DM + 512 + h * 128;
    LAS u32x2* park = (LAS u32x2*)(c.smem + 65536) + c.tid;
    ModNone mod;
    F8State<128> st;
    {
        const v8i_f qf = load_q8(c, qtok, 8 + 2 * h);
        pass8<128>(c, 6 + 2 * h, 384 + h * 128, nloc + 4, tok0, vtile, mod, qf, st);
        const float inv = 1.f / half_swap_sum(st.l);
#pragma unroll
        for (int dt = 0; dt < 4; ++dt)
#pragma unroll
            for (int g = 0; g < 4; ++g) {
                u32x2 u; u.x = pk2(st.o[dt][4 * g] * inv, st.o[dt][4 * g + 1] * inv); u.y = pk2(st.o[dt][4 * g + 2] * inv, st.o[dt][4 * g + 3] * inv);
                park[(dt * 4 + g) * NTHREADS] = u;
            }
    }
    const v8i_f qf = load_q8(c, qtok, 8 + 2 * h + 1);
    pass8<128>(c, 6 + 2 * h + 1, 384 + h * 128, nloc + 4, tok0, vtile, mod, qf, st);
    const float lam_init = 0.8f - 0.6f * __expf(-0.3f * (float)l);
    const float d1 = wave_sum(p.in[I_LQ1][l * 64 + c.lane] * p.in[I_LK1][l * 64 + c.lane]);
    const float d2 = wave_sum(p.in[I_LQ2][l * 64 + c.lane] * p.in[I_LK2][l * 64 + c.lane]);
    const float lam = __expf(d1) - __expf(d2) + lam_init;
    const float inv2 = lam / half_swap_sum(st.l);
    float ss = 0.f;
#pragma unroll
    for (int dt = 0; dt < 4; ++dt)
#pragma unroll
        for (int g = 0; g < 4; ++g) {
            const u32x2 u = park[(dt * 4 + g) * NTHREADS];
            const float a0 = bflo(u.x) - st.o[dt][4 * g] * inv2, a1 = bfhi(u.x) - st.o[dt][4 * g + 1] * inv2;
            const float a2 = bflo(u.y) - st.o[dt][4 * g + 2] * inv2, a3 = bfhi(u.y) - st.o[dt][4 * g + 3] * inv2;
            st.o[dt][4 * g] = a0; st.o[dt][4 * g + 1] = a1; st.o[dt][4 * g + 2] = a2; st.o[dt][4 * g + 3] = a3;
            ss += (a0 * a0 + a1 * a1) + (a2 * a2 + a3 * a3);
        }
    ss = half_swap_sum(ss);
    const float rn = rsqrtf(ss * (1.f / 128.f) + EPSV) * (1.f - lam_init);
    const float* sg = p.in[I_SUBLN] + l * 128;
#pragma unroll
    for (int dt = 0; dt < 4; ++dt)
#pragma unroll
        for (int g = 0; g < 4; ++g) {
            const f32x4 gg = *(const f32x4*)(sg + 32 * dt + 8 * g + 4 * c.hi);
            const float rs = rn * MIX_SCALE;
            *(unsigned*)(orow + 32 * dt + 8 * g + 4 * c.hi) = pk4_fp8(st.o[dt][4 * g] * rs * gg.x, st.o[dt][4 * g + 1] * rs * gg.y, st.o[dt][4 * g + 2] * rs * gg.z, st.o[dt][4 * g + 3] * rs * gg.w);
        }
}

DI void attn_decode(int it, int& b, int& h, int& qb, bool& ctxq) {
    if (it < 512) {
        const int xcd = it & 7, j = it >> 3;
        const int bh = xcd * 4 + (j >> 4); qb = j & 15;
        b = bh >> 2; h = bh & 3; ctxq = false;
    } else {
        const int i = it - 512;
        qb = 0; h = i & 3; b = i >> 2; ctxq = true;
    }
}
DI Ctx reopaque(const Ctx& c) {
    Ctx d = c; int t = c.tid; asm volatile("" : "+v"(t));
    d.tid = t; d.lane = t & 63; d.wid = __builtin_amdgcn_readfirstlane(t >> 6); d.r32 = t & 31; d.hi = (t >> 5) & 1;
    return d;
}
DI void phase_attn0_convert(const Ctx& c) {
    int* actr = (int*)(c.p->ws + WS_ROWCTR) + 128;
    int* cctr = (int*)(c.p->ws + WS_ROWCTR) + 192;
    LAS int* slot = (LAS int*)(c.smem + LDS_MAIN + 64);
    constexpr int NIT = 544, NATT = 3 * NIT;
    const bool prefer_conv = (c.bid & 1) != 0;
    for (;;) {
        if (c.tid == 0) {
            int k = -1, v = 0;
            if (prefer_conv) {
                v = atomicAdd(cctr, 1); if (v < CONV_NCHUNK) k = 1;
                if (k < 0) { v = atomicAdd(actr, 1); if (v < NATT) k = 0; }
            } else {
                v = atomicAdd(actr, 1); if (v < NATT) k = 0;
                if (k < 0) { v = atomicAdd(cctr, 1); if (v < CONV_NCHUNK) k = 1; }
            }
            slot[0] = k; slot[1] = v;
        }
        __syncthreads();
        const int kind = slot[0], idx = slot[1];
        __syncthreads();
        if (kind < 0) break;
        if (kind == 1) {
            convert_pairs(reopaque(c), idx * CONV_CHUNK, 1, CONV_CHUNK, [](int q) { return rmap_expert(q); });
        } else {
            const int grp = idx / NIT, it = idx - grp * NIT;
            int b, h, qb; bool ctxq; attn_decode(it, b, h, qb, ctxq);
            if (grp == 0) attn_diff_item(reopaque(c), 0, b, h, qb, ctxq);
            else if (grp == 1) attn_swa_item(reopaque(c), 0, b, h, qb, ctxq);
            else attn_na_item(reopaque(c), 0, b, h, qb, ctxq);
        }
    }
}
DI void phase_attn(const Ctx& c, int l) {
    const int NIT = 512 + ((l == 0) ? 32 : 0);
    for (int it = c.bid; it < NIT; it += c.nblk) { int b, h, qb; bool ctxq; attn_decode(it, b, h, qb, ctxq); attn_diff_item(c, l, b, h, qb, ctxq); }
    for (int it = c.bid; it < NIT; it += c.nblk) { int b, h, qb; bool ctxq; attn_decode(it, b, h, qb, ctxq); attn_swa_item(c, l, b, h, qb, ctxq); }
    for (int it = c.bid; it < NIT; it += c.nblk) { int b, h, qb; bool ctxq; attn_decode(it, b, h, qb, ctxq); attn_na_item(c, l, b, h, qb, ctxq); }
}
#ifndef WAVES_PER_SIMD
#define WAVES_PER_SIMD 2
#endif
#ifndef PROBE_REP
#define PROBE_REP 0
#endif
#ifndef DBG_MODE
#define DBG_MODE 0
#endif
DI Ctx mkctx(const Params& p, char* smem, int wave_s) {
    Ctx c; c.p = &p; c.smem = smem;
    int t = wave_s * 64 + (int)__builtin_amdgcn_mbcnt_hi(~0u, __builtin_amdgcn_mbcnt_lo(~0u, 0u)); asm volatile("" : "+v"(t));
    c.tid = t; c.lane = t & 63; c.wid = __builtin_amdgcn_readfirstlane(t >> 6); c.r32 = t & 31; c.hi = (t >> 5) & 1;
    int b = blockIdx.x, n = gridDim.x; asm volatile("" : "+s"(b), "+s"(n));
    c.bid = b; c.nblk = n;
    return c;
}
__global__ void __launch_bounds__(NTHREADS, WAVES_PER_SIMD) mega(Params p) {
    extern __shared__ __attribute__((aligned(16))) char smem[];
    Ctx c; c.p = &p; c.smem = smem; c.tid = threadIdx.x; c.lane = c.tid & 63; c.wid = c.tid >> 6; c.r32 = c.lane & 31; c.hi = c.lane >> 5;
    c.bid = blockIdx.x; c.nblk = gridDim.x;
    const int wave_s = __builtin_amdgcn_readfirstlane((int)threadIdx.x >> 6);
#define FRESH() mkctx(p, smem, wave_s)
#define GRID_SYNC() do { XcdBarrier bb_ = bar; asm volatile("" : "+s"(bb_.bar), "+s"(bb_.x)); xcd_barrier(bb_); } while (0)
    volatile LAS unsigned* xbw = (volatile LAS unsigned*)(smem + LDS_MAIN);
    if (c.tid == 0) { xbw[0] = 0u; xbw[1] = 0u; xbw[2] = 0u; xbw[3] = 0u; }
    __syncthreads();
    XcdBarrier bar = xcd_barrier_post((unsigned*)(p.ws + WS_BAR), xbw);
    asm volatile("; PHASE_MARK prologue" ::: "memory");
    phase_prologue(FRESH());
    GRID_SYNC();
#if PROBE_REP == 1
    asm volatile("; PHASE_MARK prologue" ::: "memory");
    phase_prologue(FRESH());
    GRID_SYNC();
#endif
    asm volatile("; PHASE_MARK norm" ::: "memory");
    phase_norm(FRESH(), 0, TT, true, 0);
    wrp_items(FRESH());
    GRID_SYNC();
#if PROBE_REP == 9
    phase_norm(FRESH(), 0, TT, true, 0);
    GRID_SYNC();
#endif
#if PROBE_REP == 13
#pragma unroll 1
    for (int z = 0; z < 20; ++z) { GRID_SYNC(); }
#endif
#pragma unroll 1
    for (int l = 0; l < 2; ++l) {
        const bool last = (l == 1);
        const int nrows = last ? TL : TT;
        asm volatile("; PHASE_MARK inproj" ::: "memory");
        asm volatile("; PHASE_MARK inproj" ::: "memory");
    phase_inproj(FRESH(), l);
        GRID_SYNC();
#if PROBE_REP == 2
        asm volatile("; PHASE_MARK inproj" ::: "memory");
        asm volatile("; PHASE_MARK inproj" ::: "memory");
    phase_inproj(FRESH(), l);
        GRID_SYNC();
#endif
        asm volatile("; PHASE_MARK attn" ::: "memory");
        asm volatile("; PHASE_MARK attn" ::: "memory");
        if (l == 0) phase_attn0_convert(FRESH()); else phase_attn(FRESH(), l);
        GRID_SYNC();
#if PROBE_REP == 3
        asm volatile("; PHASE_MARK attn" ::: "memory");
        asm volatile("; PHASE_MARK attn" ::: "memory");
    phase_attn(FRESH(), l);
        GRID_SYNC();
#endif
        asm volatile("; PHASE_MARK outproj" ::: "memory");
        asm volatile("; PHASE_MARK outproj" ::: "memory");
    phase_outproj(FRESH(), l, nrows);
        GRID_SYNC();
#if PROBE_REP == 7
        if (l == 0) { phase_outproj(FRESH(), l, nrows); GRID_SYNC(); }
#endif
#if DBG_MODE != 1
        asm volatile("; PHASE_MARK router" ::: "memory");
    phase_norm_router(FRESH(), l, nrows);
        GRID_SYNC();
        asm volatile("; PHASE_MARK route" ::: "memory");
        asm volatile("; PHASE_MARK route" ::: "memory");
    phase_route(FRESH(), l, nrows);
        GRID_SYNC();
        asm volatile("; PHASE_MARK e1" ::: "memory");
        asm volatile("; PHASE_MARK e1" ::: "memory");
    phase_e1(FRESH(), l, nrows);
        GRID_SYNC();
#if PROBE_REP == 4
        asm volatile("; PHASE_MARK e1" ::: "memory");
        asm volatile("; PHASE_MARK e1" ::: "memory");
    phase_e1(FRESH(), l, nrows);
        GRID_SYNC();
#endif
        asm volatile("; PHASE_MARK e2" ::: "memory");
        asm volatile("; PHASE_MARK e2" ::: "memory");
    phase_e2(FRESH(), l, nrows);
        GRID_SYNC();
#if PROBE_REP == 5
        asm volatile("; PHASE_MARK e2" ::: "memory");
        asm volatile("; PHASE_MARK e2" ::: "memory");
    phase_e2(FRESH(), l, nrows);
        GRID_SYNC();
#endif
#endif
        asm volatile("; PHASE_MARK combine" ::: "memory");
        asm volatile("; PHASE_MARK combine" ::: "memory");
    phase_combine(FRESH(), l, nrows, last);
#if PROBE_REP == 8
        if (last) { GRID_SYNC(); phase_combine(FRESH(), l, nrows, last); }
#endif
        if (!last) { GRID_SYNC(); }
    }
}

extern "C" void kernel_launch(void* const* d_in, const int* in_sizes, int n_in, void* d_out, int out_size, void* d_ws, size_t ws_size, hipStream_t stream) {
    static int grid = 0;
    if (grid == 0) {
        int dev = 0, cus = 0, per_cu = 0;
        if (n_in != 26 || ws_size < WS_END) { fprintf(stderr, "kernel_launch: unexpected n_in %d / ws %zu (need %zu)\n", n_in, ws_size, (size_t)WS_END); grid = -1; return; }
        if (hipGetDevice(&dev) != hipSuccess || hipDeviceGetAttribute(&cus, hipDeviceAttributeMultiprocessorCount, dev) != hipSuccess) { grid = -1; return; }
        if (hipFuncSetAttribute((const void*)mega, hipFuncAttributeMaxDynamicSharedMemorySize, LDS_BYTES) != hipSuccess) { grid = -1; return; }
        if (hipOccupancyMaxActiveBlocksPerMultiprocessor(&per_cu, (const void*)mega, NTHREADS, LDS_BYTES) != hipSuccess || per_cu < 1) per_cu = 1;
        (void)hipGetLastError();
        grid = cus;
    }
    if (grid < 0) return;
    (void)hipMemsetAsync((char*)d_ws + WS_BAR, 0, WS_ZERO_BYTES, stream);
    Params p{};
    for (int i = 0; i < 26; ++i) p.in[i] = (const float*)d_in[i];
    p.out = (float*)d_out; p.ws = (unsigned char*)d_ws;
    hipLaunchKernelGGL(mega, dim3(grid), dim3(NTHREADS), LDS_BYTES, stream, p);
}
```

```cpp
#include <hip/hip_runtime.h>
#include <hip/hip_bf16.h>
#include <cstdio>
#include <cstdint>

#define XB_TMO      128
#define XB_XCNT(j)  (256  + 64 * (j))
#define XB_XSUB(j)  (1280 + 64 * (j))
#define XB_XGEN(j)  (2304 + 64 * (j))
#define XB_TOP      3328
#define XB_TOPGEN   3392
#define XCD_BAR_WORDS 3456
#define XB_SPIN_CAP (1u << 22)
#define LAS __attribute__((address_space(3)))

__device__ __forceinline__ unsigned xb_ld(unsigned* p)              { return __hip_atomic_load(p, __ATOMIC_RELAXED, __HIP_MEMORY_SCOPE_AGENT); }
__device__ __forceinline__ unsigned xb_add(unsigned* p, unsigned v) { return __hip_atomic_fetch_add(p, v, __ATOMIC_RELAXED, __HIP_MEMORY_SCOPE_AGENT); }
__device__ __forceinline__ unsigned xb_xcc_id() { return (unsigned)__builtin_amdgcn_s_getreg((3 << 11) | 20) & 0xFu; }
#define XB_SPIN(cond, bar) do { unsigned _sp = 0; while (cond) { __builtin_amdgcn_s_sleep(1); \
    if ((++_sp & 255u) == 0u) { if (xb_ld(&(bar)[XB_TMO])) break; if (_sp > XB_SPIN_CAP) { atomicAdd(&(bar)[XB_TMO], 1u); break; } } } } while (0)

struct XcdBarrier {
    unsigned* bar; unsigned x;
    volatile LAS unsigned* st;
};

__device__ __forceinline__ XcdBarrier xcd_barrier_post(unsigned* bar, volatile LAS unsigned* st) {
    XcdBarrier b; b.bar = bar; b.x = xb_xcc_id(); b.st = st;
    if (threadIdx.x == 0) (void)xb_add(&bar[XB_XCNT(b.x)], 1u);
    return b;
}
__device__ __forceinline__ void xcd_barrier_complete(unsigned* bar, unsigned x, unsigned& nloc, unsigned& nx) {
    const unsigned G = gridDim.x * gridDim.y * gridDim.z;
    unsigned sum, cnt, mine, sp = 0u;
    for (;;) {
        sum = 0u; cnt = 0u; mine = 0u;
#pragma unroll
        for (unsigned j = 0; j < 16; ++j) { const unsigned c = xb_ld(&bar[XB_XCNT(j)]); sum += c; cnt += (c > 0u) ? 1u : 0u; mine = (j == x) ? c : mine; }
        if (sum == G) break;
        __builtin_amdgcn_s_sleep(1);
        if ((++sp & 255u) == 0u) { if (xb_ld(&bar[XB_TMO])) break; if (sp > XB_SPIN_CAP) { atomicAdd(&bar[XB_TMO], 1u); break; } }
    }
    nloc = mine > 0u ? mine : 1u; nx = cnt > 0u ? cnt : 1u;
}

__device__ __forceinline__ void xcd_barrier(const XcdBarrier& b) {
    asm volatile("s_waitcnt vmcnt(0)" ::: "memory");
    __syncthreads();
    if (threadIdx.x == 0) {
        unsigned* bar = b.bar;
        __builtin_amdgcn_s_waitcnt(0);
        unsigned nloc = b.st[0], nx = b.st[1];
        if (nloc == 0u) { xcd_barrier_complete(bar, b.x, nloc, nx); b.st[0] = nloc; b.st[1] = nx; }
        const unsigned old = xb_add(&bar[XB_XSUB(b.x)], 1u);
        const unsigned gen = old / nloc;
        if (old + 1u == (gen + 1u) * nloc) {
            __builtin_amdgcn_fence(__ATOMIC_RELEASE, "agent");
            asm volatile("s_waitcnt vmcnt(0)" ::: "memory");
            const unsigned og = xb_add(&bar[XB_TOP], 1u);
            const unsigned tg = og / nx;
            if (og + 1u == (tg + 1u) * nx) xb_add(&bar[XB_TOPGEN], 1u);
            else XB_SPIN(xb_ld(&bar[XB_TOPGEN]) == tg, bar);
            __builtin_amdgcn_fence(__ATOMIC_ACQUIRE, "agent");
            xb_add(&bar[XB_XGEN(b.x)], 1u);
            asm volatile("s_waitcnt vmcnt(0)" ::: "memory");
        } else {
            XB_SPIN(xb_ld(&bar[XB_XGEN(b.x)]) == gen, bar);
            __builtin_amdgcn_fence(__ATOMIC_ACQUIRE, "agent");
            asm volatile("s_waitcnt vmcnt(0)" ::: "memory");
        }
    }
    __syncthreads();
}

constexpr int DM = 1024, NB = 8, SEQ = 4096, CTXL = 256;
constexpr int TL = NB * SEQ;
constexpr int TC = NB * CTXL;
constexpr int TT = TL + TC;
constexpr int INC = 2816, QC = 1024, KVC = 1792;
constexpr int NE = 256, NEX = 257, FF = 256;
constexpr float EPSV = 1e-6f;
constexpr float LOG2E = 1.4426950408889634f;
constexpr float QSCALE = 0.125f * LOG2E;
constexpr float MIX_SCALE = 4.0f, W_SCALE = 32.0f, WD_SCALE = 16.0f, ACT_SCALE = 2.0f;
constexpr int NTHREADS = 512;
constexpr int NWAVES = 8;
constexpr int LDS_MAIN = 131072;
constexpr int LDS_AUX = 8192 + 16384 + 8192;
constexpr int LDS_BYTES = LDS_MAIN + LDS_AUX;
constexpr int LDS_STG = LDS_MAIN + 8192;
static_assert(LDS_BYTES <= 163840, "LDS");

typedef unsigned short bf16_t;
typedef __attribute__((ext_vector_type(8))) short bf16x8;
typedef __attribute__((ext_vector_type(4))) short s16x4;
typedef __attribute__((ext_vector_type(16))) float f32x16;
typedef __attribute__((ext_vector_type(2))) float f32x2;
typedef __attribute__((ext_vector_type(2))) __bf16 bf16x2v;
typedef short v4i16_t __attribute__((ext_vector_type(4)));
typedef __attribute__((ext_vector_type(4))) unsigned u32x4;
typedef __attribute__((ext_vector_type(2))) unsigned u32x2;
typedef __attribute__((ext_vector_type(4))) float f32x4;
#define DI __device__ __forceinline__
#define MFMA32(a, b, c) __builtin_amdgcn_mfma_f32_32x32x16_bf16((a), (b), (c), 0, 0, 0)

DI unsigned pk2(float lo, float hi) { f32x2 v = {lo, hi}; bf16x2v b = __builtin_convertvector(v, bf16x2v); return __builtin_bit_cast(unsigned, b); }
DI unsigned pk4_fp8(float a, float b, float c, float d) { int w = 0; w = __builtin_amdgcn_cvt_pk_fp8_f32(a, b, w, false); w = __builtin_amdgcn_cvt_pk_fp8_f32(c, d, w, true); return (unsigned)w; }
DI float bf2f(bf16_t u) { return __uint_as_float(((unsigned)u) << 16); }
DI float bflo(unsigned u) { return __uint_as_float(u << 16); }
DI float bfhi(unsigned u) { return __uint_as_float(u & 0xffff0000u); }
DI f32x4 bf4_f32(u32x2 w) { return f32x4{bflo(w.x), bfhi(w.x), bflo(w.y), bfhi(w.y)}; }
DI u32x2 f32_bf4(f32x4 v) { u32x2 o; o.x = pk2(v[0], v[1]); o.y = pk2(v[2], v[3]); return o; }
DI int crow(int reg, int hi) { return (reg & 3) + 8 * (reg >> 2) + 4 * hi; }
#define DPPI(v, CTRL) __builtin_amdgcn_update_dpp(0, (v), (CTRL), 0xf, 0xf, true)
#define DPPF(v, CTRL) __builtin_bit_cast(float, __builtin_amdgcn_update_dpp(0, __builtin_bit_cast(int, (v)), (CTRL), 0xf, 0xf, true))
#define DPP_XOR1 0xB1
#define DPP_XOR2 0x4E
#define DPP_HMIR 0x141
#define DPP_MIR  0x140
#define DPP_SHR(n) (0x110 + (n))
DI float rdlane_f(float v, int l) { return __builtin_bit_cast(float, __builtin_amdgcn_readlane(__builtin_bit_cast(int, v), l)); }
DI float wave_sum(float v) {
    v += DPPF(v, DPP_XOR1); v += DPPF(v, DPP_XOR2); v += DPPF(v, DPP_HMIR); v += DPPF(v, DPP_MIR);
    return (rdlane_f(v, 0) + rdlane_f(v, 16)) + (rdlane_f(v, 32) + rdlane_f(v, 48));
}
DI float half_swap_sum(float v) {
    const auto rr = __builtin_amdgcn_permlane32_swap(__float_as_uint(v), __float_as_uint(v), false, false);
    return __uint_as_float(rr[0]) + __uint_as_float(rr[1]);
}
DI float siluf(float v) { return v / (1.f + __expf(-v)); }

struct Params {
    const float* in[26];
    float* out;
    unsigned char* ws;
};
enum { I_X = 0, I_C, I_CTX, I_CCTX, I_WMOD, I_BMOD, I_GMIX, I_GFFN, I_WIN, I_WOUT, I_SINK, I_RPB, I_LQ1, I_LK1, I_LQ2, I_LK2, I_SUBLN,
       I_WR, I_RB, I_WG, I_WU, I_WD, I_SG, I_SU, I_SD, I_GFINAL };

constexpr size_t MiB = 1u << 20;
constexpr size_t WS_BAR = 0;
constexpr size_t WS_CNT = 16384;
constexpr int CNT_STRIDE = 64, CNT_LAYER = 257 * 64;
constexpr size_t WS_ZERO_BYTES = 163840;
constexpr size_t WS_ROPE = 196608;
constexpr size_t WS_MOD = 262144;
constexpr size_t WS_WIN = 1 * MiB;
constexpr size_t WS_WOUT = 12 * MiB;
constexpr size_t WS_WR = 16 * MiB;
constexpr size_t WS_WGU = 17 * MiB;
constexpr size_t WS_WD = WS_WGU + 514 * MiB;
constexpr size_t WS_XBUF = WS_WD + 257 * MiB;
constexpr size_t WS_HBUF = WS_XBUF + 136 * MiB;
constexpr size_t WS_SLOTW = WS_HBUF + 68 * MiB;
constexpr size_t WS_LIST = WS_SLOTW + 2 * MiB;
constexpr size_t WS_R = WS_LIST + 34 * MiB;
constexpr size_t WS_Q = WS_R;
constexpr size_t WS_KV = WS_R + 68 * MiB;
constexpr size_t WS_MIX = WS_R + 187 * MiB;
constexpr size_t WS_PARK = WS_R + 221 * MiB;
constexpr size_t WS_Q8 = WS_R + 290 * MiB;
constexpr size_t WS_K8 = WS_R + 324 * MiB;
constexpr size_t WS_VT8 = WS_R + 358 * MiB;
constexpr int VT_ROWS = 896, VT_TILE = 896 * 64;
constexpr size_t WS_LOGIT = WS_R + 256 * MiB;
constexpr size_t WS_ACT = WS_R;
constexpr size_t WS_HIN8 = WS_WGU + 300 * MiB;
constexpr size_t WS_H8 = WS_R + 80 * MiB;
constexpr size_t WS_YS = WS_R + 153 * MiB;
constexpr size_t WS_EINFO = WS_R + 512 * MiB;
constexpr size_t WS_WRP = WS_R + 460 * MiB;
constexpr size_t WS_CB = WS_R + 470 * MiB;
constexpr size_t WS_RSTD = WS_R + 471 * MiB;
constexpr size_t WS_ROWCTR = 151552;
constexpr size_t WS_END = WS_YS + 612 * MiB;
static_assert(WS_END <= 2048 * MiB, "workspace");

struct Ctx {
    const Params* p;
    char* smem;
    int tid, lane, wid, r32, hi;
    int bid, nblk;
};
DI int map_row(int type, int n) {
    if (type == 1) {
        const int hb = n >> 6, d = n & 63;
        const bool roped = (hb < 4) || (hb >= 8 && hb < 16) || (hb == 16) || (hb == 17) || (hb >= 28 && hb < 36);
        int d2 = d;
        if (roped) d2 = (d < 16) ? 2 * d : (d < 32) ? 2 * (d - 16) + 1 : (d < 48) ? 2 * (d - 16) : 2 * (d - 32) + 1;
        return (hb << 6) | d2;
    }
    if (type == 2) return 2 * n;
    if (type == 3) return 2 * n + 1;
    return n;
}

struct TItem { const float* W; int K, N, kt, nt, type; void* dst; bool f8; float ws; };
DI void tload(const Ctx& c, float (&v)[4][2][8], const TItem& it) {
    const int wid4 = c.wid & 3;
    const int k0 = it.kt * 128, n0 = it.nt * 128;
#pragma unroll
    for (int cc = 0; cc < 4; ++cc) {
        const int kc = 4 * wid4 + cc;
#pragma unroll
        for (int j = 0; j < 8; ++j)
#pragma unroll
            for (int i = 0; i < 2; ++i) v[cc][i][j] = __builtin_nontemporal_load(&it.W[(size_t)(k0 + kc * 8 + j) * it.N + n0 + c.lane + 64 * i]);
    }
}
DI void tfinish(const Ctx& c, const float (&v)[4][2][8], const TItem& it) {
    LAS char* lds = (LAS char*)c.smem + (c.tid >> 8) * 36864;
    const int wid4 = c.wid & 3, tid8 = c.tid & 255;
    const int k0 = it.kt * 128, n0 = it.nt * 128, K = it.K;
    const float wscale = it.ws;
#pragma unroll
    for (int cc = 0; cc < 4; ++cc) {
        const int kc = 4 * wid4 + cc;
#pragma unroll
        for (int i = 0; i < 2; ++i) {
            if (it.f8) {
                u32x2 u; u.x = pk4_fp8(v[cc][i][0] * wscale, v[cc][i][1] * wscale, v[cc][i][2] * wscale, v[cc][i][3] * wscale); u.y = pk4_fp8(v[cc][i][4] * wscale, v[cc][i][5] * wscale, v[cc][i][6] * wscale, v[cc][i][7] * wscale);
                *(LAS u32x2*)(lds + (c.lane + 64 * i) * 144 + kc * 8) = u;
            } else {
                u32x4 u; u.x = pk2(v[cc][i][0], v[cc][i][1]); u.y = pk2(v[cc][i][2], v[cc][i][3]); u.z = pk2(v[cc][i][4], v[cc][i][5]); u.w = pk2(v[cc][i][6], v[cc][i][7]);
                *(LAS u32x4*)(lds + (c.lane + 64 * i) * 272 + kc * 16) = u;
            }
        }
    }
    __syncthreads();
    if (it.f8) {
        unsigned char* dst = (unsigned char*)it.dst;
#pragma unroll
        for (int j = 0; j < 4; ++j) {
            const int idx = tid8 + 256 * j, c16 = idx & 7, n = idx >> 3;
            const u32x4 u = *(LAS u32x4*)(lds + n * 144 + c16 * 16);
            const int row = map_row(it.type, n0 + n);
            __builtin_nontemporal_store(u, (u32x4*)(dst + (size_t)row * K + k0 + c16 * 16));
        }
    } else {
        bf16_t* dst = (bf16_t*)it.dst;
#pragma unroll
        for (int j = 0; j < 8; ++j) {
            const int idx = tid8 + 256 * j, c16 = idx & 15, n = idx >> 4;
            const u32x4 u = *(LAS u32x4*)(lds + n * 272 + c16 * 16);
            const int row = map_row(it.type, n0 + n);
            *(u32x4*)(dst + (size_t)row * K + k0 + c16 * 8) = u;
        }
    }
    __syncthreads();
}

DI void mod_item(const Ctx& c, int l, int cg) {
    const Params& p = *c.p;
    LAS float* sv = (LAS float*)c.smem;
    LAS float* part = (LAS float*)(c.smem + 36864);
    for (int idx = c.tid; idx < 9 * 1024; idx += NTHREADS) {
        const int b = idx >> 10, k = idx & 1023;
        const float v = (b < 8) ? p.in[I_C][b * 1024 + k] : p.in[I_CCTX][k];
        sv[idx] = siluf(v);
    }
    __syncthreads();
    const int col = c.tid & 63, kq = c.tid >> 6;
    float acc[9];
#pragma unroll
    for (int b = 0; b < 9; ++b) acc[b] = 0.f;
    const float* wp = p.in[I_WMOD] + ((size_t)l * 1024 + kq * 128) * 6144 + cg * 64 + col;
    for (int k = 0; k < 128; k += 8) {
        float w[8];
#pragma unroll
        for (int u = 0; u < 8; ++u) w[u] = wp[(size_t)(k + u) * 6144];
#pragma unroll
        for (int u = 0; u < 8; ++u)
#pragma unroll
            for (int b = 0; b < 9; ++b) acc[b] += sv[b * 1024 + kq * 128 + k + u] * w[u];
    }
#pragma unroll
    for (int b = 0; b < 9; ++b) part[(kq * 9 + b) * 64 + col] = acc[b];
    __syncthreads();
    float* modv = (float*)(p.ws + WS_MOD);
    for (int idx = c.tid; idx < 576; idx += NTHREADS) {
        const int b = idx >> 6, cl = idx & 63;
        float s = 0.f;
#pragma unroll
        for (int q = 0; q < 8; ++q) s += part[(q * 9 + b) * 64 + cl];
        modv[(size_t)(l * 9 + b) * 6144 + cg * 64 + cl] = s + p.in[I_BMOD][l * 6144 + cg * 64 + cl];
    }
    __syncthreads();
}

DI void rope_item(const Ctx& c) {
    float2* tab = (float2*)(c.p->ws + WS_ROPE);
    for (int idx = c.tid; idx < 1024; idx += NTHREADS) {
        const int pos = idx >> 4, i = idx & 15;
        const float inv = 1.0f / powf(10000.0f, (float)i / 16.0f);
        const float ang = (float)pos * inv;
        float sn, cs; sincosf(ang, &sn, &cs);
        tab[idx] = make_float2(cs, sn);
    }
}

constexpr int PRO_PER_LAYER = 12592;
DI TItem transpose_decode(const Ctx& c, int r) {
    const Params& p = *c.p;
    const int l = r / PRO_PER_LAYER; r -= l * PRO_PER_LAYER;
    unsigned char* wgu = (unsigned char*)(p.ws + WS_WGU) + (size_t)l * 257 * 524288;
    unsigned char* wd = (unsigned char*)(p.ws + WS_WD) + (size_t)l * 257 * 262144;
    TItem t; t.f8 = true; t.ws = W_SCALE;
    if (r < 4096) { const int e = r >> 4, s = r & 15; t.W = p.in[I_WG] + (size_t)(l * 256 + e) * 262144; t.K = 1024; t.N = 256; t.kt = s >> 1; t.nt = s & 1; t.dst = wgu + (size_t)e * 524288; t.type = 2; }
    else if (r < 8192) { r -= 4096; const int e = r >> 4, s = r & 15; t.W = p.in[I_WU] + (size_t)(l * 256 + e) * 262144; t.K = 1024; t.N = 256; t.kt = s >> 1; t.nt = s & 1; t.dst = wgu + (size_t)e * 524288; t.type = 3; }
    else if (r < 12288) { r -= 8192; const int e = r >> 4, s = r & 15; t.W = p.in[I_WD] + (size_t)(l * 256 + e) * 262144; t.K = 256; t.N = 1024; t.kt = s >> 3; t.nt = s & 7; t.dst = wd + (size_t)e * 262144; t.type = 0; t.ws = WD_SCALE; }
    else {
        r -= 12288;
        if (r < 176) { t.W = p.in[I_WIN] + (size_t)l * 1024 * 2816; t.K = 1024; t.N = 2816; t.kt = r / 22; t.nt = r % 22; t.dst = (unsigned char*)(p.ws + WS_WIN) + (size_t)l * 2816 * 1024; t.type = 1; }
        else if (r < 240) { r -= 176; t.W = p.in[I_WOUT] + (size_t)l * 1048576; t.K = 1024; t.N = 1024; t.kt = r >> 3; t.nt = r & 7; t.dst = (unsigned char*)(p.ws + WS_WOUT) + (size_t)l * 1048576; t.type = 0; }
        else if (r < 256) { r -= 240; t.W = p.in[I_WR] + (size_t)l * 262144; t.K = 1024; t.N = 256; t.kt = r >> 1; t.nt = r & 1; t.dst = (bf16_t*)(p.ws + WS_WR) + (size_t)l * 262144; t.type = 0; t.f8 = false; }
        else if (r < 272) { r -= 256; t.W = p.in[I_SG] + (size_t)l * 262144; t.K = 1024; t.N = 256; t.kt = r >> 1; t.nt = r & 1; t.dst = wgu + (size_t)256 * 524288; t.type = 2; }
        else if (r < 288) { r -= 272; t.W = p.in[I_SU] + (size_t)l * 262144; t.K = 1024; t.N = 256; t.kt = r >> 1; t.nt = r & 1; t.dst = wgu + (size_t)256 * 524288; t.type = 3; }
        else { r -= 288; t.W = p.in[I_SD] + (size_t)l * 262144; t.K = 256; t.N = 1024; t.kt = r >> 3; t.nt = r & 7; t.dst = wd + (size_t)256 * 262144; t.type = 0; t.ws = WD_SCALE; }
    }
    return t;
}
template <class RMap>
DI void convert_pairs(const Ctx& c, int first, int stride, int n, RMap rmap) {
    if (n <= 0) return;
    const int half = c.tid >> 8;
    float va[4][2][8], vb[4][2][8];
    TItem ia = transpose_decode(c, rmap(first) + half), ib = ia;
    tload(c, va, ia);
    int i = 0;
    for (;;) {
        const bool m1 = i + 1 < n;
        if (m1) { ib = transpose_decode(c, rmap(first + (i + 1) * stride) + half); tload(c, vb, ib); }
        tfinish(c, va, ia);
        if (!m1) break;
        ++i;
        const bool m2 = i + 1 < n;
        if (m2) { ia = transpose_decode(c, rmap(first + (i + 1) * stride) + half); tload(c, va, ia); }
        tfinish(c, vb, ib);
        if (!m2) break;
        ++i;
    }
}
constexpr int PRO_EXPERT = 12288, PRO_SMALL = PRO_PER_LAYER - PRO_EXPERT;
constexpr int CONV_CHUNK = 8, CONV_NCHUNK = 2 * PRO_EXPERT / 2 / CONV_CHUNK;
DI int rmap_small(int q) { const int l = q / (PRO_SMALL / 2), s = q - l * (PRO_SMALL / 2); return l * PRO_PER_LAYER + PRO_EXPERT + 2 * s; }
DI int rmap_expert(int q) { const int l = q / (PRO_EXPERT / 2), s = q - l * (PRO_EXPERT / 2); return l * PRO_PER_LAYER + 2 * s; }
DI void phase_prologue(const Ctx& c) {
    for (int it = c.bid; it < 193; it += c.nblk) { if (it < 192) mod_item(c, it / 96, it % 96); else rope_item(c); }
    __syncthreads();
    constexpr int NP = PRO_SMALL;
    const int n = (NP > c.bid) ? (NP - c.bid + c.nblk - 1) / c.nblk : 0;
    convert_pairs(c, c.bid, c.nblk, n, [](int q) { return rmap_small(q); });
}

template <bool XBF>
DI void norm_mod_row(const float* __restrict__ xrow, const float* __restrict__ g, const float* __restrict__ sh, const float* __restrict__ sc, bf16_t* __restrict__ orow, unsigned char* __restrict__ o8, int lane) {
    float4 v[4]; float s = 0.f;
#pragma unroll
    for (int j = 0; j < 4; ++j) { if constexpr (XBF) { const f32x4 t4 = bf4_f32(((const u32x2*)xrow)[lane + 64 * j]); v[j] = make_float4(t4[0], t4[1], t4[2], t4[3]); } else v[j] = ((const float4*)xrow)[lane + 64 * j]; s += (v[j].x * v[j].x + v[j].y * v[j].y) + (v[j].z * v[j].z + v[j].w * v[j].w); }
    const float rstd = rsqrtf(wave_sum(s) * (1.f / DM) + EPSV);
#pragma unroll
    for (int j = 0; j < 4; ++j) {
        const float4 gg = ((const float4*)g)[lane + 64 * j], shh = ((const float4*)sh)[lane + 64 * j], scc = ((const float4*)sc)[lane + 64 * j];
        const float y0 = v[j].x * rstd * gg.x * (1.f + scc.x) + shh.x, y1 = v[j].y * rstd * gg.y * (1.f + scc.y) + shh.y;
        const float y2 = v[j].z * rstd * gg.z * (1.f + scc.z) + shh.z, y3 = v[j].w * rstd * gg.w * (1.f + scc.w) + shh.w;
        u32x2 o; o.x = pk2(y0, y1); o.y = pk2(y2, y3);
        if (orow) ((u32x2*)orow)[lane + 64 * j] = o;
        if (o8) ((unsigned*)o8)[lane + 64 * j] = pk4_fp8(y0, y1, y2, y3);
    }
}

DI void wrp_items(const Ctx& c) {
    const Params& p = *c.p;
    const float* modv = (const float*)(p.ws + WS_MOD);
    const bf16_t* wr = (const bf16_t*)(p.ws + WS_WR);
    bf16_t* wrp = (bf16_t*)(p.ws + WS_WRP);
    float* cb = (float*)(p.ws + WS_CB);
    const int lane = c.lane;
    for (int idx = c.bid * NWAVES + c.wid; idx < 2 * 9 * 256; idx += c.nblk * NWAVES) {
        const int l = idx / 2304, r = idx - l * 2304, b = r >> 8, e = r & 255;
        const float* g = p.in[I_GFFN] + l * 1024 + 16 * lane;
        const float* mv = modv + (size_t)(l * 9 + b) * 6144 + 3072 + 16 * lane;
        const bf16_t* src = wr + ((size_t)l * 256 + e) * 1024 + 16 * lane;
        const u32x4 w0 = *(const u32x4*)src, w1 = *(const u32x4*)(src + 8);
        float wv[16];
        wv[0] = bflo(w0.x); wv[1] = bfhi(w0.x); wv[2] = bflo(w0.y); wv[3] = bfhi(w0.y); wv[4] = bflo(w0.z); wv[5] = bfhi(w0.z); wv[6] = bflo(w0.w); wv[7] = bfhi(w0.w);
        wv[8] = bflo(w1.x); wv[9] = bfhi(w1.x); wv[10] = bflo(w1.y); wv[11] = bfhi(w1.y); wv[12] = bflo(w1.z); wv[13] = bfhi(w1.z); wv[14] = bflo(w1.w); wv[15] = bfhi(w1.w);
        float s = 0.f, o[16];
#pragma unroll
        for (int j = 0; j < 4; ++j) {
            const f32x4 gg = *(const f32x4*)(g + 4 * j), sh = *(const f32x4*)(mv + 4 * j), sc = *(const f32x4*)(mv + 1024 + 4 * j);
#pragma unroll
            for (int i = 0; i < 4; ++i) { o[4 * j + i] = wv[4 * j + i] * gg[i] * (1.f + sc[i]); s += sh[i] * wv[4 * j + i]; }
        }
        u32x4 o0, o1;
        o0.x = pk2(o[0], o[1]); o0.y = pk2(o[2], o[3]); o0.z = pk2(o[4], o[5]); o0.w = pk2(o[6], o[7]);
        o1.x = pk2(o[8], o[9]); o1.y = pk2(o[10], o[11]); o1.z = pk2(o[12], o[13]); o1.w = pk2(o[14], o[15]);
        bf16_t* dst = wrp + ((size_t)(l * 9 + b) * 256 + e) * 1024 + 16 * lane;
        *(u32x4*)dst = o0; *(u32x4*)(dst + 8) = o1;
        s = wave_sum(s);
        if (lane == 0) cb[(l * 9 + b) * 256 + e] = s;
    }
}
DI void norm_ffn_row(const bf16_t* __restrict__ xrow, const float* __restrict__ g, const float* __restrict__ sh, const float* __restrict__ sc, unsigned char* __restrict__ o8, float* __restrict__ rstd_out, int lane) {
    f32x4 v[4]; float s = 0.f;
#pragma unroll
    for (int j = 0; j < 4; ++j) { v[j] = bf4_f32(((const u32x2*)xrow)[lane + 64 * j]); s += (v[j][0] * v[j][0] + v[j][1] * v[j][1]) + (v[j][2] * v[j][2] + v[j][3] * v[j][3]); }
    const float rstd = rsqrtf(wave_sum(s) * (1.f / DM) + EPSV);
#pragma unroll
    for (int j = 0; j < 4; ++j) {
        const f32x4 gg = ((const f32x4*)g)[lane + 64 * j], shh = ((const f32x4*)sh)[lane + 64 * j], scc = ((const f32x4*)sc)[lane + 64 * j];
        const f32x4 y = v[j] * rstd * gg * (1.f + scc) + shh;
        ((unsigned*)o8)[lane + 64 * j] = pk4_fp8(y[0], y[1], y[2], y[3]);
    }
    if (lane == 0) *rstd_out = rstd;
}

DI void phase_norm(const Ctx& c, int l, int nrows, bool from_inputs, int which) {
    const Params& p = *c.p;
    const float* modv = (const float*)(p.ws + WS_MOD);
    const float* g = p.in[which ? I_GFFN : I_GMIX] + l * 1024;
    bf16_t* hbuf = (bf16_t*)(p.ws + WS_HBUF);
    const float* xbuf = (const float*)(p.ws + WS_XBUF);
    for (int t = c.bid * NWAVES + c.wid; t < nrows; t += c.nblk * NWAVES) {
        const float* xrow = from_inputs ? (t < TL ? p.in[I_X] + (size_t)t * DM : p.in[I_CTX] + (size_t)(t - TL) * DM) : (const float*)((const bf16_t*)xbuf + (size_t)t * DM);
        const int b = t < TL ? (t >> 12) : 8;
        const float* mv = modv + (size_t)(l * 9 + b) * 6144 + (which ? 3072 : 0);
        if (from_inputs) norm_mod_row<false>(xrow, g, mv, mv + 1024, (bf16_t*)nullptr,        (unsigned char*)(p.ws + (which ? WS_H8 : WS_HIN8)) + (size_t)t * DM, c.lane);
        else norm_mod_row<true>(xrow, g, mv, mv + 1024, hbuf + (size_t)t * DM, (unsigned char*)(p.ws + (which ? WS_H8 : WS_HIN8)) + (size_t)t * DM, c.lane);
    }
}

namespace g8 {
constexpr int BM = 256, BK = 64, HALF = 128, HTB = HALF * BK * 2;
DI int lds_byte(int r, int c) { const int st = (r >> 4) * 2 + (c >> 5), rr = r & 15, cc = c & 31, ob = rr * 64 + cc * 2; return st * 1024 + (ob ^ (((ob >> 9) & 1) << 5)); }
DI void stage_rc(int b, int& R, int& C) { const int st = b / 1024, sb = b % 1024, swz = sb ^ (((sb >> 9) & 1) << 5); R = (st >> 1) * 16 + swz / 64; C = (st & 1) * 32 + (swz % 64) / 2; }
DI int perm32(int rho) { const int n = rho >> 4, i = rho & 15; return 8 * (i >> 2) + 4 * n + (i & 3); }
struct Unit { int pm, pn, e, ti, ne, rbase, ix; };

typedef __attribute__((ext_vector_type(8))) int v8i_t;
typedef __attribute__((ext_vector_type(4))) int v4i_t;
template <class Epi, class Sched>
DI void gemm_phase(LAS unsigned char* lds, const int tid, const int RB, const Sched& S, const Epi& E) {
    constexpr bool F8 = Epi::F8;
    const int wid = __builtin_amdgcn_readfirstlane(tid >> 6), lane = tid & 63, wr = wid >> 2, wc = wid & 3, fr = lane & 15, fq = lane >> 4;
    const int nt = RB / 128;
    int Rr[2], Cc[2]; unsigned voffB[2], voffA[2];
#pragma unroll
    for (int i = 0; i < 2; ++i) { int R, C; stage_rc(tid * 16 + i * 8192, R, C); Rr[i] = R; Cc[i] = C * 2; const int Rb = Epi::PERM ? ((R & ~31) + perm32(R & 31)) : R; voffB[i] = (unsigned)(Rb * RB + C * 2); voffA[i] = (unsigned)(R * RB + C * 2); }
    constexpr bool GA = Sched::GATHER;
    int unit_scale = 0x7F7F7F7F; asm volatile("" : "+v"(unit_scale));
    const size_t kstep = (size_t)(BK * 2);
    const size_t hstep = (size_t)HALF * RB;
    const unsigned ldsw = (unsigned)wid * 1024u;
    const int aoff = F8 ? lds_byte(wr * 64 + fr, (fq >> 1) * 32 + (fq & 1) * 16) : lds_byte(wr * 64 + fr, fq * 8);
    const int boff = F8 ? lds_byte(wc * 32 + fr, (fq >> 1) * 32 + (fq & 1) * 16) : lds_byte(wc * 32 + fr, fq * 8);
#define G8_SA(b, h) (((b) * 2 + (h)) * HTB)
#define G8_SB(b, h) ((4 + (b) * 2 + (h)) * HTB)
#define G8_STAGE_B(bufoff, gbase) do { _Pragma("unroll") for (int _i = 0; _i < 2; ++_i) \
        __builtin_amdgcn_global_load_lds((const unsigned*)((const char*)(gbase) + voffB[_i]), (LAS unsigned*)(lds + (bufoff) + ldsw + _i * 8192), 16, 0, 0); } while (0)
#define G8_STAGE_A(bufoff, uptr, koff, VO, h) do { _Pragma("unroll") for (int _i = 0; _i < 2; ++_i) { \
        const char* _s = GA ? (Ab + (koff) + VO[h][_i]) : ((uptr) + (koff) + ((h) ? hstep : (size_t)0) + voffA[_i]); \
        __builtin_amdgcn_global_load_lds((const unsigned*)_s, (LAS unsigned*)(lds + (bufoff) + ldsw + _i * 8192), 16, 0, 0); } } while (0)
#define G8_LDA(dst, b, h) do { _Pragma("unroll") for (int m = 0; m < 4; ++m) { \
        if constexpr (F8) { dst##8[m].lo = *(const LAS v4i_t*)(lds + G8_SA(b, h) + aoff + m * 2048); dst##8[m].hi = *(const LAS v4i_t*)(lds + G8_SA(b, h) + aoff + m * 2048 + 16); } \
        else { _Pragma("unroll") for (int k = 0; k < 2; ++k) dst[m][k] = *(const LAS bf16x8*)(lds + G8_SA(b, h) + aoff + m * 2048 + k * 1024); } } } while (0)
#define G8_LDB(dst, b, h) do { _Pragma("unroll") for (int n = 0; n < 2; ++n) { \
        if constexpr (F8) { dst##8[n].lo = *(const LAS v4i_t*)(lds + G8_SB(b, h) + boff + n * 2048); dst##8[n].hi = *(const LAS v4i_t*)(lds + G8_SB(b, h) + boff + n * 2048 + 16); } \
        else { _Pragma("unroll") for (int k = 0; k < 2; ++k) dst[n][k] = *(const LAS bf16x8*)(lds + G8_SB(b, h) + boff + n * 2048 + k * 1024); } } } while (0)
#define G8_MMA(ai, bj, At, Bt) do { __builtin_amdgcn_s_setprio(1); _Pragma("unroll") for (int m = 0; m < 4; ++m) _Pragma("unroll") for (int n = 0; n < 2; ++n) { \
        if constexpr (F8) asm volatile("v_mfma_scale_f32_16x16x128_f8f6f4 %0, %1, %2, %0, %3, %3 op_sel_hi:[0,0,0]" : "+v"(acc[ai][bj][m][n]) : "v"(Bt##8[n]), "v"(At##8[m]), "v"(unit_scale)); \
        else { _Pragma("unroll") for (int k = 0; k < 2; ++k) acc[ai][bj][m][n] = __builtin_amdgcn_mfma_f32_16x16x32_bf16(Bt[n][k], At[m][k], acc[ai][bj][m][n], 0, 0, 0); } } \
        __builtin_amdgcn_s_setprio(0); } while (0)
#define G8_WAIT_V(n) asm volatile("s_waitcnt vmcnt(" #n ")" ::: "memory")
#define G8_WAIT_L(n) asm volatile("s_waitcnt lgkmcnt(" #n ")" ::: "memory")
#define G8_BAR __builtin_amdgcn_s_barrier()
#define G8_SCHED __builtin_amdgcn_sched_barrier(0)
    Unit cur, nxt; int ui = 0;
    if (!S.next(0, cur)) return;
    f32x4 acc[2][2][4][2];
#pragma unroll
    for (int a = 0; a < 2; ++a)
#pragma unroll
        for (int b = 0; b < 2; ++b)
#pragma unroll
            for (int m = 0; m < 4; ++m)
#pragma unroll
                for (int n = 0; n < 2; ++n) acc[a][b][m][n] = (f32x4){0.f, 0.f, 0.f, 0.f};
    if constexpr (F8) asm volatile("s_nop 3" ::: "memory");
    bf16x8 At[F8 ? 1 : 4][2], B0[F8 ? 1 : 2][2], B1[F8 ? 1 : 2][2];
    v8i_t At8[F8 ? 4 : 1], B08[F8 ? 2 : 1], B18[F8 ? 2 : 1];
    unsigned vAc[2][2], vAn[2][2];
#pragma unroll
    for (int h = 0; h < 2; ++h)
#pragma unroll
        for (int i = 0; i < 2; ++i) vAc[h][i] = GA ? (S.a_off(cur, h * 128 + Rr[i]) + (unsigned)Cc[i]) : 0u;
    const char* Ab = S.a_base();
    const char* cA = GA ? Ab : S.a_ptr(cur);
    const char* cB = S.b_base(cur);
    G8_STAGE_B(G8_SB(0, 0), cB); G8_STAGE_A(G8_SA(0, 0), cA, 0, vAc, 0); G8_STAGE_B(G8_SB(0, 1), cB + hstep); G8_STAGE_A(G8_SA(0, 1), cA, 0, vAc, 1);
    if (wr == 1) G8_BAR;
    G8_WAIT_V(4); G8_BAR;
    G8_STAGE_B(G8_SB(1, 0), cB + kstep); G8_STAGE_A(G8_SA(1, 0), cA, kstep, vAc, 0); G8_STAGE_B(G8_SB(1, 1), cB + hstep + kstep);
    G8_WAIT_V(6); G8_BAR;
    for (;;) {
        const bool has_next = S.next(ui + 1, nxt);
        const char* nB = has_next ? S.b_base(nxt) : cB;
        const char* nA = GA ? Ab : (has_next ? S.a_ptr(nxt) : cA);
#pragma unroll
        for (int h = 0; h < 2; ++h)
#pragma unroll
            for (int i = 0; i < 2; ++i) vAn[h][i] = GA ? (has_next ? (S.a_off(nxt, h * 128 + Rr[i]) + (unsigned)Cc[i]) : vAc[h][i]) : 0u;
#pragma unroll 1
        for (int t = 0; t < nt; t += 2) {
            const bool last = (t == nt - 2);
            const size_t ka1 = (size_t)(t + 1) * kstep;
            const size_t ka2 = last ? (size_t)0 : (size_t)(t + 2) * kstep;
            const size_t ka3 = ka2 + kstep;
            const char* b2 = last ? nB : cB + (size_t)(t + 2) * kstep;
            const char* b3 = b2 + kstep;
            unsigned v2[2][2];
#pragma unroll
            for (int h = 0; h < 2; ++h)
#pragma unroll
                for (int i = 0; i < 2; ++i) v2[h][i] = GA ? (last ? vAn[h][i] : vAc[h][i]) : 0u;
            const char* a2p = last ? nA : cA;
            G8_LDB(B0, 0, 0); G8_SCHED; G8_LDA(At, 0, 0); G8_STAGE_A(G8_SA(1, 1), cA, ka1, vAc, 1);
            G8_WAIT_L(8); G8_BAR; G8_WAIT_L(0); G8_MMA(0, 0, At, B0); G8_BAR; G8_SCHED;
            G8_LDB(B1, 0, 1); G8_STAGE_B(G8_SB(0, 0), b2);
            G8_BAR; G8_WAIT_L(0); G8_MMA(0, 1, At, B1); G8_BAR;
            G8_LDA(At, 0, 1); G8_STAGE_A(G8_SA(0, 0), a2p, ka2, v2, 0);
            G8_BAR; G8_WAIT_L(0); G8_MMA(1, 0, At, B0); G8_BAR; G8_SCHED;
            G8_STAGE_B(G8_SB(0, 1), b2 + hstep);
            G8_WAIT_V(6); G8_BAR; G8_MMA(1, 1, At, B1); G8_BAR;
            G8_LDB(B0, 1, 0); G8_SCHED; G8_LDA(At, 1, 0); G8_STAGE_A(G8_SA(0, 1), a2p, ka2, v2, 1);
            G8_WAIT_L(8); G8_BAR; G8_WAIT_L(0); G8_MMA(0, 0, At, B0); G8_BAR; G8_SCHED;
            G8_LDB(B1, 1, 1); G8_STAGE_B(G8_SB(1, 0), b3);
            G8_BAR; G8_WAIT_L(0); G8_MMA(0, 1, At, B1); G8_BAR;
            G8_LDA(At, 1, 1); G8_STAGE_A(G8_SA(1, 0), a2p, ka3, v2, 0);
            G8_BAR; G8_WAIT_L(0); G8_MMA(1, 0, At, B0); G8_BAR; G8_SCHED;
            G8_STAGE_B(G8_SB(1, 1), b3 + hstep);
            G8_WAIT_V(6); G8_BAR; G8_MMA(1, 1, At, B1); G8_BAR;
        }
        if constexpr (F8) asm volatile("s_nop 15\n\ts_nop 15" ::: "memory");
        E(acc, cur, wr, wc, fr, fq);
        if (!has_next) break;
#pragma unroll
        for (int a = 0; a < 2; ++a)
#pragma unroll
            for (int b = 0; b < 2; ++b)
#pragma unroll
                for (int m = 0; m < 4; ++m)
#pragma unroll
                    for (int n = 0; n < 2; ++n) acc[a][b][m][n] = (f32x4){0.f, 0.f, 0.f, 0.f};
        if constexpr (F8) asm volatile("s_nop 3" ::: "memory");
        cur = nxt; cB = nB; cA = nA; ++ui;
#pragma unroll
        for (int h = 0; h < 2; ++h)
#pragma unroll
            for (int i = 0; i < 2; ++i) vAc[h][i] = vAn[h][i];
    }
    G8_WAIT_V(0);
    if (wr == 0) G8_BAR;
    G8_BAR;
#undef G8_SA
#undef G8_SB
#undef G8_STAGE_A
#undef G8_STAGE_B
#undef G8_LDA
#undef G8_LDB
#undef G8_MMA
#undef G8_WAIT_V
#undef G8_WAIT_L
#undef G8_BAR
#undef G8_SCHED
}

struct DenseSched {
    static constexpr bool GATHER = false;
    int nM, nN, nwg, G, c, RB; const char* A; const char* Bt;
    DI void init(const void* A_, const void* Bt_, int M, int N, int RB_, int G_, int c_) { A = (const char*)A_; Bt = (const char*)Bt_; nM = M / BM; nN = N / BM; nwg = nM * nN; G = G_; c = c_; RB = RB_; }
    DI bool next(int i, Unit& u) const {
        const int L = i * G + c; if (L >= nwg) return false;
        int wgid = L; { const int q = nwg / 8, r = nwg % 8, xcd = wgid % 8, off = wgid / 8; wgid = (xcd < r ? xcd * (q + 1) : r * (q + 1) + (xcd - r) * q) + off; }
        const int nig = 8 * nN, gid = wgid / nig, fm = gid * 8, gsz = (nM - fm) < 8 ? (nM - fm) : 8;
        u.pm = fm + ((wgid % nig) % gsz); u.pn = (wgid % nig) / gsz; u.e = 0; u.ti = 0; u.ne = 0; u.rbase = 0; u.ix = 0; return true;
    }
    DI const char* a_base() const { return A; }
    DI unsigned a_off(const Unit&, int) const { return 0u; }
    DI const char* a_ptr(const Unit& u) const { return A + (size_t)u.pm * BM * RB; }
    DI const char* b_base(const Unit& u) const { return Bt + (size_t)u.pn * BM * RB; }
};
}
struct EpiInproj {
    static constexpr bool F8 = true;
    static constexpr bool PERM = true;
    const LAS float2* rope;
    unsigned char* q8; unsigned char* k8; unsigned char* vt8;
    LAS unsigned char* stg; int tid;
    static DI bool isv_cb(int cb) { const int kv = cb - 16; return (cb >= 16) && ((kv == 2) || (kv == 3) || (kv >= 8 && kv < 12) || (kv >= 20)); }
    DI void operator()(const f32x4 (&acc)[2][2][4][2], const g8::Unit& u, int wr, int wc, int fr, int fq) const {
        const bool lat = (u.pm * 256 < TL);
#pragma unroll
        for (int bj = 0; bj < 2; ++bj) {
            const int col0 = u.pn * 256 + bj * 128 + wc * 32 + 8 * fq;
            const int cb = col0 >> 6, kv = cb - 16;
            if (!isv_cb(cb)) continue;
            const float scale = 1.0f / W_SCALE;
            const int vrow0 = (kv < 4 ? (kv - 2) * 64 : (kv < 12 ? 128 + (kv - 8) * 64 : 384 + (kv - 20) * 64)) + (col0 & 63);
            const int pos = 32 * ((fr >> 2) & 1) + 4 * (((fr >> 3) << 2) | (fr & 3));
#pragma unroll
            for (int ai = 0; ai < 2; ++ai) {
                const int t0 = u.pm * 256 + ai * 128 + wr * 64;
                const int b = t0 < TL ? (t0 >> 12) : ((t0 - TL) >> 8);
                const int tile = t0 < TL ? ((t0 & 4095) >> 6) : (64 + (((t0 - TL) & 255) >> 6));
                unsigned char* base = vt8 + (size_t)(b * 68 + tile) * VT_TILE + (size_t)vrow0 * 64 + pos;
#pragma unroll
                for (int n = 0; n < 2; ++n)
#pragma unroll
                    for (int j = 0; j < 4; ++j)
                        *(unsigned*)(base + (4 * n + j) * 64) = pk4_fp8(acc[ai][bj][0][n][j] * scale, acc[ai][bj][1][n][j] * scale, acc[ai][bj][2][n][j] * scale, acc[ai][bj][3][n][j] * scale);
            }
        }
        if (!((u.pn < 6) || (u.pn == 7) || (u.pn == 8))) return;
        constexpr int RS = 272;
        if (wr == 0) __builtin_amdgcn_s_barrier();
#pragma unroll
        for (int ai = 0; ai < 2; ++ai)
#pragma unroll
            for (int mh = 0; mh < 2; ++mh) {
#pragma unroll
                for (int bj = 0; bj < 2; ++bj) {
                    const int col0 = u.pn * 256 + bj * 128 + wc * 32 + 8 * fq;
                    const int cb = col0 >> 6, i0 = (col0 & 63) >> 1;
                    if (isv_cb(cb)) continue;
                    const bool isq = cb < 16;
                    const bool roped = ((cb < 4) || (cb >= 8 && cb < 16) || (cb == 16) || (cb == 17) || (cb >= 28 && cb < 36)) && lat;
                    const float scale = (isq ? QSCALE : 1.0f) * (1.0f / W_SCALE);
#pragma unroll
                    for (int mm = 0; mm < 2; ++mm) {
                        const int m = mh * 2 + mm;
                        const int t = u.pm * 256 + ai * 128 + wr * 64 + m * 16 + fr;
                        f32x4 v0 = acc[ai][bj][m][0], v1 = acc[ai][bj][m][1];
                        if (roped) {
                            const int s = t & 4095;
                            const int pos = (i0 < 16) ? (s >> 6) : (s & 63);
                            const f32x4 ca = *(const LAS f32x4*)(rope + pos * 16 + (i0 & 15)), cb2 = *(const LAS f32x4*)(rope + pos * 16 + (i0 & 15) + 2);
                            f32x4 o0, o1;
                            o0[0] = v0[0] * ca[0] - v0[1] * ca[1]; o0[1] = v0[1] * ca[0] + v0[0] * ca[1];
                            o0[2] = v0[2] * ca[2] - v0[3] * ca[3]; o0[3] = v0[3] * ca[2] + v0[2] * ca[3];
                            o1[0] = v1[0] * cb2[0] - v1[1] * cb2[1]; o1[1] = v1[1] * cb2[0] + v1[0] * cb2[1];
                            o1[2] = v1[2] * cb2[2] - v1[3] * cb2[3]; o1[3] = v1[3] * cb2[2] + v1[2] * cb2[3];
                            v0 = o0; v1 = o1;
                        }
                        v0 *= scale; v1 *= scale;
                        u32x2 w; w.x = pk4_fp8(v0[0], v0[1], v0[2], v0[3]); w.y = pk4_fp8(v1[0], v1[1], v1[2], v1[3]);
                        *(LAS u32x2*)(stg + (wr * 32 + mm * 16 + fr) * RS + bj * 128 + wc * 32 + 8 * fq) = w;
                    }
                }
                asm volatile("s_waitcnt lgkmcnt(0)" ::: "memory"); __builtin_amdgcn_s_barrier(); asm volatile("" ::: "memory");
#pragma unroll
                for (int k = 0; k < 2; ++k) {
                    const int idx = tid + k * 512, rl = idx >> 4, pc = idx & 15;
                    const int cb = u.pn * 4 + (pc >> 2);
                    if (!isv_cb(cb)) {
                        const u32x4 v = *(const LAS u32x4*)(stg + rl * RS + pc * 16);
                        const int t = u.pm * 256 + ai * 128 + (rl >> 5) * 64 + mh * 32 + (rl & 31);
                        const int kv = cb - 16, ki = kv < 2 ? kv : (kv < 8 ? kv - 2 : kv - 6);
                        unsigned char* dst = (cb < 16) ? q8 + (size_t)t * 1024 + cb * 64 + (pc & 3) * 16 : k8 + (size_t)t * 1024 + ki * 64 + (pc & 3) * 16;
                        *(u32x4*)dst = v;
                    }
                }
                asm volatile("s_waitcnt lgkmcnt(0)" ::: "memory"); __builtin_amdgcn_s_barrier(); asm volatile("" ::: "memory");
            }
        if (wr == 1) __builtin_amdgcn_s_barrier();
    }
};
DI void phase_inproj(const Ctx& c, int l) {
    const Params& p = *c.p;
    g8::DenseSched S; S.init(p.ws + WS_HIN8, (const unsigned char*)(p.ws + WS_WIN) + (size_t)l * 2816 * 1024, TT, INC, DM, c.nblk, c.bid);
    {
        const float* rg = (const float*)(p.ws + WS_ROPE);
        LAS float* rl = (LAS float*)(c.smem + LDS_MAIN + 256);
        for (int i = c.tid; i < 2048; i += NTHREADS) rl[i] = rg[i];
        __syncthreads();
    }
    EpiInproj E; E.rope = (const LAS float2*)(c.smem + LDS_MAIN + 256); E.stg = (LAS unsigned char*)c.smem + LDS_MAIN + 256 + 8192; E.tid = c.tid;
    E.q8 = (unsigned char*)(p.ws + WS_Q8); E.k8 = (unsigned char*)(p.ws + WS_K8); E.vt8 = (unsigned char*)(p.ws + WS_VT8);
    g8::gemm_phase((LAS unsigned char*)c.smem, c.tid, DM, S, E);
}

struct EpiOutproj {
    static constexpr bool F8 = true;
    static constexpr bool PERM = false;
    float* xbuf; const float* modv; const float* x_in; const float* ctx_in; int l;
    DI void operator()(const f32x4 (&acc)[2][2][4][2], const g8::Unit& u, int wr, int wc, int fr, int fq) const {
        const int b = (u.pm * 256) < TL ? ((u.pm * 256) >> 12) : 8;
        const int col0 = u.pn * 256 + wc * 32 + 4 * fq;
        const float* gate = modv + (size_t)(l * 9 + b) * 6144 + 2048 + col0;
        f32x4 g[2][2];
#pragma unroll
        for (int bj = 0; bj < 2; ++bj)
#pragma unroll
            for (int n = 0; n < 2; ++n) g[bj][n] = *(const f32x4*)(gate + bj * 128 + n * 16) * (1.0f / (MIX_SCALE * W_SCALE));
#pragma unroll
        for (int ai = 0; ai < 2; ++ai)
#pragma unroll
            for (int m = 0; m < 4; ++m) {
                const int t = u.pm * 256 + ai * 128 + wr * 64 + m * 16 + fr;
                const float* xin = (t < TL ? x_in + (size_t)t * DM : ctx_in + (size_t)(t - TL) * DM) + col0;
                bf16_t* xo = (bf16_t*)xbuf + (size_t)t * DM + col0;
#pragma unroll
                for (int bj = 0; bj < 2; ++bj)
#pragma unroll
                    for (int n = 0; n < 2; ++n) {
                        const f32x4 x = (l == 0) ? *(const f32x4*)(xin + bj * 128 + n * 16) : bf4_f32(*(const u32x2*)(xo + bj * 128 + n * 16));
                        *(u32x2*)(xo + bj * 128 + n * 16) = f32_bf4(x + g[bj][n] * acc[ai][bj][m][n]);
                    }
            }
    }
};
DI void phase_outproj(const Ctx& c, int l, int nrows) {
    const Params& p = *c.p;
    g8::DenseSched S; S.init(p.ws + WS_MIX, (const unsigned char*)(p.ws + WS_WOUT) + (size_t)l * 1048576, nrows, DM, DM, c.nblk, c.bid);
    EpiOutproj E; E.xbuf = (float*)(p.ws + WS_XBUF); E.modv = (const float*)(p.ws + WS_MOD); E.x_in = p.in[I_X]; E.ctx_in = p.in[I_CTX]; E.l = l;
    g8::gemm_phase((LAS unsigned char*)c.smem, c.tid, DM, S, E);
}

struct EpiRouter {
    static constexpr bool F8 = false;
    static constexpr bool PERM = false;
    float* logit;
    DI void operator()(const f32x4 (&acc)[2][2][4][2], const g8::Unit& u, int wr, int wc, int fr, int fq) const {
#pragma unroll
        for (int ai = 0; ai < 2; ++ai)
#pragma unroll
            for (int m = 0; m < 4; ++m) {
                const int t = u.pm * 256 + ai * 128 + wr * 64 + m * 16 + fr;
#pragma unroll
                for (int bj = 0; bj < 2; ++bj)
#pragma unroll
                    for (int n = 0; n < 2; ++n) *(f32x4*)(logit + (size_t)t * NE + bj * 128 + wc * 32 + n * 16 + 4 * fq) = acc[ai][bj][m][n];
            }
    }
};
DI void phase_router(const Ctx& c, int l, int nrows) {
    const Params& p = *c.p;
    g8::DenseSched S; S.init(p.ws + WS_HBUF, (const bf16_t*)(p.ws + WS_WR) + (size_t)l * 262144, nrows, NE, DM * 2, c.nblk, c.bid);
    EpiRouter E; E.logit = (float*)(p.ws + WS_LOGIT);
    g8::gemm_phase((LAS unsigned char*)c.smem, c.tid, DM * 2, S, E);
}

struct RouterSched : g8::DenseSched {
    DI const char* b_base(const g8::Unit& u) const { const int b = (u.pm * 256) < TL ? ((u.pm * 256) >> 12) : 8; return Bt + (size_t)b * 524288 + (size_t)u.pn * 256 * RB; }
};
DI void phase_norm_router(const Ctx& c, int l, int nrows) {
    const Params& p = *c.p;
    {
        RouterSched S; S.init(p.ws + WS_XBUF, (const bf16_t*)(p.ws + WS_WRP) + (size_t)l * 9 * 262144, nrows, NE, DM * 2, c.nblk, c.bid);
        EpiRouter E; E.logit = (float*)(p.ws + WS_LOGIT);
        g8::gemm_phase((LAS unsigned char*)c.smem, c.tid, DM * 2, S, E);
    }
    int* ctr = (int*)(p.ws + WS_ROWCTR) + l * 64;
    LAS int* slot = (LAS int*)(c.smem + LDS_MAIN + 64);
    const float* modv = (const float*)(p.ws + WS_MOD);
    const float* g = p.in[I_GFFN] + l * 1024;
    const bf16_t* xbuf = (const bf16_t*)(p.ws + WS_XBUF);
    unsigned char* h8 = (unsigned char*)(p.ws + WS_H8);
    float* rstd = (float*)(p.ws + WS_RSTD);
    for (;;) {
        if (c.tid == 0) slot[0] = atomicAdd(ctr, 64);
        __syncthreads();
        const int base = slot[0];
        __syncthreads();
        if (base >= nrows) break;
#pragma unroll 1
        for (int i = 0; i < 8; ++i) {
            const int t = base + c.wid * 8 + i;
            if (t < nrows) {
                const int b = t < TL ? (t >> 12) : 8;
                const float* mv = modv + (size_t)(l * 9 + b) * 6144 + 3072;
                norm_ffn_row(xbuf + (size_t)t * DM, g, mv, mv + 1024, h8 + (size_t)t * DM, rstd + t, c.lane);
            }
        }
    }
}

DI void phase_route(const Ctx& c, int l, int nrows) {
    const Params& p = *c.p;
    const float* logit = (const float*)(p.ws + WS_LOGIT);
    const float* rb = p.in[I_RB] + l * NE;
    int* cnt = (int*)(p.ws + WS_CNT) + l * CNT_LAYER;
    int* list = (int*)(p.ws + WS_LIST);
    float* slotw = (float*)(p.ws + WS_SLOTW);
    int* einfo = (int*)(p.ws + WS_EINFO);
    LAS int* lcnt = (LAS int*)c.smem;
    LAS int* rec = (LAS int*)(c.smem + 1024);
    LAS float* recw = (LAS float*)(c.smem + 1024 + 8 * 24 * 8 * 4);
    constexpr int RMAX = 24;
    const int lane = c.lane;
    if (c.tid < 256) lcnt[c.tid] = 0;
    __syncthreads();
    const f32x4 bias = ((const f32x4*)rb)[lane];
    const float NINF = -__builtin_inff();
    int it = 0;
    const float* rstd = (const float*)(p.ws + WS_RSTD);
    const float* cbl = (const float*)(p.ws + WS_CB) + l * 9 * 256;
    for (int t = c.bid * NWAVES + c.wid; t < nrows; t += c.nblk * NWAVES, ++it) {
        const int bb = t < TL ? (t >> 12) : 8;
        const f32x4 lg = ((const f32x4*)(logit + (size_t)t * NE))[lane] * rstd[t] + ((const f32x4*)(cbl + bb * 256))[lane];
        const float s0 = 1.f / (1.f + __expf(-lg.x)), s1 = 1.f / (1.f + __expf(-lg.y)), s2 = 1.f / (1.f + __expf(-lg.z)), s3 = 1.f / (1.f + __expf(-lg.w));
        float m0 = s0 + bias.x, m1 = s1 + bias.y, m2 = s2 + bias.z, m3 = s3 + bias.w;
        float a1 = fmaxf(m0, m1), a2 = fminf(m0, m1);
        { const float b1 = fmaxf(m2, m3), b2 = fminf(m2, m3); const float n1 = fmaxf(a1, b1), n2 = fmaxf(fminf(a1, b1), fmaxf(a2, b2)); a1 = n1; a2 = n2; }
        { const float b1 = DPPF(a1, DPP_XOR1), b2 = DPPF(a2, DPP_XOR1); const float n1 = fmaxf(a1, b1), n2 = fmaxf(fminf(a1, b1), fmaxf(a2, b2)); a1 = n1; a2 = n2; }
        { const float b1 = DPPF(a1, DPP_XOR2), b2 = DPPF(a2, DPP_XOR2); const float n1 = fmaxf(a1, b1), n2 = fmaxf(fminf(a1, b1), fmaxf(a2, b2)); a1 = n1; a2 = n2; }
        { const float b1 = DPPF(a1, DPP_HMIR), b2 = DPPF(a2, DPP_HMIR); const float n1 = fmaxf(a1, b1), n2 = fmaxf(fminf(a1, b1), fmaxf(a2, b2)); a1 = n1; a2 = n2; }
        const float gs = a1 + a2;
        const int g = lane >> 3;
        int rank = 0;
#pragma unroll
        for (int j = 0; j < 8; ++j) { const float gj = rdlane_f(gs, j * 8); rank += ((gj > gs) || (gj == gs && j < g)) ? 1 : 0; }
        if (rank >= 4) { m0 = NINF; m1 = NINF; m2 = NINF; m3 = NINF; }
        float wsum = 0.f, my_w = 0.f; int my_e = 0;
#pragma unroll
        for (int k = 0; k < 8; ++k) {
            float bv = m0, bs = s0; int bi = 0;
            if (m1 > bv) { bv = m1; bs = s1; bi = 1; }
            if (m2 > bv) { bv = m2; bs = s2; bi = 2; }
            if (m3 > bv) { bv = m3; bs = s3; bi = 3; }
            float v = bv;
            v = fmaxf(v, DPPF(v, DPP_XOR1)); v = fmaxf(v, DPPF(v, DPP_XOR2)); v = fmaxf(v, DPPF(v, DPP_HMIR)); v = fmaxf(v, DPPF(v, DPP_MIR));
            const float wmx = fmaxf(fmaxf(rdlane_f(v, 0), rdlane_f(v, 16)), fmaxf(rdlane_f(v, 32), rdlane_f(v, 48)));
            const unsigned long long bal = __ballot(bv == wmx);
            const int win = __ffsll((long long)bal) - 1;
            const int sub = __builtin_amdgcn_readlane(bi, win);
            const float sw = rdlane_f(bs, win);
            if (lane == win) { if (sub == 0) m0 = NINF; else if (sub == 1) m1 = NINF; else if (sub == 2) m2 = NINF; else m3 = NINF; }
            wsum += sw;
            if (lane == k) { my_e = win * 4 + sub; my_w = sw; }
        }
        if (lane < 8 && it < RMAX) {
            const int lp = __hip_atomic_fetch_add(&lcnt[my_e], 1, __ATOMIC_RELAXED, __HIP_MEMORY_SCOPE_WORKGROUP);
            rec[(c.wid * RMAX + it) * 8 + lane] = (my_e << 16) | lp;
            recw[(c.wid * RMAX + it) * 8 + lane] = my_w / wsum * 2.5f;
        }
    }
    __syncthreads();
    if (c.tid < 256) { const int n = lcnt[c.tid]; lcnt[c.tid] = (n > 0) ? atomicAdd(&cnt[c.tid * CNT_STRIDE], n) : 0; }
    __syncthreads();
    it = 0;
    for (int t = c.bid * NWAVES + c.wid; t < nrows; t += c.nblk * NWAVES, ++it) {
        if (lane < 8 && it < RMAX) {
            const int r = rec[(c.wid * RMAX + it) * 8 + lane];
            const int e = r >> 16, pos = lcnt[e] + (r & 0xffff);
            list[(size_t)e * TT + pos] = t;
            slotw[(size_t)t * 8 + lane] = recw[(c.wid * RMAX + it) * 8 + lane];
            einfo[(size_t)t * 8 + lane] = (e << 16) | pos;
        }
    }
}

DI void moe_setup(const Ctx& c, int l, int nrows) {
    const int* cnt = (const int*)(c.p->ws + WS_CNT) + l * CNT_LAYER;
    LAS int* tstart = (LAS int*)(c.smem + LDS_MAIN + 1024);
    LAS int* roff = (LAS int*)(c.smem + LDS_MAIN + 2064);
    LAS int* cntl = (LAS int*)(c.smem + LDS_MAIN + 3104);
    LAS int* wtot = (LAS int*)(c.smem + LDS_MAIN + 4160);
    const int n = (c.tid < 256) ? cnt[c.tid * CNT_STRIDE] : 0;
    const int nt = (n + 255) >> 8;
    int vt = nt, vr = n;
    vt += DPPI(vt, DPP_SHR(1)); vr += DPPI(vr, DPP_SHR(1)); vt += DPPI(vt, DPP_SHR(2)); vr += DPPI(vr, DPP_SHR(2));
    vt += DPPI(vt, DPP_SHR(4)); vr += DPPI(vr, DPP_SHR(4)); vt += DPPI(vt, DPP_SHR(8)); vr += DPPI(vr, DPP_SHR(8));
    { const int t0 = __builtin_amdgcn_readlane(vt, 15), t1 = __builtin_amdgcn_readlane(vt, 31), t2 = __builtin_amdgcn_readlane(vt, 47);
      const int r0 = __builtin_amdgcn_readlane(vr, 15), r1 = __builtin_amdgcn_readlane(vr, 31), r2 = __builtin_amdgcn_readlane(vr, 47);
      const int row = c.lane >> 4;
      vt += (row > 0 ? t0 : 0) + (row > 1 ? t1 : 0) + (row > 2 ? t2 : 0); vr += (row > 0 ? r0 : 0) + (row > 1 ? r1 : 0) + (row > 2 ? r2 : 0); }
    if (c.lane == 63 && c.wid < 4) { wtot[c.wid] = vt; wtot[4 + c.wid] = vr; }
    __syncthreads();
    if (c.tid < 256) {
        int pt = 0, pr = 0;
        for (int w = 0; w < c.wid; ++w) { pt += wtot[w]; pr += wtot[4 + w]; }
        tstart[c.tid] = pt + vt - nt; roff[c.tid] = pr + vr - n; cntl[c.tid] = n;
        if (c.tid == 255) { tstart[256] = pt + vt; roff[256] = pr + vr; tstart[257] = pt + vt + nrows / 256; roff[257] = pr + vr + nrows; cntl[256] = nrows; }
    }
    __syncthreads();
}

constexpr int MOE_MAXU = 32, MOE_MAXG = 12;
template <bool GATHER_>
struct MoeSched {
    static constexpr bool GATHER = GATHER_;
    const LAS int* utab; const LAS unsigned* toks; int nmy;
    const char* A; const char* W; size_t wstride; int RB;
    DI bool next(int i, g8::Unit& u) const {
        if (i >= nmy) return false;
        const LAS int* e = utab + i * 8;
        u.pn = __builtin_amdgcn_readfirstlane(e[0]); u.e = __builtin_amdgcn_readfirstlane(e[1]); u.ti = __builtin_amdgcn_readfirstlane(e[2]);
        u.ne = __builtin_amdgcn_readfirstlane(e[3]); u.rbase = __builtin_amdgcn_readfirstlane(e[4]); u.pm = __builtin_amdgcn_readfirstlane(e[5]); u.ix = i;
        return true;
    }
    DI const char* a_base() const { return A; }
    DI unsigned a_off(const g8::Unit& u, int row) const { return toks[u.ix * 256 + row]; }
    DI const char* a_ptr(const g8::Unit& u) const { return A + (size_t)u.rbase * RB; }
    DI const char* b_base(const g8::Unit& u) const { return W + (size_t)u.e * wstride + (size_t)u.pn * 256 * RB; }
};
DI int moe_units(const Ctx& c, int NB, bool gather, const int* list, int rowbytes) {
    const LAS int* tstart = (const LAS int*)(c.smem + LDS_MAIN + 1024);
    const LAS int* roff = (const LAS int*)(c.smem + LDS_MAIN + 2064);
    const LAS int* cntl = (const LAS int*)(c.smem + LDS_MAIN + 3104);
    LAS int* utab = (LAS int*)(c.smem + LDS_MAIN + 4224);
    LAS unsigned* toks = (LAS unsigned*)(c.smem + LDS_MAIN + 8192);
    const int nunits = tstart[257] * NB;
    int nmy = (nunits > c.bid) ? (nunits - c.bid + c.nblk - 1) / c.nblk : 0;
    { const int cap = gather ? MOE_MAXG : MOE_MAXU; nmy = nmy > cap ? cap : nmy; }
    if (c.tid < nmy) {
        const int L = c.tid * c.nblk + c.bid;
        int w = L; { const int q = nunits / 8, r = nunits % 8, xcd = w % 8, off = w / 8; w = (xcd < r ? xcd * (q + 1) : r * (q + 1) + (xcd - r) * q) + off; }
        const int tile = w / NB;
        int lo = 0, hi = 256;
        while (lo < hi) { const int mid = (lo + hi + 1) >> 1; if (tstart[mid] <= tile) lo = mid; else hi = mid - 1; }
        const int ti = tile - tstart[lo];
        LAS int* e = utab + c.tid * 8;
        e[0] = w - tile * NB; e[1] = lo; e[2] = ti; e[3] = cntl[lo]; e[4] = roff[lo] + ti * 256; e[5] = tile;
    }
    __syncthreads();
    if (gather) {
        for (int idx = c.tid; idx < nmy * 256; idx += NTHREADS) {
            const LAS int* e = utab + (idx >> 8) * 8;
            const int ex = e[1], ne = e[3];
            int ridx = e[2] * 256 + (idx & 255); ridx = ridx < ne ? ridx : ne - 1;
            const int tok = (ex < 256) ? list[(size_t)ex * TT + ridx] : ridx;
            toks[idx] = (unsigned)tok * (unsigned)rowbytes;
        }
        __syncthreads();
    }
    return nmy;
}

#ifdef E1_DIRECT
struct EpiE1 {
    static constexpr bool F8 = true;
    static constexpr bool PERM = true;
    unsigned char* act;
    LAS unsigned char* stg; int tid;
    DI void operator()(const f32x4 (&acc)[2][2][4][2], const g8::Unit& u, int wr, int wc, int fr, int fq) const {
        constexpr float IS = 1.0f / W_SCALE;
#pragma unroll
        for (int ai = 0; ai < 2; ++ai)
#pragma unroll
            for (int m = 0; m < 4; ++m) {
                const int row = ai * 128 + wr * 64 + m * 16 + fr;
                if (u.ti * 256 + row < u.ne) {
#pragma unroll
                    for (int bj = 0; bj < 2; ++bj) {
                        const int col0 = u.pn * 256 + bj * 128 + wc * 32 + 8 * fq;
                        const f32x4 v0 = acc[ai][bj][m][0] * IS, v1 = acc[ai][bj][m][1] * IS;
                        const float a0 = v0[0] * __builtin_amdgcn_rcpf(1.f + __expf(-v0[0])) * v0[1], a1 = v0[2] * __builtin_amdgcn_rcpf(1.f + __expf(-v0[2])) * v0[3];
                        const float a2 = v1[0] * __builtin_amdgcn_rcpf(1.f + __expf(-v1[0])) * v1[1], a3 = v1[2] * __builtin_amdgcn_rcpf(1.f + __expf(-v1[2])) * v1[3];
                        *(unsigned*)(act + (size_t)(u.rbase + row) * FF + (col0 >> 1)) = pk4_fp8(a0 * ACT_SCALE, a1 * ACT_SCALE, a2 * ACT_SCALE, a3 * ACT_SCALE);
                    }
                }
            }
    }
};
#else
struct EpiE1 {
    static constexpr bool F8 = true;
    static constexpr bool PERM = true;
    unsigned char* act;
    LAS unsigned char* stg; int tid;
    DI void operator()(const f32x4 (&acc)[2][2][4][2], const g8::Unit& u, int wr, int wc, int fr, int fq) const {
        constexpr float IS = 1.0f / W_SCALE;
        constexpr int RS = 144;
        if (wr == 0) __builtin_amdgcn_s_barrier();
#pragma unroll
        for (int ai = 0; ai < 2; ++ai)
#pragma unroll
            for (int mh = 0; mh < 2; ++mh) {
#pragma unroll
                for (int mm = 0; mm < 2; ++mm) {
                    const int m = mh * 2 + mm;
                    LAS unsigned char* d = stg + (wr * 32 + mm * 16 + fr) * RS + wc * 16 + 4 * fq;
#pragma unroll
                    for (int bj = 0; bj < 2; ++bj) {
                        const f32x4 v0 = acc[ai][bj][m][0] * IS, v1 = acc[ai][bj][m][1] * IS;
                        const float a0 = v0[0] * __builtin_amdgcn_rcpf(1.f + __expf(-v0[0])) * v0[1], a1 = v0[2] * __builtin_amdgcn_rcpf(1.f + __expf(-v0[2])) * v0[3];
                        const float a2 = v1[0] * __builtin_amdgcn_rcpf(1.f + __expf(-v1[0])) * v1[1], a3 = v1[2] * __builtin_amdgcn_rcpf(1.f + __expf(-v1[2])) * v1[3];
                        *(LAS unsigned*)(d + bj * 64) = pk4_fp8(a0 * ACT_SCALE, a1 * ACT_SCALE, a2 * ACT_SCALE, a3 * ACT_SCALE);
                    }
                }
                asm volatile("s_waitcnt lgkmcnt(0)" ::: "memory"); __builtin_amdgcn_s_barrier(); asm volatile("" ::: "memory");
                {
                    const int rl = tid >> 3, pc = tid & 7;
                    const u32x4 v = *(const LAS u32x4*)(stg + rl * RS + pc * 16);
                    const int row = ai * 128 + (rl >> 5) * 64 + mh * 32 + (rl & 31);
                    if (u.ti * 256 + row < u.ne) __builtin_nontemporal_store(v, (u32x4*)(act + (size_t)(u.rbase + row) * FF + u.pn * 128 + pc * 16));
                }
                asm volatile("s_waitcnt lgkmcnt(0)" ::: "memory"); __builtin_amdgcn_s_barrier(); asm volatile("" ::: "memory");
            }
        if (wr == 1) __builtin_amdgcn_s_barrier();
    }
};
#endif
DI void phase_e1(const Ctx& c, int l, int nrows) {
    const Params& p = *c.p;
    moe_setup(c, l, nrows);
    MoeSched<true> S;
    S.nmy = moe_units(c, 2, true, (const int*)(p.ws + WS_LIST), DM);
    S.utab = (const LAS int*)(c.smem + LDS_MAIN + 4224); S.toks = (const LAS unsigned*)(c.smem + LDS_MAIN + 8192);
    S.A = (const char*)(p.ws + WS_H8); S.W = (const char*)(p.ws + WS_WGU) + (size_t)l * 257 * 524288; S.wstride = 524288; S.RB = DM;
    EpiE1 E; E.act = (unsigned char*)(p.ws + WS_ACT); E.stg = (LAS unsigned char*)c.smem + LDS_MAIN + 8192 + MOE_MAXG * 1024; E.tid = c.tid;
    g8::gemm_phase((LAS unsigned char*)c.smem, c.tid, DM, S, E);
}

struct EpiE2 {
    static constexpr bool F8 = true;
    static constexpr bool PERM = true;
    unsigned char* ys;
    LAS unsigned char* stg; int tid;
    DI void operator()(const f32x4 (&acc)[2][2][4][2], const g8::Unit& u, int wr, int wc, int fr, int fq) const {
        constexpr float SC = 16.f / (ACT_SCALE * WD_SCALE);
        constexpr int RS = 272;
        if (wr == 0) __builtin_amdgcn_s_barrier();
#pragma unroll
        for (int ai = 0; ai < 2; ++ai)
#pragma unroll
            for (int mh = 0; mh < 2; ++mh) {
#pragma unroll
                for (int mm = 0; mm < 2; ++mm) {
                    const int m = mh * 2 + mm;
                    LAS unsigned char* d = stg + (wr * 32 + mm * 16 + fr) * RS + wc * 32 + 8 * fq;
#pragma unroll
                    for (int bj = 0; bj < 2; ++bj) {
                        const f32x4 v0 = acc[ai][bj][m][0] * SC, v1 = acc[ai][bj][m][1] * SC;
                        int w0 = 0, w1 = 0;
                        w0 = __builtin_amdgcn_cvt_pk_fp8_f32(v0[0], v0[1], w0, false); w0 = __builtin_amdgcn_cvt_pk_fp8_f32(v0[2], v0[3], w0, true);
                        w1 = __builtin_amdgcn_cvt_pk_fp8_f32(v1[0], v1[1], w1, false); w1 = __builtin_amdgcn_cvt_pk_fp8_f32(v1[2], v1[3], w1, true);
                        u32x2 o; o.x = (unsigned)w0; o.y = (unsigned)w1;
                        *(LAS u32x2*)(d + bj * 128) = o;
                    }
                }
                asm volatile("s_waitcnt lgkmcnt(0)" ::: "memory"); __builtin_amdgcn_s_barrier(); asm volatile("" ::: "memory");
#pragma unroll
                for (int k = 0; k < 2; ++k) {
                    const int idx = tid + k * 512, rl = idx >> 4, pc = idx & 15;
                    const u32x4 v = *(const LAS u32x4*)(stg + rl * RS + pc * 16);
                    const int row = ai * 128 + (rl >> 5) * 64 + mh * 32 + (rl & 31);
                    if (u.ti * 256 + row < u.ne) __builtin_nontemporal_store(v, (u32x4*)(ys + (size_t)(u.rbase + row) * DM + u.pn * 256 + pc * 16));
                }
                asm volatile("s_waitcnt lgkmcnt(0)" ::: "memory"); __builtin_amdgcn_s_barrier(); asm volatile("" ::: "memory");
            }
        if (wr == 1) __builtin_amdgcn_s_barrier();
    }
};
DI void phase_e2(const Ctx& c, int l, int nrows) {
    const Params& p = *c.p;
    moe_setup(c, l, nrows);
    MoeSched<false> S;
    S.nmy = moe_units(c, 4, false, nullptr, 0);
    S.utab = (const LAS int*)(c.smem + LDS_MAIN + 4224); S.toks = (const LAS unsigned*)(c.smem + LDS_MAIN + 8192);
    S.A = (const char*)(p.ws + WS_ACT); S.W = (const char*)(p.ws + WS_WD) + (size_t)l * 257 * 262144; S.wstride = 262144; S.RB = FF;
    EpiE2 E; E.ys = (unsigned char*)(p.ws + WS_YS); E.stg = (LAS unsigned char*)c.smem + LDS_STG; E.tid = c.tid;
    g8::gemm_phase((LAS unsigned char*)c.smem, c.tid, FF, S, E);
}

DI void phase_combine(const Ctx& c, int l, int nrows, bool last) {
    const Params& p = *c.p;
    moe_setup(c, l, nrows);
    const LAS int* roff = (const LAS int*)(c.smem + LDS_MAIN + 2064);
    const unsigned char* ys = (const unsigned char*)(p.ws + WS_YS);
    const int* einfo = (const int*)(p.ws + WS_EINFO);
    const float* slotw = (const float*)(p.ws + WS_SLOTW);
    float* xbuf = (float*)(p.ws + WS_XBUF);
    bf16_t* hbuf = (bf16_t*)(p.ws + WS_HBUF);
    const float* modv = (const float*)(p.ws + WS_MOD);
    const int lane = c.lane;
    const int shared0 = roff[256];
    for (int t = c.bid * NWAVES + c.wid; t < nrows; t += c.nblk * NWAVES) {
        const int b = t < TL ? (t >> 12) : 8;
        const float* gate = modv + (size_t)(l * 9 + b) * 6144 + 5120 + 16 * lane;
        int myrow = 0; float myw = 0.f;
        if (lane < 8) { const int ei = einfo[(size_t)t * 8 + lane]; myrow = roff[ei >> 16] + (ei & 0xffff); myw = slotw[(size_t)t * 8 + lane] * (1.f / 16.f); }
        if (lane == 8) { myrow = shared0 + t; myw = 1.f / 16.f; }
        f32x4 v[4], a[4];
        {
            const u32x4 x0 = *(const u32x4*)((const bf16_t*)xbuf + (size_t)t * DM + 16 * lane), x1 = *(const u32x4*)((const bf16_t*)xbuf + (size_t)t * DM + 16 * lane + 8);
            v[0] = bf4_f32(u32x2{x0.x, x0.y}); v[1] = bf4_f32(u32x2{x0.z, x0.w}); v[2] = bf4_f32(u32x2{x1.x, x1.y}); v[3] = bf4_f32(u32x2{x1.z, x1.w});
        }
#pragma unroll
        for (int j = 0; j < 4; ++j) a[j] = f32x4{0.f, 0.f, 0.f, 0.f};
#pragma unroll
        for (int k = 0; k < 9; ++k) {
            const int row = __builtin_amdgcn_readlane(myrow, k); const float w = rdlane_f(myw, k);
            const u32x4 y = *(const u32x4*)(ys + (size_t)row * DM + 16 * lane);
#pragma unroll
            for (int j = 0; j < 4; ++j) {
                const unsigned word = (j == 0) ? y.x : (j == 1) ? y.y : (j == 2) ? y.z : y.w;
                const auto lo = __builtin_amdgcn_cvt_pk_f32_fp8((int)word, false), hi = __builtin_amdgcn_cvt_pk_f32_fp8((int)word, true);
                a[j].x += w * lo[0]; a[j].y += w * lo[1]; a[j].z += w * hi[0]; a[j].w += w * hi[1];
            }
        }
        float s = 0.f;
#pragma unroll
        for (int j = 0; j < 4; ++j) {
            const f32x4 g = *(const f32x4*)(gate + 4 * j);
            v[j] += g * a[j];
            s += (v[j].x * v[j].x + v[j].y * v[j].y) + (v[j].z * v[j].z + v[j].w * v[j].w);
        }
        const float rstd = rsqrtf(wave_sum(s) * (1.f / DM) + EPSV);
        if (last) {
            const float* gf = p.in[I_GFINAL] + 16 * lane;
#pragma unroll
            for (int j = 0; j < 4; ++j) {
                const f32x4 g = *(const f32x4*)(gf + 4 * j);
                *(f32x4*)(p.out + (size_t)t * DM + 16 * lane + 4 * j) = v[j] * rstd * g;
            }
        } else {
            const float* g = p.in[I_GMIX] + (l + 1) * 1024 + 16 * lane;
            const float* mv = modv + (size_t)((l + 1) * 9 + b) * 6144 + 16 * lane;
            u32x4 o8;
#pragma unroll
            for (int j = 0; j < 4; ++j) {
                *(u32x2*)((bf16_t*)xbuf + (size_t)t * DM + 16 * lane + 4 * j) = f32_bf4(v[j]);
                const f32x4 gg = *(const f32x4*)(g + 4 * j), shh = *(const f32x4*)(mv + 4 * j), scc = *(const f32x4*)(mv + 1024 + 4 * j);
                const f32x4 y = v[j] * rstd * gg * (1.f + scc) + shh;
                const unsigned w8 = pk4_fp8(y.x, y.y, y.z, y.w);
                if (j == 0) o8.x = w8; else if (j == 1) o8.y = w8; else if (j == 2) o8.z = w8; else o8.w = w8;
            }
            *(u32x4*)((unsigned char*)(p.ws + WS_HIN8) + (size_t)t * DM + 16 * lane) = o8;
        }
    }
}
DI void glds16(const void* g, LAS char* l) { __builtin_amdgcn_global_load_lds((const unsigned*)g, (LAS unsigned*)l, 16, 0, 0); }
#define VM_DRAIN() asm volatile("s_waitcnt vmcnt(0)" ::: "memory")
constexpr float FLASH_THR = 8.0f;
struct ModNone { DI bool active(int) const { return true; } DI void apply(int, f32x16&, f32x16&) const {} };
struct ModSwa {
    int nloc, kpos0, qpos, qmin, hi_;
    DI bool active(int j) const { if (j >= nloc) return true; const int k0 = kpos0 + 64 * j; return (k0 + 63 >= qmin - 128) && (k0 <= qmin + 31 + 128); }
    DI void apply(int j, f32x16& s0, f32x16& s1) const {
        if (j >= nloc) return;
        const int hi = hi_;
        const int kb = kpos0 + 64 * j + 4 * hi - qpos;
        const float NINF = -__builtin_inff();
#pragma unroll
        for (int r = 0; r < 16; ++r) {
            const int d = kb + (r & 3) + 8 * (r >> 2);
            if (d < -128 || d > 128) s0[r] = NINF;
            if (d + 32 < -128 || d + 32 > 128) s1[r] = NINF;
        }
    }
};
struct ModNa {
    int nloc, kr0, qr, qc, rs, cs, hi_;
    const LAS float* rpb;
    DI bool active(int j) const { if (j >= nloc) return true; const int kr = kr0 + j; return kr >= rs && kr < rs + 8; }
    DI void apply(int j, f32x16& s0, f32x16& s1) const {
        if (j >= nloc) return;
        const int hi = hi_;
        const int kr = kr0 + j;
        const LAS float* row = rpb + (kr - qr + 7) * 31 + 15 - qc;
        const float NINF = -__builtin_inff();
        float b0[16], b1[16];
#pragma unroll
        for (int r = 0; r < 16; ++r) { const int kc = 4 * hi + (r & 3) + 8 * (r >> 2); b0[r] = row[kc]; b1[r] = row[kc + 32]; }
#pragma unroll
        for (int r = 0; r < 16; ++r) {
            const int kc = 4 * hi + (r & 3) + 8 * (r >> 2);
            const bool ok0 = (kc >= cs) && (kc < cs + 16), ok1 = (kc + 32 >= cs) && (kc + 32 < cs + 16);
            s0[r] = ok0 ? s0[r] + b0[r] : NINF;
            s1[r] = ok1 ? s1[r] + b1[r] : NINF;
        }
    }
};


typedef __attribute__((ext_vector_type(8))) int v8i_f;
typedef __attribute__((ext_vector_type(4))) int v4i_f;
DI void mfma8(f32x16& d, const v8i_f& a, const v8i_f& b, const f32x16& c, int sc) {
    asm volatile("v_mfma_scale_f32_32x32x64_f8f6f4 %0, %1, %2, %3, %4, %4 op_sel_hi:[0,0,0]" : "=&v"(d) : "v"(a), "v"(b), "v"(c), "v"(sc));
}
DI void mfma8_acc(f32x16& d, const v8i_f& a, const v8i_f& b, int sc) {
    asm volatile("v_mfma_scale_f32_32x32x64_f8f6f4 %0, %1, %2, %0, %3, %3 op_sel_hi:[0,0,0]" : "+v"(d) : "v"(a), "v"(b), "v"(sc));
}
template <int DV> struct F8State { float m, l; f32x16 o[DV / 32]; f32x16 cinit; };

template <int DV, class Tok0, class Tile0, class Mod>
DI void pass8(const Ctx& c, int ki, int vrow0, int ntiles, Tok0 tok0, Tile0 vtile, Mod& mod, const v8i_f& qf, F8State<DV>& st) {
    constexpr int ND = DV / 32, STAGE = 4096 + DV * 64;
    const unsigned char* k8 = (const unsigned char*)(c.p->ws + WS_K8);
    const unsigned char* vt8 = (const unsigned char*)(c.p->ws + WS_VT8);
    LAS char* lds = (LAS char*)c.smem;
    const int lane = c.lane, r32 = c.r32, hi = c.hi, w = c.wid;
    int usc = 0x7F7F7F7F; asm volatile("" : "+v"(usc));
    const int prow = 16 * (w & 3) + (lane >> 2), pslot = lane & 3;
    const unsigned koff = (unsigned)(prow * 1024 + ki * 64 + ((pslot ^ ((prow >> 2) & 3)) << 4));
    const int vpiece = (DV == 128) ? w : (w & 3);
    const int vrow = 16 * vpiece + (lane >> 2);
    const unsigned voff = (unsigned)((vrow0 + vrow) * 64 + ((pslot ^ ((vrow >> 2) & 3)) << 4));
    auto issue = [&](int j, LAS char* stage) {
        if (w < 4) glds16(k8 + tok0(j) * 1024 + koff, stage + w * 1024);
        if (DV == 128 || w >= 4) glds16(vt8 + vtile(j) * (size_t)VT_TILE + voff, stage + 4096 + vpiece * 1024);
    };
    st.m = 0.f; st.l = 0.f;
#pragma unroll
    for (int r = 0; r < 16; ++r) st.cinit[r] = 0.f;
#pragma unroll
    for (int d = 0; d < ND; ++d)
#pragma unroll
        for (int r = 0; r < 16; ++r) st.o[d][r] = 0.f;
    issue(0, lds);
    VM_DRAIN();
    __syncthreads();
    const int f = (r32 >> 2) & 3;
    const int o_lo = r32 * 64 + (((2 * hi) ^ f) << 4), o_hi = r32 * 64 + (((2 * hi + 1) ^ f) << 4);
    if (__builtin_amdgcn_readfirstlane(w) >= 4) __builtin_amdgcn_s_setprio(1);
    for (int j = 0; j < ntiles; ++j) {
        if (j + 1 < ntiles) issue(j + 1, lds + ((j + 1) & 1) * STAGE);
        const LAS char* stage = lds + (j & 1) * STAGE;
        if (mod.active(j)) {
            v8i_f ka, kb;
            ka.lo = *(const LAS v4i_f*)(stage + o_lo); ka.hi = *(const LAS v4i_f*)(stage + o_hi);
            kb.lo = *(const LAS v4i_f*)(stage + 2048 + o_lo); kb.hi = *(const LAS v4i_f*)(stage + 2048 + o_hi);
            f32x16 s0, s1;
            mfma8(s0, ka, qf, st.cinit, usc); mfma8(s1, kb, qf, st.cinit, usc);
            v8i_f va, vb;
            va.lo = *(const LAS v4i_f*)(stage + 4096 + o_lo); va.hi = *(const LAS v4i_f*)(stage + 4096 + o_hi);
            vb.lo = *(const LAS v4i_f*)(stage + 4096 + 2048 + o_lo); vb.hi = *(const LAS v4i_f*)(stage + 4096 + 2048 + o_hi);
            asm volatile("s_nop 15\n\ts_nop 15" : "+v"(s0), "+v"(s1));
            mod.apply(j, s0, s1);
            float mx = fmaxf(fmaxf(s0[0], s0[1]), s1[0]);
            mx = fmaxf(fmaxf(mx, s1[1]), fmaxf(s0[2], s1[2]));
#pragma unroll
            for (int r = 3; r < 15; r += 2) mx = fmaxf(fmaxf(mx, s0[r]), fmaxf(s0[r + 1], fmaxf(s1[r], s1[r + 1])));
            mx = fmaxf(mx, fmaxf(s0[15], s1[15]));
            { const auto rr = __builtin_amdgcn_permlane32_swap(__float_as_uint(mx), __float_as_uint(mx), false, false); mx = fmaxf(__uint_as_float(rr[0]), __uint_as_float(rr[1])); }
            const bool seen = mx > -1e29f;
            const bool started = half_swap_sum(st.l) > 0.f;
            const bool mv = (mx > FLASH_THR) || (!started && seen);
            if (__any(mv)) {
                const float d = mv ? mx : 0.f;
                const float fs = (mv && started) ? __builtin_amdgcn_exp2f(-d) : 1.f;
                st.m += d; st.l *= fs;
                const float nm2 = -st.m;
                asm volatile("s_nop 15\n\ts_nop 15");
#pragma unroll
                for (int dd = 0; dd < ND; ++dd) asm volatile("" : "+v"(st.o[dd]));
#pragma unroll
                for (int r = 0; r < 16; ++r) { s0[r] -= d; s1[r] -= d; st.cinit[r] = nm2; }
#pragma unroll
                for (int dd = 0; dd < ND; ++dd)
#pragma unroll
                    for (int r = 0; r < 16; ++r) st.o[dd][r] *= fs;
            }
            float rs0 = 0.f, rs1 = 0.f;
#pragma unroll
            for (int r = 0; r < 16; ++r) { s0[r] = __builtin_amdgcn_exp2f(s0[r]); s1[r] = __builtin_amdgcn_exp2f(s1[r]); rs0 += s0[r]; rs1 += s1[r]; }
            st.l += rs0 + rs1;
            v8i_f pf;
#pragma unroll
            for (int idx = 0; idx < 8; ++idx) { const int r0 = (idx >> 2) * 4 + (idx & 3); pf[idx] = (int)pk4_fp8(s0[r0], s0[r0 + 8], s1[r0], s1[r0 + 8]); }
            asm volatile("s_nop 3" : "+v"(pf));
            mfma8_acc(st.o[0], va, pf, usc); mfma8_acc(st.o[1], vb, pf, usc);
            if constexpr (DV == 128) {
                va.lo = *(const LAS v4i_f*)(stage + 4096 + 4096 + o_lo); va.hi = *(const LAS v4i_f*)(stage + 4096 + 4096 + o_hi);
                vb.lo = *(const LAS v4i_f*)(stage + 4096 + 6144 + o_lo); vb.hi = *(const LAS v4i_f*)(stage + 4096 + 6144 + o_hi);
                mfma8_acc(st.o[2], va, pf, usc); mfma8_acc(st.o[3], vb, pf, usc);
            }
        }
        VM_DRAIN();
        __syncthreads();
    }
    __builtin_amdgcn_s_setprio(0);
    asm volatile("s_nop 15\n\ts_nop 15");
#pragma unroll
    for (int dd = 0; dd < ND; ++dd) asm volatile("" : "+v"(st.o[dd]));
}

DI v8i_f load_q8(const Ctx& c, size_t qtok, int cb) {
    const unsigned char* q8 = (const unsigned char*)(c.p->ws + WS_Q8) + qtok * 1024 + cb * 64 + 32 * c.hi;
    v8i_f qf; qf.lo = *(const v4i_f*)q8; qf.hi = *(const v4i_f*)(q8 + 16);
    return qf;
}
template <int DV>
DI void store_o8(const F8State<DV>& st, float inv, unsigned char* __restrict__ orow, int hi) {
    const float s = inv * MIX_SCALE;
#pragma unroll
    for (int dt = 0; dt < DV / 32; ++dt)
#pragma unroll
        for (int g = 0; g < 4; ++g)
            *(unsigned*)(orow + 32 * dt + 8 * g + 4 * hi) = pk4_fp8(st.o[dt][4 * g] * s, st.o[dt][4 * g + 1] * s, st.o[dt][4 * g + 2] * s, st.o[dt][4 * g + 3] * s);
}

DI void attn_swa_item(const Ctx& c, int l, int b, int h, int qb, bool ctxq) {
    const Params& p = *c.p;
    unsigned char* mix = (unsigned char*)(p.ws + WS_MIX);
    const int kvh = h >> 1;
    const size_t qtok = ctxq ? (size_t)TL + b * CTXL + c.wid * 32 + c.r32 : (size_t)b * SEQ + qb * 256 + c.wid * 32 + c.r32;
    const v8i_f qf = load_q8(c, qtok, h);
    F8State<64> st;
    ModSwa mod; mod.hi_ = c.hi;
    int j0 = 0;
    if (ctxq) { mod.nloc = 0; mod.kpos0 = 0; }
    else { j0 = 4 * qb - 2; if (j0 < 0) j0 = 0; int j1 = 4 * qb + 5; if (j1 > 63) j1 = 63; mod.nloc = j1 - j0 + 1; mod.kpos0 = 64 * j0; }
    mod.qmin = qb * 256 + c.wid * 32; mod.qpos = mod.qmin + c.r32;
    const int nloc = mod.nloc;
    const size_t lbase = (size_t)b * SEQ + 64 * j0, cbase = (size_t)TL + b * CTXL;
    auto tok0 = [&](int j) { return j < nloc ? lbase + 64 * j : cbase + 64 * (j - nloc); };
    const size_t vt0 = (size_t)b * 68;
    auto vtile = [&](int j) { return vt0 + (j < nloc ? j0 + j : 64 + (j - nloc)); };
    pass8<64>(c, kvh, kvh * 64, nloc + 4, tok0, vtile, mod, qf, st);
    float lt = half_swap_sum(st.l);
    lt += __builtin_amdgcn_exp2f(p.in[I_SINK][l * 4 + h] * LOG2E - st.m);
    store_o8<64>(st, 1.f / lt, mix + qtok * DM + h * 64, c.hi);
}

DI void attn_na_item(const Ctx& c, int l, int b, int h, int qb, bool ctxq) {
    const Params& p = *c.p;
    unsigned char* mix = (unsigned char*)(p.ws + WS_MIX);
    LAS float* rpbl = (LAS float*)(c.smem + LDS_MAIN + 1024);
    __syncthreads();
    if (!ctxq) for (int i = c.tid; i < 465; i += NTHREADS) rpbl[i] = p.in[I_RPB][(size_t)(l * 4 + h) * 465 + i] * LOG2E;
    __syncthreads();
    const size_t qtok = ctxq ? (size_t)TL + b * CTXL + c.wid * 32 + c.r32 : (size_t)b * SEQ + qb * 256 + c.wid * 32 + c.r32;
    const v8i_f qf = load_q8(c, qtok, 4 + h);
    F8State<64> st;
    ModNa mod; mod.rpb = rpbl; mod.hi_ = c.hi;
    int kr0 = 0;
    if (ctxq) { mod.nloc = 0; mod.kr0 = 0; mod.qr = 0; mod.qc = 0; mod.rs = 0; mod.cs = 0; }
    else {
        const int r_lo = 4 * qb, r_hi = 4 * qb + 3;
        int a = r_lo - 4; a = a < 0 ? 0 : (a > 56 ? 56 : a);
        int bb = r_hi - 4; bb = bb < 0 ? 0 : (bb > 56 ? 56 : bb);
        kr0 = a; mod.kr0 = a; mod.nloc = bb + 7 - a + 1;
        mod.qr = 4 * qb + (c.wid >> 1); mod.qc = 32 * (c.wid & 1) + c.r32;
        int rs = mod.qr - 4; rs = rs < 0 ? 0 : (rs > 56 ? 56 : rs); mod.rs = rs;
        int cs = mod.qc - 8; cs = cs < 0 ? 0 : (cs > 48 ? 48 : cs); mod.cs = cs;
    }
    const int nloc = mod.nloc;
    const size_t lbase = (size_t)b * SEQ + 64 * kr0, cbase = (size_t)TL + b * CTXL;
    auto tok0 = [&](int j) { return j < nloc ? lbase + 64 * j : cbase + 64 * (j - nloc); };
    const size_t vt0 = (size_t)b * 68;
    auto vtile = [&](int j) { return vt0 + (j < nloc ? kr0 + j : 64 + (j - nloc)); };
    pass8<64>(c, 2 + h, 128 + h * 64, nloc + 4, tok0, vtile, mod, qf, st);
    const float lt = half_swap_sum(st.l);
    store_o8<64>(st, 1.f / lt, mix + qtok * DM + 256 + h * 64, c.hi);
}

DI void attn_diff_item(const Ctx& c, int l, int b, int h, int qb, bool ctxq) {
    const Params& p = *c.p;
    unsigned char* mix = (unsigned char*)(p.ws + WS_MIX);
    const size_t qtok = ctxq ? (size_t)TL + b * CTXL + c.wid * 32 + c.r32 : (size_t)b * SEQ + qb * 256 + c.wid * 32 + c.r32;
    const int nloc = ctxq ? 0 : 64;
    const size_t lbase = (size_t)b * SEQ, cbase = (size_t)TL + b * CTXL;
    auto tok0 = [&](int j) { return j < nloc ? lbase + 64 * j : cbase + 64 * (j - nloc); };
    const size_t vt0 = (size_t)b * 68;
    auto vtile = [&](int j) { return vt0 + (j < nloc ? j : 64 + (j - nloc)); };
    unsigned char* orow = mix + qtok * DM + 512 + h * 128;
    LAS u32x2* park = (LAS u32x2*)(c.smem + 65536) + c.tid;
    ModNone mod;
    F8State<128> st;
    {
        const v8i_f qf = load_q8(c, qtok, 8 + 2 * h);
        pass8<128>(c, 6 + 2 * h, 384 + h * 128, nloc + 4, tok0, vtile, mod, qf, st);
        const float inv = 1.f / half_swap_sum(st.l);
#pragma unroll
        for (int dt = 0; dt < 4; ++dt)
#pragma unroll
            for (int g = 0; g < 4; ++g) {
                u32x2 u; u.x = pk2(st.o[dt][4 * g] * inv, st.o[dt][4 * g + 1] * inv); u.y = pk2(st.o[dt][4 * g + 2] * inv, st.o[dt][4 * g + 3] * inv);
                park[(dt * 4 + g) * NTHREADS] = u;
            }
    }
    const v8i_f qf = load_q8(c, qtok, 8 + 2 * h + 1);
    pass8<128>(c, 6 + 2 * h + 1, 384 + h * 128, nloc + 4, tok0, vtile, mod, qf, st);
    const float lam_init = 0.8f - 0.6f * __expf(-0.3f * (float)l);
    const float d1 = wave_sum(p.in[I_LQ1][l * 64 + c.lane] * p.in[I_LK1][l * 64 + c.lane]);
    const float d2 = wave_sum(p.in[I_LQ2][l * 64 + c.lane] * p.in[I_LK2][l * 64 + c.lane]);
    const float lam = __expf(d1) - __expf(d2) + lam_init;
    const float inv2 = lam / half_swap_sum(st.l);
    float ss = 0.f;
#pragma unroll
    for (int dt = 0; dt < 4; ++dt)
#pragma unroll
        for (int g = 0; g < 4; ++g) {
            const u32x2 u = park[(dt * 4 + g) * NTHREADS];
            const float a0 = bflo(u.x) - st.o[dt][4 * g] * inv2, a1 = bfhi(u.x) - st.o[dt][4 * g + 1] * inv2;
            const float a2 = bflo(u.y) - st.o[dt][4 * g + 2] * inv2, a3 = bfhi(u.y) - st.o[dt][4 * g + 3] * inv2;
            st.o[dt][4 * g] = a0; st.o[dt][4 * g + 1] = a1; st.o[dt][4 * g + 2] = a2; st.o[dt][4 * g + 3] = a3;
            ss += (a0 * a0 + a1 * a1) + (a2 * a2 + a3 * a3);
        }
    ss = half_swap_sum(ss);
    const float rn = rsqrtf(ss * (1.f / 128.f) + EPSV) * (1.f - lam_init);
    const float* sg = p.in[I_SUBLN] + l * 128;
#pragma unroll
    for (int dt = 0; dt < 4; ++dt)
#pragma unroll
        for (int g = 0; g < 4; ++g) {
            const f32x4 gg = *(const f32x4*)(sg + 32 * dt + 8 * g + 4 * c.hi);
            const float rs = rn * MIX_SCALE;
            *(unsigned*)(orow + 32 * dt + 8 * g + 4 * c.hi) = pk4_fp8(st.o[dt][4 * g] * rs * gg.x, st.o[dt][4 * g + 1] * rs * gg.y, st.o[dt][4 * g + 2] * rs * gg.z, st.o[dt][4 * g + 3] * rs * gg.w);
        }
}

DI void attn_decode(int it, int& b, int& h, int& qb, bool& ctxq) {
    if (it < 512) {
        const int xcd = it & 7, j = it >> 3;
        const int bh = xcd * 4 + (j >> 4); qb = j & 15;
        b = bh >> 2; h = bh & 3; ctxq = false;
    } else {
        const int i = it - 512;
        qb = 0; h = i & 3; b = i >> 2; ctxq = true;
    }
}
DI Ctx reopaque(const Ctx& c) {
    Ctx d = c; int t = c.tid; asm volatile("" : "+v"(t));
    d.tid = t; d.lane = t & 63; d.wid = __builtin_amdgcn_readfirstlane(t >> 6); d.r32 = t & 31; d.hi = (t >> 5) & 1;
    return d;
}
DI void phase_attn0_convert(const Ctx& c) {
    const int xcd = c.bid & 7;
    int* actr = (int*)(c.p->ws + WS_ROWCTR) + 128 + 64 * xcd;
    int* cctr = (int*)(c.p->ws + WS_ROWCTR) + 1024;
    LAS int* slot = (LAS int*)(c.smem + LDS_MAIN + 64);
    constexpr int NIT = 544, NATT = 3 * NIT;
    const bool prefer_conv = ((c.bid >> 3) & 1) != 0;
    for (;;) {
        if (c.tid == 0) {
            int k = -1, v = 0;
            if (prefer_conv) {
                v = atomicAdd(cctr, 1); if (v < CONV_NCHUNK) k = 1;
                if (k < 0) { v = atomicAdd(actr, 1) * 8 + xcd; if (v < NATT) k = 0; }
            } else {
                v = atomicAdd(actr, 1) * 8 + xcd; if (v < NATT) k = 0;
                if (k < 0) { v = atomicAdd(cctr, 1); if (v < CONV_NCHUNK) k = 1; }
            }
            slot[0] = k; slot[1] = v;
        }
        __syncthreads();
        const int kind = slot[0], idx = slot[1];
        __syncthreads();
        if (kind < 0) break;
        if (kind == 1) {
            convert_pairs(reopaque(c), idx * CONV_CHUNK, 1, CONV_CHUNK, [](int q) { return rmap_expert(q); });
        } else {
            const int grp = idx / NIT, it = idx - grp * NIT;
            int b, h, qb; bool ctxq; attn_decode(it, b, h, qb, ctxq);
            if (grp == 0) attn_diff_item(reopaque(c), 0, b, h, qb, ctxq);
            else if (grp == 1) attn_swa_item(reopaque(c), 0, b, h, qb, ctxq);
            else attn_na_item(reopaque(c), 0, b, h, qb, ctxq);
        }
    }
}
DI void phase_attn(const Ctx& c, int l) {
    const int NIT = 512 + ((l == 0) ? 32 : 0);
    for (int it = c.bid; it < NIT; it += c.nblk) { int b, h, qb; bool ctxq; attn_decode(it, b, h, qb, ctxq); attn_diff_item(c, l, b, h, qb, ctxq); }
    for (int it = c.bid; it < NIT; it += c.nblk) { int b, h, qb; bool ctxq; attn_decode(it, b, h, qb, ctxq); attn_swa_item(c, l, b, h, qb, ctxq); }
    for (int it = c.bid; it < NIT; it += c.nblk) { int b, h, qb; bool ctxq; attn_decode(it, b, h, qb, ctxq); attn_na_item(c, l, b, h, qb, ctxq); }
}
#ifndef WAVES_PER_SIMD
#define WAVES_PER_SIMD 2
#endif
#ifndef PROBE_REP
#define PROBE_REP 0
#endif
#ifndef DBG_MODE
#define DBG_MODE 0
#endif
DI Ctx mkctx(const Params& p, char* smem, int wave_s) {
    Ctx c; c.p = &p; c.smem = smem;
    int t = wave_s * 64 + (int)__builtin_amdgcn_mbcnt_hi(~0u, __builtin_amdgcn_mbcnt_lo(~0u, 0u)); asm volatile("" : "+v"(t));
    c.tid = t; c.lane = t & 63; c.wid = __builtin_amdgcn_readfirstlane(t >> 6); c.r32 = t & 31; c.hi = (t >> 5) & 1;
    int b = blockIdx.x, n = gridDim.x; asm volatile("" : "+s"(b), "+s"(n));
    c.bid = b; c.nblk = n;
    return c;
}
__global__ void __launch_bounds__(NTHREADS, WAVES_PER_SIMD) mega(Params p) {
    extern __shared__ __attribute__((aligned(16))) char smem[];
    Ctx c; c.p = &p; c.smem = smem; c.tid = threadIdx.x; c.lane = c.tid & 63; c.wid = c.tid >> 6; c.r32 = c.lane & 31; c.hi = c.lane >> 5;
    c.bid = blockIdx.x; c.nblk = gridDim.x;
    const int wave_s = __builtin_amdgcn_readfirstlane((int)threadIdx.x >> 6);
#define FRESH() mkctx(p, smem, wave_s)
#define GRID_SYNC() do { XcdBarrier bb_ = bar; asm volatile("" : "+s"(bb_.bar), "+s"(bb_.x)); xcd_barrier(bb_); } while (0)
    volatile LAS unsigned* xbw = (volatile LAS unsigned*)(smem + LDS_MAIN);
    if (c.tid == 0) { xbw[0] = 0u; xbw[1] = 0u; xbw[2] = 0u; xbw[3] = 0u; }
    __syncthreads();
    XcdBarrier bar = xcd_barrier_post((unsigned*)(p.ws + WS_BAR), xbw);
    asm volatile("; PHASE_MARK prologue" ::: "memory");
    phase_prologue(FRESH());
    GRID_SYNC();
#if PROBE_REP == 1
    asm volatile("; PHASE_MARK prologue" ::: "memory");
    phase_prologue(FRESH());
    GRID_SYNC();
#endif
    asm volatile("; PHASE_MARK norm" ::: "memory");
    phase_norm(FRESH(), 0, TT, true, 0);
    wrp_items(FRESH());
    GRID_SYNC();
#if PROBE_REP == 9
    phase_norm(FRESH(), 0, TT, true, 0);
    GRID_SYNC();
#endif
#if PROBE_REP == 13
#pragma unroll 1
    for (int z = 0; z < 20; ++z) { GRID_SYNC(); }
#endif
#pragma unroll 1
    for (int l = 0; l < 2; ++l) {
        const bool last = (l == 1);
        const int nrows = last ? TL : TT;
        asm volatile("; PHASE_MARK inproj" ::: "memory");
        asm volatile("; PHASE_MARK inproj" ::: "memory");
    phase_inproj(FRESH(), l);
        GRID_SYNC();
#if PROBE_REP == 2
        asm volatile("; PHASE_MARK inproj" ::: "memory");
        asm volatile("; PHASE_MARK inproj" ::: "memory");
    phase_inproj(FRESH(), l);
        GRID_SYNC();
#endif
        asm volatile("; PHASE_MARK attn" ::: "memory");
        asm volatile("; PHASE_MARK attn" ::: "memory");
        if (l == 0) phase_attn0_convert(FRESH()); else phase_attn(FRESH(), l);
        GRID_SYNC();
#if PROBE_REP == 3
        asm volatile("; PHASE_MARK attn" ::: "memory");
        asm volatile("; PHASE_MARK attn" ::: "memory");
    phase_attn(FRESH(), l);
        GRID_SYNC();
#endif
        asm volatile("; PHASE_MARK outproj" ::: "memory");
        asm volatile("; PHASE_MARK outproj" ::: "memory");
    phase_outproj(FRESH(), l, nrows);
        GRID_SYNC();
#if PROBE_REP == 7
        if (l == 0) { phase_outproj(FRESH(), l, nrows); GRID_SYNC(); }
#endif
#if DBG_MODE != 1
        asm volatile("; PHASE_MARK router" ::: "memory");
    phase_norm_router(FRESH(), l, nrows);
        GRID_SYNC();
        asm volatile("; PHASE_MARK route" ::: "memory");
        asm volatile("; PHASE_MARK route" ::: "memory");
    phase_route(FRESH(), l, nrows);
        GRID_SYNC();
        asm volatile("; PHASE_MARK e1" ::: "memory");
        asm volatile("; PHASE_MARK e1" ::: "memory");
    phase_e1(FRESH(), l, nrows);
        GRID_SYNC();
#if PROBE_REP == 4
        asm volatile("; PHASE_MARK e1" ::: "memory");
        asm volatile("; PHASE_MARK e1" ::: "memory");
    phase_e1(FRESH(), l, nrows);
        GRID_SYNC();
#endif
        asm volatile("; PHASE_MARK e2" ::: "memory");
        asm volatile("; PHASE_MARK e2" ::: "memory");
    phase_e2(FRESH(), l, nrows);
        GRID_SYNC();
#if PROBE_REP == 5
        asm volatile("; PHASE_MARK e2" ::: "memory");
        asm volatile("; PHASE_MARK e2" ::: "memory");
    phase_e2(FRESH(), l, nrows);
        GRID_SYNC();
#endif
#endif
        asm volatile("; PHASE_MARK combine" ::: "memory");
        asm volatile("; PHASE_MARK combine" ::: "memory");
    phase_combine(FRESH(), l, nrows, last);
#if PROBE_REP == 8
        if (last) { GRID_SYNC(); phase_combine(FRESH(), l, nrows, last); }
#endif
        if (!last) { GRID_SYNC(); }
    }
}

extern "C" void kernel_launch(void* const* d_in, const int* in_sizes, int n_in, void* d_out, int out_size, void* d_ws, size_t ws_size, hipStream_t stream) {
    static int grid = 0;
    if (grid == 0) {
        int dev = 0, cus = 0, per_cu = 0;
        if (n_in != 26 || ws_size < WS_END) { fprintf(stderr, "kernel_launch: unexpected n_in %d / ws %zu (need %zu)\n", n_in, ws_size, (size_t)WS_END); grid = -1; return; }
        if (hipGetDevice(&dev) != hipSuccess || hipDeviceGetAttribute(&cus, hipDeviceAttributeMultiprocessorCount, dev) != hipSuccess) { grid = -1; return; }
        if (hipFuncSetAttribute((const void*)mega, hipFuncAttributeMaxDynamicSharedMemorySize, LDS_BYTES) != hipSuccess) { grid = -1; return; }
        if (hipOccupancyMaxActiveBlocksPerMultiprocessor(&per_cu, (const void*)mega, NTHREADS, LDS_BYTES) != hipSuccess || per_cu < 1) per_cu = 1;
        (void)hipGetLastError();
        grid = cus;
    }
    if (grid < 0) return;
    (void)hipMemsetAsync((char*)d_ws + WS_BAR, 0, WS_ZERO_BYTES, stream);
    Params p{};
    for (int i = 0; i < 26; ++i) p.in[i] = (const float*)d_in[i];
    p.out = (float*)d_out; p.ws = (unsigned char*)d_ws;
    hipLaunchKernelGGL(mega, dim3(grid), dim3(NTHREADS), LDS_BYTES, stream, p);
}
```

```cpp
#include <hip/hip_runtime.h>
#include <hip/hip_bf16.h>
#include <cstdio>
#include <cstdint>

#define XB_TMO      128
#define XB_XCNT(j)  (256  + 64 * (j))
#define XB_XSUB(j)  (1280 + 64 * (j))
#define XB_XGEN(j)  (2304 + 64 * (j))
#define XB_TOP      3328
#define XB_TOPGEN   3392
#define XCD_BAR_WORDS 3456
#define XB_SPIN_CAP (1u << 22)
#define LAS __attribute__((address_space(3)))

__device__ __forceinline__ unsigned xb_ld(unsigned* p)              { return __hip_atomic_load(p, __ATOMIC_RELAXED, __HIP_MEMORY_SCOPE_AGENT); }
__device__ __forceinline__ unsigned xb_add(unsigned* p, unsigned v) { return __hip_atomic_fetch_add(p, v, __ATOMIC_RELAXED, __HIP_MEMORY_SCOPE_AGENT); }
__device__ __forceinline__ unsigned xb_xcc_id() { return (unsigned)__builtin_amdgcn_s_getreg((3 << 11) | 20) & 0xFu; }
#define XB_SPIN(cond, bar) do { unsigned _sp = 0; while (cond) { __builtin_amdgcn_s_sleep(1); \
    if ((++_sp & 255u) == 0u) { if (xb_ld(&(bar)[XB_TMO])) break; if (_sp > XB_SPIN_CAP) { atomicAdd(&(bar)[XB_TMO], 1u); break; } } } } while (0)

struct XcdBarrier {
    unsigned* bar; unsigned x;
    volatile LAS unsigned* st;
};

__device__ __forceinline__ XcdBarrier xcd_barrier_post(unsigned* bar, volatile LAS unsigned* st) {
    XcdBarrier b; b.bar = bar; b.x = xb_xcc_id(); b.st = st;
    if (threadIdx.x == 0) (void)xb_add(&bar[XB_XCNT(b.x)], 1u);
    return b;
}
__device__ __forceinline__ void xcd_barrier_complete(unsigned* bar, unsigned x, unsigned& nloc, unsigned& nx) {
    const unsigned G = gridDim.x * gridDim.y * gridDim.z;
    unsigned sum, cnt, mine, sp = 0u;
    for (;;) {
        sum = 0u; cnt = 0u; mine = 0u;
#pragma unroll
        for (unsigned j = 0; j < 16; ++j) { const unsigned c = xb_ld(&bar[XB_XCNT(j)]); sum += c; cnt += (c > 0u) ? 1u : 0u; mine = (j == x) ? c : mine; }
        if (sum == G) break;
        __builtin_amdgcn_s_sleep(1);
        if ((++sp & 255u) == 0u) { if (xb_ld(&bar[XB_TMO])) break; if (sp > XB_SPIN_CAP) { atomicAdd(&bar[XB_TMO], 1u); break; } }
    }
    nloc = mine > 0u ? mine : 1u; nx = cnt > 0u ? cnt : 1u;
}

__device__ __forceinline__ void xcd_barrier(const XcdBarrier& b) {
    asm volatile("s_waitcnt vmcnt(0)" ::: "memory");
    __syncthreads();
    if (threadIdx.x == 0) {
        unsigned* bar = b.bar;
        __builtin_amdgcn_s_waitcnt(0);
        unsigned nloc = b.st[0], nx = b.st[1];
        if (nloc == 0u) { xcd_barrier_complete(bar, b.x, nloc, nx); b.st[0] = nloc; b.st[1] = nx; }
        const unsigned old = xb_add(&bar[XB_XSUB(b.x)], 1u);
        const unsigned gen = old / nloc;
        if (old + 1u == (gen + 1u) * nloc) {
            __builtin_amdgcn_fence(__ATOMIC_RELEASE, "agent");
            asm volatile("s_waitcnt vmcnt(0)" ::: "memory");
            const unsigned og = xb_add(&bar[XB_TOP], 1u);
            const unsigned tg = og / nx;
            if (og + 1u == (tg + 1u) * nx) xb_add(&bar[XB_TOPGEN], 1u);
            else XB_SPIN(xb_ld(&bar[XB_TOPGEN]) == tg, bar);
            __builtin_amdgcn_fence(__ATOMIC_ACQUIRE, "agent");
            xb_add(&bar[XB_XGEN(b.x)], 1u);
            asm volatile("s_waitcnt vmcnt(0)" ::: "memory");
        } else {
            XB_SPIN(xb_ld(&bar[XB_XGEN(b.x)]) == gen, bar);
            __builtin_amdgcn_fence(__ATOMIC_ACQUIRE, "agent");
            asm volatile("s_waitcnt vmcnt(0)" ::: "memory");
        }
    }
    __syncthreads();
}

constexpr int DM = 1024, NB = 8, SEQ = 4096, CTXL = 256;
constexpr int TL = NB * SEQ;
constexpr int TC = NB * CTXL;
constexpr int TT = TL + TC;
constexpr int INC = 2816, QC = 1024, KVC = 1792;
constexpr int NE = 256, NEX = 257, FF = 256;
constexpr float EPSV = 1e-6f;
constexpr float LOG2E = 1.4426950408889634f;
constexpr float QSCALE = 0.125f * LOG2E;
constexpr float MIX_SCALE = 4.0f, W_SCALE = 32.0f, WD_SCALE = 16.0f, ACT_SCALE = 2.0f;
constexpr int NTHREADS = 512;
constexpr int NWAVES = 8;
constexpr int LDS_MAIN = 131072;
constexpr int LDS_AUX = 8192 + 16384 + 8192;
constexpr int LDS_BYTES = LDS_MAIN + LDS_AUX;
constexpr int LDS_STG = LDS_MAIN + 8192;
static_assert(LDS_BYTES <= 163840, "LDS");

typedef unsigned short bf16_t;
typedef __attribute__((ext_vector_type(8))) short bf16x8;
typedef __attribute__((ext_vector_type(4))) short s16x4;
typedef __attribute__((ext_vector_type(16))) float f32x16;
typedef __attribute__((ext_vector_type(2))) float f32x2;
typedef __attribute__((ext_vector_type(2))) __bf16 bf16x2v;
typedef short v4i16_t __attribute__((ext_vector_type(4)));
typedef __attribute__((ext_vector_type(4))) unsigned u32x4;
typedef __attribute__((ext_vector_type(2))) unsigned u32x2;
typedef __attribute__((ext_vector_type(4))) float f32x4;
#define DI __device__ __forceinline__
#define MFMA32(a, b, c) __builtin_amdgcn_mfma_f32_32x32x16_bf16((a), (b), (c), 0, 0, 0)

DI unsigned pk2(float lo, float hi) { f32x2 v = {lo, hi}; bf16x2v b = __builtin_convertvector(v, bf16x2v); return __builtin_bit_cast(unsigned, b); }
DI unsigned pk4_fp8(float a, float b, float c, float d) { int w = 0; w = __builtin_amdgcn_cvt_pk_fp8_f32(a, b, w, false); w = __builtin_amdgcn_cvt_pk_fp8_f32(c, d, w, true); return (unsigned)w; }
DI float bf2f(bf16_t u) { return __uint_as_float(((unsigned)u) << 16); }
DI float bflo(unsigned u) { return __uint_as_float(u << 16); }
DI float bfhi(unsigned u) { return __uint_as_float(u & 0xffff0000u); }
DI f32x4 bf4_f32(u32x2 w) { return f32x4{bflo(w.x), bfhi(w.x), bflo(w.y), bfhi(w.y)}; }
DI u32x2 f32_bf4(f32x4 v) { u32x2 o; o.x = pk2(v[0], v[1]); o.y = pk2(v[2], v[3]); return o; }
DI int crow(int reg, int hi) { return (reg & 3) + 8 * (reg >> 2) + 4 * hi; }
#define DPPI(v, CTRL) __builtin_amdgcn_update_dpp(0, (v), (CTRL), 0xf, 0xf, true)
#define DPPF(v, CTRL) __builtin_bit_cast(float, __builtin_amdgcn_update_dpp(0, __builtin_bit_cast(int, (v)), (CTRL), 0xf, 0xf, true))
#define DPP_XOR1 0xB1
#define DPP_XOR2 0x4E
#define DPP_HMIR 0x141
#define DPP_MIR  0x140
#define DPP_SHR(n) (0x110 + (n))
DI float rdlane_f(float v, int l) { return __builtin_bit_cast(float, __builtin_amdgcn_readlane(__builtin_bit_cast(int, v), l)); }
DI float wave_sum(float v) {
    v += DPPF(v, DPP_XOR1); v += DPPF(v, DPP_XOR2); v += DPPF(v, DPP_HMIR); v += DPPF(v, DPP_MIR);
    return (rdlane_f(v, 0) + rdlane_f(v, 16)) + (rdlane_f(v, 32) + rdlane_f(v, 48));
}
DI float half_swap_sum(float v) {
    const auto rr = __builtin_amdgcn_permlane32_swap(__float_as_uint(v), __float_as_uint(v), false, false);
    return __uint_as_float(rr[0]) + __uint_as_float(rr[1]);
}
DI float siluf(float v) { return v / (1.f + __expf(-v)); }

struct Params {
    const float* in[26];
    float* out;
    unsigned char* ws;
};
enum { I_X = 0, I_C, I_CTX, I_CCTX, I_WMOD, I_BMOD, I_GMIX, I_GFFN, I_WIN, I_WOUT, I_SINK, I_RPB, I_LQ1, I_LK1, I_LQ2, I_LK2, I_SUBLN,
       I_WR, I_RB, I_WG, I_WU, I_WD, I_SG, I_SU, I_SD, I_GFINAL };

constexpr size_t MiB = 1u << 20;
constexpr size_t WS_BAR = 0;
constexpr size_t WS_CNT = 16384;
constexpr int CNT_STRIDE = 64, CNT_LAYER = 257 * 64;
constexpr size_t WS_ZERO_BYTES = 163840;
constexpr size_t WS_ROPE = 196608;
constexpr size_t WS_MOD = 262144;
constexpr size_t WS_WIN = 1 * MiB;
constexpr size_t WS_WOUT = 12 * MiB;
constexpr size_t WS_WR = 16 * MiB;
constexpr size_t WS_WGU = 17 * MiB;
constexpr size_t WS_WD = WS_WGU + 514 * MiB;
constexpr size_t WS_XBUF = WS_WD + 257 * MiB;
constexpr size_t WS_HBUF = WS_XBUF + 136 * MiB;
constexpr size_t WS_SLOTW = WS_HBUF + 68 * MiB;
constexpr size_t WS_LIST = WS_SLOTW + 2 * MiB;
constexpr size_t WS_R = WS_LIST + 34 * MiB;
constexpr size_t WS_Q = WS_R;
constexpr size_t WS_KV = WS_R + 68 * MiB;
constexpr size_t WS_MIX = WS_R + 187 * MiB;
constexpr size_t WS_PARK = WS_R + 221 * MiB;
constexpr size_t WS_Q8 = WS_R + 290 * MiB;
constexpr size_t WS_K8 = WS_R + 324 * MiB;
constexpr size_t WS_VT8 = WS_R + 358 * MiB;
constexpr int VT_ROWS = 896, VT_TILE = 896 * 64;
constexpr size_t WS_LOGIT = WS_R + 256 * MiB;
constexpr size_t WS_ACT = WS_R;
constexpr size_t WS_HIN8 = WS_WGU + 300 * MiB;
constexpr size_t WS_H8 = WS_R + 80 * MiB;
constexpr size_t WS_YS = WS_R + 153 * MiB;
constexpr size_t WS_EINFO = WS_R + 512 * MiB;
constexpr size_t WS_WRP = WS_R + 460 * MiB;
constexpr size_t WS_CB = WS_R + 470 * MiB;
constexpr size_t WS_RSTD = WS_R + 471 * MiB;
constexpr size_t WS_ROWCTR = 151552;
constexpr size_t WS_END = WS_YS + 612 * MiB;
static_assert(WS_END <= 2048 * MiB, "workspace");

struct Ctx {
    const Params* p;
    char* smem;
    int tid, lane, wid, r32, hi;
    int bid, nblk;
};
DI int map_row(int type, int n) {
    if (type == 1) {
        const int hb = n >> 6, d = n & 63;
        const bool roped = (hb < 4) || (hb >= 8 && hb < 16) || (hb == 16) || (hb == 17) || (hb >= 28 && hb < 36);
        int d2 = d;
        if (roped) d2 = (d < 16) ? 2 * d : (d < 32) ? 2 * (d - 16) + 1 : (d < 48) ? 2 * (d - 16) : 2 * (d - 32) + 1;
        return (hb << 6) | d2;
    }
    if (type == 2) return 2 * n;
    if (type == 3) return 2 * n + 1;
    return n;
}

struct TItem { const float* W; int K, N, kt, nt, type; void* dst; bool f8; float ws; };
DI void tload(const Ctx& c, float (&v)[4][2][8], const TItem& it) {
    const int wid4 = c.wid & 3;
    const int k0 = it.kt * 128, n0 = it.nt * 128;
#pragma unroll
    for (int cc = 0; cc < 4; ++cc) {
        const int kc = 4 * wid4 + cc;
#pragma unroll
        for (int j = 0; j < 8; ++j)
#pragma unroll
            for (int i = 0; i < 2; ++i) v[cc][i][j] = __builtin_nontemporal_load(&it.W[(size_t)(k0 + kc * 8 + j) * it.N + n0 + c.lane + 64 * i]);
    }
}
DI void tfinish(const Ctx& c, const float (&v)[4][2][8], const TItem& it) {
    LAS char* lds = (LAS char*)c.smem + (c.tid >> 8) * 36864;
    const int wid4 = c.wid & 3, tid8 = c.tid & 255;
    const int k0 = it.kt * 128, n0 = it.nt * 128, K = it.K;
    const float wscale = it.ws;
#pragma unroll
    for (int cc = 0; cc < 4; ++cc) {
        const int kc = 4 * wid4 + cc;
#pragma unroll
        for (int i = 0; i < 2; ++i) {
            if (it.f8) {
                u32x2 u; u.x = pk4_fp8(v[cc][i][0] * wscale, v[cc][i][1] * wscale, v[cc][i][2] * wscale, v[cc][i][3] * wscale); u.y = pk4_fp8(v[cc][i][4] * wscale, v[cc][i][5] * wscale, v[cc][i][6] * wscale, v[cc][i][7] * wscale);
                *(LAS u32x2*)(lds + (c.lane + 64 * i) * 144 + kc * 8) = u;
            } else {
                u32x4 u; u.x = pk2(v[cc][i][0], v[cc][i][1]); u.y = pk2(v[cc][i][2], v[cc][i][3]); u.z = pk2(v[cc][i][4], v[cc][i][5]); u.w = pk2(v[cc][i][6], v[cc][i][7]);
                *(LAS u32x4*)(lds + (c.lane + 64 * i) * 272 + kc * 16) = u;
            }
        }
    }
    __syncthreads();
    if (it.f8) {
        unsigned char* dst = (unsigned char*)it.dst;
#pragma unroll
        for (int j = 0; j < 4; ++j) {
            const int idx = tid8 + 256 * j, c16 = idx & 7, n = idx >> 3;
            const u32x4 u = *(LAS u32x4*)(lds + n * 144 + c16 * 16);
            const int row = map_row(it.type, n0 + n);
            __builtin_nontemporal_store(u, (u32x4*)(dst + (size_t)row * K + k0 + c16 * 16));
        }
    } else {
        bf16_t* dst = (bf16_t*)it.dst;
#pragma unroll
        for (int j = 0; j < 8; ++j) {
            const int idx = tid8 + 256 * j, c16 = idx & 15, n = idx >> 4;
            const u32x4 u = *(LAS u32x4*)(lds + n * 272 + c16 * 16);
            const int row = map_row(it.type, n0 + n);
            *(u32x4*)(dst + (size_t)row * K + k0 + c16 * 8) = u;
        }
    }
    __syncthreads();
}

DI void mod_item(const Ctx& c, int l, int cg) {
    const Params& p = *c.p;
    LAS float* sv = (LAS float*)c.smem;
    LAS float* part = (LAS float*)(c.smem + 36864);
    for (int idx = c.tid; idx < 9 * 1024; idx += NTHREADS) {
        const int b = idx >> 10, k = idx & 1023;
        const float v = (b < 8) ? p.in[I_C][b * 1024 + k] : p.in[I_CCTX][k];
        sv[idx] = siluf(v);
    }
    __syncthreads();
    const int col = c.tid & 63, kq = c.tid >> 6;
    float acc[9];
#pragma unroll
    for (int b = 0; b < 9; ++b) acc[b] = 0.f;
    const float* wp = p.in[I_WMOD] + ((size_t)l * 1024 + kq * 128) * 6144 + cg * 64 + col;
    for (int k = 0; k < 128; k += 8) {
        float w[8];
#pragma unroll
        for (int u = 0; u < 8; ++u) w[u] = wp[(size_t)(k + u) * 6144];
#pragma unroll
        for (int u = 0; u < 8; ++u)
#pragma unroll
            for (int b = 0; b < 9; ++b) acc[b] += sv[b * 1024 + kq * 128 + k + u] * w[u];
    }
#pragma unroll
    for (int b = 0; b < 9; ++b) part[(kq * 9 + b) * 64 + col] = acc[b];
    __syncthreads();
    float* modv = (float*)(p.ws + WS_MOD);
    for (int idx = c.tid; idx < 576; idx += NTHREADS) {
        const int b = idx >> 6, cl = idx & 63;
        float s = 0.f;
#pragma unroll
        for (int q = 0; q < 8; ++q) s += part[(q * 9 + b) * 64 + cl];
        modv[(size_t)(l * 9 + b) * 6144 + cg * 64 + cl] = s + p.in[I_BMOD][l * 6144 + cg * 64 + cl];
    }
    __syncthreads();
}

DI void rope_item(const Ctx& c) {
    float2* tab = (float2*)(c.p->ws + WS_ROPE);
    for (int idx = c.tid; idx < 1024; idx += NTHREADS) {
        const int pos = idx >> 4, i = idx & 15;
        const float inv = 1.0f / powf(10000.0f, (float)i / 16.0f);
        const float ang = (float)pos * inv;
        float sn, cs; sincosf(ang, &sn, &cs);
        tab[idx] = make_float2(cs, sn);
    }
}

constexpr int PRO_PER_LAYER = 12592;
DI TItem transpose_decode(const Ctx& c, int r) {
    const Params& p = *c.p;
    const int l = r / PRO_PER_LAYER; r -= l * PRO_PER_LAYER;
    unsigned char* wgu = (unsigned char*)(p.ws + WS_WGU) + (size_t)l * 257 * 524288;
    unsigned char* wd = (unsigned char*)(p.ws + WS_WD) + (size_t)l * 257 * 262144;
    TItem t; t.f8 = true; t.ws = W_SCALE;
    if (r < 4096) { const int e = r >> 4, s = r & 15; t.W = p.in[I_WG] + (size_t)(l * 256 + e) * 262144; t.K = 1024; t.N = 256; t.kt = s >> 1; t.nt = s & 1; t.dst = wgu + (size_t)e * 524288; t.type = 2; }
    else if (r < 8192) { r -= 4096; const int e = r >> 4, s = r & 15; t.W = p.in[I_WU] + (size_t)(l * 256 + e) * 262144; t.K = 1024; t.N = 256; t.kt = s >> 1; t.nt = s & 1; t.dst = wgu + (size_t)e * 524288; t.type = 3; }
    else if (r < 12288) { r -= 8192; const int e = r >> 4, s = r & 15; t.W = p.in[I_WD] + (size_t)(l * 256 + e) * 262144; t.K = 256; t.N = 1024; t.kt = s >> 3; t.nt = s & 7; t.dst = wd + (size_t)e * 262144; t.type = 0; t.ws = WD_SCALE; }
    else {
        r -= 12288;
        if (r < 176) { t.W = p.in[I_WIN] + (size_t)l * 1024 * 2816; t.K = 1024; t.N = 2816; t.kt = r / 22; t.nt = r % 22; t.dst = (unsigned char*)(p.ws + WS_WIN) + (size_t)l * 2816 * 1024; t.type = 1; }
        else if (r < 240) { r -= 176; t.W = p.in[I_WOUT] + (size_t)l * 1048576; t.K = 1024; t.N = 1024; t.kt = r >> 3; t.nt = r & 7; t.dst = (unsigned char*)(p.ws + WS_WOUT) + (size_t)l * 1048576; t.type = 0; }
        else if (r < 256) { r -= 240; t.W = p.in[I_WR] + (size_t)l * 262144; t.K = 1024; t.N = 256; t.kt = r >> 1; t.nt = r & 1; t.dst = (bf16_t*)(p.ws + WS_WR) + (size_t)l * 262144; t.type = 0; t.f8 = false; }
        else if (r < 272) { r -= 256; t.W = p.in[I_SG] + (size_t)l * 262144; t.K = 1024; t.N = 256; t.kt = r >> 1; t.nt = r & 1; t.dst = wgu + (size_t)256 * 524288; t.type = 2; }
        else if (r < 288) { r -= 272; t.W = p.in[I_SU] + (size_t)l * 262144; t.K = 1024; t.N = 256; t.kt = r >> 1; t.nt = r & 1; t.dst = wgu + (size_t)256 * 524288; t.type = 3; }
        else { r -= 288; t.W = p.in[I_SD] + (size_t)l * 262144; t.K = 256; t.N = 1024; t.kt = r >> 3; t.nt = r & 7; t.dst = wd + (size_t)256 * 262144; t.type = 0; t.ws = WD_SCALE; }
    }
    return t;
}
template <class RMap>
DI void convert_pairs(const Ctx& c, int first, int stride, int n, RMap rmap) {
    if (n <= 0) return;
    const int half = c.tid >> 8;
    float va[4][2][8], vb[4][2][8];
    TItem ia = transpose_decode(c, rmap(first) + half), ib = ia;
    tload(c, va, ia);
    int i = 0;
    for (;;) {
        const bool m1 = i + 1 < n;
        if (m1) { ib = transpose_decode(c, rmap(first + (i + 1) * stride) + half); tload(c, vb, ib); }
        tfinish(c, va, ia);
        if (!m1) break;
        ++i;
        const bool m2 = i + 1 < n;
        if (m2) { ia = transpose_decode(c, rmap(first + (i + 1) * stride) + half); tload(c, va, ia); }
        tfinish(c, vb, ib);
        if (!m2) break;
        ++i;
    }
}
constexpr int PRO_EXPERT = 12288, PRO_SMALL = PRO_PER_LAYER - PRO_EXPERT;
constexpr int CONV_CHUNK = 8, CONV_NCHUNK = 2 * PRO_EXPERT / 2 / CONV_CHUNK;
DI int rmap_small(int q) { const int l = q / (PRO_SMALL / 2), s = q - l * (PRO_SMALL / 2); return l * PRO_PER_LAYER + PRO_EXPERT + 2 * s; }
DI int rmap_expert(int q) { const int l = q / (PRO_EXPERT / 2), s = q - l * (PRO_EXPERT / 2); return l * PRO_PER_LAYER + 2 * s; }
DI void phase_prologue(const Ctx& c) {
    for (int it = c.bid; it < 193; it += c.nblk) { if (it < 192) mod_item(c, it / 96, it % 96); else rope_item(c); }
    __syncthreads();
    constexpr int NP = PRO_SMALL;
    const int n = (NP > c.bid) ? (NP - c.bid + c.nblk - 1) / c.nblk : 0;
    convert_pairs(c, c.bid, c.nblk, n, [](int q) { return rmap_small(q); });
}

template <bool XBF>
DI void norm_mod_row(const float* __restrict__ xrow, const float* __restrict__ g, const float* __restrict__ sh, const float* __restrict__ sc, bf16_t* __restrict__ orow, unsigned char* __restrict__ o8, int lane) {
    float4 v[4]; float s = 0.f;
#pragma unroll
    for (int j = 0; j < 4; ++j) { if constexpr (XBF) { const f32x4 t4 = bf4_f32(((const u32x2*)xrow)[lane + 64 * j]); v[j] = make_float4(t4[0], t4[1], t4[2], t4[3]); } else v[j] = ((const float4*)xrow)[lane + 64 * j]; s += (v[j].x * v[j].x + v[j].y * v[j].y) + (v[j].z * v[j].z + v[j].w * v[j].w); }
    const float rstd = rsqrtf(wave_sum(s) * (1.f / DM) + EPSV);
#pragma unroll
    for (int j = 0; j < 4; ++j) {
        const float4 gg = ((const float4*)g)[lane + 64 * j], shh = ((const float4*)sh)[lane + 64 * j], scc = ((const float4*)sc)[lane + 64 * j];
        const float y0 = v[j].x * rstd * gg.x * (1.f + scc.x) + shh.x, y1 = v[j].y * rstd * gg.y * (1.f + scc.y) + shh.y;
        const float y2 = v[j].z * rstd * gg.z * (1.f + scc.z) + shh.z, y3 = v[j].w * rstd * gg.w * (1.f + scc.w) + shh.w;
        u32x2 o; o.x = pk2(y0, y1); o.y = pk2(y2, y3);
        if (orow) ((u32x2*)orow)[lane + 64 * j] = o;
        if (o8) ((unsigned*)o8)[lane + 64 * j] = pk4_fp8(y0, y1, y2, y3);
    }
}

DI void wrp_items(const Ctx& c) {
    const Params& p = *c.p;
    const float* modv = (const float*)(p.ws + WS_MOD);
    const bf16_t* wr = (const bf16_t*)(p.ws + WS_WR);
    bf16_t* wrp = (bf16_t*)(p.ws + WS_WRP);
    float* cb = (float*)(p.ws + WS_CB);
    const int lane = c.lane;
    for (int idx = c.bid * NWAVES + c.wid; idx < 2 * 9 * 256; idx += c.nblk * NWAVES) {
        const int l = idx / 2304, r = idx - l * 2304, b = r >> 8, e = r & 255;
        const float* g = p.in[I_GFFN] + l * 1024 + 16 * lane;
        const float* mv = modv + (size_t)(l * 9 + b) * 6144 + 3072 + 16 * lane;
        const bf16_t* src = wr + ((size_t)l * 256 + e) * 1024 + 16 * lane;
        const u32x4 w0 = *(const u32x4*)src, w1 = *(const u32x4*)(src + 8);
        float wv[16];
        wv[0] = bflo(w0.x); wv[1] = bfhi(w0.x); wv[2] = bflo(w0.y); wv[3] = bfhi(w0.y); wv[4] = bflo(w0.z); wv[5] = bfhi(w0.z); wv[6] = bflo(w0.w); wv[7] = bfhi(w0.w);
        wv[8] = bflo(w1.x); wv[9] = bfhi(w1.x); wv[10] = bflo(w1.y); wv[11] = bfhi(w1.y); wv[12] = bflo(w1.z); wv[13] = bfhi(w1.z); wv[14] = bflo(w1.w); wv[15] = bfhi(w1.w);
        float s = 0.f, o[16];
#pragma unroll
        for (int j = 0; j < 4; ++j) {
            const f32x4 gg = *(const f32x4*)(g + 4 * j), sh = *(const f32x4*)(mv + 4 * j), sc = *(const f32x4*)(mv + 1024 + 4 * j);
#pragma unroll
            for (int i = 0; i < 4; ++i) { o[4 * j + i] = wv[4 * j + i] * gg[i] * (1.f + sc[i]); s += sh[i] * wv[4 * j + i]; }
        }
        u32x4 o0, o1;
        o0.x = pk2(o[0], o[1]); o0.y = pk2(o[2], o[3]); o0.z = pk2(o[4], o[5]); o0.w = pk2(o[6], o[7]);
        o1.x = pk2(o[8], o[9]); o1.y = pk2(o[10], o[11]); o1.z = pk2(o[12], o[13]); o1.w = pk2(o[14], o[15]);
        bf16_t* dst = wrp + ((size_t)(l * 9 + b) * 256 + e) * 1024 + 16 * lane;
        *(u32x4*)dst = o0; *(u32x4*)(dst + 8) = o1;
        s = wave_sum(s);
        if (lane == 0) cb[(l * 9 + b) * 256 + e] = s;
    }
}
DI void norm_ffn_row(const bf16_t* __restrict__ xrow, const float* __restrict__ g, const float* __restrict__ sh, const float* __restrict__ sc, unsigned char* __restrict__ o8, float* __restrict__ rstd_out, int lane) {
    f32x4 v[4]; float s = 0.f;
#pragma unroll
    for (int j = 0; j < 4; ++j) { v[j] = bf4_f32(((const u32x2*)xrow)[lane + 64 * j]); s += (v[j][0] * v[j][0] + v[j][1] * v[j][1]) + (v[j][2] * v[j][2] + v[j][3] * v[j][3]); }
    const float rstd = rsqrtf(wave_sum(s) * (1.f / DM) + EPSV);
#pragma unroll
    for (int j = 0; j < 4; ++j) {
        const f32x4 gg = ((const f32x4*)g)[lane + 64 * j], shh = ((const f32x4*)sh)[lane + 64 * j], scc = ((const f32x4*)sc)[lane + 64 * j];
        const f32x4 y = v[j] * rstd * gg * (1.f + scc) + shh;
        ((unsigned*)o8)[lane + 64 * j] = pk4_fp8(y[0], y[1], y[2], y[3]);
    }
    if (lane == 0) *rstd_out = rstd;
}

DI void phase_norm(const Ctx& c, int l, int nrows, bool from_inputs, int which) {
    const Params& p = *c.p;
    const float* modv = (const float*)(p.ws + WS_MOD);
    const float* g = p.in[which ? I_GFFN : I_GMIX] + l * 1024;
    bf16_t* hbuf = (bf16_t*)(p.ws + WS_HBUF);
    const float* xbuf = (const float*)(p.ws + WS_XBUF);
    for (int t = c.bid * NWAVES + c.wid; t < nrows; t += c.nblk * NWAVES) {
        const float* xrow = from_inputs ? (t < TL ? p.in[I_X] + (size_t)t * DM : p.in[I_CTX] + (size_t)(t - TL) * DM) : (const float*)((const bf16_t*)xbuf + (size_t)t * DM);
        const int b = t < TL ? (t >> 12) : 8;
        const float* mv = modv + (size_t)(l * 9 + b) * 6144 + (which ? 3072 : 0);
        if (from_inputs) norm_mod_row<false>(xrow, g, mv, mv + 1024, (bf16_t*)nullptr,        (unsigned char*)(p.ws + (which ? WS_H8 : WS_HIN8)) + (size_t)t * DM, c.lane);
        else norm_mod_row<true>(xrow, g, mv, mv + 1024, hbuf + (size_t)t * DM, (unsigned char*)(p.ws + (which ? WS_H8 : WS_HIN8)) + (size_t)t * DM, c.lane);
    }
}

namespace g8 {
constexpr int BM = 256, BK = 64, HALF = 128, HTB = HALF * BK * 2;
DI int lds_byte(int r, int c) { const int st = (r >> 4) * 2 + (c >> 5), rr = r & 15, cc = c & 31, ob = rr * 64 + cc * 2; return st * 1024 + (ob ^ (((ob >> 9) & 1) << 5)); }
DI void stage_rc(int b, int& R, int& C) { const int st = b / 1024, sb = b % 1024, swz = sb ^ (((sb >> 9) & 1) << 5); R = (st >> 1) * 16 + swz / 64; C = (st & 1) * 32 + (swz % 64) / 2; }
DI int perm32(int rho) { const int n = rho >> 4, i = rho & 15; return 8 * (i >> 2) + 4 * n + (i & 3); }
struct Unit { int pm, pn, e, ti, ne, rbase, ix; };

typedef __attribute__((ext_vector_type(8))) int v8i_t;
typedef __attribute__((ext_vector_type(4))) int v4i_t;
template <class Epi, class Sched>
DI void gemm_phase(LAS unsigned char* lds, const int tid, const int RB, const Sched& S, const Epi& E) {
    constexpr bool F8 = Epi::F8;
    const int wid = __builtin_amdgcn_readfirstlane(tid >> 6), lane = tid & 63, wr = wid >> 2, wc = wid & 3, fr = lane & 15, fq = lane >> 4;
    const int nt = RB / 128;
    int Rr[2], Cc[2]; unsigned voffB[2], voffA[2];
#pragma unroll
    for (int i = 0; i < 2; ++i) { int R, C; stage_rc(tid * 16 + i * 8192, R, C); Rr[i] = R; Cc[i] = C * 2; const int Rb = Epi::PERM ? ((R & ~31) + perm32(R & 31)) : R; voffB[i] = (unsigned)(Rb * RB + C * 2); voffA[i] = (unsigned)(R * RB + C * 2); }
    constexpr bool GA = Sched::GATHER;
    int unit_scale = 0x7F7F7F7F; asm volatile("" : "+v"(unit_scale));
    const size_t kstep = (size_t)(BK * 2);
    const size_t hstep = (size_t)HALF * RB;
    const unsigned ldsw = (unsigned)wid * 1024u;
    const int aoff = F8 ? lds_byte(wr * 64 + fr, (fq >> 1) * 32 + (fq & 1) * 16) : lds_byte(wr * 64 + fr, fq * 8);
    const int boff = F8 ? lds_byte(wc * 32 + fr, (fq >> 1) * 32 + (fq & 1) * 16) : lds_byte(wc * 32 + fr, fq * 8);
#define G8_SA(b, h) (((b) * 2 + (h)) * HTB)
#define G8_SB(b, h) ((4 + (b) * 2 + (h)) * HTB)
#define G8_STAGE_B(bufoff, gbase) do { _Pragma("unroll") for (int _i = 0; _i < 2; ++_i) \
        __builtin_amdgcn_global_load_lds((const unsigned*)((const char*)(gbase) + voffB[_i]), (LAS unsigned*)(lds + (bufoff) + ldsw + _i * 8192), 16, 0, 0); } while (0)
#define G8_STAGE_A(bufoff, uptr, koff, VO, h) do { _Pragma("unroll") for (int _i = 0; _i < 2; ++_i) { \
        const char* _s = GA ? (Ab + (koff) + VO[h][_i]) : ((uptr) + (koff) + ((h) ? hstep : (size_t)0) + voffA[_i]); \
        __builtin_amdgcn_global_load_lds((const unsigned*)_s, (LAS unsigned*)(lds + (bufoff) + ldsw + _i * 8192), 16, 0, 0); } } while (0)
#define G8_LDA(dst, b, h) do { _Pragma("unroll") for (int m = 0; m < 4; ++m) { \
        if constexpr (F8) { dst##8[m].lo = *(const LAS v4i_t*)(lds + G8_SA(b, h) + aoff + m * 2048); dst##8[m].hi = *(const LAS v4i_t*)(lds + G8_SA(b, h) + aoff + m * 2048 + 16); } \
        else { _Pragma("unroll") for (int k = 0; k < 2; ++k) dst[m][k] = *(const LAS bf16x8*)(lds + G8_SA(b, h) + aoff + m * 2048 + k * 1024); } } } while (0)
#define G8_LDB(dst, b, h) do { _Pragma("unroll") for (int n = 0; n < 2; ++n) { \
        if constexpr (F8) { dst##8[n].lo = *(const LAS v4i_t*)(lds + G8_SB(b, h) + boff + n * 2048); dst##8[n].hi = *(const LAS v4i_t*)(lds + G8_SB(b, h) + boff + n * 2048 + 16); } \
        else { _Pragma("unroll") for (int k = 0; k < 2; ++k) dst[n][k] = *(const LAS bf16x8*)(lds + G8_SB(b, h) + boff + n * 2048 + k * 1024); } } } while (0)
#define G8_MMA(ai, bj, At, Bt) do { __builtin_amdgcn_s_setprio(1); _Pragma("unroll") for (int m = 0; m < 4; ++m) _Pragma("unroll") for (int n = 0; n < 2; ++n) { \
        if constexpr (F8) asm volatile("v_mfma_scale_f32_16x16x128_f8f6f4 %0, %1, %2, %0, %3, %3 op_sel_hi:[0,0,0]" : "+v"(acc[ai][bj][m][n]) : "v"(Bt##8[n]), "v"(At##8[m]), "v"(unit_scale)); \
        else { _Pragma("unroll") for (int k = 0; k < 2; ++k) acc[ai][bj][m][n] = __builtin_amdgcn_mfma_f32_16x16x32_bf16(Bt[n][k], At[m][k], acc[ai][bj][m][n], 0, 0, 0); } } \
        __builtin_amdgcn_s_setprio(0); } while (0)
#define G8_WAIT_V(n) asm volatile("s_waitcnt vmcnt(" #n ")" ::: "memory")
#define G8_WAIT_L(n) asm volatile("s_waitcnt lgkmcnt(" #n ")" ::: "memory")
#define G8_BAR __builtin_amdgcn_s_barrier()
#define G8_SCHED __builtin_amdgcn_sched_barrier(0)
    Unit cur, nxt; int ui = 0;
    if (!S.next(0, cur)) return;
    f32x4 acc[2][2][4][2];
#pragma unroll
    for (int a = 0; a < 2; ++a)
#pragma unroll
        for (int b = 0; b < 2; ++b)
#pragma unroll
            for (int m = 0; m < 4; ++m)
#pragma unroll
                for (int n = 0; n < 2; ++n) acc[a][b][m][n] = (f32x4){0.f, 0.f, 0.f, 0.f};
    if constexpr (F8) asm volatile("s_nop 3" ::: "memory");
    bf16x8 At[F8 ? 1 : 4][2], B0[F8 ? 1 : 2][2], B1[F8 ? 1 : 2][2];
    v8i_t At8[F8 ? 4 : 1], B08[F8 ? 2 : 1], B18[F8 ? 2 : 1];
    unsigned vAc[2][2], vAn[2][2];
#pragma unroll
    for (int h = 0; h < 2; ++h)
#pragma unroll
        for (int i = 0; i < 2; ++i) vAc[h][i] = GA ? (S.a_off(cur, h * 128 + Rr[i]) + (unsigned)Cc[i]) : 0u;
    const char* Ab = S.a_base();
    const char* cA = GA ? Ab : S.a_ptr(cur);
    const char* cB = S.b_base(cur);
    G8_STAGE_B(G8_SB(0, 0), cB); G8_STAGE_A(G8_SA(0, 0), cA, 0, vAc, 0); G8_STAGE_B(G8_SB(0, 1), cB + hstep); G8_STAGE_A(G8_SA(0, 1), cA, 0, vAc, 1);
    if (wr == 1) G8_BAR;
    G8_WAIT_V(4); G8_BAR;
    G8_STAGE_B(G8_SB(1, 0), cB + kstep); G8_STAGE_A(G8_SA(1, 0), cA, kstep, vAc, 0); G8_STAGE_B(G8_SB(1, 1), cB + hstep + kstep);
    G8_WAIT_V(6); G8_BAR;
    for (;;) {
        const bool has_next = S.next(ui + 1, nxt);
        const char* nB = has_next ? S.b_base(nxt) : cB;
        const char* nA = GA ? Ab : (has_next ? S.a_ptr(nxt) : cA);
#pragma unroll
        for (int h = 0; h < 2; ++h)
#pragma unroll
            for (int i = 0; i < 2; ++i) vAn[h][i] = GA ? (has_next ? (S.a_off(nxt, h * 128 + Rr[i]) + (unsigned)Cc[i]) : vAc[h][i]) : 0u;
#pragma unroll 1
        for (int t = 0; t < nt; t += 2) {
            const bool last = (t == nt - 2);
            const size_t ka1 = (size_t)(t + 1) * kstep;
            const size_t ka2 = last ? (size_t)0 : (size_t)(t + 2) * kstep;
            const size_t ka3 = ka2 + kstep;
            const char* b2 = last ? nB : cB + (size_t)(t + 2) * kstep;
            const char* b3 = b2 + kstep;
            unsigned v2[2][2];
#pragma unroll
            for (int h = 0; h < 2; ++h)
#pragma unroll
                for (int i = 0; i < 2; ++i) v2[h][i] = GA ? (last ? vAn[h][i] : vAc[h][i]) : 0u;
            const char* a2p = last ? nA : cA;
            G8_LDB(B0, 0, 0); G8_SCHED; G8_LDA(At, 0, 0); G8_STAGE_A(G8_SA(1, 1), cA, ka1, vAc, 1);
            G8_WAIT_L(8); G8_BAR; G8_WAIT_L(0); G8_MMA(0, 0, At, B0); G8_BAR; G8_SCHED;
            G8_LDB(B1, 0, 1); G8_STAGE_B(G8_SB(0, 0), b2);
            G8_BAR; G8_WAIT_L(0); G8_MMA(0, 1, At, B1); G8_BAR;
            G8_LDA(At, 0, 1); G8_STAGE_A(G8_SA(0, 0), a2p, ka2, v2, 0);
            G8_BAR; G8_WAIT_L(0); G8_MMA(1, 0, At, B0); G8_BAR; G8_SCHED;
            G8_STAGE_B(G8_SB(0, 1), b2 + hstep);
            G8_WAIT_V(6); G8_BAR; G8_MMA(1, 1, At, B1); G8_BAR;
            G8_LDB(B0, 1, 0); G8_SCHED; G8_LDA(At, 1, 0); G8_STAGE_A(G8_SA(0, 1), a2p, ka2, v2, 1);
            G8_WAIT_L(8); G8_BAR; G8_WAIT_L(0); G8_MMA(0, 0, At, B0); G8_BAR; G8_SCHED;
            G8_LDB(B1, 1, 1); G8_STAGE_B(G8_SB(1, 0), b3);
            G8_BAR; G8_WAIT_L(0); G8_MMA(0, 1, At, B1); G8_BAR;
            G8_LDA(At, 1, 1); G8_STAGE_A(G8_SA(1, 0), a2p, ka3, v2, 0);
            G8_BAR; G8_WAIT_L(0); G8_MMA(1, 0, At, B0); G8_BAR; G8_SCHED;
            G8_STAGE_B(G8_SB(1, 1), b3 + hstep);
            G8_WAIT_V(6); G8_BAR; G8_MMA(1, 1, At, B1); G8_BAR;
        }
        if constexpr (F8) asm volatile("s_nop 15\n\ts_nop 15" ::: "memory");
        E(acc, cur, wr, wc, fr, fq);
        if (!has_next) break;
#pragma unroll
        for (int a = 0; a < 2; ++a)
#pragma unroll
            for (int b = 0; b < 2; ++b)
#pragma unroll
                for (int m = 0; m < 4; ++m)
#pragma unroll
                    for (int n = 0; n < 2; ++n) acc[a][b][m][n] = (f32x4){0.f, 0.f, 0.f, 0.f};
        if constexpr (F8) asm volatile("s_nop 3" ::: "memory");
        cur = nxt; cB = nB; cA = nA; ++ui;
#pragma unroll
        for (int h = 0; h < 2; ++h)
#pragma unroll
            for (int i = 0; i < 2; ++i) vAc[h][i] = vAn[h][i];
    }
    G8_WAIT_V(0);
    if (wr == 0) G8_BAR;
    G8_BAR;
#undef G8_SA
#undef G8_SB
#undef G8_STAGE_A
#undef G8_STAGE_B
#undef G8_LDA
#undef G8_LDB
#undef G8_MMA
#undef G8_WAIT_V
#undef G8_WAIT_L
#undef G8_BAR
#undef G8_SCHED
}

struct DenseSched {
    static constexpr bool GATHER = false;
    int nM, nN, nwg, G, c, RB; const char* A; const char* Bt;
    DI void init(const void* A_, const void* Bt_, int M, int N, int RB_, int G_, int c_) { A = (const char*)A_; Bt = (const char*)Bt_; nM = M / BM; nN = N / BM; nwg = nM * nN; G = G_; c = c_; RB = RB_; }
    DI bool next(int i, Unit& u) const {
        const int L = i * G + c; if (L >= nwg) return false;
        int wgid = L; { const int q = nwg / 8, r = nwg % 8, xcd = wgid % 8, off = wgid / 8; wgid = (xcd < r ? xcd * (q + 1) : r * (q + 1) + (xcd - r) * q) + off; }
        const int nig = 8 * nN, gid = wgid / nig, fm = gid * 8, gsz = (nM - fm) < 8 ? (nM - fm) : 8;
        u.pm = fm + ((wgid % nig) % gsz); u.pn = (wgid % nig) / gsz; u.e = 0; u.ti = 0; u.ne = 0; u.rbase = 0; u.ix = 0; return true;
    }
    DI const char* a_base() const { return A; }
    DI unsigned a_off(const Unit&, int) const { return 0u; }
    DI const char* a_ptr(const Unit& u) const { return A + (size_t)u.pm * BM * RB; }
    DI const char* b_base(const Unit& u) const { return Bt + (size_t)u.pn * BM * RB; }
};
}
struct EpiInproj {
    static constexpr bool F8 = true;
    static constexpr bool PERM = true;
    const LAS float2* rope;
    unsigned char* q8; unsigned char* k8; unsigned char* vt8;
    LAS unsigned char* stg; int tid;
    static DI bool isv_cb(int cb) { const int kv = cb - 16; return (cb >= 16) && ((kv == 2) || (kv == 3) || (kv >= 8 && kv < 12) || (kv >= 20)); }
    DI void operator()(const f32x4 (&acc)[2][2][4][2], const g8::Unit& u, int wr, int wc, int fr, int fq) const {
        const bool lat = (u.pm * 256 < TL);
#pragma unroll
        for (int bj = 0; bj < 2; ++bj) {
            const int col0 = u.pn * 256 + bj * 128 + wc * 32 + 8 * fq;
            const int cb = col0 >> 6, kv = cb - 16;
            if (!isv_cb(cb)) continue;
            const float scale = 1.0f / W_SCALE;
            const int vrow0 = (kv < 4 ? (kv - 2) * 64 : (kv < 12 ? 128 + (kv - 8) * 64 : 384 + (kv - 20) * 64)) + (col0 & 63);
            const int pos = 32 * ((fr >> 2) & 1) + 4 * (((fr >> 3) << 2) | (fr & 3));
#pragma unroll
            for (int ai = 0; ai < 2; ++ai) {
                const int t0 = u.pm * 256 + ai * 128 + wr * 64;
                const int b = t0 < TL ? (t0 >> 12) : ((t0 - TL) >> 8);
                const int tile = t0 < TL ? ((t0 & 4095) >> 6) : (64 + (((t0 - TL) & 255) >> 6));
                unsigned char* base = vt8 + (size_t)(b * 68 + tile) * VT_TILE + (size_t)vrow0 * 64 + pos;
#pragma unroll
                for (int n = 0; n < 2; ++n)
#pragma unroll
                    for (int j = 0; j < 4; ++j)
                        *(unsigned*)(base + (4 * n + j) * 64) = pk4_fp8(acc[ai][bj][0][n][j] * scale, acc[ai][bj][1][n][j] * scale, acc[ai][bj][2][n][j] * scale, acc[ai][bj][3][n][j] * scale);
            }
        }
        if (!((u.pn < 6) || (u.pn == 7) || (u.pn == 8))) return;
        constexpr int RS = 272;
        if (wr == 0) __builtin_amdgcn_s_barrier();
#pragma unroll
        for (int ai = 0; ai < 2; ++ai)
#pragma unroll
            for (int mh = 0; mh < 2; ++mh) {
#pragma unroll
                for (int bj = 0; bj < 2; ++bj) {
                    const int col0 = u.pn * 256 + bj * 128 + wc * 32 + 8 * fq;
                    const int cb = col0 >> 6, i0 = (col0 & 63) >> 1;
                    if (isv_cb(cb)) continue;
                    const bool isq = cb < 16;
                    const bool roped = ((cb < 4) || (cb >= 8 && cb < 16) || (cb == 16) || (cb == 17) || (cb >= 28 && cb < 36)) && lat;
                    const float scale = (isq ? QSCALE : 1.0f) * (1.0f / W_SCALE);
#pragma unroll
                    for (int mm = 0; mm < 2; ++mm) {
                        const int m = mh * 2 + mm;
                        const int t = u.pm * 256 + ai * 128 + wr * 64 + m * 16 + fr;
                        f32x4 v0 = acc[ai][bj][m][0], v1 = acc[ai][bj][m][1];
                        if (roped) {
                            const int s = t & 4095;
                            const int pos = (i0 < 16) ? (s >> 6) : (s & 63);
                            const f32x4 ca = *(const LAS f32x4*)(rope + pos * 16 + (i0 & 15)), cb2 = *(const LAS f32x4*)(rope + pos * 16 + (i0 & 15) + 2);
                            f32x4 o0, o1;
                            o0[0] = v0[0] * ca[0] - v0[1] * ca[1]; o0[1] = v0[1] * ca[0] + v0[0] * ca[1];
                            o0[2] = v0[2] * ca[2] - v0[3] * ca[3]; o0[3] = v0[3] * ca[2] + v0[2] * ca[3];
                            o1[0] = v1[0] * cb2[0] - v1[1] * cb2[1]; o1[1] = v1[1] * cb2[0] + v1[0] * cb2[1];
                            o1[2] = v1[2] * cb2[2] - v1[3] * cb2[3]; o1[3] = v1[3] * cb2[2] + v1[2] * cb2[3];
                            v0 = o0; v1 = o1;
                        }
                        v0 *= scale; v1 *= scale;
                        u32x2 w; w.x = pk4_fp8(v0[0], v0[1], v0[2], v0[3]); w.y = pk4_fp8(v1[0], v1[1], v1[2], v1[3]);
                        *(LAS u32x2*)(stg + (wr * 32 + mm * 16 + fr) * RS + bj * 128 + wc * 32 + 8 * fq) = w;
                    }
                }
                asm volatile("s_waitcnt lgkmcnt(0)" ::: "memory"); __builtin_amdgcn_s_barrier(); asm volatile("" ::: "memory");
#pragma unroll
                for (int k = 0; k < 2; ++k) {
                    const int idx = tid + k * 512, rl = idx >> 4, pc = idx & 15;
                    const int cb = u.pn * 4 + (pc >> 2);
                    if (!isv_cb(cb)) {
                        const u32x4 v = *(const LAS u32x4*)(stg + rl * RS + pc * 16);
                        const int t = u.pm * 256 + ai * 128 + (rl >> 5) * 64 + mh * 32 + (rl & 31);
                        const int kv = cb - 16, ki = kv < 2 ? kv : (kv < 8 ? kv - 2 : kv - 6);
                        unsigned char* dst = (cb < 16) ? q8 + (size_t)t * 1024 + cb * 64 + (pc & 3) * 16 : k8 + (size_t)t * 1024 + ki * 64 + (pc & 3) * 16;
                        *(u32x4*)dst = v;
                    }
                }
                asm volatile("s_waitcnt lgkmcnt(0)" ::: "memory"); __builtin_amdgcn_s_barrier(); asm volatile("" ::: "memory");
            }
        if (wr == 1) __builtin_amdgcn_s_barrier();
    }
};
DI void phase_inproj(const Ctx& c, int l) {
    const Params& p = *c.p;
    g8::DenseSched S; S.init(p.ws + WS_HIN8, (const unsigned char*)(p.ws + WS_WIN) + (size_t)l * 2816 * 1024, TT, INC, DM, c.nblk, c.bid);
    {
        const float* rg = (const float*)(p.ws + WS_ROPE);
        LAS float* rl = (LAS float*)(c.smem + LDS_MAIN + 256);
        for (int i = c.tid; i < 2048; i += NTHREADS) rl[i] = rg[i];
        __syncthreads();
    }
    EpiInproj E; E.rope = (const LAS float2*)(c.smem + LDS_MAIN + 256); E.stg = (LAS unsigned char*)c.smem + LDS_MAIN + 256 + 8192; E.tid = c.tid;
    E.q8 = (unsigned char*)(p.ws + WS_Q8); E.k8 = (unsigned char*)(p.ws + WS_K8); E.vt8 = (unsigned char*)(p.ws + WS_VT8);
    g8::gemm_phase((LAS unsigned char*)c.smem, c.tid, DM, S, E);
}

struct EpiOutproj {
    static constexpr bool F8 = true;
    static constexpr bool PERM = false;
    float* xbuf; const float* modv; const float* x_in; const float* ctx_in; int l;
    DI void operator()(const f32x4 (&acc)[2][2][4][2], const g8::Unit& u, int wr, int wc, int fr, int fq) const {
        const int b = (u.pm * 256) < TL ? ((u.pm * 256) >> 12) : 8;
        const int col0 = u.pn * 256 + wc * 32 + 4 * fq;
        const float* gate = modv + (size_t)(l * 9 + b) * 6144 + 2048 + col0;
        f32x4 g[2][2];
#pragma unroll
        for (int bj = 0; bj < 2; ++bj)
#pragma unroll
            for (int n = 0; n < 2; ++n) g[bj][n] = *(const f32x4*)(gate + bj * 128 + n * 16) * (1.0f / (MIX_SCALE * W_SCALE));
#pragma unroll
        for (int ai = 0; ai < 2; ++ai)
#pragma unroll
            for (int m = 0; m < 4; ++m) {
                const int t = u.pm * 256 + ai * 128 + wr * 64 + m * 16 + fr;
                const float* xin = (t < TL ? x_in + (size_t)t * DM : ctx_in + (size_t)(t - TL) * DM) + col0;
                bf16_t* xo = (bf16_t*)xbuf + (size_t)t * DM + col0;
#pragma unroll
                for (int bj = 0; bj < 2; ++bj)
#pragma unroll
                    for (int n = 0; n < 2; ++n) {
                        const f32x4 x = (l == 0) ? *(const f32x4*)(xin + bj * 128 + n * 16) : bf4_f32(*(const u32x2*)(xo + bj * 128 + n * 16));
                        *(u32x2*)(xo + bj * 128 + n * 16) = f32_bf4(x + g[bj][n] * acc[ai][bj][m][n]);
                    }
            }
    }
};
DI void phase_outproj(const Ctx& c, int l, int nrows) {
    const Params& p = *c.p;
    g8::DenseSched S; S.init(p.ws + WS_MIX, (const unsigned char*)(p.ws + WS_WOUT) + (size_t)l * 1048576, nrows, DM, DM, c.nblk, c.bid);
    EpiOutproj E; E.xbuf = (float*)(p.ws + WS_XBUF); E.modv = (const float*)(p.ws + WS_MOD); E.x_in = p.in[I_X]; E.ctx_in = p.in[I_CTX]; E.l = l;
    g8::gemm_phase((LAS unsigned char*)c.smem, c.tid, DM, S, E);
}

struct EpiRouter {
    static constexpr bool F8 = false;
    static constexpr bool PERM = false;
    float* logit;
    DI void operator()(const f32x4 (&acc)[2][2][4][2], const g8::Unit& u, int wr, int wc, int fr, int fq) const {
#pragma unroll
        for (int ai = 0; ai < 2; ++ai)
#pragma unroll
            for (int m = 0; m < 4; ++m) {
                const int t = u.pm * 256 + ai * 128 + wr * 64 + m * 16 + fr;
#pragma unroll
                for (int bj = 0; bj < 2; ++bj)
#pragma unroll
                    for (int n = 0; n < 2; ++n) *(f32x4*)(logit + (size_t)t * NE + bj * 128 + wc * 32 + n * 16 + 4 * fq) = acc[ai][bj][m][n];
            }
    }
};
DI void phase_router(const Ctx& c, int l, int nrows) {
    const Params& p = *c.p;
    g8::DenseSched S; S.init(p.ws + WS_HBUF, (const bf16_t*)(p.ws + WS_WR) + (size_t)l * 262144, nrows, NE, DM * 2, c.nblk, c.bid);
    EpiRouter E; E.logit = (float*)(p.ws + WS_LOGIT);
    g8::gemm_phase((LAS unsigned char*)c.smem, c.tid, DM * 2, S, E);
}

struct RouterSched : g8::DenseSched {
    DI const char* b_base(const g8::Unit& u) const { const int b = (u.pm * 256) < TL ? ((u.pm * 256) >> 12) : 8; return Bt + (size_t)b * 524288 + (size_t)u.pn * 256 * RB; }
};
DI void phase_norm_router(const Ctx& c, int l, int nrows) {
    const Params& p = *c.p;
    {
        RouterSched S; S.init(p.ws + WS_XBUF, (const bf16_t*)(p.ws + WS_WRP) + (size_t)l * 9 * 262144, nrows, NE, DM * 2, c.nblk, c.bid);
        EpiRouter E; E.logit = (float*)(p.ws + WS_LOGIT);
        g8::gemm_phase((LAS unsigned char*)c.smem, c.tid, DM * 2, S, E);
    }
    int* ctr = (int*)(p.ws + WS_ROWCTR) + l * 64;
    LAS int* slot = (LAS int*)(c.smem + LDS_MAIN + 64);
    const float* modv = (const float*)(p.ws + WS_MOD);
    const float* g = p.in[I_GFFN] + l * 1024;
    const bf16_t* xbuf = (const bf16_t*)(p.ws + WS_XBUF);
    unsigned char* h8 = (unsigned char*)(p.ws + WS_H8);
    float* rstd = (float*)(p.ws + WS_RSTD);
    for (;;) {
        if (c.tid == 0) slot[0] = atomicAdd(ctr, 64);
        __syncthreads();
        const int base = slot[0];
        __syncthreads();
        if (base >= nrows) break;
#pragma unroll 1
        for (int i = 0; i < 8; ++i) {
            const int t = base + c.wid * 8 + i;
            if (t < nrows) {
                const int b = t < TL ? (t >> 12) : 8;
                const float* mv = modv + (size_t)(l * 9 + b) * 6144 + 3072;
                norm_ffn_row(xbuf + (size_t)t * DM, g, mv, mv + 1024, h8 + (size_t)t * DM, rstd + t, c.lane);
            }
        }
    }
}

DI void phase_route(const Ctx& c, int l, int nrows) {
    const Params& p = *c.p;
    const float* logit = (const float*)(p.ws + WS_LOGIT);
    const float* rb = p.in[I_RB] + l * NE;
    int* cnt = (int*)(p.ws + WS_CNT) + l * CNT_LAYER;
    int* list = (int*)(p.ws + WS_LIST);
    float* slotw = (float*)(p.ws + WS_SLOTW);
    int* einfo = (int*)(p.ws + WS_EINFO);
    LAS int* lcnt = (LAS int*)c.smem;
    LAS int* rec = (LAS int*)(c.smem + 1024);
    LAS float* recw = (LAS float*)(c.smem + 1024 + 8 * 24 * 8 * 4);
    constexpr int RMAX = 24;
    const int lane = c.lane;
    if (c.tid < 256) lcnt[c.tid] = 0;
    __syncthreads();
    const f32x4 bias = ((const f32x4*)rb)[lane];
    const float NINF = -__builtin_inff();
    int it = 0;
    const float* rstd = (const float*)(p.ws + WS_RSTD);
    const float* cbl = (const float*)(p.ws + WS_CB) + l * 9 * 256;
    for (int t = c.bid * NWAVES + c.wid; t < nrows; t += c.nblk * NWAVES, ++it) {
        const int bb = t < TL ? (t >> 12) : 8;
        const f32x4 lg = ((const f32x4*)(logit + (size_t)t * NE))[lane] * rstd[t] + ((const f32x4*)(cbl + bb * 256))[lane];
        const float s0 = 1.f / (1.f + __expf(-lg.x)), s1 = 1.f / (1.f + __expf(-lg.y)), s2 = 1.f / (1.f + __expf(-lg.z)), s3 = 1.f / (1.f + __expf(-lg.w));
        float m0 = s0 + bias.x, m1 = s1 + bias.y, m2 = s2 + bias.z, m3 = s3 + bias.w;
        float a1 = fmaxf(m0, m1), a2 = fminf(m0, m1);
        { const float b1 = fmaxf(m2, m3), b2 = fminf(m2, m3); const float n1 = fmaxf(a1, b1), n2 = fmaxf(fminf(a1, b1), fmaxf(a2, b2)); a1 = n1; a2 = n2; }
        { const float b1 = DPPF(a1, DPP_XOR1), b2 = DPPF(a2, DPP_XOR1); const float n1 = fmaxf(a1, b1), n2 = fmaxf(fminf(a1, b1), fmaxf(a2, b2)); a1 = n1; a2 = n2; }
        { const float b1 = DPPF(a1, DPP_XOR2), b2 = DPPF(a2, DPP_XOR2); const float n1 = fmaxf(a1, b1), n2 = fmaxf(fminf(a1, b1), fmaxf(a2, b2)); a1 = n1; a2 = n2; }
        { const float b1 = DPPF(a1, DPP_HMIR), b2 = DPPF(a2, DPP_HMIR); const float n1 = fmaxf(a1, b1), n2 = fmaxf(fminf(a1, b1), fmaxf(a2, b2)); a1 = n1; a2 = n2; }
        const float gs = a1 + a2;
        const int g = lane >> 3;
        int rank = 0;
#pragma unroll
        for (int j = 0; j < 8; ++j) { const float gj = rdlane_f(gs, j * 8); rank += ((gj > gs) || (gj == gs && j < g)) ? 1 : 0; }
        if (rank >= 4) { m0 = NINF; m1 = NINF; m2 = NINF; m3 = NINF; }
        float wsum = 0.f, my_w = 0.f; int my_e = 0;
#pragma unroll
        for (int k = 0; k < 8; ++k) {
            float bv = m0, bs = s0; int bi = 0;
            if (m1 > bv) { bv = m1; bs = s1; bi = 1; }
            if (m2 > bv) { bv = m2; bs = s2; bi = 2; }
            if (m3 > bv) { bv = m3; bs = s3; bi = 3; }
            float v = bv;
            v = fmaxf(v, DPPF(v, DPP_XOR1)); v = fmaxf(v, DPPF(v, DPP_XOR2)); v = fmaxf(v, DPPF(v, DPP_HMIR)); v = fmaxf(v, DPPF(v, DPP_MIR));
            const float wmx = fmaxf(fmaxf(rdlane_f(v, 0), rdlane_f(v, 16)), fmaxf(rdlane_f(v, 32), rdlane_f(v, 48)));
            const unsigned long long bal = __ballot(bv == wmx);
            const int win = __ffsll((long long)bal) - 1;
            const int sub = __builtin_amdgcn_readlane(bi, win);
            const float sw = rdlane_f(bs, win);
            if (lane == win) { if (sub == 0) m0 = NINF; else if (sub == 1) m1 = NINF; else if (sub == 2) m2 = NINF; else m3 = NINF; }
            wsum += sw;
            if (lane == k) { my_e = win * 4 + sub; my_w = sw; }
        }
        if (lane < 8 && it < RMAX) {
            const int lp = __hip_atomic_fetch_add(&lcnt[my_e], 1, __ATOMIC_RELAXED, __HIP_MEMORY_SCOPE_WORKGROUP);
            rec[(c.wid * RMAX + it) * 8 + lane] = (my_e << 16) | lp;
            recw[(c.wid * RMAX + it) * 8 + lane] = my_w / wsum * 2.5f;
        }
    }
    __syncthreads();
    if (c.tid < 256) { const int n = lcnt[c.tid]; lcnt[c.tid] = (n > 0) ? atomicAdd(&cnt[c.tid * CNT_STRIDE], n) : 0; }
    __syncthreads();
    it = 0;
    for (int t = c.bid * NWAVES + c.wid; t < nrows; t += c.nblk * NWAVES, ++it) {
        if (lane < 8 && it < RMAX) {
            const int r = rec[(c.wid * RMAX + it) * 8 + lane];
            const int e = r >> 16, pos = lcnt[e] + (r & 0xffff);
            list[(size_t)e * TT + pos] = t;
            slotw[(size_t)t * 8 + lane] = recw[(c.wid * RMAX + it) * 8 + lane];
            einfo[(size_t)t * 8 + lane] = (e << 16) | pos;
        }
    }
}

DI void moe_setup(const Ctx& c, int l, int nrows) {
    const int* cnt = (const int*)(c.p->ws + WS_CNT) + l * CNT_LAYER;
    LAS int* tstart = (LAS int*)(c.smem + LDS_MAIN + 1024);
    LAS int* roff = (LAS int*)(c.smem + LDS_MAIN + 2064);
    LAS int* cntl = (LAS int*)(c.smem + LDS_MAIN + 3104);
    LAS int* wtot = (LAS int*)(c.smem + LDS_MAIN + 4160);
    const int n = (c.tid < 256) ? cnt[c.tid * CNT_STRIDE] : 0;
    const int nt = (n + 255) >> 8;
    int vt = nt, vr = n;
    vt += DPPI(vt, DPP_SHR(1)); vr += DPPI(vr, DPP_SHR(1)); vt += DPPI(vt, DPP_SHR(2)); vr += DPPI(vr, DPP_SHR(2));
    vt += DPPI(vt, DPP_SHR(4)); vr += DPPI(vr, DPP_SHR(4)); vt += DPPI(vt, DPP_SHR(8)); vr += DPPI(vr, DPP_SHR(8));
    { const int t0 = __builtin_amdgcn_readlane(vt, 15), t1 = __builtin_amdgcn_readlane(vt, 31), t2 = __builtin_amdgcn_readlane(vt, 47);
      const int r0 = __builtin_amdgcn_readlane(vr, 15), r1 = __builtin_amdgcn_readlane(vr, 31), r2 = __builtin_amdgcn_readlane(vr, 47);
      const int row = c.lane >> 4;
      vt += (row > 0 ? t0 : 0) + (row > 1 ? t1 : 0) + (row > 2 ? t2 : 0); vr += (row > 0 ? r0 : 0) + (row > 1 ? r1 : 0) + (row > 2 ? r2 : 0); }
    if (c.lane == 63 && c.wid < 4) { wtot[c.wid] = vt; wtot[4 + c.wid] = vr; }
    __syncthreads();
    if (c.tid < 256) {
        int pt = 0, pr = 0;
        for (int w = 0; w < c.wid; ++w) { pt += wtot[w]; pr += wtot[4 + w]; }
        tstart[c.tid] = pt + vt - nt; roff[c.tid] = pr + vr - n; cntl[c.tid] = n;
        if (c.tid == 255) { tstart[256] = pt + vt; roff[256] = pr + vr; tstart[257] = pt + vt + nrows / 256; roff[257] = pr + vr + nrows; cntl[256] = nrows; }
    }
    __syncthreads();
}

constexpr int MOE_MAXU = 32, MOE_MAXG = 12;
template <bool GATHER_>
struct MoeSched {
    static constexpr bool GATHER = GATHER_;
    const LAS int* utab; const LAS unsigned* toks; int nmy;
    const char* A; const char* W; size_t wstride; int RB;
    DI bool next(int i, g8::Unit& u) const {
        if (i >= nmy) return false;
        const LAS int* e = utab + i * 8;
        u.pn = __builtin_amdgcn_readfirstlane(e[0]); u.e = __builtin_amdgcn_readfirstlane(e[1]); u.ti = __builtin_amdgcn_readfirstlane(e[2]);
        u.ne = __builtin_amdgcn_readfirstlane(e[3]); u.rbase = __builtin_amdgcn_readfirstlane(e[4]); u.pm = __builtin_amdgcn_readfirstlane(e[5]); u.ix = i;
        return true;
    }
    DI const char* a_base() const { return A; }
    DI unsigned a_off(const g8::Unit& u, int row) const { return toks[u.ix * 256 + row]; }
    DI const char* a_ptr(const g8::Unit& u) const { return A + (size_t)u.rbase * RB; }
    DI const char* b_base(const g8::Unit& u) const { return W + (size_t)u.e * wstride + (size_t)u.pn * 256 * RB; }
};
DI int moe_units(const Ctx& c, int NB, bool gather, const int* list, int rowbytes) {
    const LAS int* tstart = (const LAS int*)(c.smem + LDS_MAIN + 1024);
    const LAS int* roff = (const LAS int*)(c.smem + LDS_MAIN + 2064);
    const LAS int* cntl = (const LAS int*)(c.smem + LDS_MAIN + 3104);
    LAS int* utab = (LAS int*)(c.smem + LDS_MAIN + 4224);
    LAS unsigned* toks = (LAS unsigned*)(c.smem + LDS_MAIN + 8192);
    const int nunits = tstart[257] * NB;
    int nmy = (nunits > c.bid) ? (nunits - c.bid + c.nblk - 1) / c.nblk : 0;
    { const int cap = gather ? MOE_MAXG : MOE_MAXU; nmy = nmy > cap ? cap : nmy; }
    if (c.tid < nmy) {
        const int L = c.tid * c.nblk + c.bid;
        int w = L; { const int q = nunits / 8, r = nunits % 8, xcd = w % 8, off = w / 8; w = (xcd < r ? xcd * (q + 1) : r * (q + 1) + (xcd - r) * q) + off; }
        const int tile = w / NB;
        int lo = 0, hi = 256;
        while (lo < hi) { const int mid = (lo + hi + 1) >> 1; if (tstart[mid] <= tile) lo = mid; else hi = mid - 1; }
        const int ti = tile - tstart[lo];
        LAS int* e = utab + c.tid * 8;
        e[0] = w - tile * NB; e[1] = lo; e[2] = ti; e[3] = cntl[lo]; e[4] = roff[lo] + ti * 256; e[5] = tile;
    }
    __syncthreads();
    if (gather) {
        for (int idx = c.tid; idx < nmy * 256; idx += NTHREADS) {
            const LAS int* e = utab + (idx >> 8) * 8;
            const int ex = e[1], ne = e[3];
            int ridx = e[2] * 256 + (idx & 255); ridx = ridx < ne ? ridx : ne - 1;
            const int tok = (ex < 256) ? list[(size_t)ex * TT + ridx] : ridx;
            toks[idx] = (unsigned)tok * (unsigned)rowbytes;
        }
        __syncthreads();
    }
    return nmy;
}

#ifdef E1_DIRECT
struct EpiE1 {
    static constexpr bool F8 = true;
    static constexpr bool PERM = true;
    unsigned char* act;
    LAS unsigned char* stg; int tid;
    DI void operator()(const f32x4 (&acc)[2][2][4][2], const g8::Unit& u, int wr, int wc, int fr, int fq) const {
        constexpr float IS = 1.0f / W_SCALE;
#pragma unroll
        for (int ai = 0; ai < 2; ++ai)
#pragma unroll
            for (int m = 0; m < 4; ++m) {
                const int row = ai * 128 + wr * 64 + m * 16 + fr;
                if (u.ti * 256 + row < u.ne) {
#pragma unroll
                    for (int bj = 0; bj < 2; ++bj) {
                        const int col0 = u.pn * 256 + bj * 128 + wc * 32 + 8 * fq;
                        const f32x4 v0 = acc[ai][bj][m][0] * IS, v1 = acc[ai][bj][m][1] * IS;
                        const float a0 = v0[0] * __builtin_amdgcn_rcpf(1.f + __expf(-v0[0])) * v0[1], a1 = v0[2] * __builtin_amdgcn_rcpf(1.f + __expf(-v0[2])) * v0[3];
                        const float a2 = v1[0] * __builtin_amdgcn_rcpf(1.f + __expf(-v1[0])) * v1[1], a3 = v1[2] * __builtin_amdgcn_rcpf(1.f + __expf(-v1[2])) * v1[3];
                        *(unsigned*)(act + (size_t)(u.rbase + row) * FF + (col0 >> 1)) = pk4_fp8(a0 * ACT_SCALE, a1 * ACT_SCALE, a2 * ACT_SCALE, a3 * ACT_SCALE);
                    }
                }
            }
    }
};
#else
struct EpiE1 {
    static constexpr bool F8 = true;
    static constexpr bool PERM = true;
    unsigned char* act;
    LAS unsigned char* stg; int tid;
    DI void operator()(const f32x4 (&acc)[2][2][4][2], const g8::Unit& u, int wr, int wc, int fr, int fq) const {
        constexpr float IS = 1.0f / W_SCALE;
        constexpr int RS = 144;
        if (wr == 0) __builtin_amdgcn_s_barrier();
#pragma unroll
        for (int ai = 0; ai < 2; ++ai)
#pragma unroll
            for (int mh = 0; mh < 2; ++mh) {
#pragma unroll
                for (int mm = 0; mm < 2; ++mm) {
                    const int m = mh * 2 + mm;
                    LAS unsigned char* d = stg + (wr * 32 + mm * 16 + fr) * RS + wc * 16 + 4 * fq;
#pragma unroll
                    for (int bj = 0; bj < 2; ++bj) {
                        const f32x4 v0 = acc[ai][bj][m][0] * IS, v1 = acc[ai][bj][m][1] * IS;
                        const float a0 = v0[0] * __builtin_amdgcn_rcpf(1.f + __expf(-v0[0])) * v0[1], a1 = v0[2] * __builtin_amdgcn_rcpf(1.f + __expf(-v0[2])) * v0[3];
                        const float a2 = v1[0] * __builtin_amdgcn_rcpf(1.f + __expf(-v1[0])) * v1[1], a3 = v1[2] * __builtin_amdgcn_rcpf(1.f + __expf(-v1[2])) * v1[3];
                        *(LAS unsigned*)(d + bj * 64) = pk4_fp8(a0 * ACT_SCALE, a1 * ACT_SCALE, a2 * ACT_SCALE, a3 * ACT_SCALE);
                    }
                }
                asm volatile("s_waitcnt lgkmcnt(0)" ::: "memory"); __builtin_amdgcn_s_barrier(); asm volatile("" ::: "memory");
                {
                    const int rl = tid >> 3, pc = tid & 7;
                    const u32x4 v = *(const LAS u32x4*)(stg + rl * RS + pc * 16);
                    const int row = ai * 128 + (rl >> 5) * 64 + mh * 32 + (rl & 31);
                    if (u.ti * 256 + row < u.ne) __builtin_nontemporal_store(v, (u32x4*)(act + (size_t)(u.rbase + row) * FF + u.pn * 128 + pc * 16));
                }
                asm volatile("s_waitcnt lgkmcnt(0)" ::: "memory"); __builtin_amdgcn_s_barrier(); asm volatile("" ::: "memory");
            }
        if (wr == 1) __builtin_amdgcn_s_barrier();
    }
};
#endif
DI void phase_e1(const Ctx& c, int l, int nrows) {
    const Params& p = *c.p;
    moe_setup(c, l, nrows);
    MoeSched<true> S;
    S.nmy = moe_units(c, 2, true, (const int*)(p.ws + WS_LIST), DM);
    S.utab = (const LAS int*)(c.smem + LDS_MAIN + 4224); S.toks = (const LAS unsigned*)(c.smem + LDS_MAIN + 8192);
    S.A = (const char*)(p.ws + WS_H8); S.W = (const char*)(p.ws + WS_WGU) + (size_t)l * 257 * 524288; S.wstride = 524288; S.RB = DM;
    EpiE1 E; E.act = (unsigned char*)(p.ws + WS_ACT); E.stg = (LAS unsigned char*)c.smem + LDS_MAIN + 8192 + MOE_MAXG * 1024; E.tid = c.tid;
    g8::gemm_phase((LAS unsigned char*)c.smem, c.tid, DM, S, E);
}

struct EpiE2 {
    static constexpr bool F8 = true;
    static constexpr bool PERM = true;
    unsigned char* ys;
    LAS unsigned char* stg; int tid;
    DI void operator()(const f32x4 (&acc)[2][2][4][2], const g8::Unit& u, int wr, int wc, int fr, int fq) const {
        constexpr float SC = 16.f / (ACT_SCALE * WD_SCALE);
        constexpr int RS = 272;
        if (wr == 0) __builtin_amdgcn_s_barrier();
#pragma unroll
        for (int ai = 0; ai < 2; ++ai)
#pragma unroll
            for (int mh = 0; mh < 2; ++mh) {
#pragma unroll
                for (int mm = 0; mm < 2; ++mm) {
                    const int m = mh * 2 + mm;
                    LAS unsigned char* d = stg + (wr * 32 + mm * 16 + fr) * RS + wc * 32 + 8 * fq;
#pragma unroll
                    for (int bj = 0; bj < 2; ++bj) {
                        const f32x4 v0 = acc[ai][bj][m][0] * SC, v1 = acc[ai][bj][m][1] * SC;
                        int w0 = 0, w1 = 0;
                        w0 = __builtin_amdgcn_cvt_pk_fp8_f32(v0[0], v0[1], w0, false); w0 = __builtin_amdgcn_cvt_pk_fp8_f32(v0[2], v0[3], w0, true);
                        w1 = __builtin_amdgcn_cvt_pk_fp8_f32(v1[0], v1[1], w1, false); w1 = __builtin_amdgcn_cvt_pk_fp8_f32(v1[2], v1[3], w1, true);
                        u32x2 o; o.x = (unsigned)w0; o.y = (unsigned)w1;
                        *(LAS u32x2*)(d + bj * 128) = o;
                    }
                }
                asm volatile("s_waitcnt lgkmcnt(0)" ::: "memory"); __builtin_amdgcn_s_barrier(); asm volatile("" ::: "memory");
#pragma unroll
                for (int k = 0; k < 2; ++k) {
                    const int idx = tid + k * 512, rl = idx >> 4, pc = idx & 15;
                    const u32x4 v = *(const LAS u32x4*)(stg + rl * RS + pc * 16);
                    const int row = ai * 128 + (rl >> 5) * 64 + mh * 32 + (rl & 31);
                    if (u.ti * 256 + row < u.ne) __builtin_nontemporal_store(v, (u32x4*)(ys + (size_t)(u.rbase + row) * DM + u.pn * 256 + pc * 16));
                }
                asm volatile("s_waitcnt lgkmcnt(0)" ::: "memory"); __builtin_amdgcn_s_barrier(); asm volatile("" ::: "memory");
            }
        if (wr == 1) __builtin_amdgcn_s_barrier();
    }
};
DI void phase_e2(const Ctx& c, int l, int nrows) {
    const Params& p = *c.p;
    moe_setup(c, l, nrows);
    MoeSched<false> S;
    S.nmy = moe_units(c, 4, false, nullptr, 0);
    S.utab = (const LAS int*)(c.smem + LDS_MAIN + 4224); S.toks = (const LAS unsigned*)(c.smem + LDS_MAIN + 8192);
    S.A = (const char*)(p.ws + WS_ACT); S.W = (const char*)(p.ws + WS_WD) + (size_t)l * 257 * 262144; S.wstride = 262144; S.RB = FF;
    EpiE2 E; E.ys = (unsigned char*)(p.ws + WS_YS); E.stg = (LAS unsigned char*)c.smem + LDS_STG; E.tid = c.tid;
    g8::gemm_phase((LAS unsigned char*)c.smem, c.tid, FF, S, E);
}

DI void phase_combine(const Ctx& c, int l, int nrows, bool last) {
    const Params& p = *c.p;
    moe_setup(c, l, nrows);
    const LAS int* roff = (const LAS int*)(c.smem + LDS_MAIN + 2064);
    const unsigned char* ys = (const unsigned char*)(p.ws + WS_YS);
    const int* einfo = (const int*)(p.ws + WS_EINFO);
    const float* slotw = (const float*)(p.ws + WS_SLOTW);
    float* xbuf = (float*)(p.ws + WS_XBUF);
    bf16_t* hbuf = (bf16_t*)(p.ws + WS_HBUF);
    const float* modv = (const float*)(p.ws + WS_MOD);
    const int lane = c.lane;
    const int shared0 = roff[256];
    for (int t = c.bid * NWAVES + c.wid; t < nrows; t += c.nblk * NWAVES) {
        const int b = t < TL ? (t >> 12) : 8;
        const float* gate = modv + (size_t)(l * 9 + b) * 6144 + 5120 + 16 * lane;
        int myrow = 0; float myw = 0.f;
        if (lane < 8) { const int ei = einfo[(size_t)t * 8 + lane]; myrow = roff[ei >> 16] + (ei & 0xffff); myw = slotw[(size_t)t * 8 + lane] * (1.f / 16.f); }
        if (lane == 8) { myrow = shared0 + t; myw = 1.f / 16.f; }
        f32x4 v[4], a[4];
        {
            const u32x4 x0 = *(const u32x4*)((const bf16_t*)xbuf + (size_t)t * DM + 16 * lane), x1 = *(const u32x4*)((const bf16_t*)xbuf + (size_t)t * DM + 16 * lane + 8);
            v[0] = bf4_f32(u32x2{x0.x, x0.y}); v[1] = bf4_f32(u32x2{x0.z, x0.w}); v[2] = bf4_f32(u32x2{x1.x, x1.y}); v[3] = bf4_f32(u32x2{x1.z, x1.w});
        }
#pragma unroll
        for (int j = 0; j < 4; ++j) a[j] = f32x4{0.f, 0.f, 0.f, 0.f};
#pragma unroll
        for (int k = 0; k < 9; ++k) {
            const int row = __builtin_amdgcn_readlane(myrow, k); const float w = rdlane_f(myw, k);
            const u32x4 y = *(const u32x4*)(ys + (size_t)row * DM + 16 * lane);
#pragma unroll
            for (int j = 0; j < 4; ++j) {
                const unsigned word = (j == 0) ? y.x : (j == 1) ? y.y : (j == 2) ? y.z : y.w;
                const auto lo = __builtin_amdgcn_cvt_pk_f32_fp8((int)word, false), hi = __builtin_amdgcn_cvt_pk_f32_fp8((int)word, true);
                a[j].x += w * lo[0]; a[j].y += w * lo[1]; a[j].z += w * hi[0]; a[j].w += w * hi[1];
            }
        }
        float s = 0.f;
#pragma unroll
        for (int j = 0; j < 4; ++j) {
            const f32x4 g = *(const f32x4*)(gate + 4 * j);
            v[j] += g * a[j];
            s += (v[j].x * v[j].x + v[j].y * v[j].y) + (v[j].z * v[j].z + v[j].w * v[j].w);
        }
        const float rstd = rsqrtf(wave_sum(s) * (1.f / DM) + EPSV);
        if (last) {
            const float* gf = p.in[I_GFINAL] + 16 * lane;
            LAS f32x4* orow = (LAS f32x4*)(c.smem + 32768) + c.wid * 256;
#pragma unroll
            for (int j = 0; j < 4; ++j) {
                const f32x4 g = *(const f32x4*)(gf + 4 * j);
                orow[4 * lane + j] = v[j] * rstd * g;
            }
#pragma unroll
            for (int j = 0; j < 4; ++j)
                __builtin_nontemporal_store(orow[lane + 64 * j], (f32x4*)(p.out + (size_t)t * DM + 4 * (lane + 64 * j)));
        } else {
            const float* g = p.in[I_GMIX] + (l + 1) * 1024 + 16 * lane;
            const float* mv = modv + (size_t)((l + 1) * 9 + b) * 6144 + 16 * lane;
            u32x4 o8;
#pragma unroll
            for (int j = 0; j < 4; ++j) {
                *(u32x2*)((bf16_t*)xbuf + (size_t)t * DM + 16 * lane + 4 * j) = f32_bf4(v[j]);
                const f32x4 gg = *(const f32x4*)(g + 4 * j), shh = *(const f32x4*)(mv + 4 * j), scc = *(const f32x4*)(mv + 1024 + 4 * j);
                const f32x4 y = v[j] * rstd * gg * (1.f + scc) + shh;
                const unsigned w8 = pk4_fp8(y.x, y.y, y.z, y.w);
                if (j == 0) o8.x = w8; else if (j == 1) o8.y = w8; else if (j == 2) o8.z = w8; else o8.w = w8;
            }
            *(u32x4*)((unsigned char*)(p.ws + WS_HIN8) + (size_t)t * DM + 16 * lane) = o8;
        }
    }
}
DI void glds16(const void* g, LAS char* l) { __builtin_amdgcn_global_load_lds((const unsigned*)g, (LAS unsigned*)l, 16, 0, 0); }
#define VM_DRAIN() asm volatile("s_waitcnt vmcnt(0)" ::: "memory")
constexpr float FLASH_THR = 8.0f;
struct ModNone { DI bool active(int) const { return true; } DI void apply(int, f32x16&, f32x16&) const {} };
struct ModSwa {
    int nloc, kpos0, qpos, qmin, hi_;
    DI bool active(int j) const { if (j >= nloc) return true; const int k0 = kpos0 + 64 * j; return (k0 + 63 >= qmin - 128) && (k0 <= qmin + 31 + 128); }
    DI void apply(int j, f32x16& s0, f32x16& s1) const {
        if (j >= nloc) return;
        const int hi = hi_;
        const int kb = kpos0 + 64 * j + 4 * hi - qpos;
        const float NINF = -__builtin_inff();
#pragma unroll
        for (int r = 0; r < 16; ++r) {
            const int d = kb + (r & 3) + 8 * (r >> 2);
            if (d < -128 || d > 128) s0[r] = NINF;
            if (d + 32 < -128 || d + 32 > 128) s1[r] = NINF;
        }
    }
};
struct ModNa {
    int nloc, kr0, qr, qc, rs, cs, hi_;
    const LAS float* rpb;
    DI bool active(int j) const { if (j >= nloc) return true; const int kr = kr0 + j; return kr >= rs && kr < rs + 8; }
    DI void apply(int j, f32x16& s0, f32x16& s1) const {
        if (j >= nloc) return;
        const int hi = hi_;
        const int kr = kr0 + j;
        const LAS float* row = rpb + (kr - qr + 7) * 31 + 15 - qc;
        const float NINF = -__builtin_inff();
        float b0[16], b1[16];
#pragma unroll
        for (int r = 0; r < 16; ++r) { const int kc = 4 * hi + (r & 3) + 8 * (r >> 2); b0[r] = row[kc]; b1[r] = row[kc + 32]; }
#pragma unroll
        for (int r = 0; r < 16; ++r) {
            const int kc = 4 * hi + (r & 3) + 8 * (r >> 2);
            const bool ok0 = (kc >= cs) && (kc < cs + 16), ok1 = (kc + 32 >= cs) && (kc + 32 < cs + 16);
            s0[r] = ok0 ? s0[r] + b0[r] : NINF;
            s1[r] = ok1 ? s1[r] + b1[r] : NINF;
        }
    }
};


typedef __attribute__((ext_vector_type(8))) int v8i_f;
typedef __attribute__((ext_vector_type(4))) int v4i_f;
DI void mfma8(f32x16& d, const v8i_f& a, const v8i_f& b, const f32x16& c, int sc) {
    asm volatile("v_mfma_scale_f32_32x32x64_f8f6f4 %0, %1, %2, %3, %4, %4 op_sel_hi:[0,0,0]" : "=&v"(d) : "v"(a), "v"(b), "v"(c), "v"(sc));
}
DI void mfma8_acc(f32x16& d, const v8i_f& a, const v8i_f& b, int sc) {
    asm volatile("v_mfma_scale_f32_32x32x64_f8f6f4 %0, %1, %2, %0, %3, %3 op_sel_hi:[0,0,0]" : "+v"(d) : "v"(a), "v"(b), "v"(sc));
}
template <int DV> struct F8State { float m, l; f32x16 o[DV / 32]; f32x16 cinit; };

template <int DV, class Tok0, class Tile0, class Mod>
DI void pass8(const Ctx& c, int ki, int vrow0, int ntiles, Tok0 tok0, Tile0 vtile, Mod& mod, const v8i_f& qf, F8State<DV>& st) {
    constexpr int ND = DV / 32, STAGE = 4096 + DV * 64;
    const unsigned char* k8 = (const unsigned char*)(c.p->ws + WS_K8);
    const unsigned char* vt8 = (const unsigned char*)(c.p->ws + WS_VT8);
    LAS char* lds = (LAS char*)c.smem;
    const int lane = c.lane, r32 = c.r32, hi = c.hi, w = c.wid;
    int usc = 0x7F7F7F7F; asm volatile("" : "+v"(usc));
    const int prow = 16 * (w & 3) + (lane >> 2), pslot = lane & 3;
    const unsigned koff = (unsigned)(prow * 1024 + ki * 64 + ((pslot ^ ((prow >> 2) & 3)) << 4));
    const int vpiece = (DV == 128) ? w : (w & 3);
    const int vrow = 16 * vpiece + (lane >> 2);
    const unsigned voff = (unsigned)((vrow0 + vrow) * 64 + ((pslot ^ ((vrow >> 2) & 3)) << 4));
    auto issue = [&](int j, LAS char* stage) {
        if (w < 4) glds16(k8 + tok0(j) * 1024 + koff, stage + w * 1024);
        if (DV == 128 || w >= 4) glds16(vt8 + vtile(j) * (size_t)VT_TILE + voff, stage + 4096 + vpiece * 1024);
    };
    st.m = 0.f; st.l = 0.f;
#pragma unroll
    for (int r = 0; r < 16; ++r) st.cinit[r] = 0.f;
#pragma unroll
    for (int d = 0; d < ND; ++d)
#pragma unroll
        for (int r = 0; r < 16; ++r) st.o[d][r] = 0.f;
    issue(0, lds);
    VM_DRAIN();
    __syncthreads();
    const int f = (r32 >> 2) & 3;
    const int o_lo = r32 * 64 + (((2 * hi) ^ f) << 4), o_hi = r32 * 64 + (((2 * hi + 1) ^ f) << 4);
    if (__builtin_amdgcn_readfirstlane(w) >= 4) __builtin_amdgcn_s_setprio(1);
    for (int j = 0; j < ntiles; ++j) {
        if (j + 1 < ntiles) issue(j + 1, lds + ((j + 1) & 1) * STAGE);
        const LAS char* stage = lds + (j & 1) * STAGE;
        if (mod.active(j)) {
            v8i_f ka, kb;
            ka.lo = *(const LAS v4i_f*)(stage + o_lo); ka.hi = *(const LAS v4i_f*)(stage + o_hi);
            kb.lo = *(const LAS v4i_f*)(stage + 2048 + o_lo); kb.hi = *(const LAS v4i_f*)(stage + 2048 + o_hi);
            f32x16 s0, s1;
            mfma8(s0, ka, qf, st.cinit, usc); mfma8(s1, kb, qf, st.cinit, usc);
            v8i_f va, vb;
            va.lo = *(const LAS v4i_f*)(stage + 4096 + o_lo); va.hi = *(const LAS v4i_f*)(stage + 4096 + o_hi);
            vb.lo = *(const LAS v4i_f*)(stage + 4096 + 2048 + o_lo); vb.hi = *(const LAS v4i_f*)(stage + 4096 + 2048 + o_hi);
            asm volatile("s_nop 15\n\ts_nop 15" : "+v"(s0), "+v"(s1));
            mod.apply(j, s0, s1);
            float mx = fmaxf(fmaxf(s0[0], s0[1]), s1[0]);
            mx = fmaxf(fmaxf(mx, s1[1]), fmaxf(s0[2], s1[2]));
#pragma unroll
            for (int r = 3; r < 15; r += 2) mx = fmaxf(fmaxf(mx, s0[r]), fmaxf(s0[r + 1], fmaxf(s1[r], s1[r + 1])));
            mx = fmaxf(mx, fmaxf(s0[15], s1[15]));
            { const auto rr = __builtin_amdgcn_permlane32_swap(__float_as_uint(mx), __float_as_uint(mx), false, false); mx = fmaxf(__uint_as_float(rr[0]), __uint_as_float(rr[1])); }
            const bool seen = mx > -1e29f;
            const bool started = half_swap_sum(st.l) > 0.f;
            const bool mv = (mx > FLASH_THR) || (!started && seen);
            if (__any(mv)) {
                const float d = mv ? mx : 0.f;
                const float fs = (mv && started) ? __builtin_amdgcn_exp2f(-d) : 1.f;
                st.m += d; st.l *= fs;
                const float nm2 = -st.m;
                asm volatile("s_nop 15\n\ts_nop 15");
#pragma unroll
                for (int dd = 0; dd < ND; ++dd) asm volatile("" : "+v"(st.o[dd]));
#pragma unroll
                for (int r = 0; r < 16; ++r) { s0[r] -= d; s1[r] -= d; st.cinit[r] = nm2; }
#pragma unroll
                for (int dd = 0; dd < ND; ++dd)
#pragma unroll
                    for (int r = 0; r < 16; ++r) st.o[dd][r] *= fs;
            }
            float rs0 = 0.f, rs1 = 0.f;
#pragma unroll
            for (int r = 0; r < 16; ++r) { s0[r] = __builtin_amdgcn_exp2f(s0[r]); s1[r] = __builtin_amdgcn_exp2f(s1[r]); rs0 += s0[r]; rs1 += s1[r]; }
            st.l += rs0 + rs1;
            v8i_f pf;
#pragma unroll
            for (int idx = 0; idx < 8; ++idx) { const int r0 = (idx >> 2) * 4 + (idx & 3); pf[idx] = (int)pk4_fp8(s0[r0], s0[r0 + 8], s1[r0], s1[r0 + 8]); }
            asm volatile("s_nop 3" : "+v"(pf));
            mfma8_acc(st.o[0], va, pf, usc); mfma8_acc(st.o[1], vb, pf, usc);
            if constexpr (DV == 128) {
                va.lo = *(const LAS v4i_f*)(stage + 4096 + 4096 + o_lo); va.hi = *(const LAS v4i_f*)(stage + 4096 + 4096 + o_hi);
                vb.lo = *(const LAS v4i_f*)(stage + 4096 + 6144 + o_lo); vb.hi = *(const LAS v4i_f*)(stage + 4096 + 6144 + o_hi);
                mfma8_acc(st.o[2], va, pf, usc); mfma8_acc(st.o[3], vb, pf, usc);
            }
        }
        VM_DRAIN();
        __syncthreads();
    }
    __builtin_amdgcn_s_setprio(0);
    asm volatile("s_nop 15\n\ts_nop 15");
#pragma unroll
    for (int dd = 0; dd < ND; ++dd) asm volatile("" : "+v"(st.o[dd]));
}

DI v8i_f load_q8(const Ctx& c, size_t qtok, int cb) {
    const unsigned char* q8 = (const unsigned char*)(c.p->ws + WS_Q8) + qtok * 1024 + cb * 64 + 32 * c.hi;
    v8i_f qf; qf.lo = *(const v4i_f*)q8; qf.hi = *(const v4i_f*)(q8 + 16);
    return qf;
}
template <int DV>
DI void store_o8(const F8State<DV>& st, float inv, unsigned char* __restrict__ orow, int hi) {
    const float s = inv * MIX_SCALE;
#pragma unroll
    for (int dt = 0; dt < DV / 32; ++dt)
#pragma unroll
        for (int g = 0; g < 4; ++g)
            *(unsigned*)(orow + 32 * dt + 8 * g + 4 * hi) = pk4_fp8(st.o[dt][4 * g] * s, st.o[dt][4 * g + 1] * s, st.o[dt][4 * g + 2] * s, st.o[dt][4 * g + 3] * s);
}

DI void attn_swa_item(const Ctx& c, int l, int b, int h, int qb, bool ctxq) {
    const Params& p = *c.p;
    unsigned char* mix = (unsigned char*)(p.ws + WS_MIX);
    const int kvh = h >> 1;
    const size_t qtok = ctxq ? (size_t)TL + b * CTXL + c.wid * 32 + c.r32 : (size_t)b * SEQ + qb * 256 + c.wid * 32 + c.r32;
    const v8i_f qf = load_q8(c, qtok, h);
    F8State<64> st;
    ModSwa mod; mod.hi_ = c.hi;
    int j0 = 0;
    if (ctxq) { mod.nloc = 0; mod.kpos0 = 0; }
    else { j0 = 4 * qb - 2; if (j0 < 0) j0 = 0; int j1 = 4 * qb + 5; if (j1 > 63) j1 = 63; mod.nloc = j1 - j0 + 1; mod.kpos0 = 64 * j0; }
    mod.qmin = qb * 256 + c.wid * 32; mod.qpos = mod.qmin + c.r32;
    const int nloc = mod.nloc;
    const size_t lbase = (size_t)b * SEQ + 64 * j0, cbase = (size_t)TL + b * CTXL;
    auto tok0 = [&](int j) { return j < nloc ? lbase + 64 * j : cbase + 64 * (j - nloc); };
    const size_t vt0 = (size_t)b * 68;
    auto vtile = [&](int j) { return vt0 + (j < nloc ? j0 + j : 64 + (j - nloc)); };
    pass8<64>(c, kvh, kvh * 64, nloc + 4, tok0, vtile, mod, qf, st);
    float lt = half_swap_sum(st.l);
    lt += __builtin_amdgcn_exp2f(p.in[I_SINK][l * 4 + h] * LOG2E - st.m);
    store_o8<64>(st, 1.f / lt, mix + qtok * DM + h * 64, c.hi);
}

DI void attn_na_item(const Ctx& c, int l, int b, int h, int qb, bool ctxq) {
    const Params& p = *c.p;
    unsigned char* mix = (unsigned char*)(p.ws + WS_MIX);
    LAS float* rpbl = (LAS float*)(c.smem + LDS_MAIN + 1024);
    __syncthreads();
    if (!ctxq) for (int i = c.tid; i < 465; i += NTHREADS) rpbl[i] = p.in[I_RPB][(size_t)(l * 4 + h) * 465 + i] * LOG2E;
    __syncthreads();
    const size_t qtok = ctxq ? (size_t)TL + b * CTXL + c.wid * 32 + c.r32 : (size_t)b * SEQ + qb * 256 + c.wid * 32 + c.r32;
    const v8i_f qf = load_q8(c, qtok, 4 + h);
    F8State<64> st;
    ModNa mod; mod.rpb = rpbl; mod.hi_ = c.hi;
    int kr0 = 0;
    if (ctxq) { mod.nloc = 0; mod.kr0 = 0; mod.qr = 0; mod.qc = 0; mod.rs = 0; mod.cs = 0; }
    else {
        const int r_lo = 4 * qb, r_hi = 4 * qb + 3;
        int a = r_lo - 4; a = a < 0 ? 0 : (a > 56 ? 56 : a);
        int bb = r_hi - 4; bb = bb < 0 ? 0 : (bb > 56 ? 56 : bb);
        kr0 = a; mod.kr0 = a; mod.nloc = bb + 7 - a + 1;
        mod.qr = 4 * qb + (c.wid >> 1); mod.qc = 32 * (c.wid & 1) + c.r32;
        int rs = mod.qr - 4; rs = rs < 0 ? 0 : (rs > 56 ? 56 : rs); mod.rs = rs;
        int cs = mod.qc - 8; cs = cs < 0 ? 0 : (cs > 48 ? 48 : cs); mod.cs = cs;
    }
    const int nloc = mod.nloc;
    const size_t lbase = (size_t)b * SEQ + 64 * kr0, cbase = (size_t)TL + b * CTXL;
    auto tok0 = [&](int j) { return j < nloc ? lbase + 64 * j : cbase + 64 * (j - nloc); };
    const size_t vt0 = (size_t)b * 68;
    auto vtile = [&](int j) { return vt0 + (j < nloc ? kr0 + j : 64 + (j - nloc)); };
    pass8<64>(c, 2 + h, 128 + h * 64, nloc + 4, tok0, vtile, mod, qf, st);
    const float lt = half_swap_sum(st.l);
    store_o8<64>(st, 1.f / lt, mix + qtok * DM + 256 + h * 64, c.hi);
}

DI void attn_diff_item(const Ctx& c, int l, int b, int h, int qb, bool ctxq) {
    const Params& p = *c.p;
    unsigned char* mix = (unsigned char*)(p.ws + WS_MIX);
    const size_t qtok = ctxq ? (size_t)TL + b * CTXL + c.wid * 32 + c.r32 : (size_t)b * SEQ + qb * 256 + c.wid * 32 + c.r32;
    const int nloc = ctxq ? 0 : 64;
    const size_t lbase = (size_t)b * SEQ, cbase = (size_t)TL + b * CTXL;
    auto tok0 = [&](int j) { return j < nloc ? lbase + 64 * j : cbase + 64 * (j - nloc); };
    const size_t vt0 = (size_t)b * 68;
    auto vtile = [&](int j) { return vt0 + (j < nloc ? j : 64 + (j - nloc)); };
    unsigned char* orow = mix + qtok * DM + 512 + h * 128;
    LAS u32x2* park = (LAS u32x2*)(c.smem + 65536) + c.tid;
    ModNone mod;
    F8State<128> st;
    {
        const v8i_f qf = load_q8(c, qtok, 8 + 2 * h);
        pass8<128>(c, 6 + 2 * h, 384 + h * 128, nloc + 4, tok0, vtile, mod, qf, st);
        const float inv = 1.f / half_swap_sum(st.l);
#pragma unroll
        for (int dt = 0; dt < 4; ++dt)
#pragma unroll
            for (int g = 0; g < 4; ++g) {
                u32x2 u; u.x = pk2(st.o[dt][4 * g] * inv, st.o[dt][4 * g + 1] * inv); u.y = pk2(st.o[dt][4 * g + 2] * inv, st.o[dt][4 * g + 3] * inv);
                park[(dt * 4 + g) * NTHREADS] = u;
            }
    }
    const v8i_f qf = load_q8(c, qtok, 8 + 2 * h + 1);
    pass8<128>(c, 6 + 2 * h + 1, 384 + h * 128, nloc + 4, tok0, vtile, mod, qf, st);
    const float lam_init = 0.8f - 0.6f * __expf(-0.3f * (float)l);
    const float d1 = wave_sum(p.in[I_LQ1][l * 64 + c.lane] * p.in[I_LK1][l * 64 + c.lane]);
    const float d2 = wave_sum(p.in[I_LQ2][l * 64 + c.lane] * p.in[I_LK2][l * 64 + c.lane]);
    const float lam = __expf(d1) - __expf(d2) + lam_init;
    const float inv2 = lam / half_swap_sum(st.l);
    float ss = 0.f;
#pragma unroll
    for (int dt = 0; dt < 4; ++dt)
#pragma unroll
        for (int g = 0; g < 4; ++g) {
            const u32x2 u = park[(dt * 4 + g) * NTHREADS];
            const float a0 = bflo(u.x) - st.o[dt][4 * g] * inv2, a1 = bfhi(u.x) - st.o[dt][4 * g + 1] * inv2;
            const float a2 = bflo(u.y) - st.o[dt][4 * g + 2] * inv2, a3 = bfhi(u.y) - st.o[dt][4 * g + 3] * inv2;
            st.o[dt][4 * g] = a0; st.o[dt][4 * g + 1] = a1; st.o[dt][4 * g + 2] = a2; st.o[dt][4 * g + 3] = a3;
            ss += (a0 * a0 + a1 * a1) + (a2 * a2 + a3 * a3);
        }
    ss = half_swap_sum(ss);
    const float rn = rsqrtf(ss * (1.f / 128.f) + EPSV) * (1.f - lam_init);
    const float* sg = p.in[I_SUBLN] + l * 128;
#pragma unroll
    for (int dt = 0; dt < 4; ++dt)
#pragma unroll
        for (int g = 0; g < 4; ++g) {
            const f32x4 gg = *(const f32x4*)(sg + 32 * dt + 8 * g + 4 * c.hi);
            const float rs = rn * MIX_SCALE;
            *(unsigned*)(orow + 32 * dt + 8 * g + 4 * c.hi) = pk4_fp8(st.o[dt][4 * g] * rs * gg.x, st.o[dt][4 * g + 1] * rs * gg.y, st.o[dt][4 * g + 2] * rs * gg.z, st.o[dt][4 * g + 3] * rs * gg.w);
        }
}

DI void attn_decode(int it, int& b, int& h, int& qb, bool& ctxq) {
    if (it < 512) {
        const int xcd = it & 7, j = it >> 3;
        const int bh = xcd * 4 + (j >> 4); qb = j & 15;
        b = bh >> 2; h = bh & 3; ctxq = false;
    } else {
        const int i = it - 512;
        qb = 0; h = i & 3; b = i >> 2; ctxq = true;
    }
}
DI Ctx reopaque(const Ctx& c) {
    Ctx d = c; int t = c.tid; asm volatile("" : "+v"(t));
    d.tid = t; d.lane = t & 63; d.wid = __builtin_amdgcn_readfirstlane(t >> 6); d.r32 = t & 31; d.hi = (t >> 5) & 1;
    return d;
}
DI void phase_attn0_convert(const Ctx& c) {
    const int xcd = c.bid & 7;
    int* actr = (int*)(c.p->ws + WS_ROWCTR) + 128 + 64 * xcd;
    int* cctr = (int*)(c.p->ws + WS_ROWCTR) + 1024;
    LAS int* slot = (LAS int*)(c.smem + LDS_MAIN + 64);
    constexpr int NIT = 544, NATT = 3 * NIT;
    const bool prefer_conv = ((c.bid >> 3) & 1) != 0;
    for (;;) {
        if (c.tid == 0) {
            int k = -1, v = 0;
            if (prefer_conv) {
                v = atomicAdd(cctr, 1); if (v < CONV_NCHUNK) k = 1;
                if (k < 0) { v = atomicAdd(actr, 1) * 8 + xcd; if (v < NATT) k = 0; }
            } else {
                v = atomicAdd(actr, 1) * 8 + xcd; if (v < NATT) k = 0;
                if (k < 0) { v = atomicAdd(cctr, 1); if (v < CONV_NCHUNK) k = 1; }
            }
            slot[0] = k; slot[1] = v;
        }
        __syncthreads();
        const int kind = slot[0], idx = slot[1];
        __syncthreads();
        if (kind < 0) break;
        if (kind == 1) {
            convert_pairs(reopaque(c), idx * CONV_CHUNK, 1, CONV_CHUNK, [](int q) { return rmap_expert(q); });
        } else {
            const int grp = idx / NIT, it = idx - grp * NIT;
            int b, h, qb; bool ctxq; attn_decode(it, b, h, qb, ctxq);
            if (grp == 0) attn_diff_item(reopaque(c), 0, b, h, qb, ctxq);
            else if (grp == 1) attn_swa_item(reopaque(c), 0, b, h, qb, ctxq);
            else attn_na_item(reopaque(c), 0, b, h, qb, ctxq);
        }
    }
}
DI void phase_attn(const Ctx& c, int l) {
    const int NIT = 512 + ((l == 0) ? 32 : 0);
    for (int it = c.bid; it < NIT; it += c.nblk) { int b, h, qb; bool ctxq; attn_decode(it, b, h, qb, ctxq); attn_diff_item(c, l, b, h, qb, ctxq); }
    for (int it = c.bid; it < NIT; it += c.nblk) { int b, h, qb; bool ctxq; attn_decode(it, b, h, qb, ctxq); attn_swa_item(c, l, b, h, qb, ctxq); }
    for (int it = c.bid; it < NIT; it += c.nblk) { int b, h, qb; bool ctxq; attn_decode(it, b, h, qb, ctxq); attn_na_item(c, l, b, h, qb, ctxq); }
}
#ifndef WAVES_PER_SIMD
#define WAVES_PER_SIMD 2
#endif
#ifndef PROBE_REP
#define PROBE_REP 0
#endif
#ifndef DBG_MODE
#define DBG_MODE 0
#endif
DI Ctx mkctx(const Params& p, char* smem, int wave_s) {
    Ctx c; c.p = &p; c.smem = smem;
    int t = wave_s * 64 + (int)__builtin_amdgcn_mbcnt_hi(~0u, __builtin_amdgcn_mbcnt_lo(~0u, 0u)); asm volatile("" : "+v"(t));
    c.tid = t; c.lane = t & 63; c.wid = __builtin_amdgcn_readfirstlane(t >> 6); c.r32 = t & 31; c.hi = (t >> 5) & 1;
    int b = blockIdx.x, n = gridDim.x; asm volatile("" : "+s"(b), "+s"(n));
    c.bid = b; c.nblk = n;
    return c;
}
__global__ void __launch_bounds__(NTHREADS, WAVES_PER_SIMD) mega(Params p) {
    extern __shared__ __attribute__((aligned(16))) char smem[];
    Ctx c; c.p = &p; c.smem = smem; c.tid = threadIdx.x; c.lane = c.tid & 63; c.wid = c.tid >> 6; c.r32 = c.lane & 31; c.hi = c.lane >> 5;
    c.bid = blockIdx.x; c.nblk = gridDim.x;
    const int wave_s = __builtin_amdgcn_readfirstlane((int)threadIdx.x >> 6);
#define FRESH() mkctx(p, smem, wave_s)
#define GRID_SYNC() do { XcdBarrier bb_ = bar; asm volatile("" : "+s"(bb_.bar), "+s"(bb_.x)); xcd_barrier(bb_); } while (0)
    volatile LAS unsigned* xbw = (volatile LAS unsigned*)(smem + LDS_MAIN);
    if (c.tid == 0) { xbw[0] = 0u; xbw[1] = 0u; xbw[2] = 0u; xbw[3] = 0u; }
    __syncthreads();
    XcdBarrier bar = xcd_barrier_post((unsigned*)(p.ws + WS_BAR), xbw);
    asm volatile("; PHASE_MARK prologue" ::: "memory");
    phase_prologue(FRESH());
    GRID_SYNC();
#if PROBE_REP == 1
    asm volatile("; PHASE_MARK prologue" ::: "memory");
    phase_prologue(FRESH());
    GRID_SYNC();
#endif
    asm volatile("; PHASE_MARK norm" ::: "memory");
    phase_norm(FRESH(), 0, TT, true, 0);
    wrp_items(FRESH());
    GRID_SYNC();
#if PROBE_REP == 9
    phase_norm(FRESH(), 0, TT, true, 0);
    GRID_SYNC();
#endif
#if PROBE_REP == 13
#pragma unroll 1
    for (int z = 0; z < 20; ++z) { GRID_SYNC(); }
#endif
#pragma unroll 1
    for (int l = 0; l < 2; ++l) {
        const bool last = (l == 1);
        const int nrows = last ? TL : TT;
        asm volatile("; PHASE_MARK inproj" ::: "memory");
        asm volatile("; PHASE_MARK inproj" ::: "memory");
    phase_inproj(FRESH(), l);
        GRID_SYNC();
#if PROBE_REP == 2
        asm volatile("; PHASE_MARK inproj" ::: "memory");
        asm volatile("; PHASE_MARK inproj" ::: "memory");
    phase_inproj(FRESH(), l);
        GRID_SYNC();
#endif
        asm volatile("; PHASE_MARK attn" ::: "memory");
        asm volatile("; PHASE_MARK attn" ::: "memory");
        if (l == 0) phase_attn0_convert(FRESH()); else phase_attn(FRESH(), l);
        GRID_SYNC();
#if PROBE_REP == 3
        asm volatile("; PHASE_MARK attn" ::: "memory");
        asm volatile("; PHASE_MARK attn" ::: "memory");
    phase_attn(FRESH(), l);
        GRID_SYNC();
#endif
        asm volatile("; PHASE_MARK outproj" ::: "memory");
        asm volatile("; PHASE_MARK outproj" ::: "memory");
    phase_outproj(FRESH(), l, nrows);
        GRID_SYNC();
#if PROBE_REP == 7
        if (l == 0) { phase_outproj(FRESH(), l, nrows); GRID_SYNC(); }
#endif
#if DBG_MODE != 1
        asm volatile("; PHASE_MARK router" ::: "memory");
    phase_norm_router(FRESH(), l, nrows);
        GRID_SYNC();
        asm volatile("; PHASE_MARK route" ::: "memory");
        asm volatile("; PHASE_MARK route" ::: "memory");
    phase_route(FRESH(), l, nrows);
        GRID_SYNC();
        asm volatile("; PHASE_MARK e1" ::: "memory");
        asm volatile("; PHASE_MARK e1" ::: "memory");
    phase_e1(FRESH(), l, nrows);
        GRID_SYNC();
#if PROBE_REP == 4
        asm volatile("; PHASE_MARK e1" ::: "memory");
        asm volatile("; PHASE_MARK e1" ::: "memory");
    phase_e1(FRESH(), l, nrows);
        GRID_SYNC();
#endif
        asm volatile("; PHASE_MARK e2" ::: "memory");
        asm volatile("; PHASE_MARK e2" ::: "memory");
    phase_e2(FRESH(), l, nrows);
        GRID_SYNC();
#if PROBE_REP == 5
        asm volatile("; PHASE_MARK e2" ::: "memory");
        asm volatile("; PHASE_MARK e2" ::: "memory");
    phase_e2(FRESH(), l, nrows);
        GRID_SYNC();
#endif
#endif
        asm volatile("; PHASE_MARK combine" ::: "memory");
        asm volatile("; PHASE_MARK combine" ::: "memory");
    phase_combine(FRESH(), l, nrows, last);
#if PROBE_REP == 8
        if (last) { GRID_SYNC(); phase_combine(FRESH(), l, nrows, last); }
#endif
        if (!last) { GRID_SYNC(); }
    }
}

extern "C" void kernel_launch(void* const* d_in, const int* in_sizes, int n_in, void* d_out, int out_size, void* d_ws, size_t ws_size, hipStream_t stream) {
    static int grid = 0;
    if (grid == 0) {
        int dev = 0, cus = 0, per_cu = 0;
        if (n_in != 26 || ws_size < WS_END) { fprintf(stderr, "kernel_launch: unexpected n_in %d / ws %zu (need %zu)\n", n_in, ws_size, (size_t)WS_END); grid = -1; return; }
        if (hipGetDevice(&dev) != hipSuccess || hipDeviceGetAttribute(&cus, hipDeviceAttributeMultiprocessorCount, dev) != hipSuccess) { grid = -1; return; }
        if (hipFuncSetAttribute((const void*)mega, hipFuncAttributeMaxDynamicSharedMemorySize, LDS_BYTES) != hipSuccess) { grid = -1; return; }
        if (hipOccupancyMaxActiveBlocksPerMultiprocessor(&per_cu, (const void*)mega, NTHREADS, LDS_BYTES) != hipSuccess || per_cu < 1) per_cu = 1;
        (void)hipGetLastError();
        grid = cus;
    }
    if (grid < 0) return;
    (void)hipMemsetAsync((char*)d_ws + WS_BAR, 0, WS_ZERO_BYTES, stream);
    Params p{};
    for (int i = 0; i < 26; ++i) p.in[i] = (const float*)d_in[i];
    p.out = (float*)d_out; p.ws = (unsigned char*)d_ws;
    hipLaunchKernelGGL(mega, dim3(grid), dim3(NTHREADS), LDS_BYTES, stream, p);
}
```

```cpp
#include <hip/hip_runtime.h>
#include <hip/hip_bf16.h>
#include <cstdio>
#include <cstdint>

#define XB_TMO      128
#define XB_XCNT(j)  (256  + 64 * (j))
#define XB_XSUB(j)  (1280 + 64 * (j))
#define XB_XGEN(j)  (2304 + 64 * (j))
#define XB_TOP      3328
#define XB_TOPGEN   3392
#define XCD_BAR_WORDS 3456
#define XB_SPIN_CAP (1u << 22)
#define LAS __attribute__((address_space(3)))

__device__ __forceinline__ unsigned xb_ld(unsigned* p)              { return __hip_atomic_load(p, __ATOMIC_RELAXED, __HIP_MEMORY_SCOPE_AGENT); }
__device__ __forceinline__ unsigned xb_add(unsigned* p, unsigned v) { return __hip_atomic_fetch_add(p, v, __ATOMIC_RELAXED, __HIP_MEMORY_SCOPE_AGENT); }
__device__ __forceinline__ unsigned xb_xcc_id() { return (unsigned)__builtin_amdgcn_s_getreg((3 << 11) | 20) & 0xFu; }
#define XB_SPIN(cond, bar) do { unsigned _sp = 0; while (cond) { __builtin_amdgcn_s_sleep(1); \
    if ((++_sp & 255u) == 0u) { if (xb_ld(&(bar)[XB_TMO])) break; if (_sp > XB_SPIN_CAP) { atomicAdd(&(bar)[XB_TMO], 1u); break; } } } } while (0)

struct XcdBarrier {
    unsigned* bar; unsigned x;
    volatile LAS unsigned* st;
};

__device__ __forceinline__ XcdBarrier xcd_barrier_post(unsigned* bar, volatile LAS unsigned* st) {
    XcdBarrier b; b.bar = bar; b.x = xb_xcc_id(); b.st = st;
    if (threadIdx.x == 0) (void)xb_add(&bar[XB_XCNT(b.x)], 1u);
    return b;
}
__device__ __forceinline__ void xcd_barrier_complete(unsigned* bar, unsigned x, unsigned& nloc, unsigned& nx) {
    const unsigned G = gridDim.x * gridDim.y * gridDim.z;
    unsigned sum, cnt, mine, sp = 0u;
    for (;;) {
        sum = 0u; cnt = 0u; mine = 0u;
#pragma unroll
        for (unsigned j = 0; j < 16; ++j) { const unsigned c = xb_ld(&bar[XB_XCNT(j)]); sum += c; cnt += (c > 0u) ? 1u : 0u; mine = (j == x) ? c : mine; }
        if (sum == G) break;
        __builtin_amdgcn_s_sleep(1);
        if ((++sp & 255u) == 0u) { if (xb_ld(&bar[XB_TMO])) break; if (sp > XB_SPIN_CAP) { atomicAdd(&bar[XB_TMO], 1u); break; } }
    }
    nloc = mine > 0u ? mine : 1u; nx = cnt > 0u ? cnt : 1u;
}

__device__ __forceinline__ void xcd_barrier(const XcdBarrier& b) {
    asm volatile("s_waitcnt vmcnt(0)" ::: "memory");
    __syncthreads();
    if (threadIdx.x == 0) {
        unsigned* bar = b.bar;
        __builtin_amdgcn_s_waitcnt(0);
        unsigned nloc = b.st[0], nx = b.st[1];
        if (nloc == 0u) { xcd_barrier_complete(bar, b.x, nloc, nx); b.st[0] = nloc; b.st[1] = nx; }
        const unsigned old = xb_add(&bar[XB_XSUB(b.x)], 1u);
        const unsigned gen = old / nloc;
        if (old + 1u == (gen + 1u) * nloc) {
            __builtin_amdgcn_fence(__ATOMIC_RELEASE, "agent");
            asm volatile("s_waitcnt vmcnt(0)" ::: "memory");
            const unsigned og = xb_add(&bar[XB_TOP], 1u);
            const unsigned tg = og / nx;
            if (og + 1u == (tg + 1u) * nx) xb_add(&bar[XB_TOPGEN], 1u);
            else XB_SPIN(xb_ld(&bar[XB_TOPGEN]) == tg, bar);
            __builtin_amdgcn_fence(__ATOMIC_ACQUIRE, "agent");
            xb_add(&bar[XB_XGEN(b.x)], 1u);
            asm volatile("s_waitcnt vmcnt(0)" ::: "memory");
        } else {
            XB_SPIN(xb_ld(&bar[XB_XGEN(b.x)]) == gen, bar);
            __builtin_amdgcn_fence(__ATOMIC_ACQUIRE, "agent");
            asm volatile("s_waitcnt vmcnt(0)" ::: "memory");
        }
    }
    __syncthreads();
}

constexpr int DM = 1024, NB = 8, SEQ = 4096, CTXL = 256;
constexpr int TL = NB * SEQ;
constexpr int TC = NB * CTXL;
constexpr int TT = TL + TC;
constexpr int INC = 2816, QC = 1024, KVC = 1792;
constexpr int NE = 256, NEX = 257, FF = 256;
constexpr float EPSV = 1e-6f;
constexpr float LOG2E = 1.4426950408889634f;
constexpr float QSCALE = 0.125f * LOG2E;
constexpr float MIX_SCALE = 4.0f, W_SCALE = 32.0f, WD_SCALE = 16.0f, ACT_SCALE = 2.0f;
constexpr int NTHREADS = 512;
constexpr int NWAVES = 8;
constexpr int LDS_MAIN = 131072;
constexpr int LDS_AUX = 8192 + 16384 + 8192;
constexpr int LDS_BYTES = LDS_MAIN + LDS_AUX;
constexpr int LDS_STG = LDS_MAIN + 8192;
static_assert(LDS_BYTES <= 163840, "LDS");

typedef unsigned short bf16_t;
typedef __attribute__((ext_vector_type(8))) short bf16x8;
typedef __attribute__((ext_vector_type(4))) short s16x4;
typedef __attribute__((ext_vector_type(16))) float f32x16;
typedef __attribute__((ext_vector_type(2))) float f32x2;
typedef __attribute__((ext_vector_type(2))) __bf16 bf16x2v;
typedef short v4i16_t __attribute__((ext_vector_type(4)));
typedef __attribute__((ext_vector_type(4))) unsigned u32x4;
typedef __attribute__((ext_vector_type(2))) unsigned u32x2;
typedef __attribute__((ext_vector_type(4))) float f32x4;
#define DI __device__ __forceinline__
#define MFMA32(a, b, c) __builtin_amdgcn_mfma_f32_32x32x16_bf16((a), (b), (c), 0, 0, 0)

DI unsigned pk2(float lo, float hi) { f32x2 v = {lo, hi}; bf16x2v b = __builtin_convertvector(v, bf16x2v); return __builtin_bit_cast(unsigned, b); }
DI unsigned pk4_fp8(float a, float b, float c, float d) { int w = 0; w = __builtin_amdgcn_cvt_pk_fp8_f32(a, b, w, false); w = __builtin_amdgcn_cvt_pk_fp8_f32(c, d, w, true); return (unsigned)w; }
DI float bf2f(bf16_t u) { return __uint_as_float(((unsigned)u) << 16); }
DI float bflo(unsigned u) { return __uint_as_float(u << 16); }
DI float bfhi(unsigned u) { return __uint_as_float(u & 0xffff0000u); }
DI f32x4 bf4_f32(u32x2 w) { return f32x4{bflo(w.x), bfhi(w.x), bflo(w.y), bfhi(w.y)}; }
DI u32x2 f32_bf4(f32x4 v) { u32x2 o; o.x = pk2(v[0], v[1]); o.y = pk2(v[2], v[3]); return o; }
DI int crow(int reg, int hi) { return (reg & 3) + 8 * (reg >> 2) + 4 * hi; }
#define DPPI(v, CTRL) __builtin_amdgcn_update_dpp(0, (v), (CTRL), 0xf, 0xf, true)
#define DPPF(v, CTRL) __builtin_bit_cast(float, __builtin_amdgcn_update_dpp(0, __builtin_bit_cast(int, (v)), (CTRL), 0xf, 0xf, true))
#define DPP_XOR1 0xB1
#define DPP_XOR2 0x4E
#define DPP_HMIR 0x141
#define DPP_MIR  0x140
#define DPP_SHR(n) (0x110 + (n))
DI float rdlane_f(float v, int l) { return __builtin_bit_cast(float, __builtin_amdgcn_readlane(__builtin_bit_cast(int, v), l)); }
DI float wave_sum(float v) {
    v += DPPF(v, DPP_XOR1); v += DPPF(v, DPP_XOR2); v += DPPF(v, DPP_HMIR); v += DPPF(v, DPP_MIR);
    return (rdlane_f(v, 0) + rdlane_f(v, 16)) + (rdlane_f(v, 32) + rdlane_f(v, 48));
}
DI float half_swap_sum(float v) {
    const auto rr = __builtin_amdgcn_permlane32_swap(__float_as_uint(v), __float_as_uint(v), false, false);
    return __uint_as_float(rr[0]) + __uint_as_float(rr[1]);
}
DI float siluf(float v) { return v / (1.f + __expf(-v)); }

struct Params {
    const float* in[26];
    float* out;
    unsigned char* ws;
};
enum { I_X = 0, I_C, I_CTX, I_CCTX, I_WMOD, I_BMOD, I_GMIX, I_GFFN, I_WIN, I_WOUT, I_SINK, I_RPB, I_LQ1, I_LK1, I_LQ2, I_LK2, I_SUBLN,
       I_WR, I_RB, I_WG, I_WU, I_WD, I_SG, I_SU, I_SD, I_GFINAL };

constexpr size_t MiB = 1u << 20;
constexpr size_t WS_BAR = 0;
constexpr size_t WS_CNT = 16384;
constexpr int CNT_STRIDE = 64, CNT_LAYER = 257 * 64;
constexpr size_t WS_ZERO_BYTES = 163840;
constexpr size_t WS_ROPE = 196608;
constexpr size_t WS_MOD = 262144;
constexpr size_t WS_WIN = 1 * MiB;
constexpr size_t WS_WOUT = 12 * MiB;
constexpr size_t WS_WR = 16 * MiB;
constexpr size_t WS_WGU = 17 * MiB;
constexpr size_t WS_WD = WS_WGU + 514 * MiB;
constexpr size_t WS_XBUF = WS_WD + 257 * MiB;
constexpr size_t WS_HBUF = WS_XBUF + 136 * MiB;
constexpr size_t WS_SLOTW = WS_HBUF + 68 * MiB;
constexpr size_t WS_LIST = WS_SLOTW + 2 * MiB;
constexpr size_t WS_R = WS_LIST + 34 * MiB;
constexpr size_t WS_Q = WS_R;
constexpr size_t WS_KV = WS_R + 68 * MiB;
constexpr size_t WS_MIX = WS_R + 187 * MiB;
constexpr size_t WS_PARK = WS_R + 221 * MiB;
constexpr size_t WS_Q8 = WS_R + 290 * MiB;
constexpr size_t WS_K8 = WS_R + 324 * MiB;
constexpr size_t WS_VT8 = WS_R + 358 * MiB;
constexpr int VT_ROWS = 896, VT_TILE = 896 * 64;
constexpr size_t WS_LOGIT = WS_R + 256 * MiB;
constexpr size_t WS_ACT = WS_R;
constexpr size_t WS_HIN8 = WS_WGU + 300 * MiB;
constexpr size_t WS_H8 = WS_R + 80 * MiB;
constexpr size_t WS_YS = WS_R + 153 * MiB;
constexpr size_t WS_EINFO = WS_R + 512 * MiB;
constexpr size_t WS_WRP = WS_R + 460 * MiB;
constexpr size_t WS_CB = WS_R + 470 * MiB;
constexpr size_t WS_RSTD = WS_R + 471 * MiB;
constexpr size_t WS_ROWCTR = 151552;
constexpr size_t WS_END = WS_YS + 612 * MiB;
static_assert(WS_END <= 2048 * MiB, "workspace");

struct Ctx {
    const Params* p;
    char* smem;
    int tid, lane, wid, r32, hi;
    int bid, nblk;
};
DI int map_row(int type, int n) {
    if (type == 1) {
        const int hb = n >> 6, d = n & 63;
        const bool roped = (hb < 4) || (hb >= 8 && hb < 16) || (hb == 16) || (hb == 17) || (hb >= 28 && hb < 36);
        int d2 = d;
        if (roped) d2 = (d < 16) ? 2 * d : (d < 32) ? 2 * (d - 16) + 1 : (d < 48) ? 2 * (d - 16) : 2 * (d - 32) + 1;
        return (hb << 6) | d2;
    }
    if (type == 2) return 2 * n;
    if (type == 3) return 2 * n + 1;
    return n;
}

struct TItem { const float* W; int K, N, kt, nt, type; void* dst; bool f8; float ws; };
DI void tload(const Ctx& c, float (&v)[4][2][8], const TItem& it) {
    const int wid4 = c.wid & 3;
    const int k0 = it.kt * 128, n0 = it.nt * 128;
#pragma unroll
    for (int cc = 0; cc < 4; ++cc) {
        const int kc = 4 * wid4 + cc;
#pragma unroll
        for (int j = 0; j < 8; ++j)
#pragma unroll
            for (int i = 0; i < 2; ++i) v[cc][i][j] = __builtin_nontemporal_load(&it.W[(size_t)(k0 + kc * 8 + j) * it.N + n0 + c.lane + 64 * i]);
    }
}
DI void tfinish(const Ctx& c, const float (&v)[4][2][8], const TItem& it) {
    LAS char* lds = (LAS char*)c.smem + (c.tid >> 8) * 36864;
    const int wid4 = c.wid & 3, tid8 = c.tid & 255;
    const int k0 = it.kt * 128, n0 = it.nt * 128, K = it.K;
    const float wscale = it.ws;
#pragma unroll
    for (int cc = 0; cc < 4; ++cc) {
        const int kc = 4 * wid4 + cc;
#pragma unroll
        for (int i = 0; i < 2; ++i) {
            if (it.f8) {
                u32x2 u; u.x = pk4_fp8(v[cc][i][0] * wscale, v[cc][i][1] * wscale, v[cc][i][2] * wscale, v[cc][i][3] * wscale); u.y = pk4_fp8(v[cc][i][4] * wscale, v[cc][i][5] * wscale, v[cc][i][6] * wscale, v[cc][i][7] * wscale);
                *(LAS u32x2*)(lds + (c.lane + 64 * i) * 144 + kc * 8) = u;
            } else {
                u32x4 u; u.x = pk2(v[cc][i][0], v[cc][i][1]); u.y = pk2(v[cc][i][2], v[cc][i][3]); u.z = pk2(v[cc][i][4], v[cc][i][5]); u.w = pk2(v[cc][i][6], v[cc][i][7]);
                *(LAS u32x4*)(lds + (c.lane + 64 * i) * 272 + kc * 16) = u;
            }
        }
    }
    __syncthreads();
    if (it.f8) {
        unsigned char* dst = (unsigned char*)it.dst;
#pragma unroll
        for (int j = 0; j < 4; ++j) {
            const int idx = tid8 + 256 * j, c16 = idx & 7, n = idx >> 3;
            const u32x4 u = *(LAS u32x4*)(lds + n * 144 + c16 * 16);
            const int row = map_row(it.type, n0 + n);
            __builtin_nontemporal_store(u, (u32x4*)(dst + (size_t)row * K + k0 + c16 * 16));
        }
    } else {
        bf16_t* dst = (bf16_t*)it.dst;
#pragma unroll
        for (int j = 0; j < 8; ++j) {
            const int idx = tid8 + 256 * j, c16 = idx & 15, n = idx >> 4;
            const u32x4 u = *(LAS u32x4*)(lds + n * 272 + c16 * 16);
            const int row = map_row(it.type, n0 + n);
            *(u32x4*)(dst + (size_t)row * K + k0 + c16 * 8) = u;
        }
    }
    __syncthreads();
}

DI void mod_item(const Ctx& c, int l, int cg) {
    const Params& p = *c.p;
    LAS float* sv = (LAS float*)c.smem;
    LAS float* part = (LAS float*)(c.smem + 36864);
    for (int idx = c.tid; idx < 9 * 1024; idx += NTHREADS) {
        const int b = idx >> 10, k = idx & 1023;
        const float v = (b < 8) ? p.in[I_C][b * 1024 + k] : p.in[I_CCTX][k];
        sv[idx] = siluf(v);
    }
    __syncthreads();
    const int col = c.tid & 63, kq = c.tid >> 6;
    float acc[9];
#pragma unroll
    for (int b = 0; b < 9; ++b) acc[b] = 0.f;
    const float* wp = p.in[I_WMOD] + ((size_t)l * 1024 + kq * 128) * 6144 + cg * 64 + col;
    for (int k = 0; k < 128; k += 8) {
        float w[8];
#pragma unroll
        for (int u = 0; u < 8; ++u) w[u] = wp[(size_t)(k + u) * 6144];
#pragma unroll
        for (int u = 0; u < 8; ++u)
#pragma unroll
            for (int b = 0; b < 9; ++b) acc[b] += sv[b * 1024 + kq * 128 + k + u] * w[u];
    }
#pragma unroll
    for (int b = 0; b < 9; ++b) part[(kq * 9 + b) * 64 + col] = acc[b];
    __syncthreads();
    float* modv = (float*)(p.ws + WS_MOD);
    for (int idx = c.tid; idx < 576; idx += NTHREADS) {
        const int b = idx >> 6, cl = idx & 63;
        float s = 0.f;
#pragma unroll
        for (int q = 0; q < 8; ++q) s += part[(q * 9 + b) * 64 + cl];
        modv[(size_t)(l * 9 + b) * 6144 + cg * 64 + cl] = s + p.in[I_BMOD][l * 6144 + cg * 64 + cl];
    }
    __syncthreads();
}

DI void rope_item(const Ctx& c) {
    float2* tab = (float2*)(c.p->ws + WS_ROPE);
    for (int idx = c.tid; idx < 1024; idx += NTHREADS) {
        const int pos = idx >> 4, i = idx & 15;
        const float inv = 1.0f / powf(10000.0f, (float)i / 16.0f);
        const float ang = (float)pos * inv;
        float sn, cs; sincosf(ang, &sn, &cs);
        tab[idx] = make_float2(cs, sn);
    }
}

constexpr int PRO_PER_LAYER = 12592;
DI TItem transpose_decode(const Ctx& c, int r) {
    const Params& p = *c.p;
    const int l = r / PRO_PER_LAYER; r -= l * PRO_PER_LAYER;
    unsigned char* wgu = (unsigned char*)(p.ws + WS_WGU) + (size_t)l * 257 * 524288;
    unsigned char* wd = (unsigned char*)(p.ws + WS_WD) + (size_t)l * 257 * 262144;
    TItem t; t.f8 = true; t.ws = W_SCALE;
    if (r < 4096) { const int e = r >> 4, s = r & 15; t.W = p.in[I_WG] + (size_t)(l * 256 + e) * 262144; t.K = 1024; t.N = 256; t.kt = s >> 1; t.nt = s & 1; t.dst = wgu + (size_t)e * 524288; t.type = 2; }
    else if (r < 8192) { r -= 4096; const int e = r >> 4, s = r & 15; t.W = p.in[I_WU] + (size_t)(l * 256 + e) * 262144; t.K = 1024; t.N = 256; t.kt = s >> 1; t.nt = s & 1; t.dst = wgu + (size_t)e * 524288; t.type = 3; }
    else if (r < 12288) { r -= 8192; const int e = r >> 4, s = r & 15; t.W = p.in[I_WD] + (size_t)(l * 256 + e) * 262144; t.K = 256; t.N = 1024; t.kt = s >> 3; t.nt = s & 7; t.dst = wd + (size_t)e * 262144; t.type = 0; t.ws = WD_SCALE; }
    else {
        r -= 12288;
        if (r < 176) { t.W = p.in[I_WIN] + (size_t)l * 1024 * 2816; t.K = 1024; t.N = 2816; t.kt = r / 22; t.nt = r % 22; t.dst = (unsigned char*)(p.ws + WS_WIN) + (size_t)l * 2816 * 1024; t.type = 1; }
        else if (r < 240) { r -= 176; t.W = p.in[I_WOUT] + (size_t)l * 1048576; t.K = 1024; t.N = 1024; t.kt = r >> 3; t.nt = r & 7; t.dst = (unsigned char*)(p.ws + WS_WOUT) + (size_t)l * 1048576; t.type = 0; }
        else if (r < 256) { r -= 240; t.W = p.in[I_WR] + (size_t)l * 262144; t.K = 1024; t.N = 256; t.kt = r >> 1; t.nt = r & 1; t.dst = (bf16_t*)(p.ws + WS_WR) + (size_t)l * 262144; t.type = 0; t.f8 = false; }
        else if (r < 272) { r -= 256; t.W = p.in[I_SG] + (size_t)l * 262144; t.K = 1024; t.N = 256; t.kt = r >> 1; t.nt = r & 1; t.dst = wgu + (size_t)256 * 524288; t.type = 2; }
        else if (r < 288) { r -= 272; t.W = p.in[I_SU] + (size_t)l * 262144; t.K = 1024; t.N = 256; t.kt = r >> 1; t.nt = r & 1; t.dst = wgu + (size_t)256 * 524288; t.type = 3; }
        else { r -= 288; t.W = p.in[I_SD] + (size_t)l * 262144; t.K = 256; t.N = 1024; t.kt = r >> 3; t.nt = r & 7; t.dst = wd + (size_t)256 * 262144; t.type = 0; t.ws = WD_SCALE; }
    }
    return t;
}
template <class RMap>
DI void convert_pairs(const Ctx& c, int first, int stride, int n, RMap rmap) {
    if (n <= 0) return;
    const int half = c.tid >> 8;
    float va[4][2][8], vb[4][2][8];
    TItem ia = transpose_decode(c, rmap(first) + half), ib = ia;
    tload(c, va, ia);
    int i = 0;
    for (;;) {
        const bool m1 = i + 1 < n;
        if (m1) { ib = transpose_decode(c, rmap(first + (i + 1) * stride) + half); tload(c, vb, ib); }
        tfinish(c, va, ia);
        if (!m1) break;
        ++i;
        const bool m2 = i + 1 < n;
        if (m2) { ia = transpose_decode(c, rmap(first + (i + 1) * stride) + half); tload(c, va, ia); }
        tfinish(c, vb, ib);
        if (!m2) break;
        ++i;
    }
}
constexpr int PRO_EXPERT = 12288, PRO_SMALL = PRO_PER_LAYER - PRO_EXPERT;
constexpr int CONV_CHUNK = 8, CONV_NCHUNK = 2 * PRO_EXPERT / 2 / CONV_CHUNK;
DI int rmap_small(int q) { const int l = q / (PRO_SMALL / 2), s = q - l * (PRO_SMALL / 2); return l * PRO_PER_LAYER + PRO_EXPERT + 2 * s; }
DI int rmap_expert(int q) { const int l = q / (PRO_EXPERT / 2), s = q - l * (PRO_EXPERT / 2); return l * PRO_PER_LAYER + 2 * s; }
DI void phase_prologue(const Ctx& c) {
    for (int it = c.bid; it < 193; it += c.nblk) { if (it < 192) mod_item(c, it / 96, it % 96); else rope_item(c); }
    __syncthreads();
    constexpr int NP = PRO_SMALL;
    const int n = (NP > c.bid) ? (NP - c.bid + c.nblk - 1) / c.nblk : 0;
    convert_pairs(c, c.bid, c.nblk, n, [](int q) { return rmap_small(q); });
}

template <bool XBF>
DI void norm_mod_row(const float* __restrict__ xrow, const float* __restrict__ g, const float* __restrict__ sh, const float* __restrict__ sc, bf16_t* __restrict__ orow, unsigned char* __restrict__ o8, int lane) {
    float4 v[4]; float s = 0.f;
#pragma unroll
    for (int j = 0; j < 4; ++j) { if constexpr (XBF) { const f32x4 t4 = bf4_f32(((const u32x2*)xrow)[lane + 64 * j]); v[j] = make_float4(t4[0], t4[1], t4[2], t4[3]); } else v[j] = ((const float4*)xrow)[lane + 64 * j]; s += (v[j].x * v[j].x + v[j].y * v[j].y) + (v[j].z * v[j].z + v[j].w * v[j].w); }
    const float rstd = rsqrtf(wave_sum(s) * (1.f / DM) + EPSV);
#pragma unroll
    for (int j = 0; j < 4; ++j) {
        const float4 gg = ((const float4*)g)[lane + 64 * j], shh = ((const float4*)sh)[lane + 64 * j], scc = ((const float4*)sc)[lane + 64 * j];
        const float y0 = v[j].x * rstd * gg.x * (1.f + scc.x) + shh.x, y1 = v[j].y * rstd * gg.y * (1.f + scc.y) + shh.y;
        const float y2 = v[j].z * rstd * gg.z * (1.f + scc.z) + shh.z, y3 = v[j].w * rstd * gg.w * (1.f + scc.w) + shh.w;
        u32x2 o; o.x = pk2(y0, y1); o.y = pk2(y2, y3);
        if (orow) ((u32x2*)orow)[lane + 64 * j] = o;
        if (o8) ((unsigned*)o8)[lane + 64 * j] = pk4_fp8(y0, y1, y2, y3);
    }
}

DI void wrp_items(const Ctx& c) {
    const Params& p = *c.p;
    const float* modv = (const float*)(p.ws + WS_MOD);
    const bf16_t* wr = (const bf16_t*)(p.ws + WS_WR);
    bf16_t* wrp = (bf16_t*)(p.ws + WS_WRP);
    float* cb = (float*)(p.ws + WS_CB);
    const int lane = c.lane;
    for (int idx = c.bid * NWAVES + c.wid; idx < 2 * 9 * 256; idx += c.nblk * NWAVES) {
        const int l = idx / 2304, r = idx - l * 2304, b = r >> 8, e = r & 255;
        const float* g = p.in[I_GFFN] + l * 1024 + 16 * lane;
        const float* mv = modv + (size_t)(l * 9 + b) * 6144 + 3072 + 16 * lane;
        const bf16_t* src = wr + ((size_t)l * 256 + e) * 1024 + 16 * lane;
        const u32x4 w0 = *(const u32x4*)src, w1 = *(const u32x4*)(src + 8);
        float wv[16];
        wv[0] = bflo(w0.x); wv[1] = bfhi(w0.x); wv[2] = bflo(w0.y); wv[3] = bfhi(w0.y); wv[4] = bflo(w0.z); wv[5] = bfhi(w0.z); wv[6] = bflo(w0.w); wv[7] = bfhi(w0.w);
        wv[8] = bflo(w1.x); wv[9] = bfhi(w1.x); wv[10] = bflo(w1.y); wv[11] = bfhi(w1.y); wv[12] = bflo(w1.z); wv[13] = bfhi(w1.z); wv[14] = bflo(w1.w); wv[15] = bfhi(w1.w);
        float s = 0.f, o[16];
#pragma unroll
        for (int j = 0; j < 4; ++j) {
            const f32x4 gg = *(const f32x4*)(g + 4 * j), sh = *(const f32x4*)(mv + 4 * j), sc = *(const f32x4*)(mv + 1024 + 4 * j);
#pragma unroll
            for (int i = 0; i < 4; ++i) { o[4 * j + i] = wv[4 * j + i] * gg[i] * (1.f + sc[i]); s += sh[i] * wv[4 * j + i]; }
        }
        u32x4 o0, o1;
        o0.x = pk2(o[0], o[1]); o0.y = pk2(o[2], o[3]); o0.z = pk2(o[4], o[5]); o0.w = pk2(o[6], o[7]);
        o1.x = pk2(o[8], o[9]); o1.y = pk2(o[10], o[11]); o1.z = pk2(o[12], o[13]); o1.w = pk2(o[14], o[15]);
        bf16_t* dst = wrp + ((size_t)(l * 9 + b) * 256 + e) * 1024 + 16 * lane;
        *(u32x4*)dst = o0; *(u32x4*)(dst + 8) = o1;
        s = wave_sum(s);
        if (lane == 0) cb[(l * 9 + b) * 256 + e] = s;
    }
}
DI void norm_ffn_row(const bf16_t* __restrict__ xrow, const float* __restrict__ g, const float* __restrict__ sh, const float* __restrict__ sc, unsigned char* __restrict__ o8, float* __restrict__ rstd_out, int lane) {
    f32x4 v[4]; float s = 0.f;
#pragma unroll
    for (int j = 0; j < 4; ++j) { v[j] = bf4_f32(((const u32x2*)xrow)[lane + 64 * j]); s += (v[j][0] * v[j][0] + v[j][1] * v[j][1]) + (v[j][2] * v[j][2] + v[j][3] * v[j][3]); }
    const float rstd = rsqrtf(wave_sum(s) * (1.f / DM) + EPSV);
#pragma unroll
    for (int j = 0; j < 4; ++j) {
        const f32x4 gg = ((const f32x4*)g)[lane + 64 * j], shh = ((const f32x4*)sh)[lane + 64 * j], scc = ((const f32x4*)sc)[lane + 64 * j];
        const f32x4 y = v[j] * rstd * gg * (1.f + scc) + shh;
        ((unsigned*)o8)[lane + 64 * j] = pk4_fp8(y[0], y[1], y[2], y[3]);
    }
    if (lane == 0) *rstd_out = rstd;
}

DI void phase_norm(const Ctx& c, int l, int nrows, bool from_inputs, int which) {
    const Params& p = *c.p;
    const float* modv = (const float*)(p.ws + WS_MOD);
    const float* g = p.in[which ? I_GFFN : I_GMIX] + l * 1024;
    bf16_t* hbuf = (bf16_t*)(p.ws + WS_HBUF);
    const float* xbuf = (const float*)(p.ws + WS_XBUF);
    for (int t = c.bid * NWAVES + c.wid; t < nrows; t += c.nblk * NWAVES) {
        const float* xrow = from_inputs ? (t < TL ? p.in[I_X] + (size_t)t * DM : p.in[I_CTX] + (size_t)(t - TL) * DM) : (const float*)((const bf16_t*)xbuf + (size_t)t * DM);
        const int b = t < TL ? (t >> 12) : 8;
        const float* mv = modv + (size_t)(l * 9 + b) * 6144 + (which ? 3072 : 0);
        if (from_inputs) norm_mod_row<false>(xrow, g, mv, mv + 1024, (bf16_t*)nullptr,        (unsigned char*)(p.ws + (which ? WS_H8 : WS_HIN8)) + (size_t)t * DM, c.lane);
        else norm_mod_row<true>(xrow, g, mv, mv + 1024, hbuf + (size_t)t * DM, (unsigned char*)(p.ws + (which ? WS_H8 : WS_HIN8)) + (size_t)t * DM, c.lane);
    }
}

namespace g8 {
constexpr int BM = 256, BK = 64, HALF = 128, HTB = HALF * BK * 2;
DI int lds_byte(int r, int c) { const int st = (r >> 4) * 2 + (c >> 5), rr = r & 15, cc = c & 31, ob = rr * 64 + cc * 2; return st * 1024 + (ob ^ (((ob >> 9) & 1) << 5)); }
DI void stage_rc(int b, int& R, int& C) { const int st = b / 1024, sb = b % 1024, swz = sb ^ (((sb >> 9) & 1) << 5); R = (st >> 1) * 16 + swz / 64; C = (st & 1) * 32 + (swz % 64) / 2; }
DI int perm32(int rho) { const int n = rho >> 4, i = rho & 15; return 8 * (i >> 2) + 4 * n + (i & 3); }
struct Unit { int pm, pn, e, ti, ne, rbase, ix; };

typedef __attribute__((ext_vector_type(8))) int v8i_t;
typedef __attribute__((ext_vector_type(4))) int v4i_t;
template <class Epi, class Sched>
DI void gemm_phase(LAS unsigned char* lds, const int tid, const int RB, const Sched& S, const Epi& E) {
    constexpr bool F8 = Epi::F8;
    const int wid = __builtin_amdgcn_readfirstlane(tid >> 6), lane = tid & 63, wr = wid >> 2, wc = wid & 3, fr = lane & 15, fq = lane >> 4;
    const int nt = RB / 128;
    int Rr[2], Cc[2]; unsigned voffB[2], voffA[2];
#pragma unroll
    for (int i = 0; i < 2; ++i) { int R, C; stage_rc(tid * 16 + i * 8192, R, C); Rr[i] = R; Cc[i] = C * 2; const int Rb = Epi::PERM ? ((R & ~31) + perm32(R & 31)) : R; voffB[i] = (unsigned)(Rb * RB + C * 2); voffA[i] = (unsigned)(R * RB + C * 2); }
    constexpr bool GA = Sched::GATHER;
    int unit_scale = 0x7F7F7F7F; asm volatile("" : "+v"(unit_scale));
    const size_t kstep = (size_t)(BK * 2);
    const size_t hstep = (size_t)HALF * RB;
    const unsigned ldsw = (unsigned)wid * 1024u;
    const int aoff = F8 ? lds_byte(wr * 64 + fr, (fq >> 1) * 32 + (fq & 1) * 16) : lds_byte(wr * 64 + fr, fq * 8);
    const int boff = F8 ? lds_byte(wc * 32 + fr, (fq >> 1) * 32 + (fq & 1) * 16) : lds_byte(wc * 32 + fr, fq * 8);
#define G8_SA(b, h) (((b) * 2 + (h)) * HTB)
#define G8_SB(b, h) ((4 + (b) * 2 + (h)) * HTB)
#define G8_STAGE_B(bufoff, gbase) do { _Pragma("unroll") for (int _i = 0; _i < 2; ++_i) \
        __builtin_amdgcn_global_load_lds((const unsigned*)((const char*)(gbase) + voffB[_i]), (LAS unsigned*)(lds + (bufoff) + ldsw + _i * 8192), 16, 0, 0); } while (0)
#define G8_STAGE_A(bufoff, uptr, koff, VO, h) do { _Pragma("unroll") for (int _i = 0; _i < 2; ++_i) { \
        const char* _s = GA ? (Ab + (koff) + VO[h][_i]) : ((uptr) + (koff) + ((h) ? hstep : (size_t)0) + voffA[_i]); \
        __builtin_amdgcn_global_load_lds((const unsigned*)_s, (LAS unsigned*)(lds + (bufoff) + ldsw + _i * 8192), 16, 0, 0); } } while (0)
#define G8_LDA(dst, b, h) do { _Pragma("unroll") for (int m = 0; m < 4; ++m) { \
        if constexpr (F8) { dst##8[m].lo = *(const LAS v4i_t*)(lds + G8_SA(b, h) + aoff + m * 2048); dst##8[m].hi = *(const LAS v4i_t*)(lds + G8_SA(b, h) + aoff + m * 2048 + 16); } \
        else { _Pragma("unroll") for (int k = 0; k < 2; ++k) dst[m][k] = *(const LAS bf16x8*)(lds + G8_SA(b, h) + aoff + m * 2048 + k * 1024); } } } while (0)
#define G8_LDB(dst, b, h) do { _Pragma("unroll") for (int n = 0; n < 2; ++n) { \
        if constexpr (F8) { dst##8[n].lo = *(const LAS v4i_t*)(lds + G8_SB(b, h) + boff + n * 2048); dst##8[n].hi = *(const LAS v4i_t*)(lds + G8_SB(b, h) + boff + n * 2048 + 16); } \
        else { _Pragma("unroll") for (int k = 0; k < 2; ++k) dst[n][k] = *(const LAS bf16x8*)(lds + G8_SB(b, h) + boff + n * 2048 + k * 1024); } } } while (0)
#define G8_MMA(ai, bj, At, Bt) do { __builtin_amdgcn_s_setprio(1); _Pragma("unroll") for (int m = 0; m < 4; ++m) _Pragma("unroll") for (int n = 0; n < 2; ++n) { \
        if constexpr (F8) asm volatile("v_mfma_scale_f32_16x16x128_f8f6f4 %0, %1, %2, %0, %3, %3 op_sel_hi:[0,0,0]" : "+v"(acc[ai][bj][m][n]) : "v"(Bt##8[n]), "v"(At##8[m]), "v"(unit_scale)); \
        else { _Pragma("unroll") for (int k = 0; k < 2; ++k) acc[ai][bj][m][n] = __builtin_amdgcn_mfma_f32_16x16x32_bf16(Bt[n][k], At[m][k], acc[ai][bj][m][n], 0, 0, 0); } } \
        __builtin_amdgcn_s_setprio(0); } while (0)
#define G8_WAIT_V(n) asm volatile("s_waitcnt vmcnt(" #n ")" ::: "memory")
#define G8_WAIT_L(n) asm volatile("s_waitcnt lgkmcnt(" #n ")" ::: "memory")
#define G8_BAR __builtin_amdgcn_s_barrier()
#define G8_SCHED __builtin_amdgcn_sched_barrier(0)
    Unit cur, nxt; int ui = 0;
    if (!S.next(0, cur)) return;
    f32x4 acc[2][2][4][2];
#pragma unroll
    for (int a = 0; a < 2; ++a)
#pragma unroll
        for (int b = 0; b < 2; ++b)
#pragma unroll
            for (int m = 0; m < 4; ++m)
#pragma unroll
                for (int n = 0; n < 2; ++n) acc[a][b][m][n] = (f32x4){0.f, 0.f, 0.f, 0.f};
    if constexpr (F8) asm volatile("s_nop 3" ::: "memory");
    bf16x8 At[F8 ? 1 : 4][2], B0[F8 ? 1 : 2][2], B1[F8 ? 1 : 2][2];
    v8i_t At8[F8 ? 4 : 1], B08[F8 ? 2 : 1], B18[F8 ? 2 : 1];
    unsigned vAc[2][2], vAn[2][2];
#pragma unroll
    for (int h = 0; h < 2; ++h)
#pragma unroll
        for (int i = 0; i < 2; ++i) vAc[h][i] = GA ? (S.a_off(cur, h * 128 + Rr[i]) + (unsigned)Cc[i]) : 0u;
    const char* Ab = S.a_base();
    const char* cA = GA ? Ab : S.a_ptr(cur);
    const char* cB = S.b_base(cur);
    G8_STAGE_B(G8_SB(0, 0), cB); G8_STAGE_A(G8_SA(0, 0), cA, 0, vAc, 0); G8_STAGE_B(G8_SB(0, 1), cB + hstep); G8_STAGE_A(G8_SA(0, 1), cA, 0, vAc, 1);
    if (wr == 1) G8_BAR;
    G8_WAIT_V(4); G8_BAR;
    G8_STAGE_B(G8_SB(1, 0), cB + kstep); G8_STAGE_A(G8_SA(1, 0), cA, kstep, vAc, 0); G8_STAGE_B(G8_SB(1, 1), cB + hstep + kstep);
    G8_WAIT_V(6); G8_BAR;
    for (;;) {
        const bool has_next = S.next(ui + 1, nxt);
        const char* nB = has_next ? S.b_base(nxt) : cB;
        const char* nA = GA ? Ab : (has_next ? S.a_ptr(nxt) : cA);
#pragma unroll
        for (int h = 0; h < 2; ++h)
#pragma unroll
            for (int i = 0; i < 2; ++i) vAn[h][i] = GA ? (has_next ? (S.a_off(nxt, h * 128 + Rr[i]) + (unsigned)Cc[i]) : vAc[h][i]) : 0u;
#pragma unroll 1
        for (int t = 0; t < nt; t += 2) {
            const bool last = (t == nt - 2);
            const size_t ka1 = (size_t)(t + 1) * kstep;
            const size_t ka2 = last ? (size_t)0 : (size_t)(t + 2) * kstep;
            const size_t ka3 = ka2 + kstep;
            const char* b2 = last ? nB : cB + (size_t)(t + 2) * kstep;
            const char* b3 = b2 + kstep;
            unsigned v2[2][2];
#pragma unroll
            for (int h = 0; h < 2; ++h)
#pragma unroll
                for (int i = 0; i < 2; ++i) v2[h][i] = GA ? (last ? vAn[h][i] : vAc[h][i]) : 0u;
            const char* a2p = last ? nA : cA;
            G8_LDB(B0, 0, 0); G8_SCHED; G8_LDA(At, 0, 0); G8_STAGE_A(G8_SA(1, 1), cA, ka1, vAc, 1);
            G8_WAIT_L(8); G8_BAR; G8_WAIT_L(0); G8_MMA(0, 0, At, B0); G8_BAR; G8_SCHED;
            G8_LDB(B1, 0, 1); G8_STAGE_B(G8_SB(0, 0), b2);
            G8_BAR; G8_WAIT_L(0); G8_MMA(0, 1, At, B1); G8_BAR;
            G8_LDA(At, 0, 1); G8_STAGE_A(G8_SA(0, 0), a2p, ka2, v2, 0);
            G8_BAR; G8_WAIT_L(0); G8_MMA(1, 0, At, B0); G8_BAR; G8_SCHED;
            G8_STAGE_B(G8_SB(0, 1), b2 + hstep);
            G8_WAIT_V(6); G8_BAR; G8_MMA(1, 1, At, B1); G8_BAR;
            G8_LDB(B0, 1, 0); G8_SCHED; G8_LDA(At, 1, 0); G8_STAGE_A(G8_SA(0, 1), a2p, ka2, v2, 1);
            G8_WAIT_L(8); G8_BAR; G8_WAIT_L(0); G8_MMA(0, 0, At, B0); G8_BAR; G8_SCHED;
            G8_LDB(B1, 1, 1); G8_STAGE_B(G8_SB(1, 0), b3);
            G8_BAR; G8_WAIT_L(0); G8_MMA(0, 1, At, B1); G8_BAR;
            G8_LDA(At, 1, 1); G8_STAGE_A(G8_SA(1, 0), a2p, ka3, v2, 0);
            G8_BAR; G8_WAIT_L(0); G8_MMA(1, 0, At, B0); G8_BAR; G8_SCHED;
            G8_STAGE_B(G8_SB(1, 1), b3 + hstep);
            G8_WAIT_V(6); G8_BAR; G8_MMA(1, 1, At, B1); G8_BAR;
        }
        if constexpr (F8) asm volatile("s_nop 15\n\ts_nop 15" ::: "memory");
        E(acc, cur, wr, wc, fr, fq);
        if (!has_next) break;
#pragma unroll
        for (int a = 0; a < 2; ++a)
#pragma unroll
            for (int b = 0; b < 2; ++b)
#pragma unroll
                for (int m = 0; m < 4; ++m)
#pragma unroll
                    for (int n = 0; n < 2; ++n) acc[a][b][m][n] = (f32x4){0.f, 0.f, 0.f, 0.f};
        if constexpr (F8) asm volatile("s_nop 3" ::: "memory");
        cur = nxt; cB = nB; cA = nA; ++ui;
#pragma unroll
        for (int h = 0; h < 2; ++h)
#pragma unroll
            for (int i = 0; i < 2; ++i) vAc[h][i] = vAn[h][i];
    }
    G8_WAIT_V(0);
    if (wr == 0) G8_BAR;
    G8_BAR;
#undef G8_SA
#undef G8_SB
#undef G8_STAGE_A
#undef G8_STAGE_B
#undef G8_LDA
#undef G8_LDB
#undef G8_MMA
#undef G8_WAIT_V
#undef G8_WAIT_L
#undef G8_BAR
#undef G8_SCHED
}

struct DenseSched {
    static constexpr bool GATHER = false;
    int nM, nN, nwg, G, c, RB; const char* A; const char* Bt;
    DI void init(const void* A_, const void* Bt_, int M, int N, int RB_, int G_, int c_) { A = (const char*)A_; Bt = (const char*)Bt_; nM = M / BM; nN = N / BM; nwg = nM * nN; G = G_; c = c_; RB = RB_; }
    DI bool next(int i, Unit& u) const {
        const int L = i * G + c; if (L >= nwg) return false;
        int wgid = L; { const int q = nwg / 8, r = nwg % 8, xcd = wgid % 8, off = wgid / 8; wgid = (xcd < r ? xcd * (q + 1) : r * (q + 1) + (xcd - r) * q) + off; }
        const int nig = 8 * nN, gid = wgid / nig, fm = gid * 8, gsz = (nM - fm) < 8 ? (nM - fm) : 8;
        u.pm = fm + ((wgid % nig) % gsz); u.pn = (wgid % nig) / gsz; u.e = 0; u.ti = 0; u.ne = 0; u.rbase = 0; u.ix = 0; return true;
    }
    DI const char* a_base() const { return A; }
    DI unsigned a_off(const Unit&, int) const { return 0u; }
    DI const char* a_ptr(const Unit& u) const { return A + (size_t)u.pm * BM * RB; }
    DI const char* b_base(const Unit& u) const { return Bt + (size_t)u.pn * BM * RB; }
};
}
struct EpiInproj {
    static constexpr bool F8 = true;
    static constexpr bool PERM = true;
    const LAS float2* rope;
    unsigned char* q8; unsigned char* k8; unsigned char* vt8;
    LAS unsigned char* stg; int tid;
    static DI bool isv_cb(int cb) { const int kv = cb - 16; return (cb >= 16) && ((kv == 2) || (kv == 3) || (kv >= 8 && kv < 12) || (kv >= 20)); }
    DI void operator()(const f32x4 (&acc)[2][2][4][2], const g8::Unit& u, int wr, int wc, int fr, int fq) const {
        const bool lat = (u.pm * 256 < TL);
#pragma unroll
        for (int bj = 0; bj < 2; ++bj) {
            const int col0 = u.pn * 256 + bj * 128 + wc * 32 + 8 * fq;
            const int cb = col0 >> 6, kv = cb - 16;
            if (!isv_cb(cb)) continue;
            const float scale = 1.0f / W_SCALE;
            const int vrow0 = (kv < 4 ? (kv - 2) * 64 : (kv < 12 ? 128 + (kv - 8) * 64 : 384 + (kv - 20) * 64)) + (col0 & 63);
            const int pos = 32 * ((fr >> 2) & 1) + 4 * (((fr >> 3) << 2) | (fr & 3));
#pragma unroll
            for (int ai = 0; ai < 2; ++ai) {
                const int t0 = u.pm * 256 + ai * 128 + wr * 64;
                const int b = t0 < TL ? (t0 >> 12) : ((t0 - TL) >> 8);
                const int tile = t0 < TL ? ((t0 & 4095) >> 6) : (64 + (((t0 - TL) & 255) >> 6));
                unsigned char* base = vt8 + (size_t)(b * 68 + tile) * VT_TILE + (size_t)vrow0 * 64 + pos;
#pragma unroll
                for (int n = 0; n < 2; ++n)
#pragma unroll
                    for (int j = 0; j < 4; ++j)
                        *(unsigned*)(base + (4 * n + j) * 64) = pk4_fp8(acc[ai][bj][0][n][j] * scale, acc[ai][bj][1][n][j] * scale, acc[ai][bj][2][n][j] * scale, acc[ai][bj][3][n][j] * scale);
            }
        }
        if (!((u.pn < 6) || (u.pn == 7) || (u.pn == 8))) return;
        constexpr int RS = 272;
        if (wr == 0) __builtin_amdgcn_s_barrier();
#pragma unroll
        for (int ai = 0; ai < 2; ++ai)
#pragma unroll
            for (int mh = 0; mh < 2; ++mh) {
#pragma unroll
                for (int bj = 0; bj < 2; ++bj) {
                    const int col0 = u.pn * 256 + bj * 128 + wc * 32 + 8 * fq;
                    const int cb = col0 >> 6, i0 = (col0 & 63) >> 1;
                    if (isv_cb(cb)) continue;
                    const bool isq = cb < 16;
                    const bool roped = ((cb < 4) || (cb >= 8 && cb < 16) || (cb == 16) || (cb == 17) || (cb >= 28 && cb < 36)) && lat;
                    const float scale = (isq ? QSCALE : 1.0f) * (1.0f / W_SCALE);
#pragma unroll
                    for (int mm = 0; mm < 2; ++mm) {
                        const int m = mh * 2 + mm;
                        const int t = u.pm * 256 + ai * 128 + wr * 64 + m * 16 + fr;
                        f32x4 v0 = acc[ai][bj][m][0], v1 = acc[ai][bj][m][1];
                        if (roped) {
                            const int s = t & 4095;
                            const int pos = (i0 < 16) ? (s >> 6) : (s & 63);
                            const f32x4 ca = *(const LAS f32x4*)(rope + pos * 16 + (i0 & 15)), cb2 = *(const LAS f32x4*)(rope + pos * 16 + (i0 & 15) + 2);
                            f32x4 o0, o1;
                            o0[0] = v0[0] * ca[0] - v0[1] * ca[1]; o0[1] = v0[1] * ca[0] + v0[0] * ca[1];
                            o0[2] = v0[2] * ca[2] - v0[3] * ca[3]; o0[3] = v0[3] * ca[2] + v0[2] * ca[3];
                            o1[0] = v1[0] * cb2[0] - v1[1] * cb2[1]; o1[1] = v1[1] * cb2[0] + v1[0] * cb2[1];
                            o1[2] = v1[2] * cb2[2] - v1[3] * cb2[3]; o1[3] = v1[3] * cb2[2] + v1[2] * cb2[3];
                            v0 = o0; v1 = o1;
                        }
                        v0 *= scale; v1 *= scale;
                        u32x2 w; w.x = pk4_fp8(v0[0], v0[1], v0[2], v0[3]); w.y = pk4_fp8(v1[0], v1[1], v1[2], v1[3]);
                        *(LAS u32x2*)(stg + (wr * 32 + mm * 16 + fr) * RS + bj * 128 + wc * 32 + 8 * fq) = w;
                    }
                }
                asm volatile("s_waitcnt lgkmcnt(0)" ::: "memory"); __builtin_amdgcn_s_barrier(); asm volatile("" ::: "memory");
#pragma unroll
                for (int k = 0; k < 2; ++k) {
                    const int idx = tid + k * 512, rl = idx >> 4, pc = idx & 15;
                    const int cb = u.pn * 4 + (pc >> 2);
                    if (!isv_cb(cb)) {
                        const u32x4 v = *(const LAS u32x4*)(stg + rl * RS + pc * 16);
                        const int t = u.pm * 256 + ai * 128 + (rl >> 5) * 64 + mh * 32 + (rl & 31);
                        const int kv = cb - 16, ki = kv < 2 ? kv : (kv < 8 ? kv - 2 : kv - 6);
                        unsigned char* dst = (cb < 16) ? q8 + (size_t)t * 1024 + cb * 64 + (pc & 3) * 16 : k8 + (size_t)t * 1024 + ki * 64 + (pc & 3) * 16;
                        *(u32x4*)dst = v;
                    }
                }
                asm volatile("s_waitcnt lgkmcnt(0)" ::: "memory"); __builtin_amdgcn_s_barrier(); asm volatile("" ::: "memory");
            }
        if (wr == 1) __builtin_amdgcn_s_barrier();
    }
};
DI void phase_inproj(const Ctx& c, int l) {
    const Params& p = *c.p;
    g8::DenseSched S; S.init(p.ws + WS_HIN8, (const unsigned char*)(p.ws + WS_WIN) + (size_t)l * 2816 * 1024, TT, INC, DM, c.nblk, c.bid);
    {
        const float* rg = (const float*)(p.ws + WS_ROPE);
        LAS float* rl = (LAS float*)(c.smem + LDS_MAIN + 256);
        for (int i = c.tid; i < 2048; i += NTHREADS) rl[i] = rg[i];
        __syncthreads();
    }
    EpiInproj E; E.rope = (const LAS float2*)(c.smem + LDS_MAIN + 256); E.stg = (LAS unsigned char*)c.smem + LDS_MAIN + 256 + 8192; E.tid = c.tid;
    E.q8 = (unsigned char*)(p.ws + WS_Q8); E.k8 = (unsigned char*)(p.ws + WS_K8); E.vt8 = (unsigned char*)(p.ws + WS_VT8);
    g8::gemm_phase((LAS unsigned char*)c.smem, c.tid, DM, S, E);
}

struct EpiOutproj {
    static constexpr bool F8 = true;
    static constexpr bool PERM = false;
    float* xbuf; const float* modv; const float* x_in; const float* ctx_in; int l;
    LAS unsigned char* stg; int tid;
    DI void operator()(const f32x4 (&acc)[2][2][4][2], const g8::Unit& u, int wr, int wc, int fr, int fq) const {
        const int b = (u.pm * 256) < TL ? ((u.pm * 256) >> 12) : 8;
        const int col0 = u.pn * 256 + wc * 32 + 4 * fq;
        const float* gate = modv + (size_t)(l * 9 + b) * 6144 + 2048 + col0;
        f32x4 g[2][2];
#pragma unroll
        for (int bj = 0; bj < 2; ++bj)
#pragma unroll
            for (int n = 0; n < 2; ++n) g[bj][n] = *(const f32x4*)(gate + bj * 128 + n * 16) * (1.0f / (MIX_SCALE * W_SCALE));
        constexpr int RS = 528;
        if (wr == 0) __builtin_amdgcn_s_barrier();
#pragma unroll
        for (int ai = 0; ai < 2; ++ai)
#pragma unroll
            for (int m = 0; m < 4; ++m) {
                LAS unsigned char* d = stg + (wr * 16 + fr) * RS + (wc * 32 + 4 * fq) * 2;
#pragma unroll
                for (int bj = 0; bj < 2; ++bj)
#pragma unroll
                    for (int n = 0; n < 2; ++n) *(LAS u32x2*)(d + (bj * 128 + n * 16) * 2) = f32_bf4(g[bj][n] * acc[ai][bj][m][n]);
                asm volatile("s_waitcnt lgkmcnt(0)" ::: "memory"); __builtin_amdgcn_s_barrier(); asm volatile("" ::: "memory");
                {
                    const int rl = tid >> 4, pc = tid & 15;
                    const u32x4 s0 = *(const LAS u32x4*)(stg + rl * RS + pc * 32), s1 = *(const LAS u32x4*)(stg + rl * RS + pc * 32 + 16);
                    const int t = u.pm * 256 + ai * 128 + (rl >> 4) * 64 + m * 16 + (rl & 15);
                    bf16_t* xo = (bf16_t*)xbuf + (size_t)t * DM + u.pn * 256 + pc * 16;
                    f32x4 x[4];
                    if (l == 0) {
                        const float* xin = (t < TL ? x_in + (size_t)t * DM : ctx_in + (size_t)(t - TL) * DM) + u.pn * 256 + pc * 16;
#pragma unroll
                        for (int k = 0; k < 4; ++k) x[k] = *(const f32x4*)(xin + 4 * k);
                    } else {
                        const u32x4 a0 = *(const u32x4*)xo, a1 = *(const u32x4*)(xo + 8);
                        x[0] = bf4_f32(u32x2{a0.x, a0.y}); x[1] = bf4_f32(u32x2{a0.z, a0.w}); x[2] = bf4_f32(u32x2{a1.x, a1.y}); x[3] = bf4_f32(u32x2{a1.z, a1.w});
                    }
                    x[0] += bf4_f32(u32x2{s0.x, s0.y}); x[1] += bf4_f32(u32x2{s0.z, s0.w}); x[2] += bf4_f32(u32x2{s1.x, s1.y}); x[3] += bf4_f32(u32x2{s1.z, s1.w});
                    const u32x2 o0 = f32_bf4(x[0]), o1 = f32_bf4(x[1]), o2 = f32_bf4(x[2]), o3 = f32_bf4(x[3]);
                    *(u32x4*)xo = u32x4{o0.x, o0.y, o1.x, o1.y};
                    *(u32x4*)(xo + 8) = u32x4{o2.x, o2.y, o3.x, o3.y};
                }
                asm volatile("s_waitcnt lgkmcnt(0)" ::: "memory"); __builtin_amdgcn_s_barrier(); asm volatile("" ::: "memory");
            }
        if (wr == 1) __builtin_amdgcn_s_barrier();
    }
};
DI void phase_outproj(const Ctx& c, int l, int nrows) {
    const Params& p = *c.p;
    g8::DenseSched S; S.init(p.ws + WS_MIX, (const unsigned char*)(p.ws + WS_WOUT) + (size_t)l * 1048576, nrows, DM, DM, c.nblk, c.bid);
    EpiOutproj E; E.xbuf = (float*)(p.ws + WS_XBUF); E.modv = (const float*)(p.ws + WS_MOD); E.x_in = p.in[I_X]; E.ctx_in = p.in[I_CTX]; E.l = l; E.stg = (LAS unsigned char*)c.smem + LDS_STG; E.tid = c.tid;
    g8::gemm_phase((LAS unsigned char*)c.smem, c.tid, DM, S, E);
}

struct EpiRouter {
    static constexpr bool F8 = false;
    static constexpr bool PERM = false;
    float* logit;
    DI void operator()(const f32x4 (&acc)[2][2][4][2], const g8::Unit& u, int wr, int wc, int fr, int fq) const {
#pragma unroll
        for (int ai = 0; ai < 2; ++ai)
#pragma unroll
            for (int m = 0; m < 4; ++m) {
                const int t = u.pm * 256 + ai * 128 + wr * 64 + m * 16 + fr;
#pragma unroll
                for (int bj = 0; bj < 2; ++bj)
#pragma unroll
                    for (int n = 0; n < 2; ++n) *(f32x4*)(logit + (size_t)t * NE + bj * 128 + wc * 32 + n * 16 + 4 * fq) = acc[ai][bj][m][n];
            }
    }
};
DI void phase_router(const Ctx& c, int l, int nrows) {
    const Params& p = *c.p;
    g8::DenseSched S; S.init(p.ws + WS_HBUF, (const bf16_t*)(p.ws + WS_WR) + (size_t)l * 262144, nrows, NE, DM * 2, c.nblk, c.bid);
    EpiRouter E; E.logit = (float*)(p.ws + WS_LOGIT);
    g8::gemm_phase((LAS unsigned char*)c.smem, c.tid, DM * 2, S, E);
}

struct RouterSched : g8::DenseSched {
    DI const char* b_base(const g8::Unit& u) const { const int b = (u.pm * 256) < TL ? ((u.pm * 256) >> 12) : 8; return Bt + (size_t)b * 524288 + (size_t)u.pn * 256 * RB; }
};
DI void phase_norm_router(const Ctx& c, int l, int nrows) {
    const Params& p = *c.p;
    {
        RouterSched S; S.init(p.ws + WS_XBUF, (const bf16_t*)(p.ws + WS_WRP) + (size_t)l * 9 * 262144, nrows, NE, DM * 2, c.nblk, c.bid);
        EpiRouter E; E.logit = (float*)(p.ws + WS_LOGIT);
        g8::gemm_phase((LAS unsigned char*)c.smem, c.tid, DM * 2, S, E);
    }
    int* ctr = (int*)(p.ws + WS_ROWCTR) + l * 64;
    LAS int* slot = (LAS int*)(c.smem + LDS_MAIN + 64);
    const float* modv = (const float*)(p.ws + WS_MOD);
    const float* g = p.in[I_GFFN] + l * 1024;
    const bf16_t* xbuf = (const bf16_t*)(p.ws + WS_XBUF);
    unsigned char* h8 = (unsigned char*)(p.ws + WS_H8);
    float* rstd = (float*)(p.ws + WS_RSTD);
    for (;;) {
        if (c.tid == 0) slot[0] = atomicAdd(ctr, 64);
        __syncthreads();
        const int base = slot[0];
        __syncthreads();
        if (base >= nrows) break;
#pragma unroll 1
        for (int i = 0; i < 8; ++i) {
            const int t = base + c.wid * 8 + i;
            if (t < nrows) {
                const int b = t < TL ? (t >> 12) : 8;
                const float* mv = modv + (size_t)(l * 9 + b) * 6144 + 3072;
                norm_ffn_row(xbuf + (size_t)t * DM, g, mv, mv + 1024, h8 + (size_t)t * DM, rstd + t, c.lane);
            }
        }
    }
}

DI void phase_route(const Ctx& c, int l, int nrows) {
    const Params& p = *c.p;
    const float* logit = (const float*)(p.ws + WS_LOGIT);
    const float* rb = p.in[I_RB] + l * NE;
    int* cnt = (int*)(p.ws + WS_CNT) + l * CNT_LAYER;
    int* list = (int*)(p.ws + WS_LIST);
    float* slotw = (float*)(p.ws + WS_SLOTW);
    int* einfo = (int*)(p.ws + WS_EINFO);
    LAS int* lcnt = (LAS int*)c.smem;
    LAS int* rec = (LAS int*)(c.smem + 1024);
    LAS float* recw = (LAS float*)(c.smem + 1024 + 8 * 24 * 8 * 4);
    constexpr int RMAX = 24;
    const int lane = c.lane;
    if (c.tid < 256) lcnt[c.tid] = 0;
    __syncthreads();
    const f32x4 bias = ((const f32x4*)rb)[lane];
    const float NINF = -__builtin_inff();
    int it = 0;
    const float* rstd = (const float*)(p.ws + WS_RSTD);
    const float* cbl = (const float*)(p.ws + WS_CB) + l * 9 * 256;
    for (int t = c.bid * NWAVES + c.wid; t < nrows; t += c.nblk * NWAVES, ++it) {
        const int bb = t < TL ? (t >> 12) : 8;
        const f32x4 lg = ((const f32x4*)(logit + (size_t)t * NE))[lane] * rstd[t] + ((const f32x4*)(cbl + bb * 256))[lane];
        const float s0 = 1.f / (1.f + __expf(-lg.x)), s1 = 1.f / (1.f + __expf(-lg.y)), s2 = 1.f / (1.f + __expf(-lg.z)), s3 = 1.f / (1.f + __expf(-lg.w));
        float m0 = s0 + bias.x, m1 = s1 + bias.y, m2 = s2 + bias.z, m3 = s3 + bias.w;
        float a1 = fmaxf(m0, m1), a2 = fminf(m0, m1);
        { const float b1 = fmaxf(m2, m3), b2 = fminf(m2, m3); const float n1 = fmaxf(a1, b1), n2 = fmaxf(fminf(a1, b1), fmaxf(a2, b2)); a1 = n1; a2 = n2; }
        { const float b1 = DPPF(a1, DPP_XOR1), b2 = DPPF(a2, DPP_XOR1); const float n1 = fmaxf(a1, b1), n2 = fmaxf(fminf(a1, b1), fmaxf(a2, b2)); a1 = n1; a2 = n2; }
        { const float b1 = DPPF(a1, DPP_XOR2), b2 = DPPF(a2, DPP_XOR2); const float n1 = fmaxf(a1, b1), n2 = fmaxf(fminf(a1, b1), fmaxf(a2, b2)); a1 = n1; a2 = n2; }
        { const float b1 = DPPF(a1, DPP_HMIR), b2 = DPPF(a2, DPP_HMIR); const float n1 = fmaxf(a1, b1), n2 = fmaxf(fminf(a1, b1), fmaxf(a2, b2)); a1 = n1; a2 = n2; }
        const float gs = a1 + a2;
        const int g = lane >> 3;
        int rank = 0;
#pragma unroll
        for (int j = 0; j < 8; ++j) { const float gj = rdlane_f(gs, j * 8); rank += ((gj > gs) || (gj == gs && j < g)) ? 1 : 0; }
        if (rank >= 4) { m0 = NINF; m1 = NINF; m2 = NINF; m3 = NINF; }
        float wsum = 0.f, my_w = 0.f; int my_e = 0;
#pragma unroll
        for (int k = 0; k < 8; ++k) {
            float bv = m0, bs = s0; int bi = 0;
            if (m1 > bv) { bv = m1; bs = s1; bi = 1; }
            if (m2 > bv) { bv = m2; bs = s2; bi = 2; }
            if (m3 > bv) { bv = m3; bs = s3; bi = 3; }
            float v = bv;
            v = fmaxf(v, DPPF(v, DPP_XOR1)); v = fmaxf(v, DPPF(v, DPP_XOR2)); v = fmaxf(v, DPPF(v, DPP_HMIR)); v = fmaxf(v, DPPF(v, DPP_MIR));
            const float wmx = fmaxf(fmaxf(rdlane_f(v, 0), rdlane_f(v, 16)), fmaxf(rdlane_f(v, 32), rdlane_f(v, 48)));
            const unsigned long long bal = __ballot(bv == wmx);
            const int win = __ffsll((long long)bal) - 1;
            const int sub = __builtin_amdgcn_readlane(bi, win);
            const float sw = rdlane_f(bs, win);
            if (lane == win) { if (sub == 0) m0 = NINF; else if (sub == 1) m1 = NINF; else if (sub == 2) m2 = NINF; else m3 = NINF; }
            wsum += sw;
            if (lane == k) { my_e = win * 4 + sub; my_w = sw; }
        }
        if (lane < 8 && it < RMAX) {
            const int lp = __hip_atomic_fetch_add(&lcnt[my_e], 1, __ATOMIC_RELAXED, __HIP_MEMORY_SCOPE_WORKGROUP);
            rec[(c.wid * RMAX + it) * 8 + lane] = (my_e << 16) | lp;
            recw[(c.wid * RMAX + it) * 8 + lane] = my_w / wsum * 2.5f;
        }
    }
    __syncthreads();
    if (c.tid < 256) { const int n = lcnt[c.tid]; lcnt[c.tid] = (n > 0) ? atomicAdd(&cnt[c.tid * CNT_STRIDE], n) : 0; }
    __syncthreads();
    it = 0;
    for (int t = c.bid * NWAVES + c.wid; t < nrows; t += c.nblk * NWAVES, ++it) {
        if (lane < 8 && it < RMAX) {
            const int r = rec[(c.wid * RMAX + it) * 8 + lane];
            const int e = r >> 16, pos = lcnt[e] + (r & 0xffff);
            list[(size_t)e * TT + pos] = t;
            slotw[(size_t)t * 8 + lane] = recw[(c.wid * RMAX + it) * 8 + lane];
            einfo[(size_t)t * 8 + lane] = (e << 16) | pos;
        }
    }
}

DI void moe_setup(const Ctx& c, int l, int nrows) {
    const int* cnt = (const int*)(c.p->ws + WS_CNT) + l * CNT_LAYER;
    LAS int* tstart = (LAS int*)(c.smem + LDS_MAIN + 1024);
    LAS int* roff = (LAS int*)(c.smem + LDS_MAIN + 2064);
    LAS int* cntl = (LAS int*)(c.smem + LDS_MAIN + 3104);
    LAS int* wtot = (LAS int*)(c.smem + LDS_MAIN + 4160);
    const int n = (c.tid < 256) ? cnt[c.tid * CNT_STRIDE] : 0;
    const int nt = (n + 255) >> 8;
    int vt = nt, vr = n;
    vt += DPPI(vt, DPP_SHR(1)); vr += DPPI(vr, DPP_SHR(1)); vt += DPPI(vt, DPP_SHR(2)); vr += DPPI(vr, DPP_SHR(2));
    vt += DPPI(vt, DPP_SHR(4)); vr += DPPI(vr, DPP_SHR(4)); vt += DPPI(vt, DPP_SHR(8)); vr += DPPI(vr, DPP_SHR(8));
    { const int t0 = __builtin_amdgcn_readlane(vt, 15), t1 = __builtin_amdgcn_readlane(vt, 31), t2 = __builtin_amdgcn_readlane(vt, 47);
      const int r0 = __builtin_amdgcn_readlane(vr, 15), r1 = __builtin_amdgcn_readlane(vr, 31), r2 = __builtin_amdgcn_readlane(vr, 47);
      const int row = c.lane >> 4;
      vt += (row > 0 ? t0 : 0) + (row > 1 ? t1 : 0) + (row > 2 ? t2 : 0); vr += (row > 0 ? r0 : 0) + (row > 1 ? r1 : 0) + (row > 2 ? r2 : 0); }
    if (c.lane == 63 && c.wid < 4) { wtot[c.wid] = vt; wtot[4 + c.wid] = vr; }
    __syncthreads();
    if (c.tid < 256) {
        int pt = 0, pr = 0;
        for (int w = 0; w < c.wid; ++w) { pt += wtot[w]; pr += wtot[4 + w]; }
        tstart[c.tid] = pt + vt - nt; roff[c.tid] = pr + vr - n; cntl[c.tid] = n;
        if (c.tid == 255) { tstart[256] = pt + vt; roff[256] = pr + vr; tstart[257] = pt + vt + nrows / 256; roff[257] = pr + vr + nrows; cntl[256] = nrows; }
    }
    __syncthreads();
}

constexpr int MOE_MAXU = 32, MOE_MAXG = 12;
template <bool GATHER_>
struct MoeSched {
    static constexpr bool GATHER = GATHER_;
    const LAS int* utab; const LAS unsigned* toks; int nmy;
    const char* A; const char* W; size_t wstride; int RB;
    DI bool next(int i, g8::Unit& u) const {
        if (i >= nmy) return false;
        const LAS int* e = utab + i * 8;
        u.pn = __builtin_amdgcn_readfirstlane(e[0]); u.e = __builtin_amdgcn_readfirstlane(e[1]); u.ti = __builtin_amdgcn_readfirstlane(e[2]);
        u.ne = __builtin_amdgcn_readfirstlane(e[3]); u.rbase = __builtin_amdgcn_readfirstlane(e[4]); u.pm = __builtin_amdgcn_readfirstlane(e[5]); u.ix = i;
        return true;
    }
    DI const char* a_base() const { return A; }
    DI unsigned a_off(const g8::Unit& u, int row) const { return toks[u.ix * 256 + row]; }
    DI const char* a_ptr(const g8::Unit& u) const { return A + (size_t)u.rbase * RB; }
    DI const char* b_base(const g8::Unit& u) const { return W + (size_t)u.e * wstride + (size_t)u.pn * 256 * RB; }
};
DI int moe_units(const Ctx& c, int NB, bool gather, const int* list, int rowbytes) {
    const LAS int* tstart = (const LAS int*)(c.smem + LDS_MAIN + 1024);
    const LAS int* roff = (const LAS int*)(c.smem + LDS_MAIN + 2064);
    const LAS int* cntl = (const LAS int*)(c.smem + LDS_MAIN + 3104);
    LAS int* utab = (LAS int*)(c.smem + LDS_MAIN + 4224);
    LAS unsigned* toks = (LAS unsigned*)(c.smem + LDS_MAIN + 8192);
    const int nunits = tstart[257] * NB;
    int nmy = (nunits > c.bid) ? (nunits - c.bid + c.nblk - 1) / c.nblk : 0;
    { const int cap = gather ? MOE_MAXG : MOE_MAXU; nmy = nmy > cap ? cap : nmy; }
    if (c.tid < nmy) {
        const int L = c.tid * c.nblk + c.bid;
        int w = L; { const int q = nunits / 8, r = nunits % 8, xcd = w % 8, off = w / 8; w = (xcd < r ? xcd * (q + 1) : r * (q + 1) + (xcd - r) * q) + off; }
        const int tile = w / NB;
        int lo = 0, hi = 256;
        while (lo < hi) { const int mid = (lo + hi + 1) >> 1; if (tstart[mid] <= tile) lo = mid; else hi = mid - 1; }
        const int ti = tile - tstart[lo];
        LAS int* e = utab + c.tid * 8;
        e[0] = w - tile * NB; e[1] = lo; e[2] = ti; e[3] = cntl[lo]; e[4] = roff[lo] + ti * 256; e[5] = tile;
    }
    __syncthreads();
    if (gather) {
        for (int idx = c.tid; idx < nmy * 256; idx += NTHREADS) {
            const LAS int* e = utab + (idx >> 8) * 8;
            const int ex = e[1], ne = e[3];
            int ridx = e[2] * 256 + (idx & 255); ridx = ridx < ne ? ridx : ne - 1;
            const int tok = (ex < 256) ? list[(size_t)ex * TT + ridx] : ridx;
            toks[idx] = (unsigned)tok * (unsigned)rowbytes;
        }
        __syncthreads();
    }
    return nmy;
}

#ifdef E1_DIRECT
struct EpiE1 {
    static constexpr bool F8 = true;
    static constexpr bool PERM = true;
    unsigned char* act;
    LAS unsigned char* stg; int tid;
    DI void operator()(const f32x4 (&acc)[2][2][4][2], const g8::Unit& u, int wr, int wc, int fr, int fq) const {
        constexpr float IS = 1.0f / W_SCALE;
#pragma unroll
        for (int ai = 0; ai < 2; ++ai)
#pragma unroll
            for (int m = 0; m < 4; ++m) {
                const int row = ai * 128 + wr * 64 + m * 16 + fr;
                if (u.ti * 256 + row < u.ne) {
#pragma unroll
                    for (int bj = 0; bj < 2; ++bj) {
                        const int col0 = u.pn * 256 + bj * 128 + wc * 32 + 8 * fq;
                        const f32x4 v0 = acc[ai][bj][m][0] * IS, v1 = acc[ai][bj][m][1] * IS;
                        const float a0 = v0[0] * __builtin_amdgcn_rcpf(1.f + __expf(-v0[0])) * v0[1], a1 = v0[2] * __builtin_amdgcn_rcpf(1.f + __expf(-v0[2])) * v0[3];
                        const float a2 = v1[0] * __builtin_amdgcn_rcpf(1.f + __expf(-v1[0])) * v1[1], a3 = v1[2] * __builtin_amdgcn_rcpf(1.f + __expf(-v1[2])) * v1[3];
                        *(unsigned*)(act + (size_t)(u.rbase + row) * FF + (col0 >> 1)) = pk4_fp8(a0 * ACT_SCALE, a1 * ACT_SCALE, a2 * ACT_SCALE, a3 * ACT_SCALE);
                    }
                }
            }
    }
};
#else
struct EpiE1 {
    static constexpr bool F8 = true;
    static constexpr bool PERM = true;
    unsigned char* act;
    LAS unsigned char* stg; int tid;
    DI void operator()(const f32x4 (&acc)[2][2][4][2], const g8::Unit& u, int wr, int wc, int fr, int fq) const {
        constexpr float IS = 1.0f / W_SCALE;
        constexpr int RS = 144;
        if (wr == 0) __builtin_amdgcn_s_barrier();
#pragma unroll
        for (int ai = 0; ai < 2; ++ai)
#pragma unroll
            for (int mh = 0; mh < 2; ++mh) {
#pragma unroll
                for (int mm = 0; mm < 2; ++mm) {
                    const int m = mh * 2 + mm;
                    LAS unsigned char* d = stg + (wr * 32 + mm * 16 + fr) * RS + wc * 16 + 4 * fq;
#pragma unroll
                    for (int bj = 0; bj < 2; ++bj) {
                        const f32x4 v0 = acc[ai][bj][m][0] * IS, v1 = acc[ai][bj][m][1] * IS;
                        const float a0 = v0[0] * __builtin_amdgcn_rcpf(1.f + __expf(-v0[0])) * v0[1], a1 = v0[2] * __builtin_amdgcn_rcpf(1.f + __expf(-v0[2])) * v0[3];
                        const float a2 = v1[0] * __builtin_amdgcn_rcpf(1.f + __expf(-v1[0])) * v1[1], a3 = v1[2] * __builtin_amdgcn_rcpf(1.f + __expf(-v1[2])) * v1[3];
                        *(LAS unsigned*)(d + bj * 64) = pk4_fp8(a0 * ACT_SCALE, a1 * ACT_SCALE, a2 * ACT_SCALE, a3 * ACT_SCALE);
                    }
                }
                asm volatile("s_waitcnt lgkmcnt(0)" ::: "memory"); __builtin_amdgcn_s_barrier(); asm volatile("" ::: "memory");
                {
                    const int rl = tid >> 3, pc = tid & 7;
                    const u32x4 v = *(const LAS u32x4*)(stg + rl * RS + pc * 16);
                    const int row = ai * 128 + (rl >> 5) * 64 + mh * 32 + (rl & 31);
                    if (u.ti * 256 + row < u.ne) __builtin_nontemporal_store(v, (u32x4*)(act + (size_t)(u.rbase + row) * FF + u.pn * 128 + pc * 16));
                }
                asm volatile("s_waitcnt lgkmcnt(0)" ::: "memory"); __builtin_amdgcn_s_barrier(); asm volatile("" ::: "memory");
            }
        if (wr == 1) __builtin_amdgcn_s_barrier();
    }
};
#endif
DI void phase_e1(const Ctx& c, int l, int nrows) {
    const Params& p = *c.p;
    moe_setup(c, l, nrows);
    MoeSched<true> S;
    S.nmy = moe_units(c, 2, true, (const int*)(p.ws + WS_LIST), DM);
    S.utab = (const LAS int*)(c.smem + LDS_MAIN + 4224); S.toks = (const LAS unsigned*)(c.smem + LDS_MAIN + 8192);
    S.A = (const char*)(p.ws + WS_H8); S.W = (const char*)(p.ws + WS_WGU) + (size_t)l * 257 * 524288; S.wstride = 524288; S.RB = DM;
    EpiE1 E; E.act = (unsigned char*)(p.ws + WS_ACT); E.stg = (LAS unsigned char*)c.smem + LDS_MAIN + 8192 + MOE_MAXG * 1024; E.tid = c.tid;
    g8::gemm_phase((LAS unsigned char*)c.smem, c.tid, DM, S, E);
}

struct EpiE2 {
    static constexpr bool F8 = true;
    static constexpr bool PERM = true;
    unsigned char* ys;
    LAS unsigned char* stg; int tid;
    DI void operator()(const f32x4 (&acc)[2][2][4][2], const g8::Unit& u, int wr, int wc, int fr, int fq) const {
        constexpr float SC = 16.f / (ACT_SCALE * WD_SCALE);
        constexpr int RS = 272;
        if (wr == 0) __builtin_amdgcn_s_barrier();
#pragma unroll
        for (int ai = 0; ai < 2; ++ai)
#pragma unroll
            for (int mh = 0; mh < 2; ++mh) {
#pragma unroll
                for (int mm = 0; mm < 2; ++mm) {
                    const int m = mh * 2 + mm;
                    LAS unsigned char* d = stg + (wr * 32 + mm * 16 + fr) * RS + wc * 32 + 8 * fq;
#pragma unroll
                    for (int bj = 0; bj < 2; ++bj) {
                        const f32x4 v0 = acc[ai][bj][m][0] * SC, v1 = acc[ai][bj][m][1] * SC;
                        int w0 = 0, w1 = 0;
                        w0 = __builtin_amdgcn_cvt_pk_fp8_f32(v0[0], v0[1], w0, false); w0 = __builtin_amdgcn_cvt_pk_fp8_f32(v0[2], v0[3], w0, true);
                        w1 = __builtin_amdgcn_cvt_pk_fp8_f32(v1[0], v1[1], w1, false); w1 = __builtin_amdgcn_cvt_pk_fp8_f32(v1[2], v1[3], w1, true);
                        u32x2 o; o.x = (unsigned)w0; o.y = (unsigned)w1;
                        *(LAS u32x2*)(d + bj * 128) = o;
                    }
                }
                asm volatile("s_waitcnt lgkmcnt(0)" ::: "memory"); __builtin_amdgcn_s_barrier(); asm volatile("" ::: "memory");
#pragma unroll
                for (int k = 0; k < 2; ++k) {
                    const int idx = tid + k * 512, rl = idx >> 4, pc = idx & 15;
                    const u32x4 v = *(const LAS u32x4*)(stg + rl * RS + pc * 16);
                    const int row = ai * 128 + (rl >> 5) * 64 + mh * 32 + (rl & 31);
                    if (u.ti * 256 + row < u.ne) __builtin_nontemporal_store(v, (u32x4*)(ys + (size_t)(u.rbase + row) * DM + u.pn * 256 + pc * 16));
                }
                asm volatile("s_waitcnt lgkmcnt(0)" ::: "memory"); __builtin_amdgcn_s_barrier(); asm volatile("" ::: "memory");
            }
        if (wr == 1) __builtin_amdgcn_s_barrier();
    }
};
DI void phase_e2(const Ctx& c, int l, int nrows) {
    const Params& p = *c.p;
    moe_setup(c, l, nrows);
    MoeSched<false> S;
    S.nmy = moe_units(c, 4, false, nullptr, 0);
    S.utab = (const LAS int*)(c.smem + LDS_MAIN + 4224); S.toks = (const LAS unsigned*)(c.smem + LDS_MAIN + 8192);
    S.A = (const char*)(p.ws + WS_ACT); S.W = (const char*)(p.ws + WS_WD) + (size_t)l * 257 * 262144; S.wstride = 262144; S.RB = FF;
    EpiE2 E; E.ys = (unsigned char*)(p.ws + WS_YS); E.stg = (LAS unsigned char*)c.smem + LDS_STG; E.tid = c.tid;
    g8::gemm_phase((LAS unsigned char*)c.smem, c.tid, FF, S, E);
}

DI void phase_combine(const Ctx& c, int l, int nrows, bool last) {
    const Params& p = *c.p;
    moe_setup(c, l, nrows);
    const LAS int* roff = (const LAS int*)(c.smem + LDS_MAIN + 2064);
    const unsigned char* ys = (const unsigned char*)(p.ws + WS_YS);
    const int* einfo = (const int*)(p.ws + WS_EINFO);
    const float* slotw = (const float*)(p.ws + WS_SLOTW);
    float* xbuf = (float*)(p.ws + WS_XBUF);
    bf16_t* hbuf = (bf16_t*)(p.ws + WS_HBUF);
    const float* modv = (const float*)(p.ws + WS_MOD);
    const int lane = c.lane;
    const int shared0 = roff[256];
    for (int t = c.bid * NWAVES + c.wid; t < nrows; t += c.nblk * NWAVES) {
        const int b = t < TL ? (t >> 12) : 8;
        const float* gate = modv + (size_t)(l * 9 + b) * 6144 + 5120 + 16 * lane;
        int myrow = 0; float myw = 0.f;
        if (lane < 8) { const int ei = einfo[(size_t)t * 8 + lane]; myrow = roff[ei >> 16] + (ei & 0xffff); myw = slotw[(size_t)t * 8 + lane] * (1.f / 16.f); }
        if (lane == 8) { myrow = shared0 + t; myw = 1.f / 16.f; }
        f32x4 v[4], a[4];
        {
            const u32x4 x0 = *(const u32x4*)((const bf16_t*)xbuf + (size_t)t * DM + 16 * lane), x1 = *(const u32x4*)((const bf16_t*)xbuf + (size_t)t * DM + 16 * lane + 8);
            v[0] = bf4_f32(u32x2{x0.x, x0.y}); v[1] = bf4_f32(u32x2{x0.z, x0.w}); v[2] = bf4_f32(u32x2{x1.x, x1.y}); v[3] = bf4_f32(u32x2{x1.z, x1.w});
        }
#pragma unroll
        for (int j = 0; j < 4; ++j) a[j] = f32x4{0.f, 0.f, 0.f, 0.f};
#pragma unroll
        for (int k = 0; k < 9; ++k) {
            const int row = __builtin_amdgcn_readlane(myrow, k); const float w = rdlane_f(myw, k);
            const u32x4 y = *(const u32x4*)(ys + (size_t)row * DM + 16 * lane);
#pragma unroll
            for (int j = 0; j < 4; ++j) {
                const unsigned word = (j == 0) ? y.x : (j == 1) ? y.y : (j == 2) ? y.z : y.w;
                const auto lo = __builtin_amdgcn_cvt_pk_f32_fp8((int)word, false), hi = __builtin_amdgcn_cvt_pk_f32_fp8((int)word, true);
                a[j].x += w * lo[0]; a[j].y += w * lo[1]; a[j].z += w * hi[0]; a[j].w += w * hi[1];
            }
        }
        float s = 0.f;
#pragma unroll
        for (int j = 0; j < 4; ++j) {
            const f32x4 g = *(const f32x4*)(gate + 4 * j);
            v[j] += g * a[j];
            s += (v[j].x * v[j].x + v[j].y * v[j].y) + (v[j].z * v[j].z + v[j].w * v[j].w);
        }
        const float rstd = rsqrtf(wave_sum(s) * (1.f / DM) + EPSV);
        if (last) {
            const float* gf = p.in[I_GFINAL] + 16 * lane;
            LAS f32x4* orow = (LAS f32x4*)(c.smem + 32768) + c.wid * 256;
#pragma unroll
            for (int j = 0; j < 4; ++j) {
                const f32x4 g = *(const f32x4*)(gf + 4 * j);
                orow[4 * lane + j] = v[j] * rstd * g;
            }
#pragma unroll
            for (int j = 0; j < 4; ++j)
                __builtin_nontemporal_store(orow[lane + 64 * j], (f32x4*)(p.out + (size_t)t * DM + 4 * (lane + 64 * j)));
        } else {
            const float* g = p.in[I_GMIX] + (l + 1) * 1024 + 16 * lane;
            const float* mv = modv + (size_t)((l + 1) * 9 + b) * 6144 + 16 * lane;
            u32x4 o8;
#pragma unroll
            for (int j = 0; j < 4; ++j) {
                *(u32x2*)((bf16_t*)xbuf + (size_t)t * DM + 16 * lane + 4 * j) = f32_bf4(v[j]);
                const f32x4 gg = *(const f32x4*)(g + 4 * j), shh = *(const f32x4*)(mv + 4 * j), scc = *(const f32x4*)(mv + 1024 + 4 * j);
                const f32x4 y = v[j] * rstd * gg * (1.f + scc) + shh;
                const unsigned w8 = pk4_fp8(y.x, y.y, y.z, y.w);
                if (j == 0) o8.x = w8; else if (j == 1) o8.y = w8; else if (j == 2) o8.z = w8; else o8.w = w8;
            }
            *(u32x4*)((unsigned char*)(p.ws + WS_HIN8) + (size_t)t * DM + 16 * lane) = o8;
        }
    }
}
DI void glds16(const void* g, LAS char* l) { __builtin_amdgcn_global_load_lds((const unsigned*)g, (LAS unsigned*)l, 16, 0, 0); }
#define VM_DRAIN() asm volatile("s_waitcnt vmcnt(0)" ::: "memory")
constexpr float FLASH_THR = 8.0f;
struct ModNone { DI bool active(int) const { return true; } DI void apply(int, f32x16&, f32x16&) const {} };
struct ModSwa {
    int nloc, kpos0, qpos, qmin, hi_;
    DI bool active(int j) const { if (j >= nloc) return true; const int k0 = kpos0 + 64 * j; return (k0 + 63 >= qmin - 128) && (k0 <= qmin + 31 + 128); }
    DI void apply(int j, f32x16& s0, f32x16& s1) const {
        if (j >= nloc) return;
        const int hi = hi_;
        const int kb = kpos0 + 64 * j + 4 * hi - qpos;
        const float NINF = -__builtin_inff();
#pragma unroll
        for (int r = 0; r < 16; ++r) {
            const int d = kb + (r & 3) + 8 * (r >> 2);
            if (d < -128 || d > 128) s0[r] = NINF;
            if (d + 32 < -128 || d + 32 > 128) s1[r] = NINF;
        }
    }
};
struct ModNa {
    int nloc, kr0, qr, qc, rs, cs, hi_;
    const LAS float* rpb;
    DI bool active(int j) const { if (j >= nloc) return true; const int kr = kr0 + j; return kr >= rs && kr < rs + 8; }
    DI void apply(int j, f32x16& s0, f32x16& s1) const {
        if (j >= nloc) return;
        const int hi = hi_;
        const int kr = kr0 + j;
        const LAS float* row = rpb + (kr - qr + 7) * 31 + 15 - qc;
        const float NINF = -__builtin_inff();
        float b0[16], b1[16];
#pragma unroll
        for (int r = 0; r < 16; ++r) { const int kc = 4 * hi + (r & 3) + 8 * (r >> 2); b0[r] = row[kc]; b1[r] = row[kc + 32]; }
#pragma unroll
        for (int r = 0; r < 16; ++r) {
            const int kc = 4 * hi + (r & 3) + 8 * (r >> 2);
            const bool ok0 = (kc >= cs) && (kc < cs + 16), ok1 = (kc + 32 >= cs) && (kc + 32 < cs + 16);
            s0[r] = ok0 ? s0[r] + b0[r] : NINF;
            s1[r] = ok1 ? s1[r] + b1[r] : NINF;
        }
    }
};


typedef __attribute__((ext_vector_type(8))) int v8i_f;
typedef __attribute__((ext_vector_type(4))) int v4i_f;
DI void mfma8(f32x16& d, const v8i_f& a, const v8i_f& b, const f32x16& c, int sc) {
    asm volatile("v_mfma_scale_f32_32x32x64_f8f6f4 %0, %1, %2, %3, %4, %4 op_sel_hi:[0,0,0]" : "=&v"(d) : "v"(a), "v"(b), "v"(c), "v"(sc));
}
DI void mfma8_acc(f32x16& d, const v8i_f& a, const v8i_f& b, int sc) {
    asm volatile("v_mfma_scale_f32_32x32x64_f8f6f4 %0, %1, %2, %0, %3, %3 op_sel_hi:[0,0,0]" : "+v"(d) : "v"(a), "v"(b), "v"(sc));
}
template <int DV> struct F8State { float m, l; f32x16 o[DV / 32]; f32x16 cinit; };

template <int DV, class Tok0, class Tile0, class Mod>
DI void pass8(const Ctx& c, int ki, int vrow0, int ntiles, Tok0 tok0, Tile0 vtile, Mod& mod, const v8i_f& qf, F8State<DV>& st) {
    constexpr int ND = DV / 32, STAGE = 4096 + DV * 64;
    const unsigned char* k8 = (const unsigned char*)(c.p->ws + WS_K8);
    const unsigned char* vt8 = (const unsigned char*)(c.p->ws + WS_VT8);
    LAS char* lds = (LAS char*)c.smem;
    const int lane = c.lane, r32 = c.r32, hi = c.hi, w = c.wid;
    int usc = 0x7F7F7F7F; asm volatile("" : "+v"(usc));
    const int prow = 16 * (w & 3) + (lane >> 2), pslot = lane & 3;
    const unsigned koff = (unsigned)(prow * 1024 + ki * 64 + ((pslot ^ ((prow >> 2) & 3)) << 4));
    const int vpiece = (DV == 128) ? w : (w & 3);
    const int vrow = 16 * vpiece + (lane >> 2);
    const unsigned voff = (unsigned)((vrow0 + vrow) * 64 + ((pslot ^ ((vrow >> 2) & 3)) << 4));
    auto issue = [&](int j, LAS char* stage) {
        if (w < 4) glds16(k8 + tok0(j) * 1024 + koff, stage + w * 1024);
        if (DV == 128 || w >= 4) glds16(vt8 + vtile(j) * (size_t)VT_TILE + voff, stage + 4096 + vpiece * 1024);
    };
    st.m = 0.f; st.l = 0.f;
#pragma unroll
    for (int r = 0; r < 16; ++r) st.cinit[r] = 0.f;
#pragma unroll
    for (int d = 0; d < ND; ++d)
#pragma unroll
        for (int r = 0; r < 16; ++r) st.o[d][r] = 0.f;
    issue(0, lds);
    VM_DRAIN();
    __syncthreads();
    const int f = (r32 >> 2) & 3;
    const int o_lo = r32 * 64 + (((2 * hi) ^ f) << 4), o_hi = r32 * 64 + (((2 * hi + 1) ^ f) << 4);
    if (__builtin_amdgcn_readfirstlane(w) >= 4) __builtin_amdgcn_s_setprio(1);
    for (int j = 0; j < ntiles; ++j) {
        if (j + 1 < ntiles) issue(j + 1, lds + ((j + 1) & 1) * STAGE);
        const LAS char* stage = lds + (j & 1) * STAGE;
        if (mod.active(j)) {
            v8i_f ka, kb;
            ka.lo = *(const LAS v4i_f*)(stage + o_lo); ka.hi = *(const LAS v4i_f*)(stage + o_hi);
            kb.lo = *(const LAS v4i_f*)(stage + 2048 + o_lo); kb.hi = *(const LAS v4i_f*)(stage + 2048 + o_hi);
            f32x16 s0, s1;
            mfma8(s0, ka, qf, st.cinit, usc); mfma8(s1, kb, qf, st.cinit, usc);
            v8i_f va, vb;
            va.lo = *(const LAS v4i_f*)(stage + 4096 + o_lo); va.hi = *(const LAS v4i_f*)(stage + 4096 + o_hi);
            vb.lo = *(const LAS v4i_f*)(stage + 4096 + 2048 + o_lo); vb.hi = *(const LAS v4i_f*)(stage + 4096 + 2048 + o_hi);
            asm volatile("s_nop 15\n\ts_nop 15" : "+v"(s0), "+v"(s1));
            mod.apply(j, s0, s1);
            float mx = fmaxf(fmaxf(s0[0], s0[1]), s1[0]);
            mx = fmaxf(fmaxf(mx, s1[1]), fmaxf(s0[2], s1[2]));
#pragma unroll
            for (int r = 3; r < 15; r += 2) mx = fmaxf(fmaxf(mx, s0[r]), fmaxf(s0[r + 1], fmaxf(s1[r], s1[r + 1])));
            mx = fmaxf(mx, fmaxf(s0[15], s1[15]));
            { const auto rr = __builtin_amdgcn_permlane32_swap(__float_as_uint(mx), __float_as_uint(mx), false, false); mx = fmaxf(__uint_as_float(rr[0]), __uint_as_float(rr[1])); }
            const bool seen = mx > -1e29f;
            const bool started = half_swap_sum(st.l) > 0.f;
            const bool mv = (mx > FLASH_THR) || (!started && seen);
            if (__any(mv)) {
                const float d = mv ? mx : 0.f;
                const float fs = (mv && started) ? __builtin_amdgcn_exp2f(-d) : 1.f;
                st.m += d; st.l *= fs;
                const float nm2 = -st.m;
                asm volatile("s_nop 15\n\ts_nop 15");
#pragma unroll
                for (int dd = 0; dd < ND; ++dd) asm volatile("" : "+v"(st.o[dd]));
#pragma unroll
                for (int r = 0; r < 16; ++r) { s0[r] -= d; s1[r] -= d; st.cinit[r] = nm2; }
#pragma unroll
                for (int dd = 0; dd < ND; ++dd)
#pragma unroll
                    for (int r = 0; r < 16; ++r) st.o[dd][r] *= fs;
            }
            float rs0 = 0.f, rs1 = 0.f;
#pragma unroll
            for (int r = 0; r < 16; ++r) { s0[r] = __builtin_amdgcn_exp2f(s0[r]); s1[r] = __builtin_amdgcn_exp2f(s1[r]); rs0 += s0[r]; rs1 += s1[r]; }
            st.l += rs0 + rs1;
            v8i_f pf;
#pragma unroll
            for (int idx = 0; idx < 8; ++idx) { const int r0 = (idx >> 2) * 4 + (idx & 3); pf[idx] = (int)pk4_fp8(s0[r0], s0[r0 + 8], s1[r0], s1[r0 + 8]); }
            asm volatile("s_nop 3" : "+v"(pf));
            mfma8_acc(st.o[0], va, pf, usc); mfma8_acc(st.o[1], vb, pf, usc);
            if constexpr (DV == 128) {
                va.lo = *(const LAS v4i_f*)(stage + 4096 + 4096 + o_lo); va.hi = *(const LAS v4i_f*)(stage + 4096 + 4096 + o_hi);
                vb.lo = *(const LAS v4i_f*)(stage + 4096 + 6144 + o_lo); vb.hi = *(const LAS v4i_f*)(stage + 4096 + 6144 + o_hi);
                mfma8_acc(st.o[2], va, pf, usc); mfma8_acc(st.o[3], vb, pf, usc);
            }
        }
        VM_DRAIN();
        __syncthreads();
    }
    __builtin_amdgcn_s_setprio(0);
    asm volatile("s_nop 15\n\ts_nop 15");
#pragma unroll
    for (int dd = 0; dd < ND; ++dd) asm volatile("" : "+v"(st.o[dd]));
}

DI v8i_f load_q8(const Ctx& c, size_t qtok, int cb) {
    const unsigned char* q8 = (const unsigned char*)(c.p->ws + WS_Q8) + qtok * 1024 + cb * 64 + 32 * c.hi;
    v8i_f qf; qf.lo = *(const v4i_f*)q8; qf.hi = *(const v4i_f*)(q8 + 16);
    return qf;
}
template <int DV>
DI void store_o8(const F8State<DV>& st, float inv, unsigned char* __restrict__ orow, int hi) {
    const float s = inv * MIX_SCALE;
#pragma unroll
    for (int dt = 0; dt < DV / 32; ++dt)
#pragma unroll
        for (int g = 0; g < 4; ++g)
            *(unsigned*)(orow + 32 * dt + 8 * g + 4 * hi) = pk4_fp8(st.o[dt][4 * g] * s, st.o[dt][4 * g + 1] * s, st.o[dt][4 * g + 2] * s, st.o[dt][4 * g + 3] * s);
}

DI void attn_swa_item(const Ctx& c, int l, int b, int h, int qb, bool ctxq) {
    const Params& p = *c.p;
    unsigned char* mix = (unsigned char*)(p.ws + WS_MIX);
    const int kvh = h >> 1;
    const size_t qtok = ctxq ? (size_t)TL + b * CTXL + c.wid * 32 + c.r32 : (size_t)b * SEQ + qb * 256 + c.wid * 32 + c.r32;
    const v8i_f qf = load_q8(c, qtok, h);
    F8State<64> st;
    ModSwa mod; mod.hi_ = c.hi;
    int j0 = 0;
    if (ctxq) { mod.nloc = 0; mod.kpos0 = 0; }
    else { j0 = 4 * qb - 2; if (j0 < 0) j0 = 0; int j1 = 4 * qb + 5; if (j1 > 63) j1 = 63; mod.nloc = j1 - j0 + 1; mod.kpos0 = 64 * j0; }
    mod.qmin = qb * 256 + c.wid * 32; mod.qpos = mod.qmin + c.r32;
    const int nloc = mod.nloc;
    const size_t lbase = (size_t)b * SEQ + 64 * j0, cbase = (size_t)TL + b * CTXL;
    auto tok0 = [&](int j) { return j < nloc ? lbase + 64 * j : cbase + 64 * (j - nloc); };
    const size_t vt0 = (size_t)b * 68;
    auto vtile = [&](int j) { return vt0 + (j < nloc ? j0 + j : 64 + (j - nloc)); };
    pass8<64>(c, kvh, kvh * 64, nloc + 4, tok0, vtile, mod, qf, st);
    float lt = half_swap_sum(st.l);
    lt += __builtin_amdgcn_exp2f(p.in[I_SINK][l * 4 + h] * LOG2E - st.m);
    store_o8<64>(st, 1.f / lt, mix + qtok * DM + h * 64, c.hi);
}

DI void attn_na_item(const Ctx& c, int l, int b, int h, int qb, bool ctxq) {
    const Params& p = *c.p;
    unsigned char* mix = (unsigned char*)(p.ws + WS_MIX);
    LAS float* rpbl = (LAS float*)(c.smem + LDS_MAIN + 1024);
    __syncthreads();
    if (!ctxq) for (int i = c.tid; i < 465; i += NTHREADS) rpbl[i] = p.in[I_RPB][(size_t)(l * 4 + h) * 465 + i] * LOG2E;
    __syncthreads();
    const size_t qtok = ctxq ? (size_t)TL + b * CTXL + c.wid * 32 + c.r32 : (size_t)b * SEQ + qb * 256 + c.wid * 32 + c.r32;
    const v8i_f qf = load_q8(c, qtok, 4 + h);
    F8State<64> st;
    ModNa mod; mod.rpb = rpbl; mod.hi_ = c.hi;
    int kr0 = 0;
    if (ctxq) { mod.nloc = 0; mod.kr0 = 0; mod.qr = 0; mod.qc = 0; mod.rs = 0; mod.cs = 0; }
    else {
        const int r_lo = 4 * qb, r_hi = 4 * qb + 3;
        int a = r_lo - 4; a = a < 0 ? 0 : (a > 56 ? 56 : a);
        int bb = r_hi - 4; bb = bb < 0 ? 0 : (bb > 56 ? 56 : bb);
        kr0 = a; mod.kr0 = a; mod.nloc = bb + 7 - a + 1;
        mod.qr = 4 * qb + (c.wid >> 1); mod.qc = 32 * (c.wid & 1) + c.r32;
        int rs = mod.qr - 4; rs = rs < 0 ? 0 : (rs > 56 ? 56 : rs); mod.rs = rs;
        int cs = mod.qc - 8; cs = cs < 0 ? 0 : (cs > 48 ? 48 : cs); mod.cs = cs;
    }
    const int nloc = mod.nloc;
    const size_t lbase = (size_t)b * SEQ + 64 * kr0, cbase = (size_t)TL + b * CTXL;
    auto tok0 = [&](int j) { return j < nloc ? lbase + 64 * j : cbase + 64 * (j - nloc); };
    const size_t vt0 = (size_t)b * 68;
    auto vtile = [&](int j) { return vt0 + (j < nloc ? kr0 + j : 64 + (j - nloc)); };
    pass8<64>(c, 2 + h, 128 + h * 64, nloc + 4, tok0, vtile, mod, qf, st);
    const float lt = half_swap_sum(st.l);
    store_o8<64>(st, 1.f / lt, mix + qtok * DM + 256 + h * 64, c.hi);
}

DI void attn_diff_item(const Ctx& c, int l, int b, int h, int qb, bool ctxq) {
    const Params& p = *c.p;
    unsigned char* mix = (unsigned char*)(p.ws + WS_MIX);
    const size_t qtok = ctxq ? (size_t)TL + b * CTXL + c.wid * 32 + c.r32 : (size_t)b * SEQ + qb * 256 + c.wid * 32 + c.r32;
    const int nloc = ctxq ? 0 : 64;
    const size_t lbase = (size_t)b * SEQ, cbase = (size_t)TL + b * CTXL;
    auto tok0 = [&](int j) { return j < nloc ? lbase + 64 * j : cbase + 64 * (j - nloc); };
    const size_t vt0 = (size_t)b * 68;
    auto vtile = [&](int j) { return vt0 + (j < nloc ? j : 64 + (j - nloc)); };
    unsigned char* orow = mix + qtok * DM + 512 + h * 128;
    LAS u32x2* park = (LAS u32x2*)(c.smem + 65536) + c.tid;
    ModNone mod;
    F8State<128> st;
    {
        const v8i_f qf = load_q8(c, qtok, 8 + 2 * h);
        pass8<128>(c, 6 + 2 * h, 384 + h * 128, nloc + 4, tok0, vtile, mod, qf, st);
        const float inv = 1.f / half_swap_sum(st.l);
#pragma unroll
        for (int dt = 0; dt < 4; ++dt)
#pragma unroll
            for (int g = 0; g < 4; ++g) {
                u32x2 u; u.x = pk2(st.o[dt][4 * g] * inv, st.o[dt][4 * g + 1] * inv); u.y = pk2(st.o[dt][4 * g + 2] * inv, st.o[dt][4 * g + 3] * inv);
                park[(dt * 4 + g) * NTHREADS] = u;
            }
    }
    const v8i_f qf = load_q8(c, qtok, 8 + 2 * h + 1);
    pass8<128>(c, 6 + 2 * h + 1, 384 + h * 128, nloc + 4, tok0, vtile, mod, qf, st);
    const float lam_init = 0.8f - 0.6f * __expf(-0.3f * (float)l);
    const float d1 = wave_sum(p.in[I_LQ1][l * 64 + c.lane] * p.in[I_LK1][l * 64 + c.lane]);
    const float d2 = wave_sum(p.in[I_LQ2][l * 64 + c.lane] * p.in[I_LK2][l * 64 + c.lane]);
    const float lam = __expf(d1) - __expf(d2) + lam_init;
    const float inv2 = lam / half_swap_sum(st.l);
    float ss = 0.f;
#pragma unroll
    for (int dt = 0; dt < 4; ++dt)
#pragma unroll
        for (int g = 0; g < 4; ++g) {
            const u32x2 u = park[(dt * 4 + g) * NTHREADS];
            const float a0 = bflo(u.x) - st.o[dt][4 * g] * inv2, a1 = bfhi(u.x) - st.o[dt][4 * g + 1] * inv2;
            const float a2 = bflo(u.y) - st.o[dt][4 * g + 2] * inv2, a3 = bfhi(u.y) - st.o[dt][4 * g + 3] * inv2;
            st.o[dt][4 * g] = a0; st.o[dt][4 * g + 1] = a1; st.o[dt][4 * g + 2] = a2; st.o[dt][4 * g + 3] = a3;
            ss += (a0 * a0 + a1 * a1) + (a2 * a2 + a3 * a3);
        }
    ss = half_swap_sum(ss);
    const float rn = rsqrtf(ss * (1.f / 128.f) + EPSV) * (1.f - lam_init);
    const float* sg = p.in[I_SUBLN] + l * 128;
#pragma unroll
    for (int dt = 0; dt < 4; ++dt)
#pragma unroll
        for (int g = 0; g < 4; ++g) {
            const f32x4 gg = *(const f32x4*)(sg + 32 * dt + 8 * g + 4 * c.hi);
            const float rs = rn * MIX_SCALE;
            *(unsigned*)(orow + 32 * dt + 8 * g + 4 * c.hi) = pk4_fp8(st.o[dt][4 * g] * rs * gg.x, st.o[dt][4 * g + 1] * rs * gg.y, st.o[dt][4 * g + 2] * rs * gg.z, st.o[dt][4 * g + 3] * rs * gg.w);
        }
}

DI void attn_decode(int it, int& b, int& h, int& qb, bool& ctxq) {
    if (it < 512) {
        const int xcd = it & 7, j = it >> 3;
        const int bh = xcd * 4 + (j >> 4); qb = j & 15;
        b = bh >> 2; h = bh & 3; ctxq = false;
    } else {
        const int i = it - 512;
        qb = 0; h = i & 3; b = i >> 2; ctxq = true;
    }
}
DI Ctx reopaque(const Ctx& c) {
    Ctx d = c; int t = c.tid; asm volatile("" : "+v"(t));
    d.tid = t; d.lane = t & 63; d.wid = __builtin_amdgcn_readfirstlane(t >> 6); d.r32 = t & 31; d.hi = (t >> 5) & 1;
    return d;
}
DI void phase_attn0_convert(const Ctx& c) {
    const int xcd = c.bid & 7;
    int* actr = (int*)(c.p->ws + WS_ROWCTR) + 128 + 64 * xcd;
    int* cctr = (int*)(c.p->ws + WS_ROWCTR) + 1024;
    LAS int* slot = (LAS int*)(c.smem + LDS_MAIN + 64);
    constexpr int NIT = 544, NATT = 3 * NIT;
    const bool prefer_conv = ((c.bid >> 3) & 1) != 0;
    for (;;) {
        if (c.tid == 0) {
            int k = -1, v = 0;
            if (prefer_conv) {
                v = atomicAdd(cctr, 1); if (v < CONV_NCHUNK) k = 1;
                if (k < 0) { v = atomicAdd(actr, 1) * 8 + xcd; if (v < NATT) k = 0; }
            } else {
                v = atomicAdd(actr, 1) * 8 + xcd; if (v < NATT) k = 0;
                if (k < 0) { v = atomicAdd(cctr, 1); if (v < CONV_NCHUNK) k = 1; }
            }
            slot[0] = k; slot[1] = v;
        }
        __syncthreads();
        const int kind = slot[0], idx = slot[1];
        __syncthreads();
        if (kind < 0) break;
        if (kind == 1) {
            convert_pairs(reopaque(c), idx * CONV_CHUNK, 1, CONV_CHUNK, [](int q) { return rmap_expert(q); });
        } else {
            const int grp = idx / NIT, it = idx - grp * NIT;
            int b, h, qb; bool ctxq; attn_decode(it, b, h, qb, ctxq);
            if (grp == 0) attn_diff_item(reopaque(c), 0, b, h, qb, ctxq);
            else if (grp == 1) attn_swa_item(reopaque(c), 0, b, h, qb, ctxq);
            else attn_na_item(reopaque(c), 0, b, h, qb, ctxq);
        }
    }
}
DI void phase_attn(const Ctx& c, int l) {
    const int NIT = 512 + ((l == 0) ? 32 : 0);
    for (int it = c.bid; it < NIT; it += c.nblk) { int b, h, qb; bool ctxq; attn_decode(it, b, h, qb, ctxq); attn_diff_item(c, l, b, h, qb, ctxq); }
    for (int it = c.bid; it < NIT; it += c.nblk) { int b, h, qb; bool ctxq; attn_decode(it, b, h, qb, ctxq); attn_swa_item(c, l, b, h, qb, ctxq); }
    for (int it = c.bid; it < NIT; it += c.nblk) { int b, h, qb; bool ctxq; attn_decode(it, b, h, qb, ctxq); attn_na_item(c, l, b, h, qb, ctxq); }
}
#ifndef WAVES_PER_SIMD
#define WAVES_PER_SIMD 2
#endif
#ifndef PROBE_REP
#define PROBE_REP 0
#endif
#ifndef DBG_MODE
#define DBG_MODE 0
#endif
DI Ctx mkctx(const Params& p, char* smem, int wave_s) {
    Ctx c; c.p = &p; c.smem = smem;
    int t = wave_s * 64 + (int)__builtin_amdgcn_mbcnt_hi(~0u, __builtin_amdgcn_mbcnt_lo(~0u, 0u)); asm volatile("" : "+v"(t));
    c.tid = t; c.lane = t & 63; c.wid = __builtin_amdgcn_readfirstlane(t >> 6); c.r32 = t & 31; c.hi = (t >> 5) & 1;
    int b = blockIdx.x, n = gridDim.x; asm volatile("" : "+s"(b), "+s"(n));
    c.bid = b; c.nblk = n;
    return c;
}
__global__ void __launch_bounds__(NTHREADS, WAVES_PER_SIMD) mega(Params p) {
    extern __shared__ __attribute__((aligned(16))) char smem[];
    Ctx c; c.p = &p; c.smem = smem; c.tid = threadIdx.x; c.lane = c.tid & 63; c.wid = c.tid >> 6; c.r32 = c.lane & 31; c.hi = c.lane >> 5;
    c.bid = blockIdx.x; c.nblk = gridDim.x;
    const int wave_s = __builtin_amdgcn_readfirstlane((int)threadIdx.x >> 6);
#define FRESH() mkctx(p, smem, wave_s)
#define GRID_SYNC() do { XcdBarrier bb_ = bar; asm volatile("" : "+s"(bb_.bar), "+s"(bb_.x)); xcd_barrier(bb_); } while (0)
    volatile LAS unsigned* xbw = (volatile LAS unsigned*)(smem + LDS_MAIN);
    if (c.tid == 0) { xbw[0] = 0u; xbw[1] = 0u; xbw[2] = 0u; xbw[3] = 0u; }
    __syncthreads();
    XcdBarrier bar = xcd_barrier_post((unsigned*)(p.ws + WS_BAR), xbw);
    asm volatile("; PHASE_MARK prologue" ::: "memory");
    phase_prologue(FRESH());
    GRID_SYNC();
#if PROBE_REP == 1
    asm volatile("; PHASE_MARK prologue" ::: "memory");
    phase_prologue(FRESH());
    GRID_SYNC();
#endif
    asm volatile("; PHASE_MARK norm" ::: "memory");
    phase_norm(FRESH(), 0, TT, true, 0);
    wrp_items(FRESH());
    GRID_SYNC();
#if PROBE_REP == 9
    phase_norm(FRESH(), 0, TT, true, 0);
    GRID_SYNC();
#endif
#if PROBE_REP == 13
#pragma unroll 1
    for (int z = 0; z < 20; ++z) { GRID_SYNC(); }
#endif
#pragma unroll 1
    for (int l = 0; l < 2; ++l) {
        const bool last = (l == 1);
        const int nrows = last ? TL : TT;
        asm volatile("; PHASE_MARK inproj" ::: "memory");
        asm volatile("; PHASE_MARK inproj" ::: "memory");
    phase_inproj(FRESH(), l);
        GRID_SYNC();
#if PROBE_REP == 2
        asm volatile("; PHASE_MARK inproj" ::: "memory");
        asm volatile("; PHASE_MARK inproj" ::: "memory");
    phase_inproj(FRESH(), l);
        GRID_SYNC();
#endif
        asm volatile("; PHASE_MARK attn" ::: "memory");
        asm volatile("; PHASE_MARK attn" ::: "memory");
        if (l == 0) phase_attn0_convert(FRESH()); else phase_attn(FRESH(), l);
        GRID_SYNC();
#if PROBE_REP == 3
        asm volatile("; PHASE_MARK attn" ::: "memory");
        asm volatile("; PHASE_MARK attn" ::: "memory");
    phase_attn(FRESH(), l);
        GRID_SYNC();
#endif
        asm volatile("; PHASE_MARK outproj" ::: "memory");
        asm volatile("; PHASE_MARK outproj" ::: "memory");
    phase_outproj(FRESH(), l, nrows);
        GRID_SYNC();
#if PROBE_REP == 7
        if (l == 0) { phase_outproj(FRESH(), l, nrows); GRID_SYNC(); }
#endif
#if DBG_MODE != 1
        asm volatile("; PHASE_MARK router" ::: "memory");
    phase_norm_router(FRESH(), l, nrows);
        GRID_SYNC();
        asm volatile("; PHASE_MARK route" ::: "memory");
        asm volatile("; PHASE_MARK route" ::: "memory");
    phase_route(FRESH(), l, nrows);
        GRID_SYNC();
        asm volatile("; PHASE_MARK e1" ::: "memory");
        asm volatile("; PHASE_MARK e1" ::: "memory");
    phase_e1(FRESH(), l, nrows);
        GRID_SYNC();
#if PROBE_REP == 4
        asm volatile("; PHASE_MARK e1" ::: "memory");
        asm volatile("; PHASE_MARK e1" ::: "memory");
    phase_e1(FRESH(), l, nrows);
        GRID_SYNC();
#endif
        asm volatile("; PHASE_MARK e2" ::: "memory");
        asm volatile("; PHASE_MARK e2" ::: "memory");
    phase_e2(FRESH(), l, nrows);
        GRID_SYNC();
#if PROBE_REP == 5
        asm volatile("; PHASE_MARK e2" ::: "memory");
        asm volatile("; PHASE_MARK e2" ::: "memory");
    phase_e2(FRESH(), l, nrows);
        GRID_SYNC();
#endif
#endif
        asm volatile("; PHASE_MARK combine" ::: "memory");
        asm volatile("; PHASE_MARK combine" ::: "memory");
    phase_combine(FRESH(), l, nrows, last);
#if PROBE_REP == 8
        if (last) { GRID_SYNC(); phase_combine(FRESH(), l, nrows, last); }
#endif
        if (!last) { GRID_SYNC(); }
    }
}

extern "C" void kernel_launch(void* const* d_in, const int* in_sizes, int n_in, void* d_out, int out_size, void* d_ws, size_t ws_size, hipStream_t stream) {
    static int grid = 0;
    if (grid == 0) {
        int dev = 0, cus = 0, per_cu = 0;
        if (n_in != 26 || ws_size < WS_END) { fprintf(stderr, "kernel_launch: unexpected n_in %d / ws %zu (need %zu)\n", n_in, ws_size, (size_t)WS_END); grid = -1; return; }
        if (hipGetDevice(&dev) != hipSuccess || hipDeviceGetAttribute(&cus, hipDeviceAttributeMultiprocessorCount, dev) != hipSuccess) { grid = -1; return; }
        if (hipFuncSetAttribute((const void*)mega, hipFuncAttributeMaxDynamicSharedMemorySize, LDS_BYTES) != hipSuccess) { grid = -1; return; }
        if (hipOccupancyMaxActiveBlocksPerMultiprocessor(&per_cu, (const void*)mega, NTHREADS, LDS_BYTES) != hipSuccess || per_cu < 1) per_cu = 1;
        (void)hipGetLastError();
        grid = cus;
    }
    if (grid < 0) return;
    (void)hipMemsetAsync((char*)d_ws + WS_BAR, 0, WS_ZERO_BYTES, stream);
    Params p{};
    for (int i = 0; i < 26; ++i) p.in[i] = (const float*)d_in[i];
    p.out = (float*)d_out; p.ws = (unsigned char*)d_ws;
    hipLaunchKernelGGL(mega, dim3(grid), dim3(NTHREADS), LDS_BYTES, stream, p);
}
```
